# Optimizing an MI355X kernel written in HIP

```python
import jax, jax.numpy as jnp
from jax import lax
import numpy as np

D_MODEL = 1024
BATCH = 4
SEQ = 4096
DEPTH = 1
DEC_BATCH = 32
DEC_SEQ = 32
PAST_LEN = 2048

CHUNK = 64
GDN_HEADS = 4
GDN_DK = 128
GDN_DV = 128
GDN_CONV = 4
ATT_HEADS = 8
ATT_DH = 64
BAND_CHUNKS = 8
WINDOW = BAND_CHUNKS * CHUNK
MAX_REL = 128
D_FF = 2816
FFN_CONV = 3
EPS = 1e-6

GDN_QKV = GDN_HEADS * (2 * GDN_DK + GDN_DV)
GDN_Z = GDN_HEADS * GDN_DV
ATT_W = ATT_HEADS * ATT_DH
MIX_WIDTH = GDN_HEADS * GDN_DV + ATT_W
IN_COLS = GDN_QKV + GDN_Z + 2 * GDN_HEADS + 3 * ATT_W

kernel_name = 'hybrid_gdn_bandattn_convffn_step'


def rmsnorm(x, w):
    xf = x.astype(jnp.float32)
    y = xf * lax.rsqrt(jnp.mean(xf * xf, axis=-1, keepdims=True) + EPS)
    return (y * w.astype(jnp.float32)).astype(x.dtype)


def l2norm(x):
    xf = x.astype(jnp.float32)
    return xf * lax.rsqrt(jnp.sum(xf * xf, axis=-1, keepdims=True) + EPS)


def causal_dwconv(x, prev, w):
    width = w.shape[0]
    t = x.shape[1]
    xp = jnp.concatenate([prev.astype(x.dtype), x], axis=1)
    out = sum(xp[:, i:i + t] * w[i].astype(x.dtype) for i in range(width))
    return out, xp[:, xp.shape[1] - (width - 1):]


def gated_delta_chunked(q, k, v, g, beta, s0, chunk):
    B, T, H, DK = q.shape
    DV = v.shape[-1]
    N = T // chunk
    f32 = jnp.float32

    def blocks(a):
        a = a.astype(f32).reshape((B, N, chunk) + a.shape[2:])
        return jnp.moveaxis(a, (1, 3), (0, 2))

    q = blocks(q) * (DK ** -0.5)
    k = blocks(k)
    v = blocks(v)
    g = blocks(g)
    beta = blocks(beta)
    G = jnp.cumsum(g, axis=-1)
    incl = jnp.tril(jnp.ones((chunk, chunk), bool))
    strict = jnp.tril(jnp.ones((chunk, chunk), bool), k=-1)
    diff = G[..., :, None] - G[..., None, :]
    gam = jnp.where(incl, jnp.exp(jnp.where(incl, diff, 0.0)), 0.0)
    kb = k * beta[..., None]
    a_mat = jnp.where(strict, jnp.einsum('nbhid,nbhjd->nbhij', kb, k) * gam, 0.0)
    eye = jnp.eye(chunk, dtype=f32)
    rhs = jnp.concatenate([v * beta[..., None], kb * jnp.exp(G)[..., None]], axis=-1)
    sol = lax.linalg.triangular_solve(eye + a_mat, rhs, left_side=True, lower=True, unit_diagonal=True)
    u_blk, w_blk = sol[..., :DV], sol[..., DV:]
    qk = jnp.where(incl, jnp.einsum('nbhid,nbhjd->nbhij', q, k) * gam, 0.0)
    qg = q * jnp.exp(G)[..., None]
    kg = k * jnp.exp(G[..., -1:] - G)[..., None]
    decay_last = jnp.exp(G[..., -1])

    def step(S, xs):
        qg_c, kg_c, u_c, w_c, qk_c, dl = xs
        v_new = u_c - jnp.einsum('bhck,bhkv->bhcv', w_c, S)
        o = jnp.einsum('bhck,bhkv->bhcv', qg_c, S) + jnp.einsum('bhij,bhjv->bhiv', qk_c, v_new)
        S = S * dl[..., None, None] + jnp.einsum('bhck,bhcv->bhkv', kg_c, v_new)
        return S, o

    S, o = lax.scan(step, s0.astype(f32), (qg, kg, u_blk, w_blk, qk, decay_last))
    o = jnp.moveaxis(o, (0, 2), (1, 3)).reshape(B, T, H, DV)
    return o, S


def gated_deltanet(qkv, z, b_raw, a_raw, conv_prev, s0, conv_w, a_log, dt_bias, norm_w, chunk):
    B, T, _ = qkv.shape
    qkv, conv_state = causal_dwconv(qkv, conv_prev, conv_w)
    qkv = jax.nn.silu(qkv)
    q, k, v = jnp.split(qkv, [GDN_HEADS * GDN_DK, 2 * GDN_HEADS * GDN_DK], axis=-1)
    q = l2norm(q.reshape(B, T, GDN_HEADS, GDN_DK))
    k = l2norm(k.reshape(B, T, GDN_HEADS, GDN_DK))
    v = v.reshape(B, T, GDN_HEADS, GDN_DV)
    beta = jax.nn.sigmoid(b_raw.astype(jnp.float32))
    g = -jnp.exp(a_log.astype(jnp.float32)) * jax.nn.softplus(a_raw.astype(jnp.float32) + dt_bias.astype(jnp.float32))
    o, S = gated_delta_chunked(q, k, v, g, beta, s0, chunk)
    o = rmsnorm(o.astype(qkv.dtype), norm_w) * jax.nn.silu(z.reshape(B, T, GDN_HEADS, GDN_DV))
    return o.reshape(B, T, GDN_Z), S.astype(s0.dtype), conv_state


def rel_bias_lookup(table, rel):
    idx = jnp.clip(rel, -MAX_REL, MAX_REL) + MAX_REL
    return table[:, idx].astype(jnp.float32)


def band_attention_prompt(q, k, v, table):
    B, T, H, DH = q.shape
    N = T // CHUNK
    nb = BAND_CHUNKS + 1
    qc = q.reshape(B, N, CHUNK, H, DH)
    pad = jnp.zeros((B, WINDOW, H, DH), k.dtype)
    kc = jnp.concatenate([pad, k], axis=1).reshape(B, N + BAND_CHUNKS, CHUNK, H, DH)
    vc = jnp.concatenate([pad, v], axis=1).reshape(B, N + BAND_CHUNKS, CHUNK, H, DH)
    kband = jnp.concatenate([kc[:, m:m + N] for m in range(nb)], axis=2)
    vband = jnp.concatenate([vc[:, m:m + N] for m in range(nb)], axis=2)
    s = jnp.einsum('bnqhd,bnkhd->bnhqk', qc, kband).astype(jnp.float32) * (DH ** -0.5)
    rel = WINDOW + jnp.arange(CHUNK)[:, None] - jnp.arange(nb * CHUNK)[None, :]
    s = s + rel_bias_lookup(table, rel)[None, None]
    key_pos = (jnp.arange(N)[:, None] - BAND_CHUNKS) * CHUNK + jnp.arange(nb * CHUNK)[None, :]
    s = jnp.where((key_pos >= 0)[None, :, None, None, :], s, -jnp.inf)
    p = jax.nn.softmax(s, axis=-1).astype(v.dtype)
    o = jnp.einsum('bnhqk,bnkhd->bnqhd', p, vband)
    return o.reshape(B, T, H, DH)


def band_attention_sample(q, k_new, v_new, k_cache, v_cache, table):
    T = q.shape[1]
    lc = k_cache.shape[1]
    kk = jnp.concatenate([k_cache.astype(k_new.dtype), k_new], axis=1)
    vv = jnp.concatenate([v_cache.astype(v_new.dtype), v_new], axis=1)
    s = jnp.einsum('bqhd,bkhd->bhqk', q, kk).astype(jnp.float32) * (ATT_DH ** -0.5)
    rel = lc + jnp.arange(T)[:, None] - jnp.arange(lc + T)[None, :]
    s = s + rel_bias_lookup(table, rel)[None]
    p = jax.nn.softmax(s, axis=-1).astype(vv.dtype)
    return jnp.einsum('bhqk,bkhd->bqhd', p, vv)


def hybrid_layer(x, band_cache, s0, qkv_prev, ffn_prev, gdn_chunk, lw):
    (norm_mix_pre, w_in, qkv_conv_w, a_log, dt_bias, gdn_norm_w, rel_bias,
     attn_norm_w, w_out, norm_mix_post, norm_ffn_pre, w_gate_up, ffn_conv_w,
     ffn_conv_b, w_down, norm_ffn_post) = lw
    B, T, _ = x.shape
    u = rmsnorm(x, norm_mix_pre)
    p = u @ w_in
    c0 = GDN_QKV
    c1 = c0 + GDN_Z
    c2 = c1 + GDN_HEADS
    c3 = c2 + GDN_HEADS
    c4 = c3 + ATT_W
    c5 = c4 + ATT_W
    qkv_a, z_a, b_a, a_a, q_b, k_b, v_b = jnp.split(p, [c0, c1, c2, c3, c4, c5], axis=-1)
    o_a, s_new, qkv_state = gated_deltanet(qkv_a, z_a, b_a, a_a, qkv_prev, s0, qkv_conv_w,
                                           a_log, dt_bias, gdn_norm_w, gdn_chunk)
    q_b = q_b.reshape(B, T, ATT_HEADS, ATT_DH)
    k_b = k_b.reshape(B, T, ATT_HEADS, ATT_DH)
    v_b = v_b.reshape(B, T, ATT_HEADS, ATT_DH)
    if band_cache is None:
        o_b = band_attention_prompt(q_b, k_b, v_b, rel_bias)
        keep = min(WINDOW, T)
        k_rows, v_rows = k_b[:, T - keep:], v_b[:, T - keep:]
    else:
        o_b = band_attention_sample(q_b, k_b, v_b, band_cache[0], band_cache[1], rel_bias)
        k_rows, v_rows = k_b, v_b
    o_b = rmsnorm(o_b, attn_norm_w).reshape(B, T, ATT_W)
    mix = jnp.concatenate([o_a, o_b], axis=-1) @ w_out
    x = x + rmsnorm(mix, norm_mix_post)
    u = rmsnorm(x, norm_ffn_pre)
    gate, up = jnp.split(u @ w_gate_up, 2, axis=-1)
    gate, ffn_state = causal_dwconv(gate, ffn_prev, ffn_conv_w)
    h = jax.nn.gelu(gate + ffn_conv_b.astype(gate.dtype), approximate=True) * up
    x = x + rmsnorm(h @ w_down, norm_ffn_post)
    return x, k_rows, v_rows, s_new, qkv_state, ffn_state


def setup_inputs(seed: int = 0) -> dict:
    key = jax.random.key(seed)
    ks = jax.random.split(key, 32)
    f32 = jnp.float32
    lc = min(WINDOW, PAST_LEN)

    def nrm(k, shape, scale):
        return jax.random.normal(k, shape, f32) * scale

    def gain(k, n):
        return 1.0 + 0.01 * jax.random.normal(k, (DEPTH, n), f32)

    dt = jnp.exp(jax.random.uniform(ks[9], (DEPTH, GDN_HEADS), f32, np.log(0.001), np.log(0.1)))
    return {
        'x_prompt': nrm(ks[0], (BATCH, SEQ, D_MODEL), 1.0),
        'x_sample': nrm(ks[1], (DEC_BATCH, DEC_SEQ, D_MODEL), 1.0),
        'cache_band_k': nrm(ks[2], (DEPTH, DEC_BATCH, lc, ATT_HEADS, ATT_DH), 1.0),
        'cache_band_v': nrm(ks[3], (DEPTH, DEC_BATCH, lc, ATT_HEADS, ATT_DH), 1.0),
        'state_delta': nrm(ks[4], (DEPTH, DEC_BATCH, GDN_HEADS, GDN_DK, GDN_DV), 0.1),
        'state_qkv_conv': nrm(ks[5], (DEPTH, DEC_BATCH, GDN_CONV - 1, GDN_QKV), 1.0),
        'state_ffn_conv': nrm(ks[6], (DEPTH, DEC_BATCH, FFN_CONV - 1, D_FF), 1.0),
        'norm_mix_pre': gain(ks[7], D_MODEL),
        'w_in': nrm(ks[8], (DEPTH, D_MODEL, IN_COLS), D_MODEL ** -0.5),
        'qkv_conv_w': nrm(ks[10], (DEPTH, GDN_CONV, GDN_QKV), GDN_CONV ** -0.5),
        'a_log': jnp.log(jax.random.uniform(ks[11], (DEPTH, GDN_HEADS), f32, 1.0, 16.0)),
        'dt_bias': dt + jnp.log(-jnp.expm1(-dt)),
        'gdn_norm_w': gain(ks[12], GDN_DV),
        'rel_bias': nrm(ks[13], (DEPTH, ATT_HEADS, 2 * MAX_REL + 1), 0.1),
        'attn_norm_w': gain(ks[14], ATT_DH),
        'w_out': nrm(ks[15], (DEPTH, MIX_WIDTH, D_MODEL), MIX_WIDTH ** -0.5),
        'norm_mix_post': gain(ks[16], D_MODEL),
        'norm_ffn_pre': gain(ks[17], D_MODEL),
        'w_gate_up': nrm(ks[18], (DEPTH, D_MODEL, 2 * D_FF), D_MODEL ** -0.5),
        'ffn_conv_w': nrm(ks[19], (DEPTH, FFN_CONV, D_FF), FFN_CONV ** -0.5),
        'ffn_conv_b': nrm(ks[20], (DEPTH, D_FF), 0.01),
        'w_down': nrm(ks[21], (DEPTH, D_FF, D_MODEL), D_FF ** -0.5),
        'norm_ffn_post': gain(ks[22], D_MODEL),
    }


def _stack(outs, i):
    return jnp.stack([o[i] for o in outs], axis=0)


def reference(x_prompt, x_sample, cache_band_k, cache_band_v, state_delta, state_qkv_conv,
              state_ffn_conv, norm_mix_pre, w_in, qkv_conv_w, a_log, dt_bias, gdn_norm_w,
              rel_bias, attn_norm_w, w_out, norm_mix_post, norm_ffn_pre, w_gate_up,
              ffn_conv_w, ffn_conv_b, w_down, norm_ffn_post):
    weights = (norm_mix_pre, w_in, qkv_conv_w, a_log, dt_bias, gdn_norm_w, rel_bias,
               attn_norm_w, w_out, norm_mix_post, norm_ffn_pre, w_gate_up, ffn_conv_w,
               ffn_conv_b, w_down, norm_ffn_post)
    xp, xs = x_prompt, x_sample
    bp = xp.shape[0]
    outs_p, outs_s = [], []
    for l in range(DEPTH):
        lw = tuple(w[l] for w in weights)
        s0_p = jnp.zeros((bp, GDN_HEADS, GDN_DK, GDN_DV), xp.dtype)
        qkv0_p = jnp.zeros((bp, GDN_CONV - 1, GDN_QKV), xp.dtype)
        ffn0_p = jnp.zeros((bp, FFN_CONV - 1, D_FF), xp.dtype)
        xp, kp, vp, sp, cqp, cfp = hybrid_layer(xp, None, s0_p, qkv0_p, ffn0_p, CHUNK, lw)
        xs, ksm, vsm, ssm, cqs, cfs = hybrid_layer(
            xs, (cache_band_k[l], cache_band_v[l]), state_delta[l], state_qkv_conv[l],
            state_ffn_conv[l], xs.shape[1], lw)
        outs_p.append((kp, vp, sp, cqp, cfp))
        outs_s.append((ksm, vsm, ssm, cqs, cfs))
    return (xp, xs,
            _stack(outs_p, 0), _stack(outs_p, 1), _stack(outs_p, 2), _stack(outs_p, 3), _stack(outs_p, 4),
            _stack(outs_s, 0), _stack(outs_s, 1), _stack(outs_s, 2), _stack(outs_s, 3), _stack(outs_s, 4))
```

```cpp
#include <hip/hip_runtime.h>
#include <cstdio>
#include <cstdint>
namespace pg8 {
#define PG8_LAS __attribute__((address_space(3)))
typedef unsigned short bf16_t;
typedef short bf16x8 __attribute__((ext_vector_type(8)));
typedef float f32x4 __attribute__((ext_vector_type(4)));
typedef unsigned u32x4 __attribute__((ext_vector_type(4)));
constexpr int BM = 256, BK = 64, HALF = 128, HTB = HALF * BK * 2  , STAGE_BYTES = 8 * HTB, NXCD = 8, WGM = 8;

__host__ __device__ __forceinline__ int lds_byte(int r, int c) { const int st = (r >> 4) * 2 + (c >> 5), rr = r & 15, cc = c & 31, ob = rr * 64 + cc * 2; return st * 1024 + (ob ^ (((ob >> 9) & 1) << 5)); }
__host__ __device__ __forceinline__ void stage_rc(int b, int& R, int& C) { const int st = b / 1024, sb = b % 1024, swz = sb ^ (((sb >> 9) & 1) << 5); R = (st >> 1) * 16 + swz / 64; C = (st & 1) * 32 + (swz % 64) / 2; }
__host__ __device__ __forceinline__ int perm32(int rho) { const int n = rho >> 4, i = rho & 15; return 8 * (i >> 2) + 4 * n + (i & 3); }

struct Unit { int pm, pn; };
struct Gemm { const bf16_t* A; const bf16_t* Bt; int M, N, K; };

struct StaticOrder {
    int nM, nN, nwg, G, c;
    __host__ __device__ void init(int M, int N, int G_, int c_) { nM = M / BM; nN = N / BM; nwg = nM * nN; G = G_; c = c_; }
    __host__ __device__ bool next(int i, Unit& u) const {
        const long L = (long)i * G + c; if (L >= nwg) return false;
        int wgid = (int)L; { const int q = nwg / NXCD, r = nwg % NXCD, xcd = wgid % NXCD, off = wgid / NXCD; wgid = (xcd < r ? xcd * (q + 1) : r * (q + 1) + (xcd - r) * q) + off; }
        const int nig = WGM * nN, gid = wgid / nig, fm = gid * WGM, gsz = (nM - fm) < WGM ? (nM - fm) : WGM;
        u.pm = fm + ((wgid % nig) % gsz); u.pn = (wgid % nig) / gsz; return true;
    }
    __device__ __forceinline__ void a_ready(const Unit&) const {}
    __device__ __forceinline__ void done(const Unit&) const {}
};

__device__ __forceinline__ unsigned cvt_pk_bf16(float lo, float hi) { unsigned r; asm volatile("v_cvt_pk_bf16_f32 %0, %1, %2" : "=v"(r) : "v"(lo), "v"(hi)); return r; }
typedef float f32x2 __attribute__((ext_vector_type(2)));
__device__ __forceinline__ f32x2 gelu_pk(f32x2 v) {
    const f32x2 av = __builtin_elementwise_abs(v), d = av * 0.2316418882f + 1.0f;
    f32x2 t; t.x = __builtin_amdgcn_rcpf(d.x); t.y = __builtin_amdgcn_rcpf(d.y);
    f32x2 q = t * 0.5307027145f + (-0.7265760135f); q = q * t + 0.7107068705f; q = q * t + (-0.142248368f); q = q * t + 0.127414796f; q = q * t;
    const f32x2 s = (v * v) * (-0.72134752044f);
    f32x2 e; e.x = __builtin_amdgcn_exp2f(s.x); e.y = __builtin_amdgcn_exp2f(s.y);
    const f32x2 m = v * (q * e), r = v - m;
    f32x2 o; o.x = v.x < 0.f ? m.x : r.x; o.y = v.y < 0.f ? m.y : r.y; return o;
}

template <int ACT  > struct EpiBf16 {
    static constexpr bool PERM = true, AFTER_DRAIN = false; static_assert(ACT == 0 || ACT == 1, "EpiBf16: ACT is 0 (none) or 1 (gelu_pk)");
    bf16_t* O; int ldc; const float* bias; int split_cols; size_t split_stride; float scale0;
    __device__ __forceinline__ void operator()(const f32x4 (&acc)[2][2][4][2], const Unit& u, int wr, int wc, int fr, int fq) const {
        const int row0 = u.pm * BM + wr * 64 + fr; int colt = u.pn * BM; bf16_t* base = O;
        float sc = 1.f; if (split_cols) { const int t = colt / split_cols; base += (size_t)t * split_stride; colt -= t * split_cols; if (t == 0) sc = scale0; }
        const int col0 = colt + wc * 32 + 8 * fq, bcol0 = u.pn * BM + wc * 32 + 8 * fq;
        f32x4 bv[2][2];
#pragma unroll
        for (int bj = 0; bj < 2; ++bj)
#pragma unroll
            for (int n = 0; n < 2; ++n) bv[bj][n] = bias ? *(const f32x4*)(bias + bcol0 + bj * HALF + 4 * n) : (f32x4){0.f, 0.f, 0.f, 0.f};
#pragma unroll
        for (int ai = 0; ai < 2; ++ai)
#pragma unroll
            for (int m = 0; m < 4; ++m) { bf16_t* rowp = base + (size_t)(row0 + ai * HALF + m * 16) * ldc + col0;
#pragma unroll
                for (int bj = 0; bj < 2; ++bj) { f32x4 v0 = acc[ai][bj][m][0] + bv[bj][0], v1 = acc[ai][bj][m][1] + bv[bj][1];
                    if (ACT == 1) { f32x2 a = gelu_pk((f32x2){v0[0], v0[1]}), b = gelu_pk((f32x2){v0[2], v0[3]}), c = gelu_pk((f32x2){v1[0], v1[1]}), d = gelu_pk((f32x2){v1[2], v1[3]});
                        v0 = (f32x4){a.x, a.y, b.x, b.y}; v1 = (f32x4){c.x, c.y, d.x, d.y}; }
                    v0 = v0 * sc; v1 = v1 * sc; u32x4 w; w.x = cvt_pk_bf16(v0[0], v0[1]); w.y = cvt_pk_bf16(v0[2], v0[3]); w.z = cvt_pk_bf16(v1[0], v1[1]); w.w = cvt_pk_bf16(v1[2], v1[3]);
                    *(u32x4*)(rowp + bj * HALF) = w; } }
    }
};

struct EpiF32 {
    static constexpr bool PERM = false, AFTER_DRAIN = false;
    float* O; int ldc;
    __device__ __forceinline__ void operator()(const f32x4 (&acc)[2][2][4][2], const Unit& u, int wr, int wc, int fr, int fq) const {
        const int row0 = u.pm * BM + wr * 64 + fr, col0 = u.pn * BM + wc * 32 + 4 * fq;
#pragma unroll
        for (int ai = 0; ai < 2; ++ai)
#pragma unroll
            for (int m = 0; m < 4; ++m) { float* rowp = O + (size_t)(row0 + ai * HALF + m * 16) * ldc + col0;
#pragma unroll
                for (int bj = 0; bj < 2; ++bj)
#pragma unroll
                    for (int n = 0; n < 2; ++n) *(f32x4*)(rowp + bj * HALF + n * 16) = acc[ai][bj][m][n]; }
    }
};

template <class Epi, class Sched, bool ALIGN_EPI = false, bool SP2 = false>
__device__ __forceinline__ void gemm_phase(PG8_LAS unsigned char* lds, const Gemm g, const Sched& S, const Epi& E) {
    const int tid = threadIdx.x, wid = __builtin_amdgcn_readfirstlane(tid >> 6), lane = tid & 63, wr = wid >> 2, wc = wid & 3, fr = lane & 15, fq = lane >> 4;
    const int K = g.K, nt = K / BK;
    unsigned voffA[2], voffB[2];
#pragma unroll
    for (int i = 0; i < 2; ++i) { int R, C; stage_rc(tid * 16 + i * 8192, R, C); const int Rb = Epi::PERM ? ((R & ~31) + perm32(R & 31)) : R;
        voffA[i] = (unsigned)(R * K + C) * 2u; voffB[i] = (unsigned)(Rb * K + C) * 2u; }
    const size_t kstep = (size_t)(BK * 2);
    const size_t hstep = (size_t)HALF * K * 2;
    const size_t tstep = 2 * hstep;
    const unsigned ldsw = (unsigned)wid * 1024u;
    const int aoff = lds_byte(wr * 64 + fr, fq * 8), boff = lds_byte(wc * 32 + fr, fq * 8);
#define PG8_SA(b, h) (((b) * 2 + (h)) * HTB)
#define PG8_SB(b, h) ((4 + (b) * 2 + (h)) * HTB)
#define PG8_STAGE(bufoff, gbase, voff) do { _Pragma("unroll") for (int _i = 0; _i < 2; ++_i) \
        __builtin_amdgcn_global_load_lds((const unsigned*)((const char*)(gbase) + (voff)[_i]), (PG8_LAS unsigned*)(lds + (bufoff) + ldsw + _i * 8192), 16, 0, 0); } while (0)
#define PG8_LDA(dst, b, h) do { _Pragma("unroll") for (int m = 0; m < 4; ++m) _Pragma("unroll") for (int k = 0; k < 2; ++k) dst[m][k] = *(const PG8_LAS bf16x8*)(lds + PG8_SA(b, h) + aoff + m * 2048 + k * 1024); } while (0)
#define PG8_LDB(dst, b, h) do { _Pragma("unroll") for (int n = 0; n < 2; ++n) _Pragma("unroll") for (int k = 0; k < 2; ++k) dst[n][k] = *(const PG8_LAS bf16x8*)(lds + PG8_SB(b, h) + boff + n * 2048 + k * 1024); } while (0)
#define PG8_MMA(ai, bj, At, Bt) do { __builtin_amdgcn_s_setprio(1); _Pragma("unroll") for (int m = 0; m < 4; ++m) _Pragma("unroll") for (int n = 0; n < 2; ++n) _Pragma("unroll") for (int k = 0; k < 2; ++k) \
        acc[ai][bj][m][n] = __builtin_amdgcn_mfma_f32_16x16x32_bf16(Bt[n][k], At[m][k], acc[ai][bj][m][n], 0, 0, 0); __builtin_amdgcn_s_setprio(0); } while (0)
#define PG8_WAIT_V(n) asm volatile("s_waitcnt vmcnt(" #n ")" ::: "memory")
#define PG8_WAIT_L(n) asm volatile("s_waitcnt lgkmcnt(" #n ")" ::: "memory")
#define PG8_BAR __builtin_amdgcn_s_barrier()
#define PG8_SCHED __builtin_amdgcn_sched_barrier(0)
    Unit cur, nxt; int ui = 0;
    if (!S.next(0, cur)) return;
    f32x4 acc[2][2][4][2];
#pragma unroll
    for (int a = 0; a < 2; ++a)
#pragma unroll
        for (int b = 0; b < 2; ++b)
#pragma unroll
            for (int m = 0; m < 4; ++m)
#pragma unroll
                for (int n = 0; n < 2; ++n) acc[a][b][m][n] = (f32x4){0.f, 0.f, 0.f, 0.f};
    bf16x8 At[4][2], B0[2][2], B1[2][2];
    const char* cA = (const char*)g.A + (size_t)cur.pm * tstep; const char* cB = (const char*)g.Bt + (size_t)cur.pn * tstep;
    S.a_ready(cur);
    if constexpr (SP2) {
        PG8_STAGE(PG8_SB(0, 0), cB, voffB); PG8_STAGE(PG8_SB(0, 1), cB + hstep, voffB); PG8_STAGE(PG8_SA(0, 0), cA, voffA); PG8_STAGE(PG8_SA(0, 1), cA + hstep, voffA);
        if (wr == 1) PG8_BAR;
        PG8_WAIT_V(2); PG8_BAR;
        PG8_STAGE(PG8_SB(1, 0), cB + kstep, voffB); PG8_STAGE(PG8_SA(1, 0), cA + kstep, voffA); PG8_STAGE(PG8_SB(1, 1), cB + hstep + kstep, voffB);
        PG8_WAIT_V(6); PG8_BAR;
    } else {
        PG8_STAGE(PG8_SB(0, 0), cB, voffB); PG8_STAGE(PG8_SA(0, 0), cA, voffA); PG8_STAGE(PG8_SB(0, 1), cB + hstep, voffB); PG8_STAGE(PG8_SA(0, 1), cA + hstep, voffA);
        if (wr == 1) PG8_BAR;
        PG8_WAIT_V(4); PG8_BAR;
        PG8_STAGE(PG8_SB(1, 0), cB + kstep, voffB); PG8_STAGE(PG8_SA(1, 0), cA + kstep, voffA); PG8_STAGE(PG8_SB(1, 1), cB + hstep + kstep, voffB);
        PG8_WAIT_V(6); PG8_BAR;
    }
    for (;;) {
        const bool has_next = S.next(ui + 1, nxt);
        const char* nA = has_next ? (const char*)g.A + (size_t)nxt.pm * tstep : cA; const char* nB = has_next ? (const char*)g.Bt + (size_t)nxt.pn * tstep : cB;
        for (int t = 0; t < nt; t += 2) {
            const bool last = (t == nt - 2);
            const char* a1 = cA + (size_t)(t + 1) * kstep;
            const char* a2 = last ? nA : cA + (size_t)(t + 2) * kstep; const char* b2 = last ? nB : cB + (size_t)(t + 2) * kstep;
            const char* a3 = a2 + kstep; const char* b3 = b2 + kstep;
            if (last && has_next) S.a_ready(nxt);
            if constexpr (SP2) {
            PG8_LDB(B0, 0, 0); PG8_LDB(B1, 0, 1); PG8_SCHED; PG8_LDA(At, 0, 0); PG8_STAGE(PG8_SA(1, 1), a1 + hstep, voffA);
            PG8_WAIT_V(8); PG8_WAIT_L(0); PG8_BAR; PG8_MMA(0, 0, At, B0); PG8_MMA(0, 1, At, B1); PG8_BAR; PG8_SCHED;
            PG8_LDA(At, 0, 1); PG8_STAGE(PG8_SB(0, 0), b2, voffB); PG8_STAGE(PG8_SB(0, 1), b2 + hstep, voffB); PG8_STAGE(PG8_SA(0, 0), a2, voffA);
            PG8_WAIT_V(8); PG8_WAIT_L(0); PG8_BAR; PG8_MMA(1, 0, At, B0); PG8_MMA(1, 1, At, B1); PG8_BAR; PG8_SCHED;
            PG8_LDB(B0, 1, 0); PG8_LDB(B1, 1, 1); PG8_SCHED; PG8_LDA(At, 1, 0); PG8_STAGE(PG8_SA(0, 1), a2 + hstep, voffA);
            PG8_WAIT_V(8); PG8_WAIT_L(0); PG8_BAR; PG8_MMA(0, 0, At, B0); PG8_MMA(0, 1, At, B1); PG8_BAR; PG8_SCHED;
            PG8_LDA(At, 1, 1); PG8_STAGE(PG8_SB(1, 0), b3, voffB); PG8_STAGE(PG8_SB(1, 1), b3 + hstep, voffB); PG8_STAGE(PG8_SA(1, 0), a3, voffA);
            PG8_WAIT_V(8); PG8_WAIT_L(0); PG8_BAR; PG8_MMA(1, 0, At, B0); PG8_MMA(1, 1, At, B1); PG8_BAR; PG8_SCHED;
            } else {
            PG8_LDB(B0, 0, 0); PG8_SCHED; PG8_LDA(At, 0, 0); PG8_STAGE(PG8_SA(1, 1), a1 + hstep, voffA);
            PG8_WAIT_L(8); PG8_BAR; PG8_WAIT_L(0); PG8_MMA(0, 0, At, B0); PG8_BAR; PG8_SCHED;
            PG8_LDB(B1, 0, 1); PG8_STAGE(PG8_SB(0, 0), b2, voffB);
            PG8_BAR; PG8_WAIT_L(0); PG8_MMA(0, 1, At, B1); PG8_BAR;
            PG8_LDA(At, 0, 1); PG8_STAGE(PG8_SA(0, 0), a2, voffA);
            PG8_BAR; PG8_WAIT_L(0); PG8_MMA(1, 0, At, B0); PG8_BAR; PG8_SCHED;
            PG8_STAGE(PG8_SB(0, 1), b2 + hstep, voffB);
            PG8_WAIT_V(6); PG8_BAR; PG8_MMA(1, 1, At, B1); PG8_BAR;
            PG8_LDB(B0, 1, 0); PG8_SCHED; PG8_LDA(At, 1, 0); PG8_STAGE(PG8_SA(0, 1), a2 + hstep, voffA);
            PG8_WAIT_L(8); PG8_BAR; PG8_WAIT_L(0); PG8_MMA(0, 0, At, B0); PG8_BAR; PG8_SCHED;
            PG8_LDB(B1, 1, 1); PG8_STAGE(PG8_SB(1, 0), b3, voffB);
            PG8_BAR; PG8_WAIT_L(0); PG8_MMA(0, 1, At, B1); PG8_BAR;
            PG8_LDA(At, 1, 1); PG8_STAGE(PG8_SA(1, 0), a3, voffA);
            PG8_BAR; PG8_WAIT_L(0); PG8_MMA(1, 0, At, B0); PG8_BAR; PG8_SCHED;
            PG8_STAGE(PG8_SB(1, 1), b3 + hstep, voffB);
            PG8_WAIT_V(6); PG8_BAR; PG8_MMA(1, 1, At, B1); PG8_BAR;
            }
        }
        if constexpr (ALIGN_EPI) { if (wr == 0) PG8_BAR; }
        if constexpr (!Epi::AFTER_DRAIN) { E(acc, cur, wr, wc, fr, fq); S.done(cur); }
        if (!has_next) break;
#pragma unroll
        for (int a = 0; a < 2; ++a)
#pragma unroll
            for (int b = 0; b < 2; ++b)
#pragma unroll
                for (int m = 0; m < 4; ++m)
#pragma unroll
                    for (int n = 0; n < 2; ++n) acc[a][b][m][n] = (f32x4){0.f, 0.f, 0.f, 0.f};
        cur = nxt; cA = nA; cB = nB; ++ui;
        if constexpr (ALIGN_EPI) { if (wr == 1) PG8_BAR; }
    }
    PG8_WAIT_V(0);
    if constexpr (!ALIGN_EPI) { if (wr == 0) PG8_BAR; }
    PG8_BAR;
    if constexpr (Epi::AFTER_DRAIN) { E.fused(acc, cur, wr, wc, fr, fq, lds, wid, lane); S.done(cur); }
#undef PG8_SA
#undef PG8_SB
#undef PG8_STAGE
#undef PG8_LDA
#undef PG8_LDB
#undef PG8_MMA
#undef PG8_WAIT_V
#undef PG8_WAIT_L
#undef PG8_BAR
#undef PG8_SCHED
}
}

constexpr int NWAVES = 8;
constexpr int D = 1024, SEQ = 4096, MP = 16384, MS = 1024, M = MP + MS;
constexpr int NIN = 3584, INC = 3592, FF = 2816;
constexpr int PC_Z = 1536, PC_QB = 2048, PC_KB = 2560, PC_VB = 3072;
constexpr float EPS = 1e-6f;
constexpr size_t O_YP = 0, O_YS = 16777216, O_BKP = 17825792, O_BVP = 18874368, O_DP = 19922944, O_QCP = 20185088, O_FCP = 20203520,
                 O_BKS = 20226048, O_BVS = 20750336, O_DS = 21274624, O_QCS = 23371776, O_FCS = 23519232;
constexpr size_t MiB = 1u << 20;
constexpr size_t WS_CTL = 0, CTL_ZERO_BYTES = 1 * MiB;
constexpr size_t WS_WIN = 1 * MiB, WS_WOUT = 8 * MiB, WS_WGU = 10 * MiB, WS_WDN = 21 * MiB;
constexpr size_t WS_AB = 27 * MiB, WS_DL = 27 * MiB + 768 * 1024;
constexpr size_t WS_U = 28 * MiB;
constexpr size_t WS_GQK = WS_U, WS_GS = WS_U + 8 * MiB;
constexpr size_t WS_P = 62 * MiB;
constexpr size_t WS_MIXIN = 181 * MiB;
constexpr size_t WS_G = WS_P, WS_UP = WS_P + (size_t)M * FF * 2;
constexpr size_t WS_END = 256 * MiB;
static_assert(WS_UP + (size_t)M * FF * 2 <= WS_END, "ws map");
constexpr int CW_BAR = 4096;

constexpr int LDS_BYTES = 163840;
constexpr int MISC_OFF = LDS_BYTES - 256;

#define GAS __attribute__((address_space(1)))
#define LAS __attribute__((address_space(3)))
typedef unsigned short bf16;
typedef unsigned v4u __attribute__((ext_vector_type(4)));
typedef unsigned v2u __attribute__((ext_vector_type(2)));
typedef float f32x2 __attribute__((ext_vector_type(2)));
typedef float f32x4 __attribute__((ext_vector_type(4)));
typedef float f32x16 __attribute__((ext_vector_type(16)));
typedef short bf16x8 __attribute__((ext_vector_type(8)));
typedef short s16x4 __attribute__((ext_vector_type(4)));
typedef __bf16 bf16x2_t __attribute__((ext_vector_type(2)));
typedef GAS unsigned gu32;
#define RLX_AGENT __ATOMIC_RELAXED, __HIP_MEMORY_SCOPE_AGENT
#define LDS_WAIT() asm volatile("s_waitcnt lgkmcnt(0)" ::: "memory")
#define VM_WAIT() asm volatile("s_waitcnt vmcnt(0)" ::: "memory")
__device__ __forceinline__ unsigned pk2(float lo, float hi) { f32x2 v = {lo, hi}; bf16x2_t b = __builtin_convertvector(v, bf16x2_t); return __builtin_bit_cast(unsigned, b); }
__device__ __forceinline__ float bflo(unsigned w) { return __uint_as_float(w << 16); }
__device__ __forceinline__ float bfhi(unsigned w) { return __uint_as_float(w & 0xffff0000u); }
__device__ __forceinline__ float bf1(bf16 b) { return __uint_as_float((unsigned)b << 16); }
__device__ __forceinline__ bf16 f2bf(float f) { return (bf16)(pk2(f, 0.f) & 0xffffu); }
__device__ __forceinline__ float wave_sum(float v) {
#pragma unroll
    for (int o = 1; o < 64; o <<= 1) v += __shfl_xor(v, o);
    return v;
}
__device__ __forceinline__ float sigmoidf_(float x) { return 1.0f / (1.0f + __expf(-x)); }
__device__ __forceinline__ int crow(int r, int hi) { return (r & 3) + 8 * (r >> 2) + 4 * hi; }
#define MFMA32(a, b, c) __builtin_amdgcn_mfma_f32_32x32x16_bf16((a), (b), (c), 0, 0, 0)
#define MFMA16(a, b, c) __builtin_amdgcn_mfma_f32_16x16x32_bf16((a), (b), (c), 0, 0, 0)
#define XB_TMO      128
#define XB_XCNT(j)  (256  + 64 * (j))
#define XB_XSUB(j)  (1280 + 64 * (j))
#define XB_XGEN(j)  (2304 + 64 * (j))
#define XB_TOP      3328
#define XB_TOPGEN   3392
#define XCD_BAR_WORDS 3456
#define XB_SPIN_CAP (1u << 18)

__device__ __forceinline__ unsigned xb_ld(unsigned* p)              { return __hip_atomic_load(p, __ATOMIC_RELAXED, __HIP_MEMORY_SCOPE_AGENT); }
__device__ __forceinline__ unsigned xb_add(unsigned* p, unsigned v) { return __hip_atomic_fetch_add(p, v, __ATOMIC_RELAXED, __HIP_MEMORY_SCOPE_AGENT); }
__device__ __forceinline__ unsigned xb_xcc_id() { return (unsigned)__builtin_amdgcn_s_getreg((3 << 11) | 20) & 0xFu; }
#define XB_SPIN(cond, bar) do { unsigned _sp = 0; while (cond) { __builtin_amdgcn_s_sleep(1); \
    if ((++_sp & 255u) == 0u) { if (xb_ld(&(bar)[XB_TMO])) break; if (_sp > XB_SPIN_CAP) { atomicAdd(&(bar)[XB_TMO], 1u); break; } } } } while (0)

struct XcdBarrier {
    unsigned* bar; unsigned x;
    volatile LAS unsigned* st;
};

__device__ __forceinline__ XcdBarrier xcd_barrier_post(unsigned* bar, volatile LAS unsigned* st) {
    XcdBarrier b; b.bar = bar; b.x = xb_xcc_id(); b.st = st;
    if (threadIdx.x == 0) (void)xb_add(&bar[XB_XCNT(b.x)], 1u);
    return b;
}
__device__ __forceinline__ void xcd_barrier_complete(unsigned* bar, unsigned x, unsigned& nloc, unsigned& nx) {
    const unsigned G = gridDim.x * gridDim.y * gridDim.z;
    unsigned sum, cnt, mine, sp = 0u;
    for (;;) {
        sum = 0u; cnt = 0u; mine = 0u;
#pragma unroll
        for (unsigned j = 0; j < 16; ++j) { const unsigned c = xb_ld(&bar[XB_XCNT(j)]); sum += c; cnt += (c > 0u) ? 1u : 0u; mine = (j == x) ? c : mine; }
        if (sum == G) break;
        __builtin_amdgcn_s_sleep(1);
        if ((++sp & 255u) == 0u) { if (xb_ld(&bar[XB_TMO])) break; if (sp > XB_SPIN_CAP) { atomicAdd(&bar[XB_TMO], 1u); break; } }
    }
    nloc = mine > 0u ? mine : 1u; nx = cnt > 0u ? cnt : 1u;
}

__device__ __forceinline__ void xcd_barrier(const XcdBarrier& b) {
    asm volatile("s_waitcnt vmcnt(0)" ::: "memory");
    __syncthreads();
    if (threadIdx.x == 0) {
        unsigned* bar = b.bar;
        __builtin_amdgcn_s_waitcnt(0);
        unsigned nloc = b.st[0], nx = b.st[1];
        if (nloc == 0u) { xcd_barrier_complete(bar, b.x, nloc, nx); b.st[0] = nloc; b.st[1] = nx; }
        const unsigned old = xb_add(&bar[XB_XSUB(b.x)], 1u);
        const unsigned gen = old / nloc;
        if (old + 1u == (gen + 1u) * nloc) {
            __builtin_amdgcn_fence(__ATOMIC_RELEASE, "agent");
            asm volatile("s_waitcnt vmcnt(0)" ::: "memory");
            const unsigned og = xb_add(&bar[XB_TOP], 1u);
            const unsigned tg = og / nx;
            if (og + 1u == (tg + 1u) * nx) xb_add(&bar[XB_TOPGEN], 1u);
            else XB_SPIN(xb_ld(&bar[XB_TOPGEN]) == tg, bar);
            __builtin_amdgcn_fence(__ATOMIC_ACQUIRE, "agent");
            xb_add(&bar[XB_XGEN(b.x)], 1u);
            asm volatile("s_waitcnt vmcnt(0)" ::: "memory");
        } else {
            XB_SPIN(xb_ld(&bar[XB_XGEN(b.x)]) == gen, bar);
            __builtin_amdgcn_fence(__ATOMIC_ACQUIRE, "agent");
            asm volatile("s_waitcnt vmcnt(0)" ::: "memory");
        }
    }
    __syncthreads();
}

__device__ __forceinline__ void p0_transpose_item(const float* W, int ldw, int K, int N, bf16* WT, int row_off, LAS float* scr, int item, int lane) {
    const int nblk = N / 32, kb = item / nblk, nb = item % nblk, k0 = 64 * kb, n0 = 32 * nb;
#pragma unroll 8
    for (int i = 0; i < 32; ++i) { const int kk = 2 * i + (lane >> 5); scr[kk * 33 + (lane & 31)] = W[(size_t)(k0 + kk) * ldw + n0 + (lane & 31)]; }
    LDS_WAIT(); asm volatile("" ::: "memory");
    const int c = lane & 7;
#pragma unroll
    for (int j = 0; j < 4; ++j) { const int n = (lane >> 3) + 8 * j; const LAS float* s = scr + (8 * c) * 33 + n;
        v4u o; o.x = pk2(s[0 * 33], s[1 * 33]); o.y = pk2(s[2 * 33], s[3 * 33]); o.z = pk2(s[4 * 33], s[5 * 33]); o.w = pk2(s[6 * 33], s[7 * 33]);
        *(v4u*)(WT + (size_t)(row_off + n0 + n) * K + k0 + 8 * c) = o; }
    LDS_WAIT(); asm volatile("" ::: "memory");
}

__device__ __forceinline__ void phase_prologue(LAS unsigned char* lds, const float* xp, const float* xs, const float* nw, const float* w_in, const float* w_out, const float* w_gu, const float* w_dn,
                                               unsigned char* ws, int vcu, int G, int tid, int lane, int wave) {
    LAS float* scr = (LAS float*)(lds + wave * 8448);
    LAS float* W8T = (LAS float*)(lds + 67584);
    for (int k = tid; k < 1024; k += 512) {
        const f32x4 a = *(const f32x4*)(w_in + (size_t)k * INC + 2048), b = *(const f32x4*)(w_in + (size_t)k * INC + 2052);
        W8T[0 * 1024 + k] = a.x; W8T[1 * 1024 + k] = a.y; W8T[2 * 1024 + k] = a.z; W8T[3 * 1024 + k] = a.w;
        W8T[4 * 1024 + k] = b.x; W8T[5 * 1024 + k] = b.y; W8T[6 * 1024 + k] = b.z; W8T[7 * 1024 + k] = b.w;
    }
    __syncthreads();
    const int gw = vcu * NWAVES + wave, NGW = G * NWAVES;
    bf16* Win_t = (bf16*)(ws + WS_WIN); bf16* Wout_t = (bf16*)(ws + WS_WOUT); bf16* Wgu_t = (bf16*)(ws + WS_WGU); bf16* Wdn_t = (bf16*)(ws + WS_WDN);
    constexpr int I_A = 16 * 64, I_B = 16 * 48, I_O = 16 * 32, I_GU = 16 * 176, I_DN = 44 * 32;
    constexpr int NITEMS = I_A + I_B + I_O + I_GU + I_DN;
    for (int it = gw; it < NITEMS; it += NGW) {
        int r = it;
        if (r < I_A) { p0_transpose_item(w_in, INC, D, 2048, Win_t, 0, scr, r, lane); continue; } r -= I_A;
        if (r < I_B) { p0_transpose_item(w_in + 2056, INC, D, 1536, Win_t, 2048, scr, r, lane); continue; } r -= I_B;
        if (r < I_O) { p0_transpose_item(w_out, D, D, D, Wout_t, 0, scr, r, lane); continue; } r -= I_O;
        if (r < I_GU) { p0_transpose_item(w_gu, 2 * FF, D, 2 * FF, Wgu_t, 0, scr, r, lane); continue; } r -= I_GU;
        p0_transpose_item(w_dn, D, FF, D, Wdn_t, 0, scr, r, lane);
    }
    bf16* U = (bf16*)(ws + WS_U); float* AB = (float*)(ws + WS_AB);
    for (int m = gw; m < M; m += NGW) {
        const float* xrow = m < MP ? xp + (size_t)m * D : xs + (size_t)(m - MP) * D;
        f32x4 v[4]; float s = 0.f;
#pragma unroll
        for (int j = 0; j < 4; ++j) { v[j] = ((const f32x4*)xrow)[lane + 64 * j]; s += (v[j].x * v[j].x + v[j].y * v[j].y) + (v[j].z * v[j].z + v[j].w * v[j].w); }
        const float rstd = rsqrtf(wave_sum(s) * (1.f / D) + EPS);
        unsigned long long* o8 = (unsigned long long*)(U + (size_t)m * D) + lane;
#pragma unroll
        for (int j = 0; j < 4; ++j) { const f32x4 g = ((const f32x4*)nw)[lane + 64 * j]; v[j] = v[j] * rstd * g;
            o8[64 * j] = (unsigned long long)pk2(v[j].x, v[j].y) | ((unsigned long long)pk2(v[j].z, v[j].w) << 32); }
        float dv = 0.f;
#pragma unroll
        for (int jj = 0; jj < 8; ++jj) { float acc = 0.f;
#pragma unroll
            for (int j = 0; j < 4; ++j) { const f32x4 w = *(const LAS f32x4*)(W8T + jj * 1024 + 4 * lane + 256 * j); acc += (v[j].x * w.x + v[j].y * w.y) + (v[j].z * w.z + v[j].w * w.w); }
            acc = wave_sum(acc); if (lane == jj) dv = acc; }
        if (lane < 8) AB[(size_t)m * 8 + lane] = dv;
    }
}

__device__ __forceinline__ void phase_copy_outputs(const bf16* P, float* out, int gtid, int nth) {
    for (int e = gtid; e < 4 * 512 * 512; e += nth) { const int b = e >> 18, j = (e >> 9) & 511, c = e & 511; const size_t row = (size_t)(b * SEQ + 3584 + j) * NIN;
        out[O_BKP + e] = bf1(P[row + PC_KB + c]); out[O_BVP + e] = bf1(P[row + PC_VB + c]); }
    for (int e = gtid; e < 32 * 32 * 512; e += nth) { const int r = e >> 9, c = e & 511; const size_t row = (size_t)(MP + r) * NIN;
        out[O_BKS + e] = bf1(P[row + PC_KB + c]); out[O_BVS + e] = bf1(P[row + PC_VB + c]); }
    for (int e = gtid; e < 4 * 3 * 1536; e += nth) { const int b = e / 4608, i = (e / 1536) % 3, c = e % 1536; out[O_QCP + e] = bf1(P[(size_t)(b * SEQ + 4093 + i) * NIN + c]); }
    for (int e = gtid; e < 32 * 3 * 1536; e += nth) { const int b = e / 4608, i = (e / 1536) % 3, c = e % 1536; out[O_QCS + e] = bf1(P[(size_t)(MP + b * 32 + 29 + i) * NIN + c]); }
}

__device__ __forceinline__ void gdn_pre_unit(LAS unsigned char* lds, int u, const bf16* P, const float* AB, const float* st_qkv, const float* conv_w, const float* a_log, const float* dt_bias,
                                             bf16* gmain, bf16* gqk, bf16* gs, float* DL, int tid, int lane, int wave) {
    LAS float* RHS = (LAS float*)(lds + 0);
    LAS bf16* QB = (LAS bf16*)(lds + 65536);
    LAS bf16* KB = (LAS bf16*)(lds + 82944);
    LAS bf16* RAW = (LAS bf16*)(lds + 100352);
    LAS bf16* KGT = (LAS bf16*)(lds + 117760);
    LAS float* AM = (LAS float*)(lds + 117760);
    LAS float* SMG = (LAS float*)(lds + 134144);
    const bool prompt = u < 1024;
    int b, h, n, m0, valid; bf16 *o_w, *o_qg, *o_kgt, *o_ut, *o_qk;
    if (prompt) { b = u >> 8; h = (u >> 6) & 3; n = u & 63; m0 = b * SEQ + n * 64; valid = 64; bf16* base = gmain + (size_t)u * 32768; o_w = base; o_qg = base + 8192; o_kgt = base + 16384; o_ut = base + 24576; o_qk = gqk + (size_t)u * 4096; }
    else { const int su = u - 1024; b = su >> 2; h = su & 3; n = 0; m0 = MP + b * 32; valid = 32; bf16* base = gs + (size_t)su * 36864; o_w = base; o_qg = base + 8192; o_kgt = base + 16384; o_ut = base + 24576; o_qk = base + 32768; }
    if (wave == 0) {
        const int i = lane; const bool v = i < valid;
        const float araw = v ? AB[(size_t)(m0 + i) * 8 + 4 + h] : 0.f, braw = v ? AB[(size_t)(m0 + i) * 8 + h] : 0.f;
        const float A = expf(a_log[h]); const float x = araw + dt_bias[h];
        const float sp = x > 20.f ? x : log1pf(expf(x));
        const float g = v ? -A * sp : 0.f; const float beta = v ? 1.f / (1.f + expf(-braw)) : 0.f;
        float Gc = g;
#pragma unroll
        for (int off = 1; off < 64; off <<= 1) { const float t = __shfl_up(Gc, off); if (lane >= off) Gc += t; }
        const float Gl = __shfl(Gc, 63);
        SMG[i] = Gc; SMG[64 + i] = beta; SMG[128 + i] = expf(Gc); SMG[192 + i] = expf(Gl - Gc);
        if (lane == 0) DL[u] = expf(Gl);
    }
    __syncthreads();
#pragma unroll 1
    for (int part = 0; part < 3; ++part) {
        const int pcol = (part == 0 ? 512 : part == 1 ? 0 : 1024) + h * 128;
#pragma unroll
        for (int pass = 0; pass < 3; ++pass) {
            const int rr = (tid >> 4) + 32 * pass, ch = tid & 15;
            if (rr < 67) {
                v4u val = {0u, 0u, 0u, 0u};
                if (prompt) { const int ts = n * 64 - 3 + rr; if (ts >= 0) val = *(const v4u*)(P + (size_t)(b * SEQ + ts) * NIN + pcol + ch * 8); }
                else { if (rr < 3) { const float* s = st_qkv + ((size_t)b * 3 + rr) * 1536 + pcol + ch * 8; const f32x4 a = *(const f32x4*)s, c = *(const f32x4*)(s + 4); val = (v4u){pk2(a.x, a.y), pk2(a.z, a.w), pk2(c.x, c.y), pk2(c.z, c.w)}; }
                       else if (rr - 3 < 32) val = *(const v4u*)(P + (size_t)(MP + b * 32 + rr - 3) * NIN + pcol + ch * 8); }
                *(LAS v4u*)(RAW + rr * 128 + ch * 8) = val;
            }
        }
        __syncthreads();
        float w0[4], w1[4];
#pragma unroll
        for (int i = 0; i < 4; ++i) { const f32x2 t = *(const f32x2*)(conv_w + i * 1536 + pcol + 2 * lane); w0[i] = t.x; w1[i] = t.y; }
#pragma unroll 2
        for (int rq = 0; rq < 8; ++rq) {
            const int r = wave * 8 + rq;
            float y0 = 0.f, y1 = 0.f;
#pragma unroll
            for (int i = 0; i < 4; ++i) { const unsigned xw = *(const LAS unsigned*)(RAW + (r + i) * 128 + 2 * lane); y0 += w0[i] * bflo(xw); y1 += w1[i] * bfhi(xw); }
            float s0 = y0 * sigmoidf_(y0), s1 = y1 * sigmoidf_(y1);
            if (r >= valid) { s0 = 0.f; s1 = 0.f; }
            if (part == 2) { const float be = SMG[64 + r]; *(LAS f32x2*)(RHS + r * 256 + 2 * lane) = (f32x2){s0 * be, s1 * be}; }
            else {
                const float rinv = rsqrtf(wave_sum(s0 * s0 + s1 * s1) + EPS);
                if (part == 0) { const float k0 = s0 * rinv, k1 = s1 * rinv; *(LAS unsigned*)(KB + r * 136 + 2 * lane) = pk2(k0, k1);
                    const float be = SMG[64 + r] * SMG[128 + r]; *(LAS f32x2*)(RHS + r * 256 + 128 + 2 * lane) = (f32x2){k0 * be, k1 * be};
                    const float egl = SMG[192 + r]; KGT[(2 * lane) * 64 + r] = f2bf(k0 * egl); KGT[(2 * lane + 1) * 64 + r] = f2bf(k1 * egl); }
                else { const float sc = rinv * 0.08838834764831845f; const float q0 = s0 * sc, q1 = s1 * sc; *(LAS unsigned*)(QB + r * 136 + 2 * lane) = pk2(q0, q1);
                    const float eg = SMG[128 + r]; *(unsigned*)(o_qg + r * 128 + 2 * lane) = pk2(q0 * eg, q1 * eg); }
            }
        }
        __syncthreads();
        if (part == 0) {
#pragma unroll
            for (int k = 0; k < 2; ++k) { const int pi = tid + 512 * k; *(v4u*)(o_kgt + pi * 8) = *(const LAS v4u*)(KGT + pi * 8); }
        }
    }
    {
        const int mat = wave >> 2, ti = (wave >> 1) & 1, tj = wave & 1, r32 = lane & 31, hi = lane >> 5;
        const LAS bf16* Ab = (mat == 0 ? KB : QB) + (32 * ti + r32) * 136 + 8 * hi;
        const LAS bf16* Bb = KB + (32 * tj + r32) * 136 + 8 * hi;
        f32x16 acc;
#pragma unroll
        for (int r = 0; r < 16; ++r) acc[r] = 0.f;
#pragma unroll
        for (int s = 0; s < 8; ++s) acc = MFMA32(*(const LAS bf16x8*)(Ab + 16 * s), *(const LAS bf16x8*)(Bb + 16 * s), acc);
        const int j = 32 * tj + r32; const float Gj = SMG[j];
#pragma unroll
        for (int r = 0; r < 16; ++r) { const int i = 32 * ti + crow(r, hi); const float dec = expf(fminf(SMG[i] - Gj, 0.f));
            if (mat == 0) AM[i * 64 + j] = (i > j) ? acc[r] * SMG[64 + i] * dec : 0.f;
            else o_qk[i * 64 + j] = f2bf((i >= j) ? acc[r] * dec : 0.f); }
    }
    __syncthreads();
    if (tid < 256) {
        const int c = tid; float x[64];
        int zv; asm volatile("v_mov_b32 %0, 0" : "=v"(zv));
        const LAS float* AMv = AM + zv;
#pragma unroll
        for (int i = 0; i < 64; ++i) {
            float s0 = RHS[i * 256 + c], s1 = 0.f;
#pragma unroll
            for (int j = 0; j < i; ++j) { const float a = AMv[i * 64 + j]; if (j & 1) s1 = fmaf(-a, x[j], s1); else s0 = fmaf(-a, x[j], s0); }
            x[i] = s0 + s1;
        }
        if (c < 128) {
#pragma unroll
            for (int k = 0; k < 8; ++k) { const v4u o = {pk2(x[8 * k], x[8 * k + 1]), pk2(x[8 * k + 2], x[8 * k + 3]), pk2(x[8 * k + 4], x[8 * k + 5]), pk2(x[8 * k + 6], x[8 * k + 7])}; *(v4u*)(o_ut + c * 64 + 8 * k) = o; }
        } else { const int dk = c - 128;
#pragma unroll
            for (int i = 0; i < 64; ++i) o_w[i * 128 + dk] = f2bf(x[i]); }
    }
    __syncthreads();
}

constexpr int SL_W = 0, SL_QG = 17408, SL_KGT = 34816, SL_UT = 53248, SL_QK = 71680, SL_O = 80896, SL_END = 114688;
__device__ __forceinline__ bf16x8 pack8(const f32x4& a, const f32x4& b) { const v4u t = {pk2(a[0], a[1]), pk2(a[2], a[3]), pk2(b[0], b[1]), pk2(b[2], b[3])}; return __builtin_bit_cast(bf16x8, t); }
__device__ __forceinline__ bf16x8 ldfrag(const LAS unsigned char* p) { const v2u lo = *(const LAS v2u*)p, hi = *(const LAS v2u*)(p + 32); const v4u t = {lo.x, lo.y, hi.x, hi.y}; return __builtin_bit_cast(bf16x8, t); }
__device__ __forceinline__ void scan_unit(LAS unsigned char* lds, int nsteps, int nrows, const bf16* gmain, size_t main_stride, const bf16* gqk, size_t qk_stride, const float* DLp,
                                          const float* S0, float* Sout, const bf16* Pz  , bf16* MX  , const float* gnw, int tid, int lane, int wave) {
    const int cl = lane & 15, q = lane >> 4, c0 = wave * 16;
    f32x4 S[8];
#pragma unroll
    for (int mt = 0; mt < 8; ++mt)
#pragma unroll
        for (int r = 0; r < 4; ++r) S[mt][r] = S0 ? S0[(16 * mt + 4 * q + r) * 128 + c0 + cl] : 0.f;
    v4u pre[9];
#define SCAN_LOAD(nn) do { const bf16* mp_ = gmain + (size_t)(nn) * main_stride; _Pragma("unroll") for (int k = 0; k < 8; ++k) pre[k] = *(const v4u*)(mp_ + (size_t)(tid + 512 * k) * 8); \
        pre[8] = *(const v4u*)(gqk + (size_t)(nn) * qk_stride + (size_t)tid * 8); } while (0)
    SCAN_LOAD(0);
    LAS float* OL = (LAS float*)(lds + SL_O);
#pragma unroll 1
    for (int n = 0; n < nsteps; ++n) {
#pragma unroll
        for (int k = 0; k < 8; ++k) { const int a = k >> 1, within = tid + 512 * (k & 1); int dst;
            if (a < 2) dst = (a == 0 ? SL_W : SL_QG) + (within >> 4) * 272 + (within & 15) * 16; else dst = (a == 2 ? SL_KGT : SL_UT) + (within >> 3) * 144 + (within & 7) * 16;
            *(LAS v4u*)(lds + dst) = pre[k]; }
        *(LAS v4u*)(lds + SL_QK + (tid >> 3) * 144 + (tid & 7) * 16) = pre[8];
        const float dl = DLp[n];
        if (n + 1 < nsteps) SCAN_LOAD(n + 1);
        __syncthreads();
        bf16x8 Sb[4];
#pragma unroll
        for (int ks = 0; ks < 4; ++ks) Sb[ks] = pack8(S[2 * ks], S[2 * ks + 1]);
        f32x4 vn[4], o[4];
#pragma unroll
        for (int mt = 0; mt < 4; ++mt) {
            f32x4 aw = {0.f, 0.f, 0.f, 0.f}, ao = {0.f, 0.f, 0.f, 0.f};
            const LAS unsigned char* wp = lds + SL_W + (16 * mt + cl) * 272 + q * 8; const LAS unsigned char* qp = lds + SL_QG + (16 * mt + cl) * 272 + q * 8;
#pragma unroll
            for (int ks = 0; ks < 4; ++ks) { aw = MFMA16(ldfrag(wp + ks * 64), Sb[ks], aw); ao = MFMA16(ldfrag(qp + ks * 64), Sb[ks], ao); }
            const v2u uu = *(const LAS v2u*)(lds + SL_UT + (c0 + cl) * 144 + (16 * mt + 4 * q) * 2);
            vn[mt] = (f32x4){bflo(uu.x) - aw[0], bfhi(uu.x) - aw[1], bflo(uu.y) - aw[2], bfhi(uu.y) - aw[3]};
            o[mt] = ao;
        }
        bf16x8 Vb[2];
#pragma unroll
        for (int ks = 0; ks < 2; ++ks) Vb[ks] = pack8(vn[2 * ks], vn[2 * ks + 1]);
#pragma unroll
        for (int mt = 0; mt < 4; ++mt) { const LAS unsigned char* kp = lds + SL_QK + (16 * mt + cl) * 144 + q * 8;
#pragma unroll
            for (int ks = 0; ks < 2; ++ks) o[mt] = MFMA16(ldfrag(kp + ks * 64), Vb[ks], o[mt]); }
#pragma unroll
        for (int mt = 0; mt < 8; ++mt) { S[mt] = S[mt] * dl; const LAS unsigned char* kp = lds + SL_KGT + (16 * mt + cl) * 144 + q * 8;
#pragma unroll
            for (int ks = 0; ks < 2; ++ks) S[mt] = MFMA16(ldfrag(kp + ks * 64), Vb[ks], S[mt]); }
#pragma unroll
        for (int mt = 0; mt < 4; ++mt)
#pragma unroll
            for (int r = 0; r < 4; ++r) OL[(16 * mt + 4 * q + r) * 132 + c0 + cl] = o[mt][r];
        __syncthreads();
        const f32x2 gw2 = *(const f32x2*)(gnw + 2 * lane);
#pragma unroll 2
        for (int rq = 0; rq < 8; ++rq) { const int r = wave * 8 + rq;
            if (r < nrows) { const f32x2 ov = *(const LAS f32x2*)(OL + r * 132 + 2 * lane); const float rstd = rsqrtf(wave_sum(ov.x * ov.x + ov.y * ov.y) * (1.f / 128.f) + EPS);
                const size_t mr = (size_t)n * 64 + r; const unsigned zw = *(const unsigned*)(Pz + mr * NIN + 2 * lane); const float z0 = bflo(zw), z1 = bfhi(zw);
                *(unsigned*)(MX + mr * D + 2 * lane) = pk2(ov.x * rstd * gw2.x * z0 * sigmoidf_(z0), ov.y * rstd * gw2.y * z1 * sigmoidf_(z1)); } }
    }
#undef SCAN_LOAD
#pragma unroll
    for (int mt = 0; mt < 8; ++mt)
#pragma unroll
        for (int r = 0; r < 4; ++r) Sout[(16 * mt + 4 * q + r) * 128 + c0 + cl] = S[mt][r];
    __syncthreads();
}

constexpr int ATT_WAVE_LDS = 17920;
constexpr float LOG2E = 1.4426950408889634f;
typedef short v4i16_t __attribute__((ext_vector_type(4)));
__device__ __forceinline__ s16x4 vtr(const LAS unsigned char* p) { return __builtin_bit_cast(s16x4, __builtin_amdgcn_ds_read_tr16_b64_v4i16((LAS v4i16_t*)p)); }
__device__ __forceinline__ void attn_item(LAS unsigned char* wl, int it, const bf16* P, const float* ck, const float* cv, const float* relb, const float* anw, bf16* MIXIN, int lane) {
    LAS unsigned char* KL = wl; LAS unsigned char* VL = wl + 8192; LAS float* SC = (LAS float*)(wl + 16384); LAS float* BT = (LAS float*)(wl + 16640);
    const int r32 = lane & 31, hi = lane >> 5;
    const bool sample = it < 256;
    int b, h, n = 0, half = 0, mq, t0, t1;
    if (sample) { b = it >> 3; h = it & 7; mq = MP + b * 32; t0 = 0; t1 = 9; }
    else { const int idx = it - 256; half = idx & 1; n = (idx >> 1) & 63; h = (idx >> 7) & 7; b = idx >> 10; mq = b * SEQ + n * 64 + half * 32; t0 = n > 8 ? n - 8 : 0; t1 = n + 1; }
    for (int k = lane; k < 257; k += 64) BT[k] = relb[h * 257 + k] * LOG2E;
    bf16x8 qr[4];
#pragma unroll
    for (int d0 = 0; d0 < 4; ++d0) qr[d0] = *(const bf16x8*)(P + (size_t)(mq + r32) * NIN + PC_QB + h * 64 + d0 * 16 + hi * 8);
    float mrun = -1e30f, lrun = 0.f; f32x16 o0, o1;
#pragma unroll
    for (int r = 0; r < 16; ++r) { o0[r] = 0.f; o1[r] = 0.f; }
    const int ti = lane & 15, blk = (lane >> 4) & 1;
    const LAS unsigned char* vbase = VL + (4 * hi + (ti >> 2)) * 128 + (blk * 16 + 4 * (ti & 3)) * 2;
#pragma unroll 1
    for (int t = t0; t < t1; ++t) {
        int relbase; bool maskhalf = false;
        if (sample && t < 8) {
            relbase = 512 - 64 * t;
#pragma unroll
            for (int i8 = 0; i8 < 8; ++i8) { const int idx = i8 * 64 + lane, key = idx >> 3, c8 = idx & 7; const size_t off = (((size_t)b * 512 + 64 * t + key) * 8 + h) * 64 + c8 * 8;
                const f32x4 ka = *(const f32x4*)(ck + off), kb = *(const f32x4*)(ck + off + 4), va = *(const f32x4*)(cv + off), vb = *(const f32x4*)(cv + off + 4);
                *(LAS v4u*)(KL + (c8 * 64 + key) * 16) = (v4u){pk2(ka.x, ka.y), pk2(ka.z, ka.w), pk2(kb.x, kb.y), pk2(kb.z, kb.w)};
                *(LAS v4u*)(VL + key * 128 + c8 * 16) = (v4u){pk2(va.x, va.y), pk2(va.z, va.w), pk2(vb.x, vb.y), pk2(vb.z, vb.w)}; }
        } else {
            size_t rowbase; int nvalid;
            if (sample) { relbase = 0; maskhalf = true; rowbase = (size_t)MP + b * 32; nvalid = 32; }
            else { relbase = 64 * (n - t) + 32 * half; rowbase = (size_t)b * SEQ + t * 64; nvalid = 64; }
#pragma unroll
            for (int i8 = 0; i8 < 8; ++i8) { const int idx = i8 * 64 + lane, key = idx >> 3, c8 = idx & 7; v4u kv = {0u, 0u, 0u, 0u}, vv = {0u, 0u, 0u, 0u};
                if (key < nvalid) { const bf16* rp = P + (rowbase + key) * NIN + h * 64 + c8 * 8; kv = *(const v4u*)(rp + PC_KB); vv = *(const v4u*)(rp + PC_VB); }
                *(LAS v4u*)(KL + (c8 * 64 + key) * 16) = kv; *(LAS v4u*)(VL + key * 128 + c8 * 16) = vv; }
        }
        f32x16 p0, p1;
#pragma unroll
        for (int r = 0; r < 16; ++r) { p0[r] = 0.f; p1[r] = 0.f; }
#pragma unroll
        for (int d0 = 0; d0 < 4; ++d0) { const bf16x8 k0 = *(const LAS bf16x8*)(KL + (2 * d0 + hi) * 1024 + r32 * 16), k1 = *(const LAS bf16x8*)(KL + (2 * d0 + hi) * 1024 + 512 + r32 * 16);
            p0 = MFMA32(k0, qr[d0], p0); p1 = MFMA32(k1, qr[d0], p1); }
        const float SC2 = 0.125f * LOG2E;
        if (relbase - 63 >= 128) { const float bc = BT[256];
#pragma unroll
            for (int r = 0; r < 16; ++r) { p0[r] = p0[r] * SC2 + bc; p1[r] = p1[r] * SC2 + bc; } }
        else {
#pragma unroll
            for (int r = 0; r < 16; ++r) { const int rel = relbase + r32 - crow(r, hi); int i0 = (rel > 128 ? 128 : rel) + 128, i1 = (rel - 32 > 128 ? 128 : rel - 32) + 128; i0 = i0 < 0 ? 0 : i0; i1 = i1 < 0 ? 0 : i1;
                p0[r] = p0[r] * SC2 + BT[i0]; p1[r] = p1[r] * SC2 + BT[i1]; } }
        if (maskhalf) {
#pragma unroll
            for (int r = 0; r < 16; ++r) p1[r] = -INFINITY; }
        float mx = fmaxf(p0[0], p1[0]);
#pragma unroll
        for (int r = 1; r < 16; ++r) mx = fmaxf(mx, fmaxf(p0[r], p1[r]));
        mx = fmaxf(mx, __shfl_xor(mx, 32));
        const float mnew = fmaxf(mrun, mx); const float alpha = __builtin_amdgcn_exp2f(mrun - mnew); mrun = mnew;
        float sum = 0.f;
#pragma unroll
        for (int r = 0; r < 16; ++r) { p0[r] = __builtin_amdgcn_exp2f(p0[r] - mnew); p1[r] = __builtin_amdgcn_exp2f(p1[r] - mnew); sum += p0[r] + p1[r]; }
        lrun = lrun * alpha + sum;
        if (hi == 0) SC[r32] = alpha;
#pragma unroll
        for (int r = 0; r < 16; ++r) { const float a = SC[crow(r, hi)]; o0[r] *= a; o1[r] *= a; }
#pragma unroll
        for (int s = 0; s < 4; ++s) {
            v4u pw;
            if (s < 2) pw = (v4u){pk2(p0[8 * s + 0], p0[8 * s + 1]), pk2(p0[8 * s + 2], p0[8 * s + 3]), pk2(p0[8 * s + 4], p0[8 * s + 5]), pk2(p0[8 * s + 6], p0[8 * s + 7])};
            else { const int ss = s - 2; pw = (v4u){pk2(p1[8 * ss + 0], p1[8 * ss + 1]), pk2(p1[8 * ss + 2], p1[8 * ss + 3]), pk2(p1[8 * ss + 4], p1[8 * ss + 5]), pk2(p1[8 * ss + 6], p1[8 * ss + 7])}; }
            const bf16x8 pa = __builtin_bit_cast(bf16x8, pw);
            const LAS unsigned char* vp = vbase + (16 * s) * 128;
            const s16x4 a0 = vtr(vp), a1 = vtr(vp + 8 * 128), b0 = vtr(vp + 64), b1 = vtr(vp + 8 * 128 + 64);
            const bf16x8 v0 = {a0[0], a0[1], a0[2], a0[3], a1[0], a1[1], a1[2], a1[3]}, v1 = {b0[0], b0[1], b0[2], b0[3], b1[0], b1[1], b1[2], b1[3]};
            o0 = MFMA32(pa, v0, o0); o1 = MFMA32(pa, v1, o1);
        }
    }
    lrun += __shfl_xor(lrun, 32);
    if (hi == 0) SC[32 + r32] = 1.f / lrun;
    LAS float* OL = (LAS float*)wl;
#pragma unroll
    for (int r = 0; r < 16; ++r) { const int qq = crow(r, hi); const float inv = SC[32 + qq]; OL[qq * 66 + r32] = o0[r] * inv; OL[qq * 66 + 32 + r32] = o1[r] * inv; }
    {
        const int qq = lane >> 1, dh = (lane & 1) * 32; float vals[32]; float ss = 0.f;
#pragma unroll
        for (int k = 0; k < 32; ++k) { vals[k] = OL[qq * 66 + dh + k]; ss += vals[k] * vals[k]; }
        ss += __shfl_xor(ss, 1);
        const float rstd = rsqrtf(ss * (1.f / 64.f) + EPS);
        bf16* op = MIXIN + (size_t)(mq + qq) * D + 512 + h * 64 + dh;
#pragma unroll
        for (int k4 = 0; k4 < 4; ++k4) { v4u o;
            const f32x4 wa = *(const f32x4*)(anw + dh + 8 * k4), wb = *(const f32x4*)(anw + dh + 8 * k4 + 4);
            o.x = pk2(vals[8 * k4 + 0] * rstd * wa.x, vals[8 * k4 + 1] * rstd * wa.y); o.y = pk2(vals[8 * k4 + 2] * rstd * wa.z, vals[8 * k4 + 3] * rstd * wa.w);
            o.z = pk2(vals[8 * k4 + 4] * rstd * wb.x, vals[8 * k4 + 5] * rstd * wb.y); o.w = pk2(vals[8 * k4 + 6] * rstd * wb.z, vals[8 * k4 + 7] * rstd * wb.w);
            *(v4u*)(op + 8 * k4) = o; }
    }
}

__device__ __forceinline__ void phase_rows1(const float* xp, const float* xs, const float* mix, const float* w_post, const float* w_pre2, float* out, bf16* U, int gw, int NGW, int lane) {
    for (int m = gw; m < M; m += NGW) {
        const float* xrow = m < MP ? xp + (size_t)m * D : xs + (size_t)(m - MP) * D;
        f32x4 v[4], xv[4]; float s = 0.f;
#pragma unroll
        for (int j = 0; j < 4; ++j) { v[j] = ((const f32x4*)(mix + (size_t)m * D))[lane + 64 * j]; xv[j] = ((const f32x4*)xrow)[lane + 64 * j]; s += (v[j].x * v[j].x + v[j].y * v[j].y) + (v[j].z * v[j].z + v[j].w * v[j].w); }
        const float rstd = rsqrtf(wave_sum(s) * (1.f / D) + EPS); float s2 = 0.f;
#pragma unroll
        for (int j = 0; j < 4; ++j) { const f32x4 g = ((const f32x4*)w_post)[lane + 64 * j]; v[j] = xv[j] + v[j] * rstd * g; ((f32x4*)(out + (size_t)m * D))[lane + 64 * j] = v[j];
            s2 += (v[j].x * v[j].x + v[j].y * v[j].y) + (v[j].z * v[j].z + v[j].w * v[j].w); }
        const float rstd2 = rsqrtf(wave_sum(s2) * (1.f / D) + EPS);
        unsigned long long* o8 = (unsigned long long*)(U + (size_t)m * D) + lane;
#pragma unroll
        for (int j = 0; j < 4; ++j) { const f32x4 g = ((const f32x4*)w_pre2)[lane + 64 * j]; const f32x4 t = v[j] * rstd2 * g;
            o8[64 * j] = (unsigned long long)pk2(t.x, t.y) | ((unsigned long long)pk2(t.z, t.w) << 32); }
    }
}
__device__ __forceinline__ void phase_rows2(const float* dn, const float* w, float* out, int gw, int NGW, int lane) {
    for (int m = gw; m < M; m += NGW) {
        f32x4 v[4]; float s = 0.f;
#pragma unroll
        for (int j = 0; j < 4; ++j) { v[j] = ((const f32x4*)(dn + (size_t)m * D))[lane + 64 * j]; s += (v[j].x * v[j].x + v[j].y * v[j].y) + (v[j].z * v[j].z + v[j].w * v[j].w); }
        const float rstd = rsqrtf(wave_sum(s) * (1.f / D) + EPS);
#pragma unroll
        for (int j = 0; j < 4; ++j) { const f32x4 g = ((const f32x4*)w)[lane + 64 * j]; f32x4* op = (f32x4*)(out + (size_t)m * D) + lane + 64 * j; *op = *op + v[j] * rstd * g; }
    }
}
__device__ __forceinline__ float gelu_tanh(float x) { const float y = 0.7978845608028654f * (x + 0.044715f * x * x * x); const float t = 1.f - 2.f / (1.f + __expf(2.f * y)); return 0.5f * x * (1.f + t); }
__device__ __forceinline__ void phase_h(const bf16* Gt, bf16* UP, const float* st_ffn, const float* cw, const float* cb, float* out, int gtid, int nth) {
    constexpr int CG = FF / 8;
    for (int idx = gtid; idx < M * CG; idx += nth) {
        const int m = idx / CG, c = (idx % CG) * 8;
        float g2[8], g1[8], g0[8];
        { const v4u t = *(const v4u*)(Gt + (size_t)m * FF + c); g2[0] = bflo(t.x); g2[1] = bfhi(t.x); g2[2] = bflo(t.y); g2[3] = bfhi(t.y); g2[4] = bflo(t.z); g2[5] = bfhi(t.z); g2[6] = bflo(t.w); g2[7] = bfhi(t.w); }
        int tpos, bsm = 0; const bool smp = m >= MP;
        if (smp) { tpos = (m - MP) & 31; bsm = (m - MP) >> 5; } else tpos = m & (SEQ - 1);
        if (tpos >= 1) { const v4u t = *(const v4u*)(Gt + (size_t)(m - 1) * FF + c); g1[0] = bflo(t.x); g1[1] = bfhi(t.x); g1[2] = bflo(t.y); g1[3] = bfhi(t.y); g1[4] = bflo(t.z); g1[5] = bfhi(t.z); g1[6] = bflo(t.w); g1[7] = bfhi(t.w); }
        else if (smp) { const float* s = st_ffn + ((size_t)bsm * 2 + 1) * FF + c;
#pragma unroll
            for (int e = 0; e < 8; ++e) g1[e] = s[e]; }
        else {
#pragma unroll
            for (int e = 0; e < 8; ++e) g1[e] = 0.f; }
        if (tpos >= 2) { const v4u t = *(const v4u*)(Gt + (size_t)(m - 2) * FF + c); g0[0] = bflo(t.x); g0[1] = bfhi(t.x); g0[2] = bflo(t.y); g0[3] = bfhi(t.y); g0[4] = bflo(t.z); g0[5] = bfhi(t.z); g0[6] = bflo(t.w); g0[7] = bfhi(t.w); }
        else if (smp) { const float* s = st_ffn + ((size_t)bsm * 2 + tpos) * FF + c;
#pragma unroll
            for (int e = 0; e < 8; ++e) g0[e] = s[e]; }
        else {
#pragma unroll
            for (int e = 0; e < 8; ++e) g0[e] = 0.f; }
        const v4u ut = *(const v4u*)(UP + (size_t)m * FF + c);
        float up[8] = {bflo(ut.x), bfhi(ut.x), bflo(ut.y), bfhi(ut.y), bflo(ut.z), bfhi(ut.z), bflo(ut.w), bfhi(ut.w)};
        float hv[8];
#pragma unroll
        for (int e = 0; e < 8; ++e) { const float x = cw[c + e] * g0[e] + cw[FF + c + e] * g1[e] + cw[2 * FF + c + e] * g2[e] + cb[c + e]; hv[e] = gelu_tanh(x) * up[e]; }
        const v4u o = {pk2(hv[0], hv[1]), pk2(hv[2], hv[3]), pk2(hv[4], hv[5]), pk2(hv[6], hv[7])};
        *(v4u*)(UP + (size_t)m * FF + c) = o;
        const int tl = smp ? 32 : SEQ;
        if (tpos >= tl - 2) { const int i = tpos - (tl - 2); float* op = smp ? out + O_FCS + ((size_t)bsm * 2 + i) * FF + c : out + O_FCP + ((size_t)(m >> 12) * 2 + i) * FF + c;
#pragma unroll
            for (int e = 0; e < 8; ++e) op[e] = g2[e]; }
    }
}

#ifndef MK_N_LAUNCHES
#define MK_N_LAUNCHES 1
#endif
constexpr int NPH = 10;
constexpr int N_LAUNCHES = MK_N_LAUNCHES;
struct Args { const float* in[23]; float* out; unsigned char* ws; int ph_lo, ph_hi, li, pad; };
__global__ void __launch_bounds__(NWAVES * 64, 2) hybrid_fwd(Args args) {
    extern __shared__ __attribute__((aligned(16))) unsigned char lds_raw[];
    LAS unsigned char* lds = (LAS unsigned char*)lds_raw;
    volatile LAS unsigned* MISC = (volatile LAS unsigned*)(lds + MISC_OFF);
    const int tid = threadIdx.x, lane = tid & 63, wave = __builtin_amdgcn_readfirstlane(tid >> 6);
    const int G = gridDim.x; const int bx = blockIdx.x; const int vcu = (G % 8 == 0) ? (bx % 8) * (G / 8) + bx / 8 : bx;
    unsigned char* ws = args.ws; float* out = args.out;
    gu32* ctl = (gu32*)(ws + WS_CTL);
#define x_prompt (args.in[0])
#define x_sample (args.in[1])
#define cache_k (args.in[2])
#define cache_v (args.in[3])
#define state_delta (args.in[4])
#define state_qkv (args.in[5])
#define state_ffn (args.in[6])
#define norm_mix_pre (args.in[7])
#define w_in (args.in[8])
#define qkv_conv_w (args.in[9])
#define a_log (args.in[10])
#define dt_bias (args.in[11])
#define gdn_norm_w (args.in[12])
#define rel_bias (args.in[13])
#define attn_norm_w (args.in[14])
#define w_out (args.in[15])
#define norm_mix_post (args.in[16])
#define norm_ffn_pre (args.in[17])
#define w_gate_up (args.in[18])
#define ffn_conv_w (args.in[19])
#define ffn_conv_b (args.in[20])
#define w_down (args.in[21])
#define norm_ffn_post (args.in[22])
#define Win_t ((bf16*)(ws + WS_WIN))
#define Wout_t ((bf16*)(ws + WS_WOUT))
#define Wgu_t ((bf16*)(ws + WS_WGU))
#define Wdn_t ((bf16*)(ws + WS_WDN))
#define AB ((float*)(ws + WS_AB))
#define DL ((float*)(ws + WS_DL))
#define U ((bf16*)(ws + WS_U))
#define GQK ((bf16*)(ws + WS_GQK))
#define GS ((bf16*)(ws + WS_GS))
#define P ((bf16*)(ws + WS_P))
#define MIXIN ((bf16*)(ws + WS_MIXIN))
#define MIXOUT ((float*)(ws + WS_P))
#define Gt ((bf16*)(ws + WS_G))
#define UP ((bf16*)(ws + WS_UP))
#define DOWN ((float*)(ws + WS_G))
#define GMAIN ((bf16*)out)

    for (int u = tid; u < 64; u += NWAVES * 64) ((LAS unsigned*)(lds + MISC_OFF))[u] = 0u;
    __syncthreads();
    XcdBarrier bar; bar.bar = (unsigned*)(ctl + CW_BAR); bar.x = 0; bar.st = nullptr;
    if (N_LAUNCHES == 1) bar = xcd_barrier_post((unsigned*)(ctl + CW_BAR), MISC + 8);
#define GRID_BAR() do { if (N_LAUNCHES == 1) xcd_barrier(bar); } while (0)
    const int lo = args.ph_lo, hi_ = args.ph_hi;
#define IN(k) (lo <= (k) && (k) < hi_)
#define BOTH(k) (IN(k) && IN((k) + 1))
    const int gw = vcu * NWAVES + wave, NGW = G * NWAVES, gtid = bx * (NWAVES * 64) + tid, nth = G * NWAVES * 64;

    if (IN(0)) { phase_prologue(lds, x_prompt, x_sample, norm_mix_pre, w_in, w_out, w_gate_up, w_down, ws, vcu, G, tid, lane, wave); if (BOTH(0)) GRID_BAR(); }

    if (IN(1)) {
        pg8::Gemm g{U, Win_t, M, NIN, D}; pg8::StaticOrder S; S.init(M, NIN, G, bx);
        pg8::EpiBf16<0> E{P, NIN, nullptr, 0, 0, 1.f};
        pg8::gemm_phase<pg8::EpiBf16<0>, pg8::StaticOrder, true, true>(lds, g, S, E);
        if (BOTH(1)) GRID_BAR();
    }

    if (IN(2)) {
        phase_copy_outputs(P, out, gtid, nth);
        for (int u = bx; u < 1152; u += G) gdn_pre_unit(lds, u, P, AB, state_qkv, qkv_conv_w, a_log, dt_bias, GMAIN, GQK, GS, DL, tid, lane, wave);
        if (BOTH(2)) GRID_BAR();
    }

    if (IN(3)) {
        if (bx < 16) {
            const int b = bx >> 2, h = bx & 3; const int u0 = b * 256 + h * 64; const size_t m0 = (size_t)b * SEQ;
            scan_unit(lds, 64, 64, GMAIN + (size_t)u0 * 32768, 32768, GQK + (size_t)u0 * 4096, 4096, DL + u0, nullptr, out + O_DP + (size_t)(b * 4 + h) * 16384,
                      P + m0 * NIN + PC_Z + h * 128, MIXIN + m0 * D + h * 128, gdn_norm_w, tid, lane, wave);
        } else {
            for (int su = bx - 16; su < 128; su += (G - 16)) {
                const int b = su >> 2, h = su & 3; const size_t m0 = (size_t)MP + b * 32; const bf16* base = GS + (size_t)su * 36864;
                scan_unit(lds, 1, 32, base, 0, base + 32768, 0, DL + 1024 + su, state_delta + (size_t)su * 16384, out + O_DS + (size_t)su * 16384,
                          P + m0 * NIN + PC_Z + h * 128, MIXIN + m0 * D + h * 128, gdn_norm_w, tid, lane, wave);
            }
            __syncthreads();
            LAS unsigned char* wl = lds + wave * ATT_WAVE_LDS;
            for (int it = (bx - 16) * NWAVES + wave; it < 4352; it += (G - 16) * NWAVES) attn_item(wl, it, P, cache_k, cache_v, rel_bias, attn_norm_w, MIXIN, lane);
        }
        if (BOTH(3)) GRID_BAR();
    }

    if (IN(4)) {
        pg8::Gemm g{MIXIN, Wout_t, M, D, D}; pg8::StaticOrder S; S.init(M, D, G, bx);
        pg8::EpiF32 E{MIXOUT, D};
        pg8::gemm_phase<pg8::EpiF32, pg8::StaticOrder, true, true>(lds, g, S, E);
        if (BOTH(4)) GRID_BAR();
    }

    if (IN(5)) { phase_rows1(x_prompt, x_sample, MIXOUT, norm_mix_post, norm_ffn_pre, out, U, gw, NGW, lane); if (BOTH(5)) GRID_BAR(); }

    if (IN(6)) {
        pg8::Gemm g{U, Wgu_t, M, 2 * FF, D}; pg8::StaticOrder S; S.init(M, 2 * FF, G, bx);
        pg8::EpiBf16<0> E{Gt, FF, nullptr, FF, (size_t)M * FF, 1.f};
        pg8::gemm_phase<pg8::EpiBf16<0>, pg8::StaticOrder, true, true>(lds, g, S, E);
        if (BOTH(6)) GRID_BAR();
    }

    if (IN(7)) { phase_h(Gt, UP, state_ffn, ffn_conv_w, ffn_conv_b, out, gtid, nth); if (BOTH(7)) GRID_BAR(); }

    if (IN(8)) {
        pg8::Gemm g{UP, Wdn_t, M, D, FF}; pg8::StaticOrder S; S.init(M, D, G, bx);
        pg8::EpiF32 E{DOWN, D};
        pg8::gemm_phase<pg8::EpiF32, pg8::StaticOrder, true, true>(lds, g, S, E);
        if (BOTH(8)) GRID_BAR();
    }

    if (IN(9)) phase_rows2(DOWN, norm_ffn_post, out, gw, NGW, lane);
#undef IN
#undef BOTH
#undef GRID_BAR
}

extern "C" void kernel_launch(void* const* d_in, const int* in_sizes, int n_in, void* d_out, int out_size, void* d_ws, size_t ws_size, hipStream_t stream) {
    static int grid = 0;
    if (grid == 0) {
        if (n_in != 23 || out_size != 23699456 || ws_size < WS_END) { fprintf(stderr, "kernel_launch: unexpected shapes (n_in %d, out %d, ws %zu); nothing launched\n", n_in, out_size, ws_size); grid = -1; return; }
        int dev = 0, cus = 0, per_cu = 0;
        if (hipGetDevice(&dev) != hipSuccess || hipDeviceGetAttribute(&cus, hipDeviceAttributeMultiprocessorCount, dev) != hipSuccess) { grid = -1; return; }
        if (hipFuncSetAttribute((const void*)hybrid_fwd, hipFuncAttributeMaxDynamicSharedMemorySize, LDS_BYTES) != hipSuccess) { fprintf(stderr, "kernel_launch: hipFuncSetAttribute failed\n"); grid = -1; return; }
        if (hipOccupancyMaxActiveBlocksPerMultiprocessor(&per_cu, (const void*)hybrid_fwd, NWAVES * 64, LDS_BYTES) != hipSuccess || per_cu < 1) fprintf(stderr, "kernel_launch: occupancy query reports %d\n", per_cu);
        (void)hipGetLastError();
        grid = cus;
    }
    if (grid < 0) return;
    if (hipMemsetAsync((char*)d_ws + WS_CTL, 0, CTL_ZERO_BYTES, stream) != hipSuccess) { fprintf(stderr, "kernel_launch: memset failed\n"); return; }
    Args a{};
    for (int i = 0; i < 23; ++i) a.in[i] = (const float*)d_in[i];
    a.out = (float*)d_out; a.ws = (unsigned char*)d_ws;
    if (N_LAUNCHES == 1) { a.ph_lo = 0; a.ph_hi = NPH; a.li = 0; hipLaunchKernelGGL(hybrid_fwd, dim3(grid), dim3(NWAVES * 64), LDS_BYTES, stream, a); }
    else for (int li = 0; li < NPH; ++li) { a.ph_lo = li; a.ph_hi = li + 1; a.li = li; hipLaunchKernelGGL(hybrid_fwd, dim3(grid), dim3(NWAVES * 64), LDS_BYTES, stream, a); }
    const hipError_t le = hipPeekAtLastError();
    if (le != hipSuccess) fprintf(stderr, "kernel_launch: launch failed: %s\n", hipGetErrorName(le));
}
```

```cpp
#include <hip/hip_runtime.h>
#include <cstdio>
#include <cstdint>
namespace pg8 {
#define PG8_LAS __attribute__((address_space(3)))
typedef unsigned short bf16_t;
typedef short bf16x8 __attribute__((ext_vector_type(8)));
typedef float f32x4 __attribute__((ext_vector_type(4)));
typedef unsigned u32x4 __attribute__((ext_vector_type(4)));
constexpr int BM = 256, BK = 64, HALF = 128, HTB = HALF * BK * 2  , STAGE_BYTES = 8 * HTB, NXCD = 8, WGM = 8;

__host__ __device__ __forceinline__ int lds_byte(int r, int c) { const int st = (r >> 4) * 2 + (c >> 5), rr = r & 15, cc = c & 31, ob = rr * 64 + cc * 2; return st * 1024 + (ob ^ (((ob >> 9) & 1) << 5)); }
__host__ __device__ __forceinline__ void stage_rc(int b, int& R, int& C) { const int st = b / 1024, sb = b % 1024, swz = sb ^ (((sb >> 9) & 1) << 5); R = (st >> 1) * 16 + swz / 64; C = (st & 1) * 32 + (swz % 64) / 2; }
__host__ __device__ __forceinline__ int perm32(int rho) { const int n = rho >> 4, i = rho & 15; return 8 * (i >> 2) + 4 * n + (i & 3); }

struct Unit { int pm, pn; };
struct Gemm { const bf16_t* A; const bf16_t* Bt; int M, N, K; };

struct StaticOrder {
    int nM, nN, nwg, G, c;
    __host__ __device__ void init(int M, int N, int G_, int c_) { nM = M / BM; nN = N / BM; nwg = nM * nN; G = G_; c = c_; }
    __host__ __device__ bool next(int i, Unit& u) const {
        const long L = (long)i * G + c; if (L >= nwg) return false;
        int wgid = (int)L; { const int q = nwg / NXCD, r = nwg % NXCD, xcd = wgid % NXCD, off = wgid / NXCD; wgid = (xcd < r ? xcd * (q + 1) : r * (q + 1) + (xcd - r) * q) + off; }
        const int nig = WGM * nN, gid = wgid / nig, fm = gid * WGM, gsz = (nM - fm) < WGM ? (nM - fm) : WGM;
        u.pm = fm + ((wgid % nig) % gsz); u.pn = (wgid % nig) / gsz; return true;
    }
    __device__ __forceinline__ void a_ready(const Unit&) const {}
    __device__ __forceinline__ void done(const Unit&) const {}
};

__device__ __forceinline__ unsigned cvt_pk_bf16(float lo, float hi) { unsigned r; asm volatile("v_cvt_pk_bf16_f32 %0, %1, %2" : "=v"(r) : "v"(lo), "v"(hi)); return r; }
typedef float f32x2 __attribute__((ext_vector_type(2)));
__device__ __forceinline__ f32x2 gelu_pk(f32x2 v) {
    const f32x2 av = __builtin_elementwise_abs(v), d = av * 0.2316418882f + 1.0f;
    f32x2 t; t.x = __builtin_amdgcn_rcpf(d.x); t.y = __builtin_amdgcn_rcpf(d.y);
    f32x2 q = t * 0.5307027145f + (-0.7265760135f); q = q * t + 0.7107068705f; q = q * t + (-0.142248368f); q = q * t + 0.127414796f; q = q * t;
    const f32x2 s = (v * v) * (-0.72134752044f);
    f32x2 e; e.x = __builtin_amdgcn_exp2f(s.x); e.y = __builtin_amdgcn_exp2f(s.y);
    const f32x2 m = v * (q * e), r = v - m;
    f32x2 o; o.x = v.x < 0.f ? m.x : r.x; o.y = v.y < 0.f ? m.y : r.y; return o;
}

template <int ACT  > struct EpiBf16 {
    static constexpr bool PERM = true, AFTER_DRAIN = false; static_assert(ACT == 0 || ACT == 1, "EpiBf16: ACT is 0 (none) or 1 (gelu_pk)");
    bf16_t* O; int ldc; const float* bias; int split_cols; size_t split_stride; float scale0;
    __device__ __forceinline__ void operator()(const f32x4 (&acc)[2][2][4][2], const Unit& u, int wr, int wc, int fr, int fq) const {
        const int row0 = u.pm * BM + wr * 64 + fr; int colt = u.pn * BM; bf16_t* base = O;
        float sc = 1.f; if (split_cols) { const int t = colt / split_cols; base += (size_t)t * split_stride; colt -= t * split_cols; if (t == 0) sc = scale0; }
        const int col0 = colt + wc * 32 + 8 * fq, bcol0 = u.pn * BM + wc * 32 + 8 * fq;
        f32x4 bv[2][2];
#pragma unroll
        for (int bj = 0; bj < 2; ++bj)
#pragma unroll
            for (int n = 0; n < 2; ++n) bv[bj][n] = bias ? *(const f32x4*)(bias + bcol0 + bj * HALF + 4 * n) : (f32x4){0.f, 0.f, 0.f, 0.f};
#pragma unroll
        for (int ai = 0; ai < 2; ++ai)
#pragma unroll
            for (int m = 0; m < 4; ++m) { bf16_t* rowp = base + (size_t)(row0 + ai * HALF + m * 16) * ldc + col0;
#pragma unroll
                for (int bj = 0; bj < 2; ++bj) { f32x4 v0 = acc[ai][bj][m][0] + bv[bj][0], v1 = acc[ai][bj][m][1] + bv[bj][1];
                    if (ACT == 1) { f32x2 a = gelu_pk((f32x2){v0[0], v0[1]}), b = gelu_pk((f32x2){v0[2], v0[3]}), c = gelu_pk((f32x2){v1[0], v1[1]}), d = gelu_pk((f32x2){v1[2], v1[3]});
                        v0 = (f32x4){a.x, a.y, b.x, b.y}; v1 = (f32x4){c.x, c.y, d.x, d.y}; }
                    v0 = v0 * sc; v1 = v1 * sc; u32x4 w; w.x = cvt_pk_bf16(v0[0], v0[1]); w.y = cvt_pk_bf16(v0[2], v0[3]); w.z = cvt_pk_bf16(v1[0], v1[1]); w.w = cvt_pk_bf16(v1[2], v1[3]);
                    *(u32x4*)(rowp + bj * HALF) = w; } }
    }
};

struct EpiF32 {
    static constexpr bool PERM = false, AFTER_DRAIN = false;
    float* O; int ldc;
    __device__ __forceinline__ void operator()(const f32x4 (&acc)[2][2][4][2], const Unit& u, int wr, int wc, int fr, int fq) const {
        const int row0 = u.pm * BM + wr * 64 + fr, col0 = u.pn * BM + wc * 32 + 4 * fq;
#pragma unroll
        for (int ai = 0; ai < 2; ++ai)
#pragma unroll
            for (int m = 0; m < 4; ++m) { float* rowp = O + (size_t)(row0 + ai * HALF + m * 16) * ldc + col0;
#pragma unroll
                for (int bj = 0; bj < 2; ++bj)
#pragma unroll
                    for (int n = 0; n < 2; ++n) *(f32x4*)(rowp + bj * HALF + n * 16) = acc[ai][bj][m][n]; }
    }
};

template <class Epi, class Sched, bool ALIGN_EPI = false, bool SP2 = false>
__device__ __forceinline__ void gemm_phase(PG8_LAS unsigned char* lds, const Gemm g, const Sched& S, const Epi& E) {
    const int tid = threadIdx.x, wid = __builtin_amdgcn_readfirstlane(tid >> 6), lane = tid & 63, wr = wid >> 2, wc = wid & 3, fr = lane & 15, fq = lane >> 4;
    const int K = g.K, nt = K / BK;
    unsigned voffA[2], voffB[2];
#pragma unroll
    for (int i = 0; i < 2; ++i) { int R, C; stage_rc(tid * 16 + i * 8192, R, C); const int Rb = Epi::PERM ? ((R & ~31) + perm32(R & 31)) : R;
        voffA[i] = (unsigned)(R * K + C) * 2u; voffB[i] = (unsigned)(Rb * K + C) * 2u; }
    const size_t kstep = (size_t)(BK * 2);
    const size_t hstep = (size_t)HALF * K * 2;
    const size_t tstep = 2 * hstep;
    const unsigned ldsw = (unsigned)wid * 1024u;
    const int aoff = lds_byte(wr * 64 + fr, fq * 8), boff = lds_byte(wc * 32 + fr, fq * 8);
#define PG8_SA(b, h) (((b) * 2 + (h)) * HTB)
#define PG8_SB(b, h) ((4 + (b) * 2 + (h)) * HTB)
#define PG8_STAGE(bufoff, gbase, voff) do { _Pragma("unroll") for (int _i = 0; _i < 2; ++_i) \
        __builtin_amdgcn_global_load_lds((const unsigned*)((const char*)(gbase) + (voff)[_i]), (PG8_LAS unsigned*)(lds + (bufoff) + ldsw + _i * 8192), 16, 0, 0); } while (0)
#define PG8_LDA(dst, b, h) do { _Pragma("unroll") for (int m = 0; m < 4; ++m) _Pragma("unroll") for (int k = 0; k < 2; ++k) dst[m][k] = *(const PG8_LAS bf16x8*)(lds + PG8_SA(b, h) + aoff + m * 2048 + k * 1024); } while (0)
#define PG8_LDB(dst, b, h) do { _Pragma("unroll") for (int n = 0; n < 2; ++n) _Pragma("unroll") for (int k = 0; k < 2; ++k) dst[n][k] = *(const PG8_LAS bf16x8*)(lds + PG8_SB(b, h) + boff + n * 2048 + k * 1024); } while (0)
#define PG8_MMA(ai, bj, At, Bt) do { __builtin_amdgcn_s_setprio(1); _Pragma("unroll") for (int m = 0; m < 4; ++m) _Pragma("unroll") for (int n = 0; n < 2; ++n) _Pragma("unroll") for (int k = 0; k < 2; ++k) \
        acc[ai][bj][m][n] = __builtin_amdgcn_mfma_f32_16x16x32_bf16(Bt[n][k], At[m][k], acc[ai][bj][m][n], 0, 0, 0); __builtin_amdgcn_s_setprio(0); } while (0)
#define PG8_WAIT_V(n) asm volatile("s_waitcnt vmcnt(" #n ")" ::: "memory")
#define PG8_WAIT_L(n) asm volatile("s_waitcnt lgkmcnt(" #n ")" ::: "memory")
#define PG8_BAR __builtin_amdgcn_s_barrier()
#define PG8_SCHED __builtin_amdgcn_sched_barrier(0)
    Unit cur, nxt; int ui = 0;
    if (!S.next(0, cur)) return;
    f32x4 acc[2][2][4][2];
#pragma unroll
    for (int a = 0; a < 2; ++a)
#pragma unroll
        for (int b = 0; b < 2; ++b)
#pragma unroll
            for (int m = 0; m < 4; ++m)
#pragma unroll
                for (int n = 0; n < 2; ++n) acc[a][b][m][n] = (f32x4){0.f, 0.f, 0.f, 0.f};
    bf16x8 At[4][2], B0[2][2], B1[2][2];
    const char* cA = (const char*)g.A + (size_t)cur.pm * tstep; const char* cB = (const char*)g.Bt + (size_t)cur.pn * tstep;
    S.a_ready(cur);
    if constexpr (SP2) {
        PG8_STAGE(PG8_SB(0, 0), cB, voffB); PG8_STAGE(PG8_SB(0, 1), cB + hstep, voffB); PG8_STAGE(PG8_SA(0, 0), cA, voffA); PG8_STAGE(PG8_SA(0, 1), cA + hstep, voffA);
        if (wr == 1) PG8_BAR;
        PG8_WAIT_V(2); PG8_BAR;
        PG8_STAGE(PG8_SB(1, 0), cB + kstep, voffB); PG8_STAGE(PG8_SA(1, 0), cA + kstep, voffA); PG8_STAGE(PG8_SB(1, 1), cB + hstep + kstep, voffB);
        PG8_WAIT_V(6); PG8_BAR;
    } else {
        PG8_STAGE(PG8_SB(0, 0), cB, voffB); PG8_STAGE(PG8_SA(0, 0), cA, voffA); PG8_STAGE(PG8_SB(0, 1), cB + hstep, voffB); PG8_STAGE(PG8_SA(0, 1), cA + hstep, voffA);
        if (wr == 1) PG8_BAR;
        PG8_WAIT_V(4); PG8_BAR;
        PG8_STAGE(PG8_SB(1, 0), cB + kstep, voffB); PG8_STAGE(PG8_SA(1, 0), cA + kstep, voffA); PG8_STAGE(PG8_SB(1, 1), cB + hstep + kstep, voffB);
        PG8_WAIT_V(6); PG8_BAR;
    }
    for (;;) {
        const bool has_next = S.next(ui + 1, nxt);
        const char* nA = has_next ? (const char*)g.A + (size_t)nxt.pm * tstep : cA; const char* nB = has_next ? (const char*)g.Bt + (size_t)nxt.pn * tstep : cB;
        for (int t = 0; t < nt; t += 2) {
            const bool last = (t == nt - 2);
            const char* a1 = cA + (size_t)(t + 1) * kstep;
            const char* a2 = last ? nA : cA + (size_t)(t + 2) * kstep; const char* b2 = last ? nB : cB + (size_t)(t + 2) * kstep;
            const char* a3 = a2 + kstep; const char* b3 = b2 + kstep;
            if (last && has_next) S.a_ready(nxt);
            if constexpr (SP2) {
            PG8_LDB(B0, 0, 0); PG8_LDB(B1, 0, 1); PG8_SCHED; PG8_LDA(At, 0, 0); PG8_STAGE(PG8_SA(1, 1), a1 + hstep, voffA);
            PG8_WAIT_V(8); PG8_WAIT_L(0); PG8_BAR; PG8_MMA(0, 0, At, B0); PG8_MMA(0, 1, At, B1); PG8_BAR; PG8_SCHED;
            PG8_LDA(At, 0, 1); PG8_STAGE(PG8_SB(0, 0), b2, voffB); PG8_STAGE(PG8_SB(0, 1), b2 + hstep, voffB); PG8_STAGE(PG8_SA(0, 0), a2, voffA);
            PG8_WAIT_V(8); PG8_WAIT_L(0); PG8_BAR; PG8_MMA(1, 0, At, B0); PG8_MMA(1, 1, At, B1); PG8_BAR; PG8_SCHED;
            PG8_LDB(B0, 1, 0); PG8_LDB(B1, 1, 1); PG8_SCHED; PG8_LDA(At, 1, 0); PG8_STAGE(PG8_SA(0, 1), a2 + hstep, voffA);
            PG8_WAIT_V(8); PG8_WAIT_L(0); PG8_BAR; PG8_MMA(0, 0, At, B0); PG8_MMA(0, 1, At, B1); PG8_BAR; PG8_SCHED;
            PG8_LDA(At, 1, 1); PG8_STAGE(PG8_SB(1, 0), b3, voffB); PG8_STAGE(PG8_SB(1, 1), b3 + hstep, voffB); PG8_STAGE(PG8_SA(1, 0), a3, voffA);
            PG8_WAIT_V(8); PG8_WAIT_L(0); PG8_BAR; PG8_MMA(1, 0, At, B0); PG8_MMA(1, 1, At, B1); PG8_BAR; PG8_SCHED;
            } else {
            PG8_LDB(B0, 0, 0); PG8_SCHED; PG8_LDA(At, 0, 0); PG8_STAGE(PG8_SA(1, 1), a1 + hstep, voffA);
            PG8_WAIT_L(8); PG8_BAR; PG8_WAIT_L(0); PG8_MMA(0, 0, At, B0); PG8_BAR; PG8_SCHED;
            PG8_LDB(B1, 0, 1); PG8_STAGE(PG8_SB(0, 0), b2, voffB);
            PG8_BAR; PG8_WAIT_L(0); PG8_MMA(0, 1, At, B1); PG8_BAR;
            PG8_LDA(At, 0, 1); PG8_STAGE(PG8_SA(0, 0), a2, voffA);
            PG8_BAR; PG8_WAIT_L(0); PG8_MMA(1, 0, At, B0); PG8_BAR; PG8_SCHED;
            PG8_STAGE(PG8_SB(0, 1), b2 + hstep, voffB);
            PG8_WAIT_V(6); PG8_BAR; PG8_MMA(1, 1, At, B1); PG8_BAR;
            PG8_LDB(B0, 1, 0); PG8_SCHED; PG8_LDA(At, 1, 0); PG8_STAGE(PG8_SA(0, 1), a2 + hstep, voffA);
            PG8_WAIT_L(8); PG8_BAR; PG8_WAIT_L(0); PG8_MMA(0, 0, At, B0); PG8_BAR; PG8_SCHED;
            PG8_LDB(B1, 1, 1); PG8_STAGE(PG8_SB(1, 0), b3, voffB);
            PG8_BAR; PG8_WAIT_L(0); PG8_MMA(0, 1, At, B1); PG8_BAR;
            PG8_LDA(At, 1, 1); PG8_STAGE(PG8_SA(1, 0), a3, voffA);
            PG8_BAR; PG8_WAIT_L(0); PG8_MMA(1, 0, At, B0); PG8_BAR; PG8_SCHED;
            PG8_STAGE(PG8_SB(1, 1), b3 + hstep, voffB);
            PG8_WAIT_V(6); PG8_BAR; PG8_MMA(1, 1, At, B1); PG8_BAR;
            }
        }
        if constexpr (ALIGN_EPI) { if (wr == 0) PG8_BAR; }
        if constexpr (!Epi::AFTER_DRAIN) { E(acc, cur, wr, wc, fr, fq); S.done(cur); }
        if (!has_next) break;
#pragma unroll
        for (int a = 0; a < 2; ++a)
#pragma unroll
            for (int b = 0; b < 2; ++b)
#pragma unroll
                for (int m = 0; m < 4; ++m)
#pragma unroll
                    for (int n = 0; n < 2; ++n) acc[a][b][m][n] = (f32x4){0.f, 0.f, 0.f, 0.f};
        cur = nxt; cA = nA; cB = nB; ++ui;
        if constexpr (ALIGN_EPI) { if (wr == 1) PG8_BAR; }
    }
    PG8_WAIT_V(0);
    if constexpr (!ALIGN_EPI) { if (wr == 0) PG8_BAR; }
    PG8_BAR;
    if constexpr (Epi::AFTER_DRAIN) { E.fused(acc, cur, wr, wc, fr, fq, lds, wid, lane); S.done(cur); }
#undef PG8_SA
#undef PG8_SB
#undef PG8_STAGE
#undef PG8_LDA
#undef PG8_LDB
#undef PG8_MMA
#undef PG8_WAIT_V
#undef PG8_WAIT_L
#undef PG8_BAR
#undef PG8_SCHED
}
}

constexpr int NWAVES = 8;
constexpr int D = 1024, SEQ = 4096, MP = 16384, MS = 1024, M = MP + MS;
constexpr int NIN = 3584, INC = 3592, FF = 2816;
constexpr int PC_Z = 1536, PC_QB = 2048, PC_KB = 2560, PC_VB = 3072;
constexpr float EPS = 1e-6f;
constexpr size_t O_YP = 0, O_YS = 16777216, O_BKP = 17825792, O_BVP = 18874368, O_DP = 19922944, O_QCP = 20185088, O_FCP = 20203520,
                 O_BKS = 20226048, O_BVS = 20750336, O_DS = 21274624, O_QCS = 23371776, O_FCS = 23519232;
constexpr size_t MiB = 1u << 20;
constexpr size_t WS_CTL = 0, CTL_ZERO_BYTES = 1 * MiB;
constexpr size_t WS_WIN = 1 * MiB, WS_WOUT = 8 * MiB, WS_WGU = 10 * MiB, WS_WDN = 21 * MiB;
constexpr size_t WS_AB = 27 * MiB, WS_DL = 27 * MiB + 768 * 1024;
constexpr size_t WS_U = 28 * MiB;
constexpr size_t WS_GQK = WS_U, WS_GS = WS_U + 8 * MiB;
constexpr size_t WS_P = 62 * MiB;
constexpr size_t WS_MIXIN = 181 * MiB;
constexpr size_t WS_G = WS_P, WS_UP = WS_P + (size_t)M * FF * 2;
constexpr size_t WS_END = 256 * MiB;
static_assert(WS_UP + (size_t)M * FF * 2 <= WS_END, "ws map");
constexpr int CW_BAR = 4096;

constexpr int LDS_BYTES = 163840;
constexpr int MISC_OFF = LDS_BYTES - 256;

#define GAS __attribute__((address_space(1)))
#define LAS __attribute__((address_space(3)))
typedef unsigned short bf16;
typedef unsigned v4u __attribute__((ext_vector_type(4)));
typedef unsigned v2u __attribute__((ext_vector_type(2)));
typedef float f32x2 __attribute__((ext_vector_type(2)));
typedef float f32x4 __attribute__((ext_vector_type(4)));
typedef float f32x16 __attribute__((ext_vector_type(16)));
typedef short bf16x8 __attribute__((ext_vector_type(8)));
typedef short s16x4 __attribute__((ext_vector_type(4)));
typedef __bf16 bf16x2_t __attribute__((ext_vector_type(2)));
typedef GAS unsigned gu32;
#define RLX_AGENT __ATOMIC_RELAXED, __HIP_MEMORY_SCOPE_AGENT
#define LDS_WAIT() asm volatile("s_waitcnt lgkmcnt(0)" ::: "memory")
#define VM_WAIT() asm volatile("s_waitcnt vmcnt(0)" ::: "memory")
__device__ __forceinline__ unsigned pk2(float lo, float hi) { f32x2 v = {lo, hi}; bf16x2_t b = __builtin_convertvector(v, bf16x2_t); return __builtin_bit_cast(unsigned, b); }
__device__ __forceinline__ float bflo(unsigned w) { return __uint_as_float(w << 16); }
__device__ __forceinline__ float bfhi(unsigned w) { return __uint_as_float(w & 0xffff0000u); }
__device__ __forceinline__ float bf1(bf16 b) { return __uint_as_float((unsigned)b << 16); }
__device__ __forceinline__ bf16 f2bf(float f) { return (bf16)(pk2(f, 0.f) & 0xffffu); }
__device__ __forceinline__ float wave_sum(float v) {
#pragma unroll
    for (int o = 1; o < 64; o <<= 1) v += __shfl_xor(v, o);
    return v;
}
__device__ __forceinline__ float sigmoidf_(float x) { return 1.0f / (1.0f + __expf(-x)); }
__device__ __forceinline__ int crow(int r, int hi) { return (r & 3) + 8 * (r >> 2) + 4 * hi; }
#define MFMA32(a, b, c) __builtin_amdgcn_mfma_f32_32x32x16_bf16((a), (b), (c), 0, 0, 0)
#define MFMA16(a, b, c) __builtin_amdgcn_mfma_f32_16x16x32_bf16((a), (b), (c), 0, 0, 0)
#define XB_TMO      128
#define XB_XCNT(j)  (256  + 64 * (j))
#define XB_XSUB(j)  (1280 + 64 * (j))
#define XB_XGEN(j)  (2304 + 64 * (j))
#define XB_TOP      3328
#define XB_TOPGEN   3392
#define XCD_BAR_WORDS 3456
#define XB_SPIN_CAP (1u << 18)

__device__ __forceinline__ unsigned xb_ld(unsigned* p)              { return __hip_atomic_load(p, __ATOMIC_RELAXED, __HIP_MEMORY_SCOPE_AGENT); }
__device__ __forceinline__ unsigned xb_add(unsigned* p, unsigned v) { return __hip_atomic_fetch_add(p, v, __ATOMIC_RELAXED, __HIP_MEMORY_SCOPE_AGENT); }
__device__ __forceinline__ unsigned xb_xcc_id() { return (unsigned)__builtin_amdgcn_s_getreg((3 << 11) | 20) & 0xFu; }
#define XB_SPIN(cond, bar) do { unsigned _sp = 0; while (cond) { __builtin_amdgcn_s_sleep(1); \
    if ((++_sp & 255u) == 0u) { if (xb_ld(&(bar)[XB_TMO])) break; if (_sp > XB_SPIN_CAP) { atomicAdd(&(bar)[XB_TMO], 1u); break; } } } } while (0)

struct XcdBarrier {
    unsigned* bar; unsigned x;
    volatile LAS unsigned* st;
};

__device__ __forceinline__ XcdBarrier xcd_barrier_post(unsigned* bar, volatile LAS unsigned* st) {
    XcdBarrier b; b.bar = bar; b.x = xb_xcc_id(); b.st = st;
    if (threadIdx.x == 0) (void)xb_add(&bar[XB_XCNT(b.x)], 1u);
    return b;
}
__device__ __forceinline__ void xcd_barrier_complete(unsigned* bar, unsigned x, unsigned& nloc, unsigned& nx) {
    const unsigned G = gridDim.x * gridDim.y * gridDim.z;
    unsigned sum, cnt, mine, sp = 0u;
    for (;;) {
        sum = 0u; cnt = 0u; mine = 0u;
#pragma unroll
        for (unsigned j = 0; j < 16; ++j) { const unsigned c = xb_ld(&bar[XB_XCNT(j)]); sum += c; cnt += (c > 0u) ? 1u : 0u; mine = (j == x) ? c : mine; }
        if (sum == G) break;
        __builtin_amdgcn_s_sleep(1);
        if ((++sp & 255u) == 0u) { if (xb_ld(&bar[XB_TMO])) break; if (sp > XB_SPIN_CAP) { atomicAdd(&bar[XB_TMO], 1u); break; } }
    }
    nloc = mine > 0u ? mine : 1u; nx = cnt > 0u ? cnt : 1u;
}

__device__ __forceinline__ void xcd_barrier(const XcdBarrier& b) {
    asm volatile("s_waitcnt vmcnt(0)" ::: "memory");
    __syncthreads();
    if (threadIdx.x == 0) {
        unsigned* bar = b.bar;
        __builtin_amdgcn_s_waitcnt(0);
        unsigned nloc = b.st[0], nx = b.st[1];
        if (nloc == 0u) { xcd_barrier_complete(bar, b.x, nloc, nx); b.st[0] = nloc; b.st[1] = nx; }
        const unsigned old = xb_add(&bar[XB_XSUB(b.x)], 1u);
        const unsigned gen = old / nloc;
        if (old + 1u == (gen + 1u) * nloc) {
            __builtin_amdgcn_fence(__ATOMIC_RELEASE, "agent");
            asm volatile("s_waitcnt vmcnt(0)" ::: "memory");
            const unsigned og = xb_add(&bar[XB_TOP], 1u);
            const unsigned tg = og / nx;
            if (og + 1u == (tg + 1u) * nx) xb_add(&bar[XB_TOPGEN], 1u);
            else XB_SPIN(xb_ld(&bar[XB_TOPGEN]) == tg, bar);
            __builtin_amdgcn_fence(__ATOMIC_ACQUIRE, "agent");
            xb_add(&bar[XB_XGEN(b.x)], 1u);
            asm volatile("s_waitcnt vmcnt(0)" ::: "memory");
        } else {
            XB_SPIN(xb_ld(&bar[XB_XGEN(b.x)]) == gen, bar);
            __builtin_amdgcn_fence(__ATOMIC_ACQUIRE, "agent");
            asm volatile("s_waitcnt vmcnt(0)" ::: "memory");
        }
    }
    __syncthreads();
}

__device__ __forceinline__ void p0_transpose_item(const float* W, int ldw, int K, int N, bf16* WT, int row_off, LAS float* scr, int item, int lane) {
    const int nblk = N / 32, kb = item / nblk, nb = item % nblk, k0 = 64 * kb, n0 = 32 * nb;
#pragma unroll 8
    for (int i = 0; i < 32; ++i) { const int kk = 2 * i + (lane >> 5); scr[kk * 33 + (lane & 31)] = W[(size_t)(k0 + kk) * ldw + n0 + (lane & 31)]; }
    LDS_WAIT(); asm volatile("" ::: "memory");
    const int c = lane & 7;
#pragma unroll
    for (int j = 0; j < 4; ++j) { const int n = (lane >> 3) + 8 * j; const LAS float* s = scr + (8 * c) * 33 + n;
        v4u o; o.x = pk2(s[0 * 33], s[1 * 33]); o.y = pk2(s[2 * 33], s[3 * 33]); o.z = pk2(s[4 * 33], s[5 * 33]); o.w = pk2(s[6 * 33], s[7 * 33]);
        *(v4u*)(WT + (size_t)(row_off + n0 + n) * K + k0 + 8 * c) = o; }
    LDS_WAIT(); asm volatile("" ::: "memory");
}

__device__ __forceinline__ void phase_prologue(LAS unsigned char* lds, const float* xp, const float* xs, const float* nw, const float* w_in, const float* w_out, const float* w_gu, const float* w_dn,
                                               unsigned char* ws, int vcu, int G, int tid, int lane, int wave) {
    LAS float* scr = (LAS float*)(lds + wave * 8448);
    LAS float* W8T = (LAS float*)(lds + 67584);
    for (int k = tid; k < 1024; k += 512) {
        const f32x4 a = *(const f32x4*)(w_in + (size_t)k * INC + 2048), b = *(const f32x4*)(w_in + (size_t)k * INC + 2052);
        W8T[0 * 1024 + k] = a.x; W8T[1 * 1024 + k] = a.y; W8T[2 * 1024 + k] = a.z; W8T[3 * 1024 + k] = a.w;
        W8T[4 * 1024 + k] = b.x; W8T[5 * 1024 + k] = b.y; W8T[6 * 1024 + k] = b.z; W8T[7 * 1024 + k] = b.w;
    }
    __syncthreads();
    const int gw = vcu * NWAVES + wave, NGW = G * NWAVES;
    bf16* Win_t = (bf16*)(ws + WS_WIN); bf16* Wout_t = (bf16*)(ws + WS_WOUT); bf16* Wgu_t = (bf16*)(ws + WS_WGU); bf16* Wdn_t = (bf16*)(ws + WS_WDN);
    constexpr int I_A = 16 * 64, I_B = 16 * 48, I_O = 16 * 32, I_GU = 16 * 176, I_DN = 44 * 32;
    constexpr int NITEMS = I_A + I_B + I_O + I_GU + I_DN;
    for (int it = gw; it < NITEMS; it += NGW) {
        int r = it;
        if (r < I_A) { p0_transpose_item(w_in, INC, D, 2048, Win_t, 0, scr, r, lane); continue; } r -= I_A;
        if (r < I_B) { p0_transpose_item(w_in + 2056, INC, D, 1536, Win_t, 2048, scr, r, lane); continue; } r -= I_B;
        if (r < I_O) { p0_transpose_item(w_out, D, D, D, Wout_t, 0, scr, r, lane); continue; } r -= I_O;
        if (r < I_GU) { p0_transpose_item(w_gu, 2 * FF, D, 2 * FF, Wgu_t, 0, scr, r, lane); continue; } r -= I_GU;
        p0_transpose_item(w_dn, D, FF, D, Wdn_t, 0, scr, r, lane);
    }
    bf16* U = (bf16*)(ws + WS_U); float* AB = (float*)(ws + WS_AB);
    for (int m = gw; m < M; m += NGW) {
        const float* xrow = m < MP ? xp + (size_t)m * D : xs + (size_t)(m - MP) * D;
        f32x4 v[4]; float s = 0.f;
#pragma unroll
        for (int j = 0; j < 4; ++j) { v[j] = ((const f32x4*)xrow)[lane + 64 * j]; s += (v[j].x * v[j].x + v[j].y * v[j].y) + (v[j].z * v[j].z + v[j].w * v[j].w); }
        const float rstd = rsqrtf(wave_sum(s) * (1.f / D) + EPS);
        unsigned long long* o8 = (unsigned long long*)(U + (size_t)m * D) + lane;
#pragma unroll
        for (int j = 0; j < 4; ++j) { const f32x4 g = ((const f32x4*)nw)[lane + 64 * j]; v[j] = v[j] * rstd * g;
            o8[64 * j] = (unsigned long long)pk2(v[j].x, v[j].y) | ((unsigned long long)pk2(v[j].z, v[j].w) << 32); }
        float dv = 0.f;
#pragma unroll
        for (int jj = 0; jj < 8; ++jj) { float acc = 0.f;
#pragma unroll
            for (int j = 0; j < 4; ++j) { const f32x4 w = *(const LAS f32x4*)(W8T + jj * 1024 + 4 * lane + 256 * j); acc += (v[j].x * w.x + v[j].y * w.y) + (v[j].z * w.z + v[j].w * w.w); }
            acc = wave_sum(acc); if (lane == jj) dv = acc; }
        if (lane < 8) AB[(size_t)m * 8 + lane] = dv;
    }
}

__device__ __forceinline__ void phase_copy_outputs(const bf16* P, float* out, int gtid, int nth) {
    for (int e = gtid; e < 4 * 512 * 512; e += nth) { const int b = e >> 18, j = (e >> 9) & 511, c = e & 511; const size_t row = (size_t)(b * SEQ + 3584 + j) * NIN;
        out[O_BKP + e] = bf1(P[row + PC_KB + c]); out[O_BVP + e] = bf1(P[row + PC_VB + c]); }
    for (int e = gtid; e < 32 * 32 * 512; e += nth) { const int r = e >> 9, c = e & 511; const size_t row = (size_t)(MP + r) * NIN;
        out[O_BKS + e] = bf1(P[row + PC_KB + c]); out[O_BVS + e] = bf1(P[row + PC_VB + c]); }
    for (int e = gtid; e < 4 * 3 * 1536; e += nth) { const int b = e / 4608, i = (e / 1536) % 3, c = e % 1536; out[O_QCP + e] = bf1(P[(size_t)(b * SEQ + 4093 + i) * NIN + c]); }
    for (int e = gtid; e < 32 * 3 * 1536; e += nth) { const int b = e / 4608, i = (e / 1536) % 3, c = e % 1536; out[O_QCS + e] = bf1(P[(size_t)(MP + b * 32 + 29 + i) * NIN + c]); }
}

__device__ __forceinline__ int kperm(int k) { const int kk = k & 31; return (k & ~31) | (8 * ((kk & 15) >> 2) + (kk & 3) + 4 * (kk >> 4)); }
__device__ __forceinline__ void gdn_pre_unit(LAS unsigned char* lds, int u, const bf16* P, const float* AB, const float* st_qkv, const float* conv_w, const float* a_log, const float* dt_bias,
                                             bf16* gmain, bf16* gqk, bf16* gs, float* DL, int tid, int lane, int wave) {
    LAS float* RHS = (LAS float*)(lds + 0);
    LAS bf16* QB = (LAS bf16*)(lds + 65536);
    LAS bf16* KB = (LAS bf16*)(lds + 82944);
    LAS bf16* RAW = (LAS bf16*)(lds + 100352);
    LAS bf16* KGT = (LAS bf16*)(lds + 117760);
    LAS float* AM = (LAS float*)(lds + 117760);
    LAS float* SMG = (LAS float*)(lds + 134144);
    const bool prompt = u < 1024;
    int b, h, n, m0, valid; bf16 *o_w, *o_qg, *o_kgt, *o_ut, *o_qk;
    if (prompt) { b = u >> 8; h = (u >> 6) & 3; n = u & 63; m0 = b * SEQ + n * 64; valid = 64; bf16* base = gmain + (size_t)u * 32768; o_w = base; o_qg = base + 8192; o_kgt = base + 16384; o_ut = base + 24576; o_qk = gqk + (size_t)u * 4096; }
    else { const int su = u - 1024; b = su >> 2; h = su & 3; n = 0; m0 = MP + b * 32; valid = 32; bf16* base = gs + (size_t)su * 36864; o_w = base; o_qg = base + 8192; o_kgt = base + 16384; o_ut = base + 24576; o_qk = base + 32768; }
    if (wave == 0) {
        const int i = lane; const bool v = i < valid;
        const float araw = v ? AB[(size_t)(m0 + i) * 8 + 4 + h] : 0.f, braw = v ? AB[(size_t)(m0 + i) * 8 + h] : 0.f;
        const float A = expf(a_log[h]); const float x = araw + dt_bias[h];
        const float sp = x > 20.f ? x : log1pf(expf(x));
        const float g = v ? -A * sp : 0.f; const float beta = v ? 1.f / (1.f + expf(-braw)) : 0.f;
        float Gc = g;
#pragma unroll
        for (int off = 1; off < 64; off <<= 1) { const float t = __shfl_up(Gc, off); if (lane >= off) Gc += t; }
        const float Gl = __shfl(Gc, 63);
        SMG[i] = Gc; SMG[64 + i] = beta; SMG[128 + i] = expf(Gc); SMG[192 + i] = expf(Gl - Gc);
        if (lane == 0) DL[u] = expf(Gl);
    }
    __syncthreads();
#pragma unroll 1
    for (int part = 0; part < 3; ++part) {
        const int pcol = (part == 0 ? 512 : part == 1 ? 0 : 1024) + h * 128;
#pragma unroll
        for (int pass = 0; pass < 3; ++pass) {
            const int rr = (tid >> 4) + 32 * pass, ch = tid & 15;
            if (rr < 67) {
                v4u val = {0u, 0u, 0u, 0u};
                if (prompt) { const int ts = n * 64 - 3 + rr; if (ts >= 0) val = *(const v4u*)(P + (size_t)(b * SEQ + ts) * NIN + pcol + ch * 8); }
                else { if (rr < 3) { const float* s = st_qkv + ((size_t)b * 3 + rr) * 1536 + pcol + ch * 8; const f32x4 a = *(const f32x4*)s, c = *(const f32x4*)(s + 4); val = (v4u){pk2(a.x, a.y), pk2(a.z, a.w), pk2(c.x, c.y), pk2(c.z, c.w)}; }
                       else if (rr - 3 < 32) val = *(const v4u*)(P + (size_t)(MP + b * 32 + rr - 3) * NIN + pcol + ch * 8); }
                *(LAS v4u*)(RAW + rr * 128 + ch * 8) = val;
            }
        }
        __syncthreads();
        float w0[4], w1[4];
#pragma unroll
        for (int i = 0; i < 4; ++i) { const f32x2 t = *(const f32x2*)(conv_w + i * 1536 + pcol + 2 * lane); w0[i] = t.x; w1[i] = t.y; }
#pragma unroll 2
        for (int rq = 0; rq < 8; ++rq) {
            const int r = wave * 8 + rq;
            float y0 = 0.f, y1 = 0.f;
#pragma unroll
            for (int i = 0; i < 4; ++i) { const unsigned xw = *(const LAS unsigned*)(RAW + (r + i) * 128 + 2 * lane); y0 += w0[i] * bflo(xw); y1 += w1[i] * bfhi(xw); }
            float s0 = y0 * sigmoidf_(y0), s1 = y1 * sigmoidf_(y1);
            if (r >= valid) { s0 = 0.f; s1 = 0.f; }
            if (part == 2) { const float be = SMG[64 + r]; *(LAS f32x2*)(RHS + r * 256 + 2 * lane) = (f32x2){s0 * be, s1 * be}; }
            else {
                const float rinv = rsqrtf(wave_sum(s0 * s0 + s1 * s1) + EPS);
                if (part == 0) { const float k0 = s0 * rinv, k1 = s1 * rinv; *(LAS unsigned*)(KB + r * 136 + 2 * lane) = pk2(k0, k1);
                    const float be = SMG[64 + r] * SMG[128 + r]; *(LAS f32x2*)(RHS + r * 256 + 128 + 2 * lane) = (f32x2){k0 * be, k1 * be};
                    const float egl = SMG[192 + r]; KGT[(2 * lane) * 64 + kperm(r)] = f2bf(k0 * egl); KGT[(2 * lane + 1) * 64 + kperm(r)] = f2bf(k1 * egl); }
                else { const float sc = rinv * 0.08838834764831845f; const float q0 = s0 * sc, q1 = s1 * sc; *(LAS unsigned*)(QB + r * 136 + 2 * lane) = pk2(q0, q1);
                    const float eg = SMG[128 + r]; *(unsigned*)(o_qg + r * 128 + kperm(2 * lane)) = pk2(q0 * eg, q1 * eg); }
            }
        }
        __syncthreads();
        if (part == 0) {
#pragma unroll
            for (int k = 0; k < 2; ++k) { const int pi = tid + 512 * k; *(v4u*)(o_kgt + pi * 8) = *(const LAS v4u*)(KGT + pi * 8); }
        }
    }
    {
        const int mat = wave >> 2, ti = (wave >> 1) & 1, tj = wave & 1, r32 = lane & 31, hi = lane >> 5;
        const LAS bf16* Ab = (mat == 0 ? KB : QB) + (32 * ti + r32) * 136 + 8 * hi;
        const LAS bf16* Bb = KB + (32 * tj + r32) * 136 + 8 * hi;
        f32x16 acc;
#pragma unroll
        for (int r = 0; r < 16; ++r) acc[r] = 0.f;
#pragma unroll
        for (int s = 0; s < 8; ++s) acc = MFMA32(*(const LAS bf16x8*)(Ab + 16 * s), *(const LAS bf16x8*)(Bb + 16 * s), acc);
        const int j = 32 * tj + r32; const float Gj = SMG[j];
#pragma unroll
        for (int r = 0; r < 16; ++r) { const int i = 32 * ti + crow(r, hi); const float dec = expf(fminf(SMG[i] - Gj, 0.f));
            if (mat == 0) AM[i * 64 + j] = (i > j) ? acc[r] * SMG[64 + i] * dec : 0.f;
            else o_qk[i * 64 + kperm(j)] = f2bf((i >= j) ? acc[r] * dec : 0.f); }
    }
    __syncthreads();
    if (tid < 256) {
        const int c = tid; float x[64];
        int zv; asm volatile("v_mov_b32 %0, 0" : "=v"(zv));
        const LAS float* AMv = AM + zv;
#pragma unroll
        for (int i = 0; i < 64; ++i) {
            float s0 = RHS[i * 256 + c], s1 = 0.f;
#pragma unroll
            for (int j = 0; j < i; ++j) { const float a = AMv[i * 64 + j]; if (j & 1) s1 = fmaf(-a, x[j], s1); else s0 = fmaf(-a, x[j], s0); }
            x[i] = s0 + s1;
        }
        if (c < 128) {
#pragma unroll
            for (int k = 0; k < 8; ++k) { const v4u o = {pk2(x[8 * k], x[8 * k + 1]), pk2(x[8 * k + 2], x[8 * k + 3]), pk2(x[8 * k + 4], x[8 * k + 5]), pk2(x[8 * k + 6], x[8 * k + 7])}; *(v4u*)(o_ut + c * 64 + 8 * k) = o; }
        } else { const int dk = c - 128;
#pragma unroll
            for (int i = 0; i < 64; ++i) o_w[i * 128 + kperm(dk)] = f2bf(x[i]); }
    }
    __syncthreads();
}

constexpr int SL_W = 0, SL_QG = 18432, SL_KGT = 36864, SL_UT = 57344, SL_QK = 75776, SL_O = 86016, SL_OSZ = 33792, SL_END = SL_O + 2 * SL_OSZ;
__device__ __forceinline__ bf16x8 pack8(const f32x4& a, const f32x4& b) { const v4u t = {pk2(a[0], a[1]), pk2(a[2], a[3]), pk2(b[0], b[1]), pk2(b[2], b[3])}; return __builtin_bit_cast(bf16x8, t); }
__device__ __forceinline__ bf16x8 ldfrag(const LAS unsigned char* p) { return *(const LAS bf16x8*)p; }
__device__ __forceinline__ void scan_unit(LAS unsigned char* lds, int nsteps, int nrows, const bf16* gmain, size_t main_stride, const bf16* gqk, size_t qk_stride, const float* DLp,
                                          const float* S0, float* Sout, const bf16* Pz  , bf16* MX  , const float* gnw, int tid, int lane, int wave) {
    const int cl = lane & 15, q = lane >> 4, c0 = wave * 16;
    f32x4 S[8];
#pragma unroll
    for (int mt = 0; mt < 8; ++mt)
#pragma unroll
        for (int r = 0; r < 4; ++r) S[mt][r] = S0 ? S0[(16 * mt + 4 * q + r) * 128 + c0 + cl] : 0.f;
    const f32x2 gw2 = *(const f32x2*)(gnw + 2 * lane);
    v4u Ra[9], Rb[9]; unsigned Za[8], Zb[8];
#define SCAN_LOAD(R, nn) do { const bf16* mp_ = gmain + (size_t)(nn) * main_stride; _Pragma("unroll") for (int k = 0; k < 8; ++k) R[k] = *(const v4u*)(mp_ + (size_t)(tid + 512 * k) * 8); \
        R[8] = *(const v4u*)(gqk + (size_t)(nn) * qk_stride + (size_t)tid * 8); } while (0)
#define SCAN_LOADZ(Z, nn) do { _Pragma("unroll") for (int rq = 0; rq < 8; ++rq) Z[rq] = *(const unsigned*)(Pz + ((size_t)(nn) * 64 + wave * 8 + rq) * NIN + 2 * lane); } while (0)
#define SCAN_NORM(Z, OB, nn) do { float ox_[8], oy_[8], ss_[8]; \
        _Pragma("unroll") for (int rq = 0; rq < 8; ++rq) { const f32x2 ov_ = *(const LAS f32x2*)((OB) + (wave * 8 + rq) * 132 + 2 * lane); ox_[rq] = ov_.x; oy_[rq] = ov_.y; ss_[rq] = ov_.x * ov_.x + ov_.y * ov_.y; } \
        _Pragma("unroll") for (int off_ = 1; off_ < 64; off_ <<= 1) { _Pragma("unroll") for (int rq = 0; rq < 8; ++rq) ss_[rq] += __shfl_xor(ss_[rq], off_); } \
        _Pragma("unroll") for (int rq = 0; rq < 8; ++rq) { const int r_ = wave * 8 + rq; const float rstd_ = rsqrtf(ss_[rq] * (1.f / 128.f) + EPS); const float z0_ = bflo(Z[rq]), z1_ = bfhi(Z[rq]); \
            if (r_ < nrows) *(unsigned*)(MX + ((size_t)(nn) * 64 + r_) * D + 2 * lane) = pk2(ox_[rq] * rstd_ * gw2.x * z0_ * sigmoidf_(z0_), oy_[rq] * rstd_ * gw2.y * z1_ * sigmoidf_(z1_)); } } while (0)
#define SCAN_BAR() asm volatile("s_waitcnt lgkmcnt(0)\n\ts_barrier" ::: "memory")
#define SCAN_STEP(n, R, ZC, ZP, OC, OP) do { \
        SCAN_BAR();                                            \
        _Pragma("unroll") for (int k = 0; k < 8; ++k) { const int a_ = k >> 1, within_ = tid + 512 * (k & 1); int dst_; \
            if (a_ < 2) dst_ = (a_ == 0 ? SL_W : SL_QG) + (within_ >> 4) * 288 + (within_ & 15) * 16; else dst_ = (a_ == 2 ? SL_KGT + (within_ >> 3) * 160 : SL_UT + (within_ >> 3) * 144) + (within_ & 7) * 16; \
            *(LAS v4u*)(lds + dst_) = R[k]; } \
        *(LAS v4u*)(lds + SL_QK + (tid >> 3) * 160 + (tid & 7) * 16) = R[8]; \
        asm volatile("" ::: "memory");                         \
        SCAN_LOADZ(ZC, n); \
        if ((n) + 2 < nsteps) SCAN_LOAD(R, (n) + 2); \
        const float dl_ = __uint_as_float(__builtin_amdgcn_readlane(dlbits, (n))); \
        SCAN_BAR(); \
        bf16x8 Sb_[4]; \
        _Pragma("unroll") for (int ks = 0; ks < 4; ++ks) Sb_[ks] = pack8(S[2 * ks], S[2 * ks + 1]); \
        f32x4 vn_[4], o_[4]; \
        _Pragma("unroll") for (int mt = 0; mt < 4; ++mt) { \
            f32x4 aw_ = {0.f, 0.f, 0.f, 0.f}, ao_ = {0.f, 0.f, 0.f, 0.f}; \
            const LAS unsigned char* wp_ = lds + SL_W + (16 * mt + cl) * 288 + q * 16; const LAS unsigned char* qp_ = lds + SL_QG + (16 * mt + cl) * 288 + q * 16; \
            _Pragma("unroll") for (int ks = 0; ks < 4; ++ks) { aw_ = MFMA16(ldfrag(wp_ + ks * 64), Sb_[ks], aw_); ao_ = MFMA16(ldfrag(qp_ + ks * 64), Sb_[ks], ao_); } \
            const v2u uu_ = *(const LAS v2u*)(lds + SL_UT + (c0 + cl) * 144 + (16 * mt + 4 * q) * 2); \
            vn_[mt] = (f32x4){bflo(uu_.x) - aw_[0], bfhi(uu_.x) - aw_[1], bflo(uu_.y) - aw_[2], bfhi(uu_.y) - aw_[3]}; \
            o_[mt] = ao_; } \
        bf16x8 Vb_[2]; \
        _Pragma("unroll") for (int ks = 0; ks < 2; ++ks) Vb_[ks] = pack8(vn_[2 * ks], vn_[2 * ks + 1]); \
        _Pragma("unroll") for (int mt = 0; mt < 4; ++mt) { const LAS unsigned char* kp_ = lds + SL_QK + (16 * mt + cl) * 160 + q * 16; \
            _Pragma("unroll") for (int ks = 0; ks < 2; ++ks) o_[mt] = MFMA16(ldfrag(kp_ + ks * 64), Vb_[ks], o_[mt]); } \
        _Pragma("unroll") for (int mt = 0; mt < 4; ++mt) _Pragma("unroll") for (int r = 0; r < 4; ++r) (OC)[(16 * mt + 4 * q + r) * 132 + c0 + cl] = o_[mt][r]; \
        _Pragma("unroll") for (int mt = 0; mt < 8; ++mt) { S[mt] = S[mt] * dl_; const LAS unsigned char* kp_ = lds + SL_KGT + (16 * mt + cl) * 160 + q * 16; \
            _Pragma("unroll") for (int ks = 0; ks < 2; ++ks) S[mt] = MFMA16(ldfrag(kp_ + ks * 64), Vb_[ks], S[mt]); } \
        if ((n) > 0) SCAN_NORM(ZP, OP, (n) - 1); \
    } while (0)
    LAS float* O0 = (LAS float*)(lds + SL_O); LAS float* O1 = (LAS float*)(lds + SL_O + SL_OSZ);
    const int dlbits = (int)__float_as_uint(lane < nsteps ? DLp[lane] : 1.f);
    SCAN_LOAD(Ra, 0);
    if (nsteps > 1) SCAN_LOAD(Rb, 1);
#pragma unroll 1
    for (int n = 0; n < nsteps; n += 2) {
        SCAN_STEP(n, Ra, Za, Zb, O0, O1);
        if (n + 1 < nsteps) SCAN_STEP(n + 1, Rb, Zb, Za, O1, O0);
    }
    SCAN_BAR();
    if (nsteps & 1) SCAN_NORM(Za, O0, nsteps - 1); else SCAN_NORM(Zb, O1, nsteps - 1);
#undef SCAN_LOAD
#undef SCAN_LOADZ
#undef SCAN_NORM
#undef SCAN_STEP
#undef SCAN_BAR
#pragma unroll
    for (int mt = 0; mt < 8; ++mt)
#pragma unroll
        for (int r = 0; r < 4; ++r) Sout[(16 * mt + 4 * q + r) * 128 + c0 + cl] = S[mt][r];
    __syncthreads();
}


constexpr int ATT_WAVE_LDS = 17920;
constexpr float LOG2E = 1.4426950408889634f;
typedef short v4i16_t __attribute__((ext_vector_type(4)));
__device__ __forceinline__ s16x4 vtr(const LAS unsigned char* p) { return __builtin_bit_cast(s16x4, __builtin_amdgcn_ds_read_tr16_b64_v4i16((LAS v4i16_t*)p)); }
__device__ __forceinline__ void attn_item(LAS unsigned char* wl, int it, const bf16* P, const float* ck, const float* cv, const float* relb, const float* anw, bf16* MIXIN, int lane) {
    LAS unsigned char* KL = wl; LAS unsigned char* VL = wl + 8192; LAS float* SC = (LAS float*)(wl + 16384); LAS float* BT = (LAS float*)(wl + 16640);
    const int r32 = lane & 31, hi = lane >> 5;
    const bool sample = it < 256;
    int b, h, n = 0, half = 0, mq, t0, t1;
    if (sample) { b = it >> 3; h = it & 7; mq = MP + b * 32; t0 = 0; t1 = 9; }
    else { const int idx = it - 256; half = idx & 1; n = (idx >> 1) & 63; h = (idx >> 7) & 7; b = idx >> 10; mq = b * SEQ + n * 64 + half * 32; t0 = n > 8 ? n - 8 : 0; t1 = n + 1; }
    for (int k = lane; k < 257; k += 64) BT[k] = relb[h * 257 + k] * LOG2E;
    bf16x8 qr[4];
#pragma unroll
    for (int d0 = 0; d0 < 4; ++d0) qr[d0] = *(const bf16x8*)(P + (size_t)(mq + r32) * NIN + PC_QB + h * 64 + d0 * 16 + hi * 8);
    float mrun = -1e30f, lrun = 0.f; f32x16 o0, o1;
#pragma unroll
    for (int r = 0; r < 16; ++r) { o0[r] = 0.f; o1[r] = 0.f; }
    const int ti = lane & 15, blk = (lane >> 4) & 1;
    const LAS unsigned char* vbase = VL + (4 * hi + (ti >> 2)) * 128 + (blk * 16 + 4 * (ti & 3)) * 2;
#pragma unroll 1
    for (int t = t0; t < t1; ++t) {
        int relbase; bool maskhalf = false;
        if (sample && t < 8) {
            relbase = 512 - 64 * t;
#pragma unroll
            for (int i8 = 0; i8 < 8; ++i8) { const int idx = i8 * 64 + lane, key = idx >> 3, c8 = idx & 7; const size_t off = (((size_t)b * 512 + 64 * t + key) * 8 + h) * 64 + c8 * 8;
                const f32x4 ka = *(const f32x4*)(ck + off), kb = *(const f32x4*)(ck + off + 4), va = *(const f32x4*)(cv + off), vb = *(const f32x4*)(cv + off + 4);
                *(LAS v4u*)(KL + (c8 * 64 + key) * 16) = (v4u){pk2(ka.x, ka.y), pk2(ka.z, ka.w), pk2(kb.x, kb.y), pk2(kb.z, kb.w)};
                *(LAS v4u*)(VL + key * 128 + c8 * 16) = (v4u){pk2(va.x, va.y), pk2(va.z, va.w), pk2(vb.x, vb.y), pk2(vb.z, vb.w)}; }
        } else {
            size_t rowbase; int nvalid;
            if (sample) { relbase = 0; maskhalf = true; rowbase = (size_t)MP + b * 32; nvalid = 32; }
            else { relbase = 64 * (n - t) + 32 * half; rowbase = (size_t)b * SEQ + t * 64; nvalid = 64; }
#pragma unroll
            for (int i8 = 0; i8 < 8; ++i8) { const int idx = i8 * 64 + lane, key = idx >> 3, c8 = idx & 7; v4u kv = {0u, 0u, 0u, 0u}, vv = {0u, 0u, 0u, 0u};
                if (key < nvalid) { const bf16* rp = P + (rowbase + key) * NIN + h * 64 + c8 * 8; kv = *(const v4u*)(rp + PC_KB); vv = *(const v4u*)(rp + PC_VB); }
                *(LAS v4u*)(KL + (c8 * 64 + key) * 16) = kv; *(LAS v4u*)(VL + key * 128 + c8 * 16) = vv; }
        }
        f32x16 p0, p1;
#pragma unroll
        for (int r = 0; r < 16; ++r) { p0[r] = 0.f; p1[r] = 0.f; }
#pragma unroll
        for (int d0 = 0; d0 < 4; ++d0) { const bf16x8 k0 = *(const LAS bf16x8*)(KL + (2 * d0 + hi) * 1024 + r32 * 16), k1 = *(const LAS bf16x8*)(KL + (2 * d0 + hi) * 1024 + 512 + r32 * 16);
            p0 = MFMA32(k0, qr[d0], p0); p1 = MFMA32(k1, qr[d0], p1); }
        const float SC2 = 0.125f * LOG2E;
        if (relbase - 63 >= 128) { const float bc = BT[256];
#pragma unroll
            for (int r = 0; r < 16; ++r) { p0[r] = p0[r] * SC2 + bc; p1[r] = p1[r] * SC2 + bc; } }
        else {
#pragma unroll
            for (int r = 0; r < 16; ++r) { const int rel = relbase + r32 - crow(r, hi); int i0 = (rel > 128 ? 128 : rel) + 128, i1 = (rel - 32 > 128 ? 128 : rel - 32) + 128; i0 = i0 < 0 ? 0 : i0; i1 = i1 < 0 ? 0 : i1;
                p0[r] = p0[r] * SC2 + BT[i0]; p1[r] = p1[r] * SC2 + BT[i1]; } }
        if (maskhalf) {
#pragma unroll
            for (int r = 0; r < 16; ++r) p1[r] = -INFINITY; }
        float mx = fmaxf(p0[0], p1[0]);
#pragma unroll
        for (int r = 1; r < 16; ++r) mx = fmaxf(mx, fmaxf(p0[r], p1[r]));
        mx = fmaxf(mx, __shfl_xor(mx, 32));
        const float mnew = fmaxf(mrun, mx); const float alpha = __builtin_amdgcn_exp2f(mrun - mnew); mrun = mnew;
        float sum = 0.f;
#pragma unroll
        for (int r = 0; r < 16; ++r) { p0[r] = __builtin_amdgcn_exp2f(p0[r] - mnew); p1[r] = __builtin_amdgcn_exp2f(p1[r] - mnew); sum += p0[r] + p1[r]; }
        lrun = lrun * alpha + sum;
        if (hi == 0) SC[r32] = alpha;
#pragma unroll
        for (int r = 0; r < 16; ++r) { const float a = SC[crow(r, hi)]; o0[r] *= a; o1[r] *= a; }
#pragma unroll
        for (int s = 0; s < 4; ++s) {
            v4u pw;
            if (s < 2) pw = (v4u){pk2(p0[8 * s + 0], p0[8 * s + 1]), pk2(p0[8 * s + 2], p0[8 * s + 3]), pk2(p0[8 * s + 4], p0[8 * s + 5]), pk2(p0[8 * s + 6], p0[8 * s + 7])};
            else { const int ss = s - 2; pw = (v4u){pk2(p1[8 * ss + 0], p1[8 * ss + 1]), pk2(p1[8 * ss + 2], p1[8 * ss + 3]), pk2(p1[8 * ss + 4], p1[8 * ss + 5]), pk2(p1[8 * ss + 6], p1[8 * ss + 7])}; }
            const bf16x8 pa = __builtin_bit_cast(bf16x8, pw);
            const LAS unsigned char* vp = vbase + (16 * s) * 128;
            const s16x4 a0 = vtr(vp), a1 = vtr(vp + 8 * 128), b0 = vtr(vp + 64), b1 = vtr(vp + 8 * 128 + 64);
            const bf16x8 v0 = {a0[0], a0[1], a0[2], a0[3], a1[0], a1[1], a1[2], a1[3]}, v1 = {b0[0], b0[1], b0[2], b0[3], b1[0], b1[1], b1[2], b1[3]};
            o0 = MFMA32(pa, v0, o0); o1 = MFMA32(pa, v1, o1);
        }
    }
    lrun += __shfl_xor(lrun, 32);
    if (hi == 0) SC[32 + r32] = 1.f / lrun;
    LAS float* OL = (LAS float*)wl;
#pragma unroll
    for (int r = 0; r < 16; ++r) { const int qq = crow(r, hi); const float inv = SC[32 + qq]; OL[qq * 66 + r32] = o0[r] * inv; OL[qq * 66 + 32 + r32] = o1[r] * inv; }
    {
        const int qq = lane >> 1, dh = (lane & 1) * 32; float vals[32]; float ss = 0.f;
#pragma unroll
        for (int k = 0; k < 32; ++k) { vals[k] = OL[qq * 66 + dh + k]; ss += vals[k] * vals[k]; }
        ss += __shfl_xor(ss, 1);
        const float rstd = rsqrtf(ss * (1.f / 64.f) + EPS);
        bf16* op = MIXIN + (size_t)(mq + qq) * D + 512 + h * 64 + dh;
#pragma unroll
        for (int k4 = 0; k4 < 4; ++k4) { v4u o;
            const f32x4 wa = *(const f32x4*)(anw + dh + 8 * k4), wb = *(const f32x4*)(anw + dh + 8 * k4 + 4);
            o.x = pk2(vals[8 * k4 + 0] * rstd * wa.x, vals[8 * k4 + 1] * rstd * wa.y); o.y = pk2(vals[8 * k4 + 2] * rstd * wa.z, vals[8 * k4 + 3] * rstd * wa.w);
            o.z = pk2(vals[8 * k4 + 4] * rstd * wb.x, vals[8 * k4 + 5] * rstd * wb.y); o.w = pk2(vals[8 * k4 + 6] * rstd * wb.z, vals[8 * k4 + 7] * rstd * wb.w);
            *(v4u*)(op + 8 * k4) = o; }
    }
}

__device__ __forceinline__ void phase_rows1(const float* xp, const float* xs, const float* mix, const float* w_post, const float* w_pre2, float* out, bf16* U, int gw, int NGW, int lane) {
    for (int m = gw; m < M; m += NGW) {
        const float* xrow = m < MP ? xp + (size_t)m * D : xs + (size_t)(m - MP) * D;
        f32x4 v[4], xv[4]; float s = 0.f;
#pragma unroll
        for (int j = 0; j < 4; ++j) { v[j] = ((const f32x4*)(mix + (size_t)m * D))[lane + 64 * j]; xv[j] = ((const f32x4*)xrow)[lane + 64 * j]; s += (v[j].x * v[j].x + v[j].y * v[j].y) + (v[j].z * v[j].z + v[j].w * v[j].w); }
        const float rstd = rsqrtf(wave_sum(s) * (1.f / D) + EPS); float s2 = 0.f;
#pragma unroll
        for (int j = 0; j < 4; ++j) { const f32x4 g = ((const f32x4*)w_post)[lane + 64 * j]; v[j] = xv[j] + v[j] * rstd * g; ((f32x4*)(out + (size_t)m * D))[lane + 64 * j] = v[j];
            s2 += (v[j].x * v[j].x + v[j].y * v[j].y) + (v[j].z * v[j].z + v[j].w * v[j].w); }
        const float rstd2 = rsqrtf(wave_sum(s2) * (1.f / D) + EPS);
        unsigned long long* o8 = (unsigned long long*)(U + (size_t)m * D) + lane;
#pragma unroll
        for (int j = 0; j < 4; ++j) { const f32x4 g = ((const f32x4*)w_pre2)[lane + 64 * j]; const f32x4 t = v[j] * rstd2 * g;
            o8[64 * j] = (unsigned long long)pk2(t.x, t.y) | ((unsigned long long)pk2(t.z, t.w) << 32); }
    }
}
__device__ __forceinline__ void phase_rows2(const float* dn, const float* w, float* out, int gw, int NGW, int lane) {
    for (int m = gw; m < M; m += NGW) {
        f32x4 v[4]; float s = 0.f;
#pragma unroll
        for (int j = 0; j < 4; ++j) { v[j] = ((const f32x4*)(dn + (size_t)m * D))[lane + 64 * j]; s += (v[j].x * v[j].x + v[j].y * v[j].y) + (v[j].z * v[j].z + v[j].w * v[j].w); }
        const float rstd = rsqrtf(wave_sum(s) * (1.f / D) + EPS);
#pragma unroll
        for (int j = 0; j < 4; ++j) { const f32x4 g = ((const f32x4*)w)[lane + 64 * j]; f32x4* op = (f32x4*)(out + (size_t)m * D) + lane + 64 * j; *op = *op + v[j] * rstd * g; }
    }
}
__device__ __forceinline__ float gelu_tanh(float x) { const float y = 0.7978845608028654f * (x + 0.044715f * x * x * x); const float t = 1.f - 2.f / (1.f + __expf(2.f * y)); return 0.5f * x * (1.f + t); }
__device__ __forceinline__ void phase_h(const bf16* Gt, bf16* UP, const float* st_ffn, const float* cw, const float* cb, float* out, int gtid, int nth) {
    constexpr int CG = FF / 8;
    for (int idx = gtid; idx < M * CG; idx += nth) {
        const int m = idx / CG, c = (idx % CG) * 8;
        float g2[8], g1[8], g0[8];
        { const v4u t = *(const v4u*)(Gt + (size_t)m * FF + c); g2[0] = bflo(t.x); g2[1] = bfhi(t.x); g2[2] = bflo(t.y); g2[3] = bfhi(t.y); g2[4] = bflo(t.z); g2[5] = bfhi(t.z); g2[6] = bflo(t.w); g2[7] = bfhi(t.w); }
        int tpos, bsm = 0; const bool smp = m >= MP;
        if (smp) { tpos = (m - MP) & 31; bsm = (m - MP) >> 5; } else tpos = m & (SEQ - 1);
        if (tpos >= 1) { const v4u t = *(const v4u*)(Gt + (size_t)(m - 1) * FF + c); g1[0] = bflo(t.x); g1[1] = bfhi(t.x); g1[2] = bflo(t.y); g1[3] = bfhi(t.y); g1[4] = bflo(t.z); g1[5] = bfhi(t.z); g1[6] = bflo(t.w); g1[7] = bfhi(t.w); }
        else if (smp) { const float* s = st_ffn + ((size_t)bsm * 2 + 1) * FF + c;
#pragma unroll
            for (int e = 0; e < 8; ++e) g1[e] = s[e]; }
        else {
#pragma unroll
            for (int e = 0; e < 8; ++e) g1[e] = 0.f; }
        if (tpos >= 2) { const v4u t = *(const v4u*)(Gt + (size_t)(m - 2) * FF + c); g0[0] = bflo(t.x); g0[1] = bfhi(t.x); g0[2] = bflo(t.y); g0[3] = bfhi(t.y); g0[4] = bflo(t.z); g0[5] = bfhi(t.z); g0[6] = bflo(t.w); g0[7] = bfhi(t.w); }
        else if (smp) { const float* s = st_ffn + ((size_t)bsm * 2 + tpos) * FF + c;
#pragma unroll
            for (int e = 0; e < 8; ++e) g0[e] = s[e]; }
        else {
#pragma unroll
            for (int e = 0; e < 8; ++e) g0[e] = 0.f; }
        const v4u ut = *(const v4u*)(UP + (size_t)m * FF + c);
        float up[8] = {bflo(ut.x), bfhi(ut.x), bflo(ut.y), bfhi(ut.y), bflo(ut.z), bfhi(ut.z), bflo(ut.w), bfhi(ut.w)};
        float hv[8];
#pragma unroll
        for (int e = 0; e < 8; ++e) { const float x = cw[c + e] * g0[e] + cw[FF + c + e] * g1[e] + cw[2 * FF + c + e] * g2[e] + cb[c + e]; hv[e] = gelu_tanh(x) * up[e]; }
        const v4u o = {pk2(hv[0], hv[1]), pk2(hv[2], hv[3]), pk2(hv[4], hv[5]), pk2(hv[6], hv[7])};
        *(v4u*)(UP + (size_t)m * FF + c) = o;
        const int tl = smp ? 32 : SEQ;
        if (tpos >= tl - 2) { const int i = tpos - (tl - 2); float* op = smp ? out + O_FCS + ((size_t)bsm * 2 + i) * FF + c : out + O_FCP + ((size_t)(m >> 12) * 2 + i) * FF + c;
#pragma unroll
            for (int e = 0; e < 8; ++e) op[e] = g2[e]; }
    }
}

#ifndef MK_N_LAUNCHES
#define MK_N_LAUNCHES 1
#endif
constexpr int NPH = 10;
constexpr int N_LAUNCHES = MK_N_LAUNCHES;
struct Args { const float* in[23]; float* out; unsigned char* ws; int ph_lo, ph_hi, li, pad; };
__global__ void __launch_bounds__(NWAVES * 64, 2) hybrid_fwd(Args args) {
    extern __shared__ __attribute__((aligned(16))) unsigned char lds_raw[];
    LAS unsigned char* lds = (LAS unsigned char*)lds_raw;
    volatile LAS unsigned* MISC = (volatile LAS unsigned*)(lds + MISC_OFF);
    const int tid = threadIdx.x, lane = tid & 63, wave = __builtin_amdgcn_readfirstlane(tid >> 6);
    const int G = gridDim.x; const int bx = blockIdx.x; const int vcu = (G % 8 == 0) ? (bx % 8) * (G / 8) + bx / 8 : bx;
    unsigned char* ws = args.ws; float* out = args.out;
    gu32* ctl = (gu32*)(ws + WS_CTL);
#define x_prompt (args.in[0])
#define x_sample (args.in[1])
#define cache_k (args.in[2])
#define cache_v (args.in[3])
#define state_delta (args.in[4])
#define state_qkv (args.in[5])
#define state_ffn (args.in[6])
#define norm_mix_pre (args.in[7])
#define w_in (args.in[8])
#define qkv_conv_w (args.in[9])
#define a_log (args.in[10])
#define dt_bias (args.in[11])
#define gdn_norm_w (args.in[12])
#define rel_bias (args.in[13])
#define attn_norm_w (args.in[14])
#define w_out (args.in[15])
#define norm_mix_post (args.in[16])
#define norm_ffn_pre (args.in[17])
#define w_gate_up (args.in[18])
#define ffn_conv_w (args.in[19])
#define ffn_conv_b (args.in[20])
#define w_down (args.in[21])
#define norm_ffn_post (args.in[22])
#define Win_t ((bf16*)(ws + WS_WIN))
#define Wout_t ((bf16*)(ws + WS_WOUT))
#define Wgu_t ((bf16*)(ws + WS_WGU))
#define Wdn_t ((bf16*)(ws + WS_WDN))
#define AB ((float*)(ws + WS_AB))
#define DL ((float*)(ws + WS_DL))
#define U ((bf16*)(ws + WS_U))
#define GQK ((bf16*)(ws + WS_GQK))
#define GS ((bf16*)(ws + WS_GS))
#define P ((bf16*)(ws + WS_P))
#define MIXIN ((bf16*)(ws + WS_MIXIN))
#define MIXOUT ((float*)(ws + WS_P))
#define Gt ((bf16*)(ws + WS_G))
#define UP ((bf16*)(ws + WS_UP))
#define DOWN ((float*)(ws + WS_G))
#define GMAIN ((bf16*)out)

    for (int u = tid; u < 64; u += NWAVES * 64) ((LAS unsigned*)(lds + MISC_OFF))[u] = 0u;
    __syncthreads();
    XcdBarrier bar; bar.bar = (unsigned*)(ctl + CW_BAR); bar.x = 0; bar.st = nullptr;
    if (N_LAUNCHES == 1) bar = xcd_barrier_post((unsigned*)(ctl + CW_BAR), MISC + 8);
#define GRID_BAR() do { if (N_LAUNCHES == 1) xcd_barrier(bar); } while (0)
    const int lo = args.ph_lo, hi_ = args.ph_hi;
#define IN(k) (lo <= (k) && (k) < hi_)
#define BOTH(k) (IN(k) && IN((k) + 1))
    const int gw = vcu * NWAVES + wave, NGW = G * NWAVES, gtid = bx * (NWAVES * 64) + tid, nth = G * NWAVES * 64;

    if (IN(0)) { phase_prologue(lds, x_prompt, x_sample, norm_mix_pre, w_in, w_out, w_gate_up, w_down, ws, vcu, G, tid, lane, wave); if (BOTH(0)) GRID_BAR(); }

    if (IN(1)) {
        pg8::Gemm g{U, Win_t, M, NIN, D}; pg8::StaticOrder S; S.init(M, NIN, G, bx);
        pg8::EpiBf16<0> E{P, NIN, nullptr, 0, 0, 1.f};
        pg8::gemm_phase<pg8::EpiBf16<0>, pg8::StaticOrder, true, true>(lds, g, S, E);
        if (BOTH(1)) GRID_BAR();
    }

    if (IN(2)) {
        phase_copy_outputs(P, out, gtid, nth);
        for (int u = bx; u < 1152; u += G) gdn_pre_unit(lds, u, P, AB, state_qkv, qkv_conv_w, a_log, dt_bias, GMAIN, GQK, GS, DL, tid, lane, wave);
        if (BOTH(2)) GRID_BAR();
    }

    if (IN(3)) {
        if (bx < 16) {
            const int b = bx >> 2, h = bx & 3; const int u0 = b * 256 + h * 64; const size_t m0 = (size_t)b * SEQ;
            scan_unit(lds, 64, 64, GMAIN + (size_t)u0 * 32768, 32768, GQK + (size_t)u0 * 4096, 4096, DL + u0, nullptr, out + O_DP + (size_t)(b * 4 + h) * 16384,
                      P + m0 * NIN + PC_Z + h * 128, MIXIN + m0 * D + h * 128, gdn_norm_w, tid, lane, wave);
        } else {
            for (int su = bx - 16; su < 128; su += (G - 16)) {
                const int b = su >> 2, h = su & 3; const size_t m0 = (size_t)MP + b * 32; const bf16* base = GS + (size_t)su * 36864;
                scan_unit(lds, 1, 32, base, 0, base + 32768, 0, DL + 1024 + su, state_delta + (size_t)su * 16384, out + O_DS + (size_t)su * 16384,
                          P + m0 * NIN + PC_Z + h * 128, MIXIN + m0 * D + h * 128, gdn_norm_w, tid, lane, wave);
            }
            __syncthreads();
            LAS unsigned char* wl = lds + wave * ATT_WAVE_LDS;
            for (int it = (bx - 16) * NWAVES + wave; it < 4352; it += (G - 16) * NWAVES) attn_item(wl, it, P, cache_k, cache_v, rel_bias, attn_norm_w, MIXIN, lane);
        }
        if (BOTH(3)) GRID_BAR();
    }

    if (IN(4)) {
        pg8::Gemm g{MIXIN, Wout_t, M, D, D}; pg8::StaticOrder S; S.init(M, D, G, bx);
        pg8::EpiF32 E{MIXOUT, D};
        pg8::gemm_phase<pg8::EpiF32, pg8::StaticOrder, true, true>(lds, g, S, E);
        if (BOTH(4)) GRID_BAR();
    }

    if (IN(5)) { phase_rows1(x_prompt, x_sample, MIXOUT, norm_mix_post, norm_ffn_pre, out, U, gw, NGW, lane); if (BOTH(5)) GRID_BAR(); }

    if (IN(6)) {
        pg8::Gemm g{U, Wgu_t, M, 2 * FF, D}; pg8::StaticOrder S; S.init(M, 2 * FF, G, bx);
        pg8::EpiBf16<0> E{Gt, FF, nullptr, FF, (size_t)M * FF, 1.f};
        pg8::gemm_phase<pg8::EpiBf16<0>, pg8::StaticOrder, true, true>(lds, g, S, E);
        if (BOTH(6)) GRID_BAR();
    }

    if (IN(7)) { phase_h(Gt, UP, state_ffn, ffn_conv_w, ffn_conv_b, out, gtid, nth); if (BOTH(7)) GRID_BAR(); }

    if (IN(8)) {
        pg8::Gemm g{UP, Wdn_t, M, D, FF}; pg8::StaticOrder S; S.init(M, D, G, bx);
        pg8::EpiF32 E{DOWN, D};
        pg8::gemm_phase<pg8::EpiF32, pg8::StaticOrder, true, true>(lds, g, S, E);
        if (BOTH(8)) GRID_BAR();
    }

    if (IN(9)) phase_rows2(DOWN, norm_ffn_post, out, gw, NGW, lane);
#undef IN
#undef BOTH
#undef GRID_BAR
}

extern "C" void kernel_launch(void* const* d_in, const int* in_sizes, int n_in, void* d_out, int out_size, void* d_ws, size_t ws_size, hipStream_t stream) {
    static int grid = 0;
    if (grid == 0) {
        if (n_in != 23 || out_size != 23699456 || ws_size < WS_END) { fprintf(stderr, "kernel_launch: unexpected shapes (n_in %d, out %d, ws %zu); nothing launched\n", n_in, out_size, ws_size); grid = -1; return; }
        int dev = 0, cus = 0, per_cu = 0;
        if (hipGetDevice(&dev) != hipSuccess || hipDeviceGetAttribute(&cus, hipDeviceAttributeMultiprocessorCount, dev) != hipSuccess) { grid = -1; return; }
        if (hipFuncSetAttribute((const void*)hybrid_fwd, hipFuncAttributeMaxDynamicSharedMemorySize, LDS_BYTES) != hipSuccess) { fprintf(stderr, "kernel_launch: hipFuncSetAttribute failed\n"); grid = -1; return; }
        if (hipOccupancyMaxActiveBlocksPerMultiprocessor(&per_cu, (const void*)hybrid_fwd, NWAVES * 64, LDS_BYTES) != hipSuccess || per_cu < 1) fprintf(stderr, "kernel_launch: occupancy query reports %d\n", per_cu);
        (void)hipGetLastError();
        grid = cus;
    }
    if (grid < 0) return;
    if (hipMemsetAsync((char*)d_ws + WS_CTL, 0, CTL_ZERO_BYTES, stream) != hipSuccess) { fprintf(stderr, "kernel_launch: memset failed\n"); return; }
    Args a{};
    for (int i = 0; i < 23; ++i) a.in[i] = (const float*)d_in[i];
    a.out = (float*)d_out; a.ws = (unsigned char*)d_ws;
    if (N_LAUNCHES == 1) { a.ph_lo = 0; a.ph_hi = NPH; a.li = 0; hipLaunchKernelGGL(hybrid_fwd, dim3(grid), dim3(NWAVES * 64), LDS_BYTES, stream, a); }
    else for (int li = 0; li < NPH; ++li) { a.ph_lo = li; a.ph_hi = li + 1; a.li = li; hipLaunchKernelGGL(hybrid_fwd, dim3(grid), dim3(NWAVES * 64), LDS_BYTES, stream, a);
#ifdef PROBE_DUP
        if (li == PROBE_DUP) hipLaunchKernelGGL(hybrid_fwd, dim3(grid), dim3(NWAVES * 64), LDS_BYTES, stream, a);
#endif
    }
    const hipError_t le = hipPeekAtLastError();
    if (le != hipSuccess) fprintf(stderr, "kernel_launch: launch failed: %s\n", hipGetErrorName(le));
}
```

```cpp
#include <hip/hip_runtime.h>
#include <cstdio>
#include <cstdint>
namespace pg8 {
#define PG8_LAS __attribute__((address_space(3)))
typedef unsigned short bf16_t;
typedef short bf16x8 __attribute__((ext_vector_type(8)));
typedef float f32x4 __attribute__((ext_vector_type(4)));
typedef unsigned u32x4 __attribute__((ext_vector_type(4)));
constexpr int BM = 256, BK = 64, HALF = 128, HTB = HALF * BK * 2  , STAGE_BYTES = 8 * HTB, NXCD = 8, WGM = 8;

__host__ __device__ __forceinline__ int lds_byte(int r, int c) { const int st = (r >> 4) * 2 + (c >> 5), rr = r & 15, cc = c & 31, ob = rr * 64 + cc * 2; return st * 1024 + (ob ^ (((ob >> 9) & 1) << 5)); }
__host__ __device__ __forceinline__ void stage_rc(int b, int& R, int& C) { const int st = b / 1024, sb = b % 1024, swz = sb ^ (((sb >> 9) & 1) << 5); R = (st >> 1) * 16 + swz / 64; C = (st & 1) * 32 + (swz % 64) / 2; }
__host__ __device__ __forceinline__ int perm32(int rho) { const int n = rho >> 4, i = rho & 15; return 8 * (i >> 2) + 4 * n + (i & 3); }

struct Unit { int pm, pn; };
struct Gemm { const bf16_t* A; const bf16_t* Bt; int M, N, K; };

struct StaticOrder {
    int nM, nN, nwg, G, c;
    __host__ __device__ void init(int M, int N, int G_, int c_) { nM = M / BM; nN = N / BM; nwg = nM * nN; G = G_; c = c_; }
    __host__ __device__ bool next(int i, Unit& u) const {
        const long L = (long)i * G + c; if (L >= nwg) return false;
        int wgid = (int)L; { const int q = nwg / NXCD, r = nwg % NXCD, xcd = wgid % NXCD, off = wgid / NXCD; wgid = (xcd < r ? xcd * (q + 1) : r * (q + 1) + (xcd - r) * q) + off; }
        const int nig = WGM * nN, gid = wgid / nig, fm = gid * WGM, gsz = (nM - fm) < WGM ? (nM - fm) : WGM;
        u.pm = fm + ((wgid % nig) % gsz); u.pn = (wgid % nig) / gsz; return true;
    }
    __device__ __forceinline__ void a_ready(const Unit&) const {}
    __device__ __forceinline__ void done(const Unit&) const {}
};

__device__ __forceinline__ unsigned cvt_pk_bf16(float lo, float hi) { unsigned r; asm volatile("v_cvt_pk_bf16_f32 %0, %1, %2" : "=v"(r) : "v"(lo), "v"(hi)); return r; }
typedef float f32x2 __attribute__((ext_vector_type(2)));
__device__ __forceinline__ f32x2 gelu_pk(f32x2 v) {
    const f32x2 av = __builtin_elementwise_abs(v), d = av * 0.2316418882f + 1.0f;
    f32x2 t; t.x = __builtin_amdgcn_rcpf(d.x); t.y = __builtin_amdgcn_rcpf(d.y);
    f32x2 q = t * 0.5307027145f + (-0.7265760135f); q = q * t + 0.7107068705f; q = q * t + (-0.142248368f); q = q * t + 0.127414796f; q = q * t;
    const f32x2 s = (v * v) * (-0.72134752044f);
    f32x2 e; e.x = __builtin_amdgcn_exp2f(s.x); e.y = __builtin_amdgcn_exp2f(s.y);
    const f32x2 m = v * (q * e), r = v - m;
    f32x2 o; o.x = v.x < 0.f ? m.x : r.x; o.y = v.y < 0.f ? m.y : r.y; return o;
}

template <int ACT  > struct EpiBf16 {
    static constexpr bool PERM = true, AFTER_DRAIN = false; static_assert(ACT == 0 || ACT == 1, "EpiBf16: ACT is 0 (none) or 1 (gelu_pk)");
    bf16_t* O; int ldc; const float* bias; int split_cols; size_t split_stride; float scale0;
    __device__ __forceinline__ void operator()(const f32x4 (&acc)[2][2][4][2], const Unit& u, int wr, int wc, int fr, int fq) const {
        const int row0 = u.pm * BM + wr * 64 + fr; int colt = u.pn * BM; bf16_t* base = O;
        float sc = 1.f; if (split_cols) { const int t = colt / split_cols; base += (size_t)t * split_stride; colt -= t * split_cols; if (t == 0) sc = scale0; }
        const int col0 = colt + wc * 32 + 8 * fq, bcol0 = u.pn * BM + wc * 32 + 8 * fq;
        f32x4 bv[2][2];
#pragma unroll
        for (int bj = 0; bj < 2; ++bj)
#pragma unroll
            for (int n = 0; n < 2; ++n) bv[bj][n] = bias ? *(const f32x4*)(bias + bcol0 + bj * HALF + 4 * n) : (f32x4){0.f, 0.f, 0.f, 0.f};
#pragma unroll
        for (int ai = 0; ai < 2; ++ai)
#pragma unroll
            for (int m = 0; m < 4; ++m) { bf16_t* rowp = base + (size_t)(row0 + ai * HALF + m * 16) * ldc + col0;
#pragma unroll
                for (int bj = 0; bj < 2; ++bj) { f32x4 v0 = acc[ai][bj][m][0] + bv[bj][0], v1 = acc[ai][bj][m][1] + bv[bj][1];
                    if (ACT == 1) { f32x2 a = gelu_pk((f32x2){v0[0], v0[1]}), b = gelu_pk((f32x2){v0[2], v0[3]}), c = gelu_pk((f32x2){v1[0], v1[1]}), d = gelu_pk((f32x2){v1[2], v1[3]});
                        v0 = (f32x4){a.x, a.y, b.x, b.y}; v1 = (f32x4){c.x, c.y, d.x, d.y}; }
                    v0 = v0 * sc; v1 = v1 * sc; u32x4 w; w.x = cvt_pk_bf16(v0[0], v0[1]); w.y = cvt_pk_bf16(v0[2], v0[3]); w.z = cvt_pk_bf16(v1[0], v1[1]); w.w = cvt_pk_bf16(v1[2], v1[3]);
                    *(u32x4*)(rowp + bj * HALF) = w; } }
    }
};

struct EpiF32 {
    static constexpr bool PERM = false, AFTER_DRAIN = false;
    float* O; int ldc;
    __device__ __forceinline__ void operator()(const f32x4 (&acc)[2][2][4][2], const Unit& u, int wr, int wc, int fr, int fq) const {
        const int row0 = u.pm * BM + wr * 64 + fr, col0 = u.pn * BM + wc * 32 + 4 * fq;
#pragma unroll
        for (int ai = 0; ai < 2; ++ai)
#pragma unroll
            for (int m = 0; m < 4; ++m) { float* rowp = O + (size_t)(row0 + ai * HALF + m * 16) * ldc + col0;
#pragma unroll
                for (int bj = 0; bj < 2; ++bj)
#pragma unroll
                    for (int n = 0; n < 2; ++n) *(f32x4*)(rowp + bj * HALF + n * 16) = acc[ai][bj][m][n]; }
    }
};

template <class Epi, class Sched, bool ALIGN_EPI = false, bool SP2 = false>
__device__ __forceinline__ void gemm_phase(PG8_LAS unsigned char* lds, const Gemm g, const Sched& S, const Epi& E) {
    const int tid = threadIdx.x, wid = __builtin_amdgcn_readfirstlane(tid >> 6), lane = tid & 63, wr = wid >> 2, wc = wid & 3, fr = lane & 15, fq = lane >> 4;
    const int K = g.K, nt = K / BK;
    unsigned voffA[2], voffB[2];
#pragma unroll
    for (int i = 0; i < 2; ++i) { int R, C; stage_rc(tid * 16 + i * 8192, R, C); const int Rb = Epi::PERM ? ((R & ~31) + perm32(R & 31)) : R;
        voffA[i] = (unsigned)(R * K + C) * 2u; voffB[i] = (unsigned)(Rb * K + C) * 2u; }
    const size_t kstep = (size_t)(BK * 2);
    const size_t hstep = (size_t)HALF * K * 2;
    const size_t tstep = 2 * hstep;
    const unsigned ldsw = (unsigned)wid * 1024u;
    const int aoff = lds_byte(wr * 64 + fr, fq * 8), boff = lds_byte(wc * 32 + fr, fq * 8);
#define PG8_SA(b, h) (((b) * 2 + (h)) * HTB)
#define PG8_SB(b, h) ((4 + (b) * 2 + (h)) * HTB)
#define PG8_STAGE(bufoff, gbase, voff) do { _Pragma("unroll") for (int _i = 0; _i < 2; ++_i) \
        __builtin_amdgcn_global_load_lds((const unsigned*)((const char*)(gbase) + (voff)[_i]), (PG8_LAS unsigned*)(lds + (bufoff) + ldsw + _i * 8192), 16, 0, 0); } while (0)
#define PG8_LDA(dst, b, h) do { _Pragma("unroll") for (int m = 0; m < 4; ++m) _Pragma("unroll") for (int k = 0; k < 2; ++k) dst[m][k] = *(const PG8_LAS bf16x8*)(lds + PG8_SA(b, h) + aoff + m * 2048 + k * 1024); } while (0)
#define PG8_LDB(dst, b, h) do { _Pragma("unroll") for (int n = 0; n < 2; ++n) _Pragma("unroll") for (int k = 0; k < 2; ++k) dst[n][k] = *(const PG8_LAS bf16x8*)(lds + PG8_SB(b, h) + boff + n * 2048 + k * 1024); } while (0)
#define PG8_MMA(ai, bj, At, Bt) do { __builtin_amdgcn_s_setprio(1); _Pragma("unroll") for (int m = 0; m < 4; ++m) _Pragma("unroll") for (int n = 0; n < 2; ++n) _Pragma("unroll") for (int k = 0; k < 2; ++k) \
        acc[ai][bj][m][n] = __builtin_amdgcn_mfma_f32_16x16x32_bf16(Bt[n][k], At[m][k], acc[ai][bj][m][n], 0, 0, 0); __builtin_amdgcn_s_setprio(0); } while (0)
#define PG8_WAIT_V(n) asm volatile("s_waitcnt vmcnt(" #n ")" ::: "memory")
#define PG8_WAIT_L(n) asm volatile("s_waitcnt lgkmcnt(" #n ")" ::: "memory")
#define PG8_BAR __builtin_amdgcn_s_barrier()
#define PG8_SCHED __builtin_amdgcn_sched_barrier(0)
    Unit cur, nxt; int ui = 0;
    if (!S.next(0, cur)) return;
    f32x4 acc[2][2][4][2];
#pragma unroll
    for (int a = 0; a < 2; ++a)
#pragma unroll
        for (int b = 0; b < 2; ++b)
#pragma unroll
            for (int m = 0; m < 4; ++m)
#pragma unroll
                for (int n = 0; n < 2; ++n) acc[a][b][m][n] = (f32x4){0.f, 0.f, 0.f, 0.f};
    bf16x8 At[4][2], B0[2][2], B1[2][2];
    const char* cA = (const char*)g.A + (size_t)cur.pm * tstep; const char* cB = (const char*)g.Bt + (size_t)cur.pn * tstep;
    S.a_ready(cur);
    if constexpr (SP2) {
        PG8_STAGE(PG8_SB(0, 0), cB, voffB); PG8_STAGE(PG8_SB(0, 1), cB + hstep, voffB); PG8_STAGE(PG8_SA(0, 0), cA, voffA); PG8_STAGE(PG8_SA(0, 1), cA + hstep, voffA);
        if (wr == 1) PG8_BAR;
        PG8_WAIT_V(2); PG8_BAR;
        PG8_STAGE(PG8_SB(1, 0), cB + kstep, voffB); PG8_STAGE(PG8_SA(1, 0), cA + kstep, voffA); PG8_STAGE(PG8_SB(1, 1), cB + hstep + kstep, voffB);
        PG8_WAIT_V(6); PG8_BAR;
    } else {
        PG8_STAGE(PG8_SB(0, 0), cB, voffB); PG8_STAGE(PG8_SA(0, 0), cA, voffA); PG8_STAGE(PG8_SB(0, 1), cB + hstep, voffB); PG8_STAGE(PG8_SA(0, 1), cA + hstep, voffA);
        if (wr == 1) PG8_BAR;
        PG8_WAIT_V(4); PG8_BAR;
        PG8_STAGE(PG8_SB(1, 0), cB + kstep, voffB); PG8_STAGE(PG8_SA(1, 0), cA + kstep, voffA); PG8_STAGE(PG8_SB(1, 1), cB + hstep + kstep, voffB);
        PG8_WAIT_V(6); PG8_BAR;
    }
    for (;;) {
        const bool has_next = S.next(ui + 1, nxt);
        const char* nA = has_next ? (const char*)g.A + (size_t)nxt.pm * tstep : cA; const char* nB = has_next ? (const char*)g.Bt + (size_t)nxt.pn * tstep : cB;
        for (int t = 0; t < nt; t += 2) {
            const bool last = (t == nt - 2);
            const char* a1 = cA + (size_t)(t + 1) * kstep;
            const char* a2 = last ? nA : cA + (size_t)(t + 2) * kstep; const char* b2 = last ? nB : cB + (size_t)(t + 2) * kstep;
            const char* a3 = a2 + kstep; const char* b3 = b2 + kstep;
            if (last && has_next) S.a_ready(nxt);
            if constexpr (SP2) {
            PG8_LDB(B0, 0, 0); PG8_LDB(B1, 0, 1); PG8_SCHED; PG8_LDA(At, 0, 0); PG8_STAGE(PG8_SA(1, 1), a1 + hstep, voffA);
            PG8_WAIT_V(8); PG8_WAIT_L(0); PG8_BAR; PG8_MMA(0, 0, At, B0); PG8_MMA(0, 1, At, B1); PG8_BAR; PG8_SCHED;
            PG8_LDA(At, 0, 1); PG8_STAGE(PG8_SB(0, 0), b2, voffB); PG8_STAGE(PG8_SB(0, 1), b2 + hstep, voffB); PG8_STAGE(PG8_SA(0, 0), a2, voffA);
            PG8_WAIT_V(8); PG8_WAIT_L(0); PG8_BAR; PG8_MMA(1, 0, At, B0); PG8_MMA(1, 1, At, B1); PG8_BAR; PG8_SCHED;
            PG8_LDB(B0, 1, 0); PG8_LDB(B1, 1, 1); PG8_SCHED; PG8_LDA(At, 1, 0); PG8_STAGE(PG8_SA(0, 1), a2 + hstep, voffA);
            PG8_WAIT_V(8); PG8_WAIT_L(0); PG8_BAR; PG8_MMA(0, 0, At, B0); PG8_MMA(0, 1, At, B1); PG8_BAR; PG8_SCHED;
            PG8_LDA(At, 1, 1); PG8_STAGE(PG8_SB(1, 0), b3, voffB); PG8_STAGE(PG8_SB(1, 1), b3 + hstep, voffB); PG8_STAGE(PG8_SA(1, 0), a3, voffA);
            PG8_WAIT_V(8); PG8_WAIT_L(0); PG8_BAR; PG8_MMA(1, 0, At, B0); PG8_MMA(1, 1, At, B1); PG8_BAR; PG8_SCHED;
            } else {
            PG8_LDB(B0, 0, 0); PG8_SCHED; PG8_LDA(At, 0, 0); PG8_STAGE(PG8_SA(1, 1), a1 + hstep, voffA);
            PG8_WAIT_L(8); PG8_BAR; PG8_WAIT_L(0); PG8_MMA(0, 0, At, B0); PG8_BAR; PG8_SCHED;
            PG8_LDB(B1, 0, 1); PG8_STAGE(PG8_SB(0, 0), b2, voffB);
            PG8_BAR; PG8_WAIT_L(0); PG8_MMA(0, 1, At, B1); PG8_BAR;
            PG8_LDA(At, 0, 1); PG8_STAGE(PG8_SA(0, 0), a2, voffA);
            PG8_BAR; PG8_WAIT_L(0); PG8_MMA(1, 0, At, B0); PG8_BAR; PG8_SCHED;
            PG8_STAGE(PG8_SB(0, 1), b2 + hstep, voffB);
            PG8_WAIT_V(6); PG8_BAR; PG8_MMA(1, 1, At, B1); PG8_BAR;
            PG8_LDB(B0, 1, 0); PG8_SCHED; PG8_LDA(At, 1, 0); PG8_STAGE(PG8_SA(0, 1), a2 + hstep, voffA);
            PG8_WAIT_L(8); PG8_BAR; PG8_WAIT_L(0); PG8_MMA(0, 0, At, B0); PG8_BAR; PG8_SCHED;
            PG8_LDB(B1, 1, 1); PG8_STAGE(PG8_SB(1, 0), b3, voffB);
            PG8_BAR; PG8_WAIT_L(0); PG8_MMA(0, 1, At, B1); PG8_BAR;
            PG8_LDA(At, 1, 1); PG8_STAGE(PG8_SA(1, 0), a3, voffA);
            PG8_BAR; PG8_WAIT_L(0); PG8_MMA(1, 0, At, B0); PG8_BAR; PG8_SCHED;
            PG8_STAGE(PG8_SB(1, 1), b3 + hstep, voffB);
            PG8_WAIT_V(6); PG8_BAR; PG8_MMA(1, 1, At, B1); PG8_BAR;
            }
        }
        if constexpr (ALIGN_EPI) { if (wr == 0) PG8_BAR; }
        if constexpr (!Epi::AFTER_DRAIN) { E(acc, cur, wr, wc, fr, fq); S.done(cur); }
        if (!has_next) break;
#pragma unroll
        for (int a = 0; a < 2; ++a)
#pragma unroll
            for (int b = 0; b < 2; ++b)
#pragma unroll
                for (int m = 0; m < 4; ++m)
#pragma unroll
                    for (int n = 0; n < 2; ++n) acc[a][b][m][n] = (f32x4){0.f, 0.f, 0.f, 0.f};
        cur = nxt; cA = nA; cB = nB; ++ui;
        if constexpr (ALIGN_EPI) { if (wr == 1) PG8_BAR; }
    }
    PG8_WAIT_V(0);
    if constexpr (!ALIGN_EPI) { if (wr == 0) PG8_BAR; }
    PG8_BAR;
    if constexpr (Epi::AFTER_DRAIN) { E.fused(acc, cur, wr, wc, fr, fq, lds, wid, lane); S.done(cur); }
#undef PG8_SA
#undef PG8_SB
#undef PG8_STAGE
#undef PG8_LDA
#undef PG8_LDB
#undef PG8_MMA
#undef PG8_WAIT_V
#undef PG8_WAIT_L
#undef PG8_BAR
#undef PG8_SCHED
}
}

constexpr int NWAVES = 8;
constexpr int D = 1024, SEQ = 4096, MP = 16384, MS = 1024, M = MP + MS;
constexpr int NIN = 3584, INC = 3592, FF = 2816;
constexpr int PC_Z = 1536, PC_QB = 2048, PC_KB = 2560, PC_VB = 3072;
constexpr float EPS = 1e-6f;
constexpr size_t O_YP = 0, O_YS = 16777216, O_BKP = 17825792, O_BVP = 18874368, O_DP = 19922944, O_QCP = 20185088, O_FCP = 20203520,
                 O_BKS = 20226048, O_BVS = 20750336, O_DS = 21274624, O_QCS = 23371776, O_FCS = 23519232;
constexpr size_t MiB = 1u << 20;
constexpr size_t WS_CTL = 0, CTL_ZERO_BYTES = 1 * MiB;
constexpr size_t WS_WIN = 1 * MiB, WS_WOUT = 8 * MiB, WS_WGU = 10 * MiB, WS_WDN = 21 * MiB;
constexpr size_t WS_AB = 27 * MiB, WS_DL = 27 * MiB + 768 * 1024;
constexpr size_t WS_U = 28 * MiB;
constexpr size_t WS_GQK = WS_U, WS_GS = WS_U + 8 * MiB;
constexpr size_t WS_P = 62 * MiB;
constexpr size_t WS_MIXIN = 181 * MiB;
constexpr size_t WS_G = WS_P, WS_UP = WS_P + (size_t)M * FF * 2;
constexpr size_t WS_END = 256 * MiB;
static_assert(WS_UP + (size_t)M * FF * 2 <= WS_END, "ws map");
constexpr int CW_BAR = 4096;

constexpr int LDS_BYTES = 163840;
constexpr int MISC_OFF = LDS_BYTES - 256;

#define GAS __attribute__((address_space(1)))
#define LAS __attribute__((address_space(3)))
typedef unsigned short bf16;
typedef unsigned v4u __attribute__((ext_vector_type(4)));
typedef unsigned v2u __attribute__((ext_vector_type(2)));
typedef float f32x2 __attribute__((ext_vector_type(2)));
typedef float f32x4 __attribute__((ext_vector_type(4)));
typedef float f32x16 __attribute__((ext_vector_type(16)));
typedef short bf16x8 __attribute__((ext_vector_type(8)));
typedef short s16x4 __attribute__((ext_vector_type(4)));
typedef __bf16 bf16x2_t __attribute__((ext_vector_type(2)));
typedef GAS unsigned gu32;
#define RLX_AGENT __ATOMIC_RELAXED, __HIP_MEMORY_SCOPE_AGENT
#define LDS_WAIT() asm volatile("s_waitcnt lgkmcnt(0)" ::: "memory")
#define VM_WAIT() asm volatile("s_waitcnt vmcnt(0)" ::: "memory")
__device__ __forceinline__ unsigned pk2(float lo, float hi) { f32x2 v = {lo, hi}; bf16x2_t b = __builtin_convertvector(v, bf16x2_t); return __builtin_bit_cast(unsigned, b); }
__device__ __forceinline__ float bflo(unsigned w) { return __uint_as_float(w << 16); }
__device__ __forceinline__ float bfhi(unsigned w) { return __uint_as_float(w & 0xffff0000u); }
__device__ __forceinline__ float bf1(bf16 b) { return __uint_as_float((unsigned)b << 16); }
__device__ __forceinline__ bf16 f2bf(float f) { return (bf16)(pk2(f, 0.f) & 0xffffu); }
__device__ __forceinline__ float wave_sum(float v) {
#pragma unroll
    for (int o = 1; o < 64; o <<= 1) v += __shfl_xor(v, o);
    return v;
}
__device__ __forceinline__ float sigmoidf_(float x) { return 1.0f / (1.0f + __expf(-x)); }
__device__ __forceinline__ int crow(int r, int hi) { return (r & 3) + 8 * (r >> 2) + 4 * hi; }
#define MFMA32(a, b, c) __builtin_amdgcn_mfma_f32_32x32x16_bf16((a), (b), (c), 0, 0, 0)
#define MFMA16(a, b, c) __builtin_amdgcn_mfma_f32_16x16x32_bf16((a), (b), (c), 0, 0, 0)
#define XB_TMO      128
#define XB_XCNT(j)  (256  + 64 * (j))
#define XB_XSUB(j)  (1280 + 64 * (j))
#define XB_XGEN(j)  (2304 + 64 * (j))
#define XB_TOP      3328
#define XB_TOPGEN   3392
#define XCD_BAR_WORDS 3456
#define XB_SPIN_CAP (1u << 18)

__device__ __forceinline__ unsigned xb_ld(unsigned* p)              { return __hip_atomic_load(p, __ATOMIC_RELAXED, __HIP_MEMORY_SCOPE_AGENT); }
__device__ __forceinline__ unsigned xb_add(unsigned* p, unsigned v) { return __hip_atomic_fetch_add(p, v, __ATOMIC_RELAXED, __HIP_MEMORY_SCOPE_AGENT); }
__device__ __forceinline__ unsigned xb_xcc_id() { return (unsigned)__builtin_amdgcn_s_getreg((3 << 11) | 20) & 0xFu; }
#define XB_SPIN(cond, bar) do { unsigned _sp = 0; while (cond) { __builtin_amdgcn_s_sleep(1); \
    if ((++_sp & 255u) == 0u) { if (xb_ld(&(bar)[XB_TMO])) break; if (_sp > XB_SPIN_CAP) { atomicAdd(&(bar)[XB_TMO], 1u); break; } } } } while (0)

struct XcdBarrier {
    unsigned* bar; unsigned x;
    volatile LAS unsigned* st;
};

__device__ __forceinline__ XcdBarrier xcd_barrier_post(unsigned* bar, volatile LAS unsigned* st) {
    XcdBarrier b; b.bar = bar; b.x = xb_xcc_id(); b.st = st;
    if (threadIdx.x == 0) (void)xb_add(&bar[XB_XCNT(b.x)], 1u);
    return b;
}
__device__ __forceinline__ void xcd_barrier_complete(unsigned* bar, unsigned x, unsigned& nloc, unsigned& nx) {
    const unsigned G = gridDim.x * gridDim.y * gridDim.z;
    unsigned sum, cnt, mine, sp = 0u;
    for (;;) {
        sum = 0u; cnt = 0u; mine = 0u;
#pragma unroll
        for (unsigned j = 0; j < 16; ++j) { const unsigned c = xb_ld(&bar[XB_XCNT(j)]); sum += c; cnt += (c > 0u) ? 1u : 0u; mine = (j == x) ? c : mine; }
        if (sum == G) break;
        __builtin_amdgcn_s_sleep(1);
        if ((++sp & 255u) == 0u) { if (xb_ld(&bar[XB_TMO])) break; if (sp > XB_SPIN_CAP) { atomicAdd(&bar[XB_TMO], 1u); break; } }
    }
    nloc = mine > 0u ? mine : 1u; nx = cnt > 0u ? cnt : 1u;
}

__device__ __forceinline__ void xcd_barrier(const XcdBarrier& b) {
    asm volatile("s_waitcnt vmcnt(0)" ::: "memory");
    __syncthreads();
    if (threadIdx.x == 0) {
        unsigned* bar = b.bar;
        __builtin_amdgcn_s_waitcnt(0);
        unsigned nloc = b.st[0], nx = b.st[1];
        if (nloc == 0u) { xcd_barrier_complete(bar, b.x, nloc, nx); b.st[0] = nloc; b.st[1] = nx; }
        const unsigned old = xb_add(&bar[XB_XSUB(b.x)], 1u);
        const unsigned gen = old / nloc;
        if (old + 1u == (gen + 1u) * nloc) {
            __builtin_amdgcn_fence(__ATOMIC_RELEASE, "agent");
            asm volatile("s_waitcnt vmcnt(0)" ::: "memory");
            const unsigned og = xb_add(&bar[XB_TOP], 1u);
            const unsigned tg = og / nx;
            if (og + 1u == (tg + 1u) * nx) xb_add(&bar[XB_TOPGEN], 1u);
            else XB_SPIN(xb_ld(&bar[XB_TOPGEN]) == tg, bar);
            __builtin_amdgcn_fence(__ATOMIC_ACQUIRE, "agent");
            xb_add(&bar[XB_XGEN(b.x)], 1u);
            asm volatile("s_waitcnt vmcnt(0)" ::: "memory");
        } else {
            XB_SPIN(xb_ld(&bar[XB_XGEN(b.x)]) == gen, bar);
            __builtin_amdgcn_fence(__ATOMIC_ACQUIRE, "agent");
            asm volatile("s_waitcnt vmcnt(0)" ::: "memory");
        }
    }
    __syncthreads();
}

__device__ __forceinline__ void p0_transpose_item(const float* W, int ldw, int K, int N, bf16* WT, int row_off, LAS float* scr, int item, int lane) {
    const int nblk = N / 32, kb = item / nblk, nb = item % nblk, k0 = 64 * kb, n0 = 32 * nb;
#pragma unroll 8
    for (int i = 0; i < 32; ++i) { const int kk = 2 * i + (lane >> 5); scr[kk * 33 + (lane & 31)] = W[(size_t)(k0 + kk) * ldw + n0 + (lane & 31)]; }
    LDS_WAIT(); asm volatile("" ::: "memory");
    const int c = lane & 7;
#pragma unroll
    for (int j = 0; j < 4; ++j) { const int n = (lane >> 3) + 8 * j; const LAS float* s = scr + (8 * c) * 33 + n;
        v4u o; o.x = pk2(s[0 * 33], s[1 * 33]); o.y = pk2(s[2 * 33], s[3 * 33]); o.z = pk2(s[4 * 33], s[5 * 33]); o.w = pk2(s[6 * 33], s[7 * 33]);
        *(v4u*)(WT + (size_t)(row_off + n0 + n) * K + k0 + 8 * c) = o; }
    LDS_WAIT(); asm volatile("" ::: "memory");
}

__device__ __forceinline__ void phase_prologue(LAS unsigned char* lds, const float* xp, const float* xs, const float* nw, const float* w_in, const float* w_out, const float* w_gu, const float* w_dn,
                                               unsigned char* ws, int vcu, int G, int tid, int lane, int wave) {
    LAS float* scr = (LAS float*)(lds + wave * 8448);
    LAS float* W8T = (LAS float*)(lds + 67584);
    for (int k = tid; k < 1024; k += 512) {
        const f32x4 a = *(const f32x4*)(w_in + (size_t)k * INC + 2048), b = *(const f32x4*)(w_in + (size_t)k * INC + 2052);
        W8T[0 * 1024 + k] = a.x; W8T[1 * 1024 + k] = a.y; W8T[2 * 1024 + k] = a.z; W8T[3 * 1024 + k] = a.w;
        W8T[4 * 1024 + k] = b.x; W8T[5 * 1024 + k] = b.y; W8T[6 * 1024 + k] = b.z; W8T[7 * 1024 + k] = b.w;
    }
    __syncthreads();
    const int gw = vcu * NWAVES + wave, NGW = G * NWAVES;
    bf16* Win_t = (bf16*)(ws + WS_WIN); bf16* Wout_t = (bf16*)(ws + WS_WOUT); bf16* Wgu_t = (bf16*)(ws + WS_WGU); bf16* Wdn_t = (bf16*)(ws + WS_WDN);
    constexpr int I_A = 16 * 64, I_B = 16 * 48, I_O = 16 * 32, I_GU = 16 * 176, I_DN = 44 * 32;
    constexpr int NITEMS = I_A + I_B + I_O + I_GU + I_DN;
    for (int it = gw; it < NITEMS; it += NGW) {
        int r = it;
        if (r < I_A) { p0_transpose_item(w_in, INC, D, 2048, Win_t, 0, scr, r, lane); continue; } r -= I_A;
        if (r < I_B) { p0_transpose_item(w_in + 2056, INC, D, 1536, Win_t, 2048, scr, r, lane); continue; } r -= I_B;
        if (r < I_O) { p0_transpose_item(w_out, D, D, D, Wout_t, 0, scr, r, lane); continue; } r -= I_O;
        if (r < I_GU) { p0_transpose_item(w_gu, 2 * FF, D, 2 * FF, Wgu_t, 0, scr, r, lane); continue; } r -= I_GU;
        p0_transpose_item(w_dn, D, FF, D, Wdn_t, 0, scr, r, lane);
    }
    bf16* U = (bf16*)(ws + WS_U); float* AB = (float*)(ws + WS_AB);
    for (int m = gw; m < M; m += NGW) {
        const float* xrow = m < MP ? xp + (size_t)m * D : xs + (size_t)(m - MP) * D;
        f32x4 v[4]; float s = 0.f;
#pragma unroll
        for (int j = 0; j < 4; ++j) { v[j] = ((const f32x4*)xrow)[lane + 64 * j]; s += (v[j].x * v[j].x + v[j].y * v[j].y) + (v[j].z * v[j].z + v[j].w * v[j].w); }
        const float rstd = rsqrtf(wave_sum(s) * (1.f / D) + EPS);
        unsigned long long* o8 = (unsigned long long*)(U + (size_t)m * D) + lane;
#pragma unroll
        for (int j = 0; j < 4; ++j) { const f32x4 g = ((const f32x4*)nw)[lane + 64 * j]; v[j] = v[j] * rstd * g;
            o8[64 * j] = (unsigned long long)pk2(v[j].x, v[j].y) | ((unsigned long long)pk2(v[j].z, v[j].w) << 32); }
        float dv = 0.f;
#pragma unroll
        for (int jj = 0; jj < 8; ++jj) { float acc = 0.f;
#pragma unroll
            for (int j = 0; j < 4; ++j) { const f32x4 w = *(const LAS f32x4*)(W8T + jj * 1024 + 4 * lane + 256 * j); acc += (v[j].x * w.x + v[j].y * w.y) + (v[j].z * w.z + v[j].w * w.w); }
            acc = wave_sum(acc); if (lane == jj) dv = acc; }
        if (lane < 8) AB[(size_t)m * 8 + lane] = dv;
    }
}

__device__ __forceinline__ void phase_copy_outputs(const bf16* P, float* out, int gtid, int nth) {
    for (int e = gtid; e < 4 * 512 * 512; e += nth) { const int b = e >> 18, j = (e >> 9) & 511, c = e & 511; const size_t row = (size_t)(b * SEQ + 3584 + j) * NIN;
        out[O_BKP + e] = bf1(P[row + PC_KB + c]); out[O_BVP + e] = bf1(P[row + PC_VB + c]); }
    for (int e = gtid; e < 32 * 32 * 512; e += nth) { const int r = e >> 9, c = e & 511; const size_t row = (size_t)(MP + r) * NIN;
        out[O_BKS + e] = bf1(P[row + PC_KB + c]); out[O_BVS + e] = bf1(P[row + PC_VB + c]); }
    for (int e = gtid; e < 4 * 3 * 1536; e += nth) { const int b = e / 4608, i = (e / 1536) % 3, c = e % 1536; out[O_QCP + e] = bf1(P[(size_t)(b * SEQ + 4093 + i) * NIN + c]); }
    for (int e = gtid; e < 32 * 3 * 1536; e += nth) { const int b = e / 4608, i = (e / 1536) % 3, c = e % 1536; out[O_QCS + e] = bf1(P[(size_t)(MP + b * 32 + 29 + i) * NIN + c]); }
}

__device__ __forceinline__ bf16x8 pack8(const f32x4& a, const f32x4& b) { const v4u t = {pk2(a[0], a[1]), pk2(a[2], a[3]), pk2(b[0], b[1]), pk2(b[2], b[3])}; return __builtin_bit_cast(bf16x8, t); }
__device__ __forceinline__ int kperm(int k) { const int kk = k & 31; return (k & ~31) | (8 * ((kk & 15) >> 2) + (kk & 3) + 4 * (kk >> 4)); }
__device__ __forceinline__ void gdn_pre_unit(LAS unsigned char* lds, int u, const bf16* P, const float* AB, const float* st_qkv, const float* conv_w, const float* a_log, const float* dt_bias,
                                             bf16* gmain, bf16* gqk, bf16* gs, float* DL, int tid, int lane, int wave) {
    LAS float* RHS = (LAS float*)(lds + 0);
    LAS bf16* QB = (LAS bf16*)(lds + 65536);
    LAS bf16* KB = (LAS bf16*)(lds + 82944);
    LAS bf16* RAW = (LAS bf16*)(lds + 100352);
    LAS bf16* KGT = (LAS bf16*)(lds + 117760);
    LAS bf16* AMN = (LAS bf16*)(lds + 117760);
    LAS float* TD = (LAS float*)(lds + 117760 + 10240);
    LAS bf16* TB = (LAS bf16*)(lds + 117760 + 14336);
    LAS float* SMG = (LAS float*)(lds + 136192);
    const bool prompt = u < 1024;
    int b, h, n, m0, valid; bf16 *o_w, *o_qg, *o_kgt, *o_ut, *o_qk;
    if (prompt) { b = u >> 8; h = (u >> 6) & 3; n = u & 63; m0 = b * SEQ + n * 64; valid = 64; bf16* base = gmain + (size_t)u * 32768; o_w = base; o_qg = base + 8192; o_kgt = base + 16384; o_ut = base + 24576; o_qk = gqk + (size_t)u * 4096; }
    else { const int su = u - 1024; b = su >> 2; h = su & 3; n = 0; m0 = MP + b * 32; valid = 32; bf16* base = gs + (size_t)su * 36864; o_w = base; o_qg = base + 8192; o_kgt = base + 16384; o_ut = base + 24576; o_qk = base + 32768; }
    if (wave == 0) {
        const int i = lane; const bool v = i < valid;
        const float araw = v ? AB[(size_t)(m0 + i) * 8 + 4 + h] : 0.f, braw = v ? AB[(size_t)(m0 + i) * 8 + h] : 0.f;
        const float A = expf(a_log[h]); const float x = araw + dt_bias[h];
        const float sp = x > 20.f ? x : log1pf(expf(x));
        const float g = v ? -A * sp : 0.f; const float beta = v ? 1.f / (1.f + expf(-braw)) : 0.f;
        float Gc = g;
#pragma unroll
        for (int off = 1; off < 64; off <<= 1) { const float t = __shfl_up(Gc, off); if (lane >= off) Gc += t; }
        const float Gl = __shfl(Gc, 63);
        SMG[i] = Gc; SMG[64 + i] = beta; SMG[128 + i] = expf(Gc); SMG[192 + i] = expf(Gl - Gc);
        if (lane == 0) DL[u] = expf(Gl);
    }
    __syncthreads();
#pragma unroll 1
    for (int part = 0; part < 3; ++part) {
        const int pcol = (part == 0 ? 512 : part == 1 ? 0 : 1024) + h * 128;
#pragma unroll
        for (int pass = 0; pass < 3; ++pass) {
            const int rr = (tid >> 4) + 32 * pass, ch = tid & 15;
            if (rr < 67) {
                v4u val = {0u, 0u, 0u, 0u};
                if (prompt) { const int ts = n * 64 - 3 + rr; if (ts >= 0) val = *(const v4u*)(P + (size_t)(b * SEQ + ts) * NIN + pcol + ch * 8); }
                else { if (rr < 3) { const float* s = st_qkv + ((size_t)b * 3 + rr) * 1536 + pcol + ch * 8; const f32x4 a = *(const f32x4*)s, c = *(const f32x4*)(s + 4); val = (v4u){pk2(a.x, a.y), pk2(a.z, a.w), pk2(c.x, c.y), pk2(c.z, c.w)}; }
                       else if (rr - 3 < 32) val = *(const v4u*)(P + (size_t)(MP + b * 32 + rr - 3) * NIN + pcol + ch * 8); }
                *(LAS v4u*)(RAW + rr * 128 + ch * 8) = val;
            }
        }
        __syncthreads();
        float w0[4], w1[4];
#pragma unroll
        for (int i = 0; i < 4; ++i) { const f32x2 t = *(const f32x2*)(conv_w + i * 1536 + pcol + 2 * lane); w0[i] = t.x; w1[i] = t.y; }
#pragma unroll 2
        for (int rq = 0; rq < 8; ++rq) {
            const int r = wave * 8 + rq;
            float y0 = 0.f, y1 = 0.f;
#pragma unroll
            for (int i = 0; i < 4; ++i) { const unsigned xw = *(const LAS unsigned*)(RAW + (r + i) * 128 + 2 * lane); y0 += w0[i] * bflo(xw); y1 += w1[i] * bfhi(xw); }
            float s0 = y0 * sigmoidf_(y0), s1 = y1 * sigmoidf_(y1);
            if (r >= valid) { s0 = 0.f; s1 = 0.f; }
            if (part == 2) { const float be = SMG[64 + r]; *(LAS f32x2*)(RHS + r * 256 + 2 * lane) = (f32x2){s0 * be, s1 * be}; }
            else {
                const float rinv = rsqrtf(wave_sum(s0 * s0 + s1 * s1) + EPS);
                if (part == 0) { const float k0 = s0 * rinv, k1 = s1 * rinv; *(LAS unsigned*)(KB + r * 136 + 2 * lane) = pk2(k0, k1);
                    const float be = SMG[64 + r] * SMG[128 + r]; *(LAS f32x2*)(RHS + r * 256 + 128 + 2 * lane) = (f32x2){k0 * be, k1 * be};
                    const float egl = SMG[192 + r]; KGT[(2 * lane) * 64 + kperm(r)] = f2bf(k0 * egl); KGT[(2 * lane + 1) * 64 + kperm(r)] = f2bf(k1 * egl); }
                else { const float sc = rinv * 0.08838834764831845f; const float q0 = s0 * sc, q1 = s1 * sc; *(LAS unsigned*)(QB + r * 136 + 2 * lane) = pk2(q0, q1);
                    const float eg = SMG[128 + r]; *(unsigned*)(o_qg + r * 128 + kperm(2 * lane)) = pk2(q0 * eg, q1 * eg); }
            }
        }
        __syncthreads();
        if (part == 0) {
#pragma unroll
            for (int k = 0; k < 2; ++k) { const int pi = tid + 512 * k; *(v4u*)(o_kgt + pi * 8) = *(const LAS v4u*)(KGT + pi * 8); }
        }
    }
    {
        const int mat = wave >> 2, ti = (wave >> 1) & 1, tj = wave & 1, r32 = lane & 31, hi = lane >> 5;
        const LAS bf16* Ab = (mat == 0 ? KB : QB) + (32 * ti + r32) * 136 + 8 * hi;
        const LAS bf16* Bb = KB + (32 * tj + r32) * 136 + 8 * hi;
        f32x16 acc;
#pragma unroll
        for (int r = 0; r < 16; ++r) acc[r] = 0.f;
#pragma unroll
        for (int s = 0; s < 8; ++s) acc = MFMA32(*(const LAS bf16x8*)(Ab + 16 * s), *(const LAS bf16x8*)(Bb + 16 * s), acc);
        const int j = 32 * tj + r32; const float Gj = SMG[j];
#pragma unroll
        for (int r = 0; r < 16; ++r) { const int i = 32 * ti + crow(r, hi); const float dec = expf(fminf(SMG[i] - Gj, 0.f));
            if (mat == 0) { const float av = (i > j) ? acc[r] * SMG[64 + i] * dec : 0.f; AMN[i * 80 + kperm(j)] = f2bf(-av); if ((i >> 4) == (j >> 4)) TD[(i >> 4) * 256 + (i & 15) * 16 + (j & 15)] = av; }
            else o_qk[i * 64 + kperm(j)] = f2bf((i >= j) ? acc[r] * dec : 0.f); }
    }
    __syncthreads();
    if (wave == 0) {
        const int bb = lane >> 4, c = lane & 15; float y[16];
        const LAS float* tdp = TD + bb * 256;
#pragma unroll
        for (int i = 0; i < 16; ++i) { float a[16];
#pragma unroll
            for (int j4 = 0; j4 < 4; ++j4) if (4 * j4 < i) { const f32x4 t = *(const LAS f32x4*)(tdp + i * 16 + 4 * j4); a[4 * j4] = t.x; a[4 * j4 + 1] = t.y; a[4 * j4 + 2] = t.z; a[4 * j4 + 3] = t.w; }
            float s0 = (i == c) ? 1.f : 0.f, s1 = 0.f;
#pragma unroll
            for (int j = 0; j < i; ++j) { if (j & 1) s1 = fmaf(-a[j], y[j], s1); else s0 = fmaf(-a[j], y[j], s0); }
            y[i] = s0 + s1;
            const int pc = 8 * (c >> 2) + (c & 3);
            TB[(bb * 16 + i) * 32 + pc] = f2bf(y[i]); TB[(bb * 16 + i) * 32 + pc + 4] = 0; }
    }
    __syncthreads();
    {
        const int cl = lane & 15, q = lane >> 4;
        const f32x4 zero4 = {0.f, 0.f, 0.f, 0.f};
        const LAS unsigned char* amn = (const LAS unsigned char*)AMN + cl * 160 + q * 16;
        const LAS unsigned char* tbp = (const LAS unsigned char*)TB + cl * 64 + q * 16;
#pragma unroll 1
        for (int nt = 0; nt < 2; ++nt) {
            const int col = 32 * wave + 16 * nt + cl;
            f32x4 X[4];
#pragma unroll
            for (int b4 = 0; b4 < 4; ++b4) {
                f32x4 R;
#pragma unroll
                for (int r = 0; r < 4; ++r) R[r] = RHS[(16 * b4 + 4 * q + r) * 256 + col];
                if (b4 == 1) R = MFMA16(*(const LAS bf16x8*)(amn + 16 * 160), pack8(X[0], zero4), R);
                if (b4 == 2) R = MFMA16(*(const LAS bf16x8*)(amn + 32 * 160), pack8(X[0], X[1]), R);
                if (b4 == 3) { R = MFMA16(*(const LAS bf16x8*)(amn + 48 * 160), pack8(X[0], X[1]), R); R = MFMA16(*(const LAS bf16x8*)(amn + 48 * 160 + 64), pack8(X[2], zero4), R); }
                X[b4] = MFMA16(*(const LAS bf16x8*)(tbp + b4 * 16 * 64), pack8(R, zero4), zero4);
            }
            if (wave < 4) {
#pragma unroll
                for (int b4 = 0; b4 < 4; ++b4) *(v2u*)(o_ut + col * 64 + 16 * b4 + 4 * q) = (v2u){pk2(X[b4][0], X[b4][1]), pk2(X[b4][2], X[b4][3])};
            } else { const int pk = kperm(col - 128);
#pragma unroll
                for (int b4 = 0; b4 < 4; ++b4)
#pragma unroll
                    for (int r = 0; r < 4; ++r) o_w[(16 * b4 + 4 * q + r) * 128 + pk] = f2bf(X[b4][r]); }
        }
    }
    __syncthreads();
}

constexpr int SL_W = 0, SL_QG = 18432, SL_KGT = 36864, SL_UT = 57344, SL_QK = 75776, SL_O = 86016, SL_OSZ = 33792, SL_END = SL_O + 2 * SL_OSZ;
__device__ __forceinline__ bf16x8 ldfrag(const LAS unsigned char* p) { return *(const LAS bf16x8*)p; }
__device__ __forceinline__ void scan_unit(LAS unsigned char* lds, int nsteps, int nrows, const bf16* gmain, size_t main_stride, const bf16* gqk, size_t qk_stride, const float* DLp,
                                          const float* S0, float* Sout, const bf16* Pz  , bf16* MX  , const float* gnw, int tid, int lane, int wave) {
    const int cl = lane & 15, q = lane >> 4, c0 = wave * 16;
    f32x4 S[8];
#pragma unroll
    for (int mt = 0; mt < 8; ++mt)
#pragma unroll
        for (int r = 0; r < 4; ++r) S[mt][r] = S0 ? S0[(16 * mt + 4 * q + r) * 128 + c0 + cl] : 0.f;
    const f32x2 gw2 = *(const f32x2*)(gnw + 2 * lane);
    v4u Ra[9], Rb[9]; unsigned Za[8], Zb[8];
#define SCAN_LOAD(R, nn) do { const bf16* mp_ = gmain + (size_t)(nn) * main_stride; _Pragma("unroll") for (int k = 0; k < 8; ++k) R[k] = *(const v4u*)(mp_ + (size_t)(tid + 512 * k) * 8); \
        R[8] = *(const v4u*)(gqk + (size_t)(nn) * qk_stride + (size_t)tid * 8); } while (0)
#define SCAN_LOADZ(Z, nn) do { _Pragma("unroll") for (int rq = 0; rq < 8; ++rq) Z[rq] = *(const unsigned*)(Pz + ((size_t)(nn) * 64 + wave * 8 + rq) * NIN + 2 * lane); } while (0)
#define SCAN_NORM(Z, OB, nn) do { float ox_[8], oy_[8], ss_[8]; \
        _Pragma("unroll") for (int rq = 0; rq < 8; ++rq) { const f32x2 ov_ = *(const LAS f32x2*)((OB) + (wave * 8 + rq) * 132 + 2 * lane); ox_[rq] = ov_.x; oy_[rq] = ov_.y; ss_[rq] = ov_.x * ov_.x + ov_.y * ov_.y; } \
        _Pragma("unroll") for (int off_ = 1; off_ < 64; off_ <<= 1) { _Pragma("unroll") for (int rq = 0; rq < 8; ++rq) ss_[rq] += __shfl_xor(ss_[rq], off_); } \
        _Pragma("unroll") for (int rq = 0; rq < 8; ++rq) { const int r_ = wave * 8 + rq; const float rstd_ = rsqrtf(ss_[rq] * (1.f / 128.f) + EPS); const float z0_ = bflo(Z[rq]), z1_ = bfhi(Z[rq]); \
            if (r_ < nrows) *(unsigned*)(MX + ((size_t)(nn) * 64 + r_) * D + 2 * lane) = pk2(ox_[rq] * rstd_ * gw2.x * z0_ * sigmoidf_(z0_), oy_[rq] * rstd_ * gw2.y * z1_ * sigmoidf_(z1_)); } } while (0)
#define SCAN_BAR() asm volatile("s_waitcnt lgkmcnt(0)\n\ts_barrier" ::: "memory")
#define SCAN_STEP(n, R, ZC, ZP, OC, OP) do { \
        SCAN_BAR();                                            \
        _Pragma("unroll") for (int k = 0; k < 8; ++k) { const int a_ = k >> 1, within_ = tid + 512 * (k & 1); int dst_; \
            if (a_ < 2) dst_ = (a_ == 0 ? SL_W : SL_QG) + (within_ >> 4) * 288 + (within_ & 15) * 16; else dst_ = (a_ == 2 ? SL_KGT + (within_ >> 3) * 160 : SL_UT + (within_ >> 3) * 144) + (within_ & 7) * 16; \
            *(LAS v4u*)(lds + dst_) = R[k]; } \
        *(LAS v4u*)(lds + SL_QK + (tid >> 3) * 160 + (tid & 7) * 16) = R[8]; \
        asm volatile("" ::: "memory");                         \
        SCAN_LOADZ(ZC, n); \
        if ((n) + 2 < nsteps) SCAN_LOAD(R, (n) + 2); \
        const float dl_ = __uint_as_float(__builtin_amdgcn_readlane(dlbits, (n))); \
        SCAN_BAR(); \
        bf16x8 Sb_[4]; \
        _Pragma("unroll") for (int ks = 0; ks < 4; ++ks) Sb_[ks] = pack8(S[2 * ks], S[2 * ks + 1]); \
        f32x4 vn_[4], o_[4]; \
        _Pragma("unroll") for (int mt = 0; mt < 4; ++mt) { \
            f32x4 aw_ = {0.f, 0.f, 0.f, 0.f}, ao_ = {0.f, 0.f, 0.f, 0.f}; \
            const LAS unsigned char* wp_ = lds + SL_W + (16 * mt + cl) * 288 + q * 16; const LAS unsigned char* qp_ = lds + SL_QG + (16 * mt + cl) * 288 + q * 16; \
            _Pragma("unroll") for (int ks = 0; ks < 4; ++ks) { aw_ = MFMA16(ldfrag(wp_ + ks * 64), Sb_[ks], aw_); ao_ = MFMA16(ldfrag(qp_ + ks * 64), Sb_[ks], ao_); } \
            const v2u uu_ = *(const LAS v2u*)(lds + SL_UT + (c0 + cl) * 144 + (16 * mt + 4 * q) * 2); \
            vn_[mt] = (f32x4){bflo(uu_.x) - aw_[0], bfhi(uu_.x) - aw_[1], bflo(uu_.y) - aw_[2], bfhi(uu_.y) - aw_[3]}; \
            o_[mt] = ao_; } \
        bf16x8 Vb_[2]; \
        _Pragma("unroll") for (int ks = 0; ks < 2; ++ks) Vb_[ks] = pack8(vn_[2 * ks], vn_[2 * ks + 1]); \
        _Pragma("unroll") for (int mt = 0; mt < 4; ++mt) { const LAS unsigned char* kp_ = lds + SL_QK + (16 * mt + cl) * 160 + q * 16; \
            _Pragma("unroll") for (int ks = 0; ks < 2; ++ks) o_[mt] = MFMA16(ldfrag(kp_ + ks * 64), Vb_[ks], o_[mt]); } \
        _Pragma("unroll") for (int mt = 0; mt < 4; ++mt) _Pragma("unroll") for (int r = 0; r < 4; ++r) (OC)[(16 * mt + 4 * q + r) * 132 + c0 + cl] = o_[mt][r]; \
        _Pragma("unroll") for (int mt = 0; mt < 8; ++mt) { S[mt] = S[mt] * dl_; const LAS unsigned char* kp_ = lds + SL_KGT + (16 * mt + cl) * 160 + q * 16; \
            _Pragma("unroll") for (int ks = 0; ks < 2; ++ks) S[mt] = MFMA16(ldfrag(kp_ + ks * 64), Vb_[ks], S[mt]); } \
        if ((n) > 0) SCAN_NORM(ZP, OP, (n) - 1); \
    } while (0)
    LAS float* O0 = (LAS float*)(lds + SL_O); LAS float* O1 = (LAS float*)(lds + SL_O + SL_OSZ);
    const int dlbits = (int)__float_as_uint(lane < nsteps ? DLp[lane] : 1.f);
    SCAN_LOAD(Ra, 0);
    if (nsteps > 1) SCAN_LOAD(Rb, 1);
#pragma unroll 1
    for (int n = 0; n < nsteps; n += 2) {
        SCAN_STEP(n, Ra, Za, Zb, O0, O1);
        if (n + 1 < nsteps) SCAN_STEP(n + 1, Rb, Zb, Za, O1, O0);
    }
    SCAN_BAR();
    if (nsteps & 1) SCAN_NORM(Za, O0, nsteps - 1); else SCAN_NORM(Zb, O1, nsteps - 1);
#undef SCAN_LOAD
#undef SCAN_LOADZ
#undef SCAN_NORM
#undef SCAN_STEP
#undef SCAN_BAR
#pragma unroll
    for (int mt = 0; mt < 8; ++mt)
#pragma unroll
        for (int r = 0; r < 4; ++r) Sout[(16 * mt + 4 * q + r) * 128 + c0 + cl] = S[mt][r];
    __syncthreads();
}


constexpr int ATT_WAVE_LDS = 17920;
constexpr float LOG2E = 1.4426950408889634f;
typedef short v4i16_t __attribute__((ext_vector_type(4)));
__device__ __forceinline__ s16x4 vtr(const LAS unsigned char* p) { return __builtin_bit_cast(s16x4, __builtin_amdgcn_ds_read_tr16_b64_v4i16((LAS v4i16_t*)p)); }
__device__ __forceinline__ void attn_item(LAS unsigned char* wl, int it, const bf16* P, const float* ck, const float* cv, const float* relb, const float* anw, bf16* MIXIN, int lane) {
    LAS unsigned char* KL = wl; LAS unsigned char* VL = wl + 8192; LAS float* SC = (LAS float*)(wl + 16384); LAS float* BT = (LAS float*)(wl + 16640);
    const int r32 = lane & 31, hi = lane >> 5;
    const bool sample = it < 256;
    int b, h, n = 0, half = 0, mq, t0, t1;
    if (sample) { b = it >> 3; h = it & 7; mq = MP + b * 32; t0 = 0; t1 = 9; }
    else { const int idx = it - 256; half = idx & 1; n = (idx >> 1) & 63; h = (idx >> 7) & 7; b = idx >> 10; mq = b * SEQ + n * 64 + half * 32; t0 = n > 8 ? n - 8 : 0; t1 = n + 1; }
    for (int k = lane; k < 257; k += 64) BT[k] = relb[h * 257 + k] * LOG2E;
    bf16x8 qr[4];
#pragma unroll
    for (int d0 = 0; d0 < 4; ++d0) qr[d0] = *(const bf16x8*)(P + (size_t)(mq + r32) * NIN + PC_QB + h * 64 + d0 * 16 + hi * 8);
    float mrun = -1e30f, lrun = 0.f; f32x16 o0, o1;
#pragma unroll
    for (int r = 0; r < 16; ++r) { o0[r] = 0.f; o1[r] = 0.f; }
    const int ti = lane & 15, blk = (lane >> 4) & 1;
    const LAS unsigned char* vbase = VL + (4 * hi + (ti >> 2)) * 128 + (blk * 16 + 4 * (ti & 3)) * 2;
#pragma unroll 1
    for (int t = t0; t < t1; ++t) {
        int relbase; bool maskhalf = false;
        if (sample && t < 8) {
            relbase = 512 - 64 * t;
#pragma unroll
            for (int i8 = 0; i8 < 8; ++i8) { const int idx = i8 * 64 + lane, key = idx >> 3, c8 = idx & 7; const size_t off = (((size_t)b * 512 + 64 * t + key) * 8 + h) * 64 + c8 * 8;
                const f32x4 ka = *(const f32x4*)(ck + off), kb = *(const f32x4*)(ck + off + 4), va = *(const f32x4*)(cv + off), vb = *(const f32x4*)(cv + off + 4);
                *(LAS v4u*)(KL + (c8 * 64 + key) * 16) = (v4u){pk2(ka.x, ka.y), pk2(ka.z, ka.w), pk2(kb.x, kb.y), pk2(kb.z, kb.w)};
                *(LAS v4u*)(VL + key * 128 + c8 * 16) = (v4u){pk2(va.x, va.y), pk2(va.z, va.w), pk2(vb.x, vb.y), pk2(vb.z, vb.w)}; }
        } else {
            size_t rowbase; int nvalid;
            if (sample) { relbase = 0; maskhalf = true; rowbase = (size_t)MP + b * 32; nvalid = 32; }
            else { relbase = 64 * (n - t) + 32 * half; rowbase = (size_t)b * SEQ + t * 64; nvalid = 64; }
#pragma unroll
            for (int i8 = 0; i8 < 8; ++i8) { const int idx = i8 * 64 + lane, key = idx >> 3, c8 = idx & 7; v4u kv = {0u, 0u, 0u, 0u}, vv = {0u, 0u, 0u, 0u};
                if (key < nvalid) { const bf16* rp = P + (rowbase + key) * NIN + h * 64 + c8 * 8; kv = *(const v4u*)(rp + PC_KB); vv = *(const v4u*)(rp + PC_VB); }
                *(LAS v4u*)(KL + (c8 * 64 + key) * 16) = kv; *(LAS v4u*)(VL + key * 128 + c8 * 16) = vv; }
        }
        f32x16 p0, p1;
#pragma unroll
        for (int r = 0; r < 16; ++r) { p0[r] = 0.f; p1[r] = 0.f; }
#pragma unroll
        for (int d0 = 0; d0 < 4; ++d0) { const bf16x8 k0 = *(const LAS bf16x8*)(KL + (2 * d0 + hi) * 1024 + r32 * 16), k1 = *(const LAS bf16x8*)(KL + (2 * d0 + hi) * 1024 + 512 + r32 * 16);
            p0 = MFMA32(k0, qr[d0], p0); p1 = MFMA32(k1, qr[d0], p1); }
        const float SC2 = 0.125f * LOG2E;
        if (relbase - 63 >= 128) { const float bc = BT[256];
#pragma unroll
            for (int r = 0; r < 16; ++r) { p0[r] = p0[r] * SC2 + bc; p1[r] = p1[r] * SC2 + bc; } }
        else {
#pragma unroll
            for (int r = 0; r < 16; ++r) { const int rel = relbase + r32 - crow(r, hi); int i0 = (rel > 128 ? 128 : rel) + 128, i1 = (rel - 32 > 128 ? 128 : rel - 32) + 128; i0 = i0 < 0 ? 0 : i0; i1 = i1 < 0 ? 0 : i1;
                p0[r] = p0[r] * SC2 + BT[i0]; p1[r] = p1[r] * SC2 + BT[i1]; } }
        if (maskhalf) {
#pragma unroll
            for (int r = 0; r < 16; ++r) p1[r] = -INFINITY; }
        float mx = fmaxf(p0[0], p1[0]);
#pragma unroll
        for (int r = 1; r < 16; ++r) mx = fmaxf(mx, fmaxf(p0[r], p1[r]));
        mx = fmaxf(mx, __shfl_xor(mx, 32));
        const float mnew = fmaxf(mrun, mx); const float alpha = __builtin_amdgcn_exp2f(mrun - mnew); mrun = mnew;
        float sum = 0.f;
#pragma unroll
        for (int r = 0; r < 16; ++r) { p0[r] = __builtin_amdgcn_exp2f(p0[r] - mnew); p1[r] = __builtin_amdgcn_exp2f(p1[r] - mnew); sum += p0[r] + p1[r]; }
        lrun = lrun * alpha + sum;
        if (hi == 0) SC[r32] = alpha;
#pragma unroll
        for (int r = 0; r < 16; ++r) { const float a = SC[crow(r, hi)]; o0[r] *= a; o1[r] *= a; }
#pragma unroll
        for (int s = 0; s < 4; ++s) {
            v4u pw;
            if (s < 2) pw = (v4u){pk2(p0[8 * s + 0], p0[8 * s + 1]), pk2(p0[8 * s + 2], p0[8 * s + 3]), pk2(p0[8 * s + 4], p0[8 * s + 5]), pk2(p0[8 * s + 6], p0[8 * s + 7])};
            else { const int ss = s - 2; pw = (v4u){pk2(p1[8 * ss + 0], p1[8 * ss + 1]), pk2(p1[8 * ss + 2], p1[8 * ss + 3]), pk2(p1[8 * ss + 4], p1[8 * ss + 5]), pk2(p1[8 * ss + 6], p1[8 * ss + 7])}; }
            const bf16x8 pa = __builtin_bit_cast(bf16x8, pw);
            const LAS unsigned char* vp = vbase + (16 * s) * 128;
            const s16x4 a0 = vtr(vp), a1 = vtr(vp + 8 * 128), b0 = vtr(vp + 64), b1 = vtr(vp + 8 * 128 + 64);
            const bf16x8 v0 = {a0[0], a0[1], a0[2], a0[3], a1[0], a1[1], a1[2], a1[3]}, v1 = {b0[0], b0[1], b0[2], b0[3], b1[0], b1[1], b1[2], b1[3]};
            o0 = MFMA32(pa, v0, o0); o1 = MFMA32(pa, v1, o1);
        }
    }
    lrun += __shfl_xor(lrun, 32);
    if (hi == 0) SC[32 + r32] = 1.f / lrun;
    LAS float* OL = (LAS float*)wl;
#pragma unroll
    for (int r = 0; r < 16; ++r) { const int qq = crow(r, hi); const float inv = SC[32 + qq]; OL[qq * 66 + r32] = o0[r] * inv; OL[qq * 66 + 32 + r32] = o1[r] * inv; }
    {
        const int qq = lane >> 1, dh = (lane & 1) * 32; float vals[32]; float ss = 0.f;
#pragma unroll
        for (int k = 0; k < 32; ++k) { vals[k] = OL[qq * 66 + dh + k]; ss += vals[k] * vals[k]; }
        ss += __shfl_xor(ss, 1);
        const float rstd = rsqrtf(ss * (1.f / 64.f) + EPS);
        bf16* op = MIXIN + (size_t)(mq + qq) * D + 512 + h * 64 + dh;
#pragma unroll
        for (int k4 = 0; k4 < 4; ++k4) { v4u o;
            const f32x4 wa = *(const f32x4*)(anw + dh + 8 * k4), wb = *(const f32x4*)(anw + dh + 8 * k4 + 4);
            o.x = pk2(vals[8 * k4 + 0] * rstd * wa.x, vals[8 * k4 + 1] * rstd * wa.y); o.y = pk2(vals[8 * k4 + 2] * rstd * wa.z, vals[8 * k4 + 3] * rstd * wa.w);
            o.z = pk2(vals[8 * k4 + 4] * rstd * wb.x, vals[8 * k4 + 5] * rstd * wb.y); o.w = pk2(vals[8 * k4 + 6] * rstd * wb.z, vals[8 * k4 + 7] * rstd * wb.w);
            *(v4u*)(op + 8 * k4) = o; }
    }
}

__device__ __forceinline__ void phase_rows1(const float* xp, const float* xs, const float* mix, const float* w_post, const float* w_pre2, float* out, bf16* U, int gw, int NGW, int lane) {
    for (int m = gw; m < M; m += NGW) {
        const float* xrow = m < MP ? xp + (size_t)m * D : xs + (size_t)(m - MP) * D;
        f32x4 v[4], xv[4]; float s = 0.f;
#pragma unroll
        for (int j = 0; j < 4; ++j) { v[j] = ((const f32x4*)(mix + (size_t)m * D))[lane + 64 * j]; xv[j] = ((const f32x4*)xrow)[lane + 64 * j]; s += (v[j].x * v[j].x + v[j].y * v[j].y) + (v[j].z * v[j].z + v[j].w * v[j].w); }
        const float rstd = rsqrtf(wave_sum(s) * (1.f / D) + EPS); float s2 = 0.f;
#pragma unroll
        for (int j = 0; j < 4; ++j) { const f32x4 g = ((const f32x4*)w_post)[lane + 64 * j]; v[j] = xv[j] + v[j] * rstd * g; ((f32x4*)(out + (size_t)m * D))[lane + 64 * j] = v[j];
            s2 += (v[j].x * v[j].x + v[j].y * v[j].y) + (v[j].z * v[j].z + v[j].w * v[j].w); }
        const float rstd2 = rsqrtf(wave_sum(s2) * (1.f / D) + EPS);
        unsigned long long* o8 = (unsigned long long*)(U + (size_t)m * D) + lane;
#pragma unroll
        for (int j = 0; j < 4; ++j) { const f32x4 g = ((const f32x4*)w_pre2)[lane + 64 * j]; const f32x4 t = v[j] * rstd2 * g;
            o8[64 * j] = (unsigned long long)pk2(t.x, t.y) | ((unsigned long long)pk2(t.z, t.w) << 32); }
    }
}
__device__ __forceinline__ void phase_rows2(const float* dn, const float* w, float* out, int gw, int NGW, int lane) {
    for (int m = gw; m < M; m += NGW) {
        f32x4 v[4]; float s = 0.f;
#pragma unroll
        for (int j = 0; j < 4; ++j) { v[j] = ((const f32x4*)(dn + (size_t)m * D))[lane + 64 * j]; s += (v[j].x * v[j].x + v[j].y * v[j].y) + (v[j].z * v[j].z + v[j].w * v[j].w); }
        const float rstd = rsqrtf(wave_sum(s) * (1.f / D) + EPS);
#pragma unroll
        for (int j = 0; j < 4; ++j) { const f32x4 g = ((const f32x4*)w)[lane + 64 * j]; f32x4* op = (f32x4*)(out + (size_t)m * D) + lane + 64 * j; *op = *op + v[j] * rstd * g; }
    }
}
__device__ __forceinline__ float gelu_tanh(float x) { const float y = 0.7978845608028654f * (x + 0.044715f * x * x * x); const float t = 1.f - 2.f / (1.f + __expf(2.f * y)); return 0.5f * x * (1.f + t); }
__device__ __forceinline__ void phase_h(const bf16* Gt, bf16* UP, const float* st_ffn, const float* cw, const float* cb, float* out, int gtid, int nth) {
    constexpr int CG = FF / 8;
    for (int idx = gtid; idx < M * CG; idx += nth) {
        const int m = idx / CG, c = (idx % CG) * 8;
        float g2[8], g1[8], g0[8];
        { const v4u t = *(const v4u*)(Gt + (size_t)m * FF + c); g2[0] = bflo(t.x); g2[1] = bfhi(t.x); g2[2] = bflo(t.y); g2[3] = bfhi(t.y); g2[4] = bflo(t.z); g2[5] = bfhi(t.z); g2[6] = bflo(t.w); g2[7] = bfhi(t.w); }
        int tpos, bsm = 0; const bool smp = m >= MP;
        if (smp) { tpos = (m - MP) & 31; bsm = (m - MP) >> 5; } else tpos = m & (SEQ - 1);
        if (tpos >= 1) { const v4u t = *(const v4u*)(Gt + (size_t)(m - 1) * FF + c); g1[0] = bflo(t.x); g1[1] = bfhi(t.x); g1[2] = bflo(t.y); g1[3] = bfhi(t.y); g1[4] = bflo(t.z); g1[5] = bfhi(t.z); g1[6] = bflo(t.w); g1[7] = bfhi(t.w); }
        else if (smp) { const float* s = st_ffn + ((size_t)bsm * 2 + 1) * FF + c;
#pragma unroll
            for (int e = 0; e < 8; ++e) g1[e] = s[e]; }
        else {
#pragma unroll
            for (int e = 0; e < 8; ++e) g1[e] = 0.f; }
        if (tpos >= 2) { const v4u t = *(const v4u*)(Gt + (size_t)(m - 2) * FF + c); g0[0] = bflo(t.x); g0[1] = bfhi(t.x); g0[2] = bflo(t.y); g0[3] = bfhi(t.y); g0[4] = bflo(t.z); g0[5] = bfhi(t.z); g0[6] = bflo(t.w); g0[7] = bfhi(t.w); }
        else if (smp) { const float* s = st_ffn + ((size_t)bsm * 2 + tpos) * FF + c;
#pragma unroll
            for (int e = 0; e < 8; ++e) g0[e] = s[e]; }
        else {
#pragma unroll
            for (int e = 0; e < 8; ++e) g0[e] = 0.f; }
        const v4u ut = *(const v4u*)(UP + (size_t)m * FF + c);
        float up[8] = {bflo(ut.x), bfhi(ut.x), bflo(ut.y), bfhi(ut.y), bflo(ut.z), bfhi(ut.z), bflo(ut.w), bfhi(ut.w)};
        float hv[8];
#pragma unroll
        for (int e = 0; e < 8; ++e) { const float x = cw[c + e] * g0[e] + cw[FF + c + e] * g1[e] + cw[2 * FF + c + e] * g2[e] + cb[c + e]; hv[e] = gelu_tanh(x) * up[e]; }
        const v4u o = {pk2(hv[0], hv[1]), pk2(hv[2], hv[3]), pk2(hv[4], hv[5]), pk2(hv[6], hv[7])};
        *(v4u*)(UP + (size_t)m * FF + c) = o;
        const int tl = smp ? 32 : SEQ;
        if (tpos >= tl - 2) { const int i = tpos - (tl - 2); float* op = smp ? out + O_FCS + ((size_t)bsm * 2 + i) * FF + c : out + O_FCP + ((size_t)(m >> 12) * 2 + i) * FF + c;
#pragma unroll
            for (int e = 0; e < 8; ++e) op[e] = g2[e]; }
    }
}

#ifndef MK_N_LAUNCHES
#define MK_N_LAUNCHES 1
#endif
constexpr int NPH = 10;
constexpr int N_LAUNCHES = MK_N_LAUNCHES;
struct Args { const float* in[23]; float* out; unsigned char* ws; int ph_lo, ph_hi, li, pad; };
__global__ void __launch_bounds__(NWAVES * 64, 2) hybrid_fwd(Args args) {
    extern __shared__ __attribute__((aligned(16))) unsigned char lds_raw[];
    LAS unsigned char* lds = (LAS unsigned char*)lds_raw;
    volatile LAS unsigned* MISC = (volatile LAS unsigned*)(lds + MISC_OFF);
    const int tid = threadIdx.x, lane = tid & 63, wave = __builtin_amdgcn_readfirstlane(tid >> 6);
    const int G = gridDim.x; const int bx = blockIdx.x; const int vcu = (G % 8 == 0) ? (bx % 8) * (G / 8) + bx / 8 : bx;
    unsigned char* ws = args.ws; float* out = args.out;
    gu32* ctl = (gu32*)(ws + WS_CTL);
#define x_prompt (args.in[0])
#define x_sample (args.in[1])
#define cache_k (args.in[2])
#define cache_v (args.in[3])
#define state_delta (args.in[4])
#define state_qkv (args.in[5])
#define state_ffn (args.in[6])
#define norm_mix_pre (args.in[7])
#define w_in (args.in[8])
#define qkv_conv_w (args.in[9])
#define a_log (args.in[10])
#define dt_bias (args.in[11])
#define gdn_norm_w (args.in[12])
#define rel_bias (args.in[13])
#define attn_norm_w (args.in[14])
#define w_out (args.in[15])
#define norm_mix_post (args.in[16])
#define norm_ffn_pre (args.in[17])
#define w_gate_up (args.in[18])
#define ffn_conv_w (args.in[19])
#define ffn_conv_b (args.in[20])
#define w_down (args.in[21])
#define norm_ffn_post (args.in[22])
#define Win_t ((bf16*)(ws + WS_WIN))
#define Wout_t ((bf16*)(ws + WS_WOUT))
#define Wgu_t ((bf16*)(ws + WS_WGU))
#define Wdn_t ((bf16*)(ws + WS_WDN))
#define AB ((float*)(ws + WS_AB))
#define DL ((float*)(ws + WS_DL))
#define U ((bf16*)(ws + WS_U))
#define GQK ((bf16*)(ws + WS_GQK))
#define GS ((bf16*)(ws + WS_GS))
#define P ((bf16*)(ws + WS_P))
#define MIXIN ((bf16*)(ws + WS_MIXIN))
#define MIXOUT ((float*)(ws + WS_P))
#define Gt ((bf16*)(ws + WS_G))
#define UP ((bf16*)(ws + WS_UP))
#define DOWN ((float*)(ws + WS_G))
#define GMAIN ((bf16*)out)

    for (int u = tid; u < 64; u += NWAVES * 64) ((LAS unsigned*)(lds + MISC_OFF))[u] = 0u;
    __syncthreads();
    XcdBarrier bar; bar.bar = (unsigned*)(ctl + CW_BAR); bar.x = 0; bar.st = nullptr;
    if (N_LAUNCHES == 1) bar = xcd_barrier_post((unsigned*)(ctl + CW_BAR), MISC + 8);
#define GRID_BAR() do { if (N_LAUNCHES == 1) xcd_barrier(bar); } while (0)
    const int lo = args.ph_lo, hi_ = args.ph_hi;
#define IN(k) (lo <= (k) && (k) < hi_)
#define BOTH(k) (IN(k) && IN((k) + 1))
    const int gw = vcu * NWAVES + wave, NGW = G * NWAVES, gtid = bx * (NWAVES * 64) + tid, nth = G * NWAVES * 64;

    if (IN(0)) { phase_prologue(lds, x_prompt, x_sample, norm_mix_pre, w_in, w_out, w_gate_up, w_down, ws, vcu, G, tid, lane, wave); if (BOTH(0)) GRID_BAR(); }

    if (IN(1)) {
        pg8::Gemm g{U, Win_t, M, NIN, D}; pg8::StaticOrder S; S.init(M, NIN, G, bx);
        pg8::EpiBf16<0> E{P, NIN, nullptr, 0, 0, 1.f};
        pg8::gemm_phase<pg8::EpiBf16<0>, pg8::StaticOrder, true, true>(lds, g, S, E);
        if (BOTH(1)) GRID_BAR();
    }

    if (IN(2)) {
        phase_copy_outputs(P, out, gtid, nth);
        for (int u = bx; u < 1152; u += G) gdn_pre_unit(lds, u, P, AB, state_qkv, qkv_conv_w, a_log, dt_bias, GMAIN, GQK, GS, DL, tid, lane, wave);
        if (BOTH(2)) GRID_BAR();
    }

    if (IN(3)) {
        if (bx < 16) {
            const int b = bx >> 2, h = bx & 3; const int u0 = b * 256 + h * 64; const size_t m0 = (size_t)b * SEQ;
            scan_unit(lds, 64, 64, GMAIN + (size_t)u0 * 32768, 32768, GQK + (size_t)u0 * 4096, 4096, DL + u0, nullptr, out + O_DP + (size_t)(b * 4 + h) * 16384,
                      P + m0 * NIN + PC_Z + h * 128, MIXIN + m0 * D + h * 128, gdn_norm_w, tid, lane, wave);
        } else {
            for (int su = bx - 16; su < 128; su += (G - 16)) {
                const int b = su >> 2, h = su & 3; const size_t m0 = (size_t)MP + b * 32; const bf16* base = GS + (size_t)su * 36864;
                scan_unit(lds, 1, 32, base, 0, base + 32768, 0, DL + 1024 + su, state_delta + (size_t)su * 16384, out + O_DS + (size_t)su * 16384,
                          P + m0 * NIN + PC_Z + h * 128, MIXIN + m0 * D + h * 128, gdn_norm_w, tid, lane, wave);
            }
            __syncthreads();
            LAS unsigned char* wl = lds + wave * ATT_WAVE_LDS;
            for (int it = (bx - 16) * NWAVES + wave; it < 4352; it += (G - 16) * NWAVES) attn_item(wl, it, P, cache_k, cache_v, rel_bias, attn_norm_w, MIXIN, lane);
        }
        if (BOTH(3)) GRID_BAR();
    }

    if (IN(4)) {
        pg8::Gemm g{MIXIN, Wout_t, M, D, D}; pg8::StaticOrder S; S.init(M, D, G, bx);
        pg8::EpiF32 E{MIXOUT, D};
        pg8::gemm_phase<pg8::EpiF32, pg8::StaticOrder, true, true>(lds, g, S, E);
        if (BOTH(4)) GRID_BAR();
    }

    if (IN(5)) { phase_rows1(x_prompt, x_sample, MIXOUT, norm_mix_post, norm_ffn_pre, out, U, gw, NGW, lane); if (BOTH(5)) GRID_BAR(); }

    if (IN(6)) {
        pg8::Gemm g{U, Wgu_t, M, 2 * FF, D}; pg8::StaticOrder S; S.init(M, 2 * FF, G, bx);
        pg8::EpiBf16<0> E{Gt, FF, nullptr, FF, (size_t)M * FF, 1.f};
        pg8::gemm_phase<pg8::EpiBf16<0>, pg8::StaticOrder, true, true>(lds, g, S, E);
        if (BOTH(6)) GRID_BAR();
    }

    if (IN(7)) { phase_h(Gt, UP, state_ffn, ffn_conv_w, ffn_conv_b, out, gtid, nth); if (BOTH(7)) GRID_BAR(); }

    if (IN(8)) {
        pg8::Gemm g{UP, Wdn_t, M, D, FF}; pg8::StaticOrder S; S.init(M, D, G, bx);
        pg8::EpiF32 E{DOWN, D};
        pg8::gemm_phase<pg8::EpiF32, pg8::StaticOrder, true, true>(lds, g, S, E);
        if (BOTH(8)) GRID_BAR();
    }

    if (IN(9)) phase_rows2(DOWN, norm_ffn_post, out, gw, NGW, lane);
#undef IN
#undef BOTH
#undef GRID_BAR
}

extern "C" void kernel_launch(void* const* d_in, const int* in_sizes, int n_in, void* d_out, int out_size, void* d_ws, size_t ws_size, hipStream_t stream) {
    static int grid = 0;
    if (grid == 0) {
        if (n_in != 23 || out_size != 23699456 || ws_size < WS_END) { fprintf(stderr, "kernel_launch: unexpected shapes (n_in %d, out %d, ws %zu); nothing launched\n", n_in, out_size, ws_size); grid = -1; return; }
        int dev = 0, cus = 0, per_cu = 0;
        if (hipGetDevice(&dev) != hipSuccess || hipDeviceGetAttribute(&cus, hipDeviceAttributeMultiprocessorCount, dev) != hipSuccess) { grid = -1; return; }
        if (hipFuncSetAttribute((const void*)hybrid_fwd, hipFuncAttributeMaxDynamicSharedMemorySize, LDS_BYTES) != hipSuccess) { fprintf(stderr, "kernel_launch: hipFuncSetAttribute failed\n"); grid = -1; return; }
        if (hipOccupancyMaxActiveBlocksPerMultiprocessor(&per_cu, (const void*)hybrid_fwd, NWAVES * 64, LDS_BYTES) != hipSuccess || per_cu < 1) fprintf(stderr, "kernel_launch: occupancy query reports %d\n", per_cu);
        (void)hipGetLastError();
        grid = cus;
    }
    if (grid < 0) return;
    if (hipMemsetAsync((char*)d_ws + WS_CTL, 0, CTL_ZERO_BYTES, stream) != hipSuccess) { fprintf(stderr, "kernel_launch: memset failed\n"); return; }
    Args a{};
    for (int i = 0; i < 23; ++i) a.in[i] = (const float*)d_in[i];
    a.out = (float*)d_out; a.ws = (unsigned char*)d_ws;
    if (N_LAUNCHES == 1) { a.ph_lo = 0; a.ph_hi = NPH; a.li = 0; hipLaunchKernelGGL(hybrid_fwd, dim3(grid), dim3(NWAVES * 64), LDS_BYTES, stream, a); }
    else for (int li = 0; li < NPH; ++li) { a.ph_lo = li; a.ph_hi = li + 1; a.li = li; hipLaunchKernelGGL(hybrid_fwd, dim3(grid), dim3(NWAVES * 64), LDS_BYTES, stream, a);
#ifdef PROBE_DUP
        if (li == PROBE_DUP) hipLaunchKernelGGL(hybrid_fwd, dim3(grid), dim3(NWAVES * 64), LDS_BYTES, stream, a);
#endif
    }
    const hipError_t le = hipPeekAtLastError();
    if (le != hipSuccess) fprintf(stderr, "kernel_launch: launch failed: %s\n", hipGetErrorName(le));
}
```

```cpp
#include <hip/hip_runtime.h>
#include <cstdio>
#include <cstdint>
namespace pg8 {
#define PG8_LAS __attribute__((address_space(3)))
typedef unsigned short bf16_t;
typedef short bf16x8 __attribute__((ext_vector_type(8)));
typedef float f32x4 __attribute__((ext_vector_type(4)));
typedef unsigned u32x4 __attribute__((ext_vector_type(4)));
constexpr int BM = 256, BK = 64, HALF = 128, HTB = HALF * BK * 2  , STAGE_BYTES = 8 * HTB, NXCD = 8, WGM = 8;

__host__ __device__ __forceinline__ int lds_byte(int r, int c) { const int st = (r >> 4) * 2 + (c >> 5), rr = r & 15, cc = c & 31, ob = rr * 64 + cc * 2; return st * 1024 + (ob ^ (((ob >> 9) & 1) << 5)); }
__host__ __device__ __forceinline__ void stage_rc(int b, int& R, int& C) { const int st = b / 1024, sb = b % 1024, swz = sb ^ (((sb >> 9) & 1) << 5); R = (st >> 1) * 16 + swz / 64; C = (st & 1) * 32 + (swz % 64) / 2; }
__host__ __device__ __forceinline__ int perm32(int rho) { const int n = rho >> 4, i = rho & 15; return 8 * (i >> 2) + 4 * n + (i & 3); }

struct Unit { int pm, pn; };
struct Gemm { const bf16_t* A; const bf16_t* Bt; int M, N, K; };

struct StaticOrder {
    int nM, nN, nwg, G, c;
    __host__ __device__ void init(int M, int N, int G_, int c_) { nM = M / BM; nN = N / BM; nwg = nM * nN; G = G_; c = c_; }
    __host__ __device__ bool next(int i, Unit& u) const {
        const long L = (long)i * G + c; if (L >= nwg) return false;
        int wgid = (int)L; { const int q = nwg / NXCD, r = nwg % NXCD, xcd = wgid % NXCD, off = wgid / NXCD; wgid = (xcd < r ? xcd * (q + 1) : r * (q + 1) + (xcd - r) * q) + off; }
        const int nig = WGM * nN, gid = wgid / nig, fm = gid * WGM, gsz = (nM - fm) < WGM ? (nM - fm) : WGM;
        u.pm = fm + ((wgid % nig) % gsz); u.pn = (wgid % nig) / gsz; return true;
    }
    __device__ __forceinline__ void a_ready(const Unit&) const {}
    __device__ __forceinline__ void done(const Unit&) const {}
};

__device__ __forceinline__ unsigned cvt_pk_bf16(float lo, float hi) { unsigned r; asm volatile("v_cvt_pk_bf16_f32 %0, %1, %2" : "=v"(r) : "v"(lo), "v"(hi)); return r; }
typedef float f32x2 __attribute__((ext_vector_type(2)));
__device__ __forceinline__ f32x2 gelu_pk(f32x2 v) {
    const f32x2 av = __builtin_elementwise_abs(v), d = av * 0.2316418882f + 1.0f;
    f32x2 t; t.x = __builtin_amdgcn_rcpf(d.x); t.y = __builtin_amdgcn_rcpf(d.y);
    f32x2 q = t * 0.5307027145f + (-0.7265760135f); q = q * t + 0.7107068705f; q = q * t + (-0.142248368f); q = q * t + 0.127414796f; q = q * t;
    const f32x2 s = (v * v) * (-0.72134752044f);
    f32x2 e; e.x = __builtin_amdgcn_exp2f(s.x); e.y = __builtin_amdgcn_exp2f(s.y);
    const f32x2 m = v * (q * e), r = v - m;
    f32x2 o; o.x = v.x < 0.f ? m.x : r.x; o.y = v.y < 0.f ? m.y : r.y; return o;
}

template <int ACT  > struct EpiBf16 {
    static constexpr bool PERM = true, AFTER_DRAIN = false; static_assert(ACT == 0 || ACT == 1, "EpiBf16: ACT is 0 (none) or 1 (gelu_pk)");
    bf16_t* O; int ldc; const float* bias; int split_cols; size_t split_stride; float scale0;
    __device__ __forceinline__ void operator()(const f32x4 (&acc)[2][2][4][2], const Unit& u, int wr, int wc, int fr, int fq) const {
        const int row0 = u.pm * BM + wr * 64 + fr; int colt = u.pn * BM; bf16_t* base = O;
        float sc = 1.f; if (split_cols) { const int t = colt / split_cols; base += (size_t)t * split_stride; colt -= t * split_cols; if (t == 0) sc = scale0; }
        const int col0 = colt + wc * 32 + 8 * fq, bcol0 = u.pn * BM + wc * 32 + 8 * fq;
        f32x4 bv[2][2];
#pragma unroll
        for (int bj = 0; bj < 2; ++bj)
#pragma unroll
            for (int n = 0; n < 2; ++n) bv[bj][n] = bias ? *(const f32x4*)(bias + bcol0 + bj * HALF + 4 * n) : (f32x4){0.f, 0.f, 0.f, 0.f};
#pragma unroll
        for (int ai = 0; ai < 2; ++ai)
#pragma unroll
            for (int m = 0; m < 4; ++m) { bf16_t* rowp = base + (size_t)(row0 + ai * HALF + m * 16) * ldc + col0;
#pragma unroll
                for (int bj = 0; bj < 2; ++bj) { f32x4 v0 = acc[ai][bj][m][0] + bv[bj][0], v1 = acc[ai][bj][m][1] + bv[bj][1];
                    if (ACT == 1) { f32x2 a = gelu_pk((f32x2){v0[0], v0[1]}), b = gelu_pk((f32x2){v0[2], v0[3]}), c = gelu_pk((f32x2){v1[0], v1[1]}), d = gelu_pk((f32x2){v1[2], v1[3]});
                        v0 = (f32x4){a.x, a.y, b.x, b.y}; v1 = (f32x4){c.x, c.y, d.x, d.y}; }
                    v0 = v0 * sc; v1 = v1 * sc; u32x4 w; w.x = cvt_pk_bf16(v0[0], v0[1]); w.y = cvt_pk_bf16(v0[2], v0[3]); w.z = cvt_pk_bf16(v1[0], v1[1]); w.w = cvt_pk_bf16(v1[2], v1[3]);
                    *(u32x4*)(rowp + bj * HALF) = w; } }
    }
};

struct EpiF32 {
    static constexpr bool PERM = false, AFTER_DRAIN = false;
    float* O; int ldc;
    __device__ __forceinline__ void operator()(const f32x4 (&acc)[2][2][4][2], const Unit& u, int wr, int wc, int fr, int fq) const {
        const int row0 = u.pm * BM + wr * 64 + fr, col0 = u.pn * BM + wc * 32 + 4 * fq;
#pragma unroll
        for (int ai = 0; ai < 2; ++ai)
#pragma unroll
            for (int m = 0; m < 4; ++m) { float* rowp = O + (size_t)(row0 + ai * HALF + m * 16) * ldc + col0;
#pragma unroll
                for (int bj = 0; bj < 2; ++bj)
#pragma unroll
                    for (int n = 0; n < 2; ++n) *(f32x4*)(rowp + bj * HALF + n * 16) = acc[ai][bj][m][n]; }
    }
};

template <class Epi, class Sched, bool ALIGN_EPI = false, bool SP2 = false>
__device__ __forceinline__ void gemm_phase(PG8_LAS unsigned char* lds, const Gemm g, const Sched& S, const Epi& E) {
    const int tid = threadIdx.x, wid = __builtin_amdgcn_readfirstlane(tid >> 6), lane = tid & 63, wr = wid >> 2, wc = wid & 3, fr = lane & 15, fq = lane >> 4;
    const int K = g.K, nt = K / BK;
    unsigned voffA[2], voffB[2];
#pragma unroll
    for (int i = 0; i < 2; ++i) { int R, C; stage_rc(tid * 16 + i * 8192, R, C); const int Rb = Epi::PERM ? ((R & ~31) + perm32(R & 31)) : R;
        voffA[i] = (unsigned)(R * K + C) * 2u; voffB[i] = (unsigned)(Rb * K + C) * 2u; }
    const size_t kstep = (size_t)(BK * 2);
    const size_t hstep = (size_t)HALF * K * 2;
    const size_t tstep = 2 * hstep;
    const unsigned ldsw = (unsigned)wid * 1024u;
    const int aoff = lds_byte(wr * 64 + fr, fq * 8), boff = lds_byte(wc * 32 + fr, fq * 8);
#define PG8_SA(b, h) (((b) * 2 + (h)) * HTB)
#define PG8_SB(b, h) ((4 + (b) * 2 + (h)) * HTB)
#define PG8_STAGE(bufoff, gbase, voff) do { _Pragma("unroll") for (int _i = 0; _i < 2; ++_i) \
        __builtin_amdgcn_global_load_lds((const unsigned*)((const char*)(gbase) + (voff)[_i]), (PG8_LAS unsigned*)(lds + (bufoff) + ldsw + _i * 8192), 16, 0, 0); } while (0)
#define PG8_LDA(dst, b, h) do { _Pragma("unroll") for (int m = 0; m < 4; ++m) _Pragma("unroll") for (int k = 0; k < 2; ++k) dst[m][k] = *(const PG8_LAS bf16x8*)(lds + PG8_SA(b, h) + aoff + m * 2048 + k * 1024); } while (0)
#define PG8_LDB(dst, b, h) do { _Pragma("unroll") for (int n = 0; n < 2; ++n) _Pragma("unroll") for (int k = 0; k < 2; ++k) dst[n][k] = *(const PG8_LAS bf16x8*)(lds + PG8_SB(b, h) + boff + n * 2048 + k * 1024); } while (0)
#define PG8_MMA(ai, bj, At, Bt) do { __builtin_amdgcn_s_setprio(1); _Pragma("unroll") for (int m = 0; m < 4; ++m) _Pragma("unroll") for (int n = 0; n < 2; ++n) _Pragma("unroll") for (int k = 0; k < 2; ++k) \
        acc[ai][bj][m][n] = __builtin_amdgcn_mfma_f32_16x16x32_bf16(Bt[n][k], At[m][k], acc[ai][bj][m][n], 0, 0, 0); __builtin_amdgcn_s_setprio(0); } while (0)
#define PG8_WAIT_V(n) asm volatile("s_waitcnt vmcnt(" #n ")" ::: "memory")
#define PG8_WAIT_L(n) asm volatile("s_waitcnt lgkmcnt(" #n ")" ::: "memory")
#define PG8_BAR __builtin_amdgcn_s_barrier()
#define PG8_SCHED __builtin_amdgcn_sched_barrier(0)
    Unit cur, nxt; int ui = 0;
    if (!S.next(0, cur)) return;
    f32x4 acc[2][2][4][2];
#pragma unroll
    for (int a = 0; a < 2; ++a)
#pragma unroll
        for (int b = 0; b < 2; ++b)
#pragma unroll
            for (int m = 0; m < 4; ++m)
#pragma unroll
                for (int n = 0; n < 2; ++n) acc[a][b][m][n] = (f32x4){0.f, 0.f, 0.f, 0.f};
    bf16x8 At[4][2], B0[2][2], B1[2][2];
    const char* cA = (const char*)g.A + (size_t)cur.pm * tstep; const char* cB = (const char*)g.Bt + (size_t)cur.pn * tstep;
    S.a_ready(cur);
    if constexpr (SP2) {
        PG8_STAGE(PG8_SB(0, 0), cB, voffB); PG8_STAGE(PG8_SB(0, 1), cB + hstep, voffB); PG8_STAGE(PG8_SA(0, 0), cA, voffA); PG8_STAGE(PG8_SA(0, 1), cA + hstep, voffA);
        if (wr == 1) PG8_BAR;
        PG8_WAIT_V(2); PG8_BAR;
        PG8_STAGE(PG8_SB(1, 0), cB + kstep, voffB); PG8_STAGE(PG8_SA(1, 0), cA + kstep, voffA); PG8_STAGE(PG8_SB(1, 1), cB + hstep + kstep, voffB);
        PG8_WAIT_V(6); PG8_BAR;
    } else {
        PG8_STAGE(PG8_SB(0, 0), cB, voffB); PG8_STAGE(PG8_SA(0, 0), cA, voffA); PG8_STAGE(PG8_SB(0, 1), cB + hstep, voffB); PG8_STAGE(PG8_SA(0, 1), cA + hstep, voffA);
        if (wr == 1) PG8_BAR;
        PG8_WAIT_V(4); PG8_BAR;
        PG8_STAGE(PG8_SB(1, 0), cB + kstep, voffB); PG8_STAGE(PG8_SA(1, 0), cA + kstep, voffA); PG8_STAGE(PG8_SB(1, 1), cB + hstep + kstep, voffB);
        PG8_WAIT_V(6); PG8_BAR;
    }
    for (;;) {
        const bool has_next = S.next(ui + 1, nxt);
        const char* nA = has_next ? (const char*)g.A + (size_t)nxt.pm * tstep : cA; const char* nB = has_next ? (const char*)g.Bt + (size_t)nxt.pn * tstep : cB;
        for (int t = 0; t < nt; t += 2) {
            const bool last = (t == nt - 2);
            const char* a1 = cA + (size_t)(t + 1) * kstep;
            const char* a2 = last ? nA : cA + (size_t)(t + 2) * kstep; const char* b2 = last ? nB : cB + (size_t)(t + 2) * kstep;
            const char* a3 = a2 + kstep; const char* b3 = b2 + kstep;
            if (last && has_next) S.a_ready(nxt);
            if constexpr (SP2) {
            PG8_LDB(B0, 0, 0); PG8_LDB(B1, 0, 1); PG8_SCHED; PG8_LDA(At, 0, 0); PG8_STAGE(PG8_SA(1, 1), a1 + hstep, voffA);
            PG8_WAIT_V(8); PG8_WAIT_L(0); PG8_BAR; PG8_MMA(0, 0, At, B0); PG8_MMA(0, 1, At, B1); PG8_BAR; PG8_SCHED;
            PG8_LDA(At, 0, 1); PG8_STAGE(PG8_SB(0, 0), b2, voffB); PG8_STAGE(PG8_SB(0, 1), b2 + hstep, voffB); PG8_STAGE(PG8_SA(0, 0), a2, voffA);
            PG8_WAIT_V(8); PG8_WAIT_L(0); PG8_BAR; PG8_MMA(1, 0, At, B0); PG8_MMA(1, 1, At, B1); PG8_BAR; PG8_SCHED;
            PG8_LDB(B0, 1, 0); PG8_LDB(B1, 1, 1); PG8_SCHED; PG8_LDA(At, 1, 0); PG8_STAGE(PG8_SA(0, 1), a2 + hstep, voffA);
            PG8_WAIT_V(8); PG8_WAIT_L(0); PG8_BAR; PG8_MMA(0, 0, At, B0); PG8_MMA(0, 1, At, B1); PG8_BAR; PG8_SCHED;
            PG8_LDA(At, 1, 1); PG8_STAGE(PG8_SB(1, 0), b3, voffB); PG8_STAGE(PG8_SB(1, 1), b3 + hstep, voffB); PG8_STAGE(PG8_SA(1, 0), a3, voffA);
            PG8_WAIT_V(8); PG8_WAIT_L(0); PG8_BAR; PG8_MMA(1, 0, At, B0); PG8_MMA(1, 1, At, B1); PG8_BAR; PG8_SCHED;
            } else {
            PG8_LDB(B0, 0, 0); PG8_SCHED; PG8_LDA(At, 0, 0); PG8_STAGE(PG8_SA(1, 1), a1 + hstep, voffA);
            PG8_WAIT_L(8); PG8_BAR; PG8_WAIT_L(0); PG8_MMA(0, 0, At, B0); PG8_BAR; PG8_SCHED;
            PG8_LDB(B1, 0, 1); PG8_STAGE(PG8_SB(0, 0), b2, voffB);
            PG8_BAR; PG8_WAIT_L(0); PG8_MMA(0, 1, At, B1); PG8_BAR;
            PG8_LDA(At, 0, 1); PG8_STAGE(PG8_SA(0, 0), a2, voffA);
            PG8_BAR; PG8_WAIT_L(0); PG8_MMA(1, 0, At, B0); PG8_BAR; PG8_SCHED;
            PG8_STAGE(PG8_SB(0, 1), b2 + hstep, voffB);
            PG8_WAIT_V(6); PG8_BAR; PG8_MMA(1, 1, At, B1); PG8_BAR;
            PG8_LDB(B0, 1, 0); PG8_SCHED; PG8_LDA(At, 1, 0); PG8_STAGE(PG8_SA(0, 1), a2 + hstep, voffA);
            PG8_WAIT_L(8); PG8_BAR; PG8_WAIT_L(0); PG8_MMA(0, 0, At, B0); PG8_BAR; PG8_SCHED;
            PG8_LDB(B1, 1, 1); PG8_STAGE(PG8_SB(1, 0), b3, voffB);
            PG8_BAR; PG8_WAIT_L(0); PG8_MMA(0, 1, At, B1); PG8_BAR;
            PG8_LDA(At, 1, 1); PG8_STAGE(PG8_SA(1, 0), a3, voffA);
            PG8_BAR; PG8_WAIT_L(0); PG8_MMA(1, 0, At, B0); PG8_BAR; PG8_SCHED;
            PG8_STAGE(PG8_SB(1, 1), b3 + hstep, voffB);
            PG8_WAIT_V(6); PG8_BAR; PG8_MMA(1, 1, At, B1); PG8_BAR;
            }
        }
        if constexpr (ALIGN_EPI) { if (wr == 0) PG8_BAR; }
        if constexpr (!Epi::AFTER_DRAIN) { E(acc, cur, wr, wc, fr, fq); S.done(cur); }
        if (!has_next) break;
#pragma unroll
        for (int a = 0; a < 2; ++a)
#pragma unroll
            for (int b = 0; b < 2; ++b)
#pragma unroll
                for (int m = 0; m < 4; ++m)
#pragma unroll
                    for (int n = 0; n < 2; ++n) acc[a][b][m][n] = (f32x4){0.f, 0.f, 0.f, 0.f};
        cur = nxt; cA = nA; cB = nB; ++ui;
        if constexpr (ALIGN_EPI) { if (wr == 1) PG8_BAR; }
    }
    PG8_WAIT_V(0);
    if constexpr (!ALIGN_EPI) { if (wr == 0) PG8_BAR; }
    PG8_BAR;
    if constexpr (Epi::AFTER_DRAIN) { E.fused(acc, cur, wr, wc, fr, fq, lds, wid, lane); S.done(cur); }
#undef PG8_SA
#undef PG8_SB
#undef PG8_STAGE
#undef PG8_LDA
#undef PG8_LDB
#undef PG8_MMA
#undef PG8_WAIT_V
#undef PG8_WAIT_L
#undef PG8_BAR
#undef PG8_SCHED
}
}

constexpr int NWAVES = 8;
constexpr int D = 1024, SEQ = 4096, MP = 16384, MS = 1024, M = MP + MS;
constexpr int NIN = 3584, INC = 3592, FF = 2816;
constexpr int PC_Z = 1536, PC_QB = 2048, PC_KB = 2560, PC_VB = 3072;
constexpr float EPS = 1e-6f;
constexpr size_t O_YP = 0, O_YS = 16777216, O_BKP = 17825792, O_BVP = 18874368, O_DP = 19922944, O_QCP = 20185088, O_FCP = 20203520,
                 O_BKS = 20226048, O_BVS = 20750336, O_DS = 21274624, O_QCS = 23371776, O_FCS = 23519232;
constexpr size_t MiB = 1u << 20;
constexpr size_t WS_CTL = 0, CTL_ZERO_BYTES = 1 * MiB;
constexpr size_t WS_WIN = 1 * MiB, WS_WOUT = 8 * MiB, WS_WGU = 10 * MiB, WS_WDN = 21 * MiB;
constexpr size_t WS_AB = 27 * MiB, WS_DL = 27 * MiB + 768 * 1024;
constexpr size_t WS_U = 28 * MiB;
constexpr size_t WS_GQK = WS_U, WS_GS = WS_U + 8 * MiB;
constexpr size_t WS_P = 62 * MiB;
constexpr size_t WS_MIXIN = 181 * MiB;
constexpr size_t WS_G = WS_P, WS_UP = WS_P + (size_t)M * FF * 2;
constexpr size_t WS_END = 256 * MiB;
static_assert(WS_UP + (size_t)M * FF * 2 <= WS_END, "ws map");
constexpr int CW_BAR = 4096;

constexpr int LDS_BYTES = 163840;
constexpr int MISC_OFF = LDS_BYTES - 256;

#define GAS __attribute__((address_space(1)))
#define LAS __attribute__((address_space(3)))
typedef unsigned short bf16;
typedef unsigned v4u __attribute__((ext_vector_type(4)));
typedef unsigned v2u __attribute__((ext_vector_type(2)));
typedef float f32x2 __attribute__((ext_vector_type(2)));
typedef float f32x4 __attribute__((ext_vector_type(4)));
typedef float f32x16 __attribute__((ext_vector_type(16)));
typedef short bf16x8 __attribute__((ext_vector_type(8)));
typedef short s16x4 __attribute__((ext_vector_type(4)));
typedef __bf16 bf16x2_t __attribute__((ext_vector_type(2)));
typedef GAS unsigned gu32;
#define RLX_AGENT __ATOMIC_RELAXED, __HIP_MEMORY_SCOPE_AGENT
#define LDS_WAIT() asm volatile("s_waitcnt lgkmcnt(0)" ::: "memory")
#define VM_WAIT() asm volatile("s_waitcnt vmcnt(0)" ::: "memory")
__device__ __forceinline__ unsigned pk2(float lo, float hi) { f32x2 v = {lo, hi}; bf16x2_t b = __builtin_convertvector(v, bf16x2_t); return __builtin_bit_cast(unsigned, b); }
__device__ __forceinline__ float bflo(unsigned w) { return __uint_as_float(w << 16); }
__device__ __forceinline__ float bfhi(unsigned w) { return __uint_as_float(w & 0xffff0000u); }
__device__ __forceinline__ float bf1(bf16 b) { return __uint_as_float((unsigned)b << 16); }
__device__ __forceinline__ bf16 f2bf(float f) { return (bf16)(pk2(f, 0.f) & 0xffffu); }
__device__ __forceinline__ float wave_sum(float v) {
#pragma unroll
    for (int o = 1; o < 64; o <<= 1) v += __shfl_xor(v, o);
    return v;
}
__device__ __forceinline__ float sigmoidf_(float x) { return __builtin_amdgcn_rcpf(1.0f + __builtin_amdgcn_exp2f(-1.4426950408889634f * x)); }
__device__ __forceinline__ float rsq_(float x) { return __builtin_amdgcn_rsqf(x); }
__device__ __forceinline__ int crow(int r, int hi) { return (r & 3) + 8 * (r >> 2) + 4 * hi; }
#define MFMA32(a, b, c) __builtin_amdgcn_mfma_f32_32x32x16_bf16((a), (b), (c), 0, 0, 0)
#define MFMA16(a, b, c) __builtin_amdgcn_mfma_f32_16x16x32_bf16((a), (b), (c), 0, 0, 0)
#define XB_TMO      128
#define XB_XCNT(j)  (256  + 64 * (j))
#define XB_XSUB(j)  (1280 + 64 * (j))
#define XB_XGEN(j)  (2304 + 64 * (j))
#define XB_TOP      3328
#define XB_TOPGEN   3392
#define XCD_BAR_WORDS 3456
#define XB_SPIN_CAP (1u << 18)

__device__ __forceinline__ unsigned xb_ld(unsigned* p)              { return __hip_atomic_load(p, __ATOMIC_RELAXED, __HIP_MEMORY_SCOPE_AGENT); }
__device__ __forceinline__ unsigned xb_add(unsigned* p, unsigned v) { return __hip_atomic_fetch_add(p, v, __ATOMIC_RELAXED, __HIP_MEMORY_SCOPE_AGENT); }
__device__ __forceinline__ unsigned xb_xcc_id() { return (unsigned)__builtin_amdgcn_s_getreg((3 << 11) | 20) & 0xFu; }
#define XB_SPIN(cond, bar) do { unsigned _sp = 0; while (cond) { __builtin_amdgcn_s_sleep(1); \
    if ((++_sp & 255u) == 0u) { if (xb_ld(&(bar)[XB_TMO])) break; if (_sp > XB_SPIN_CAP) { atomicAdd(&(bar)[XB_TMO], 1u); break; } } } } while (0)

struct XcdBarrier {
    unsigned* bar; unsigned x;
    volatile LAS unsigned* st;
};

__device__ __forceinline__ XcdBarrier xcd_barrier_post(unsigned* bar, volatile LAS unsigned* st) {
    XcdBarrier b; b.bar = bar; b.x = xb_xcc_id(); b.st = st;
    if (threadIdx.x == 0) (void)xb_add(&bar[XB_XCNT(b.x)], 1u);
    return b;
}
__device__ __forceinline__ void xcd_barrier_complete(unsigned* bar, unsigned x, unsigned& nloc, unsigned& nx) {
    const unsigned G = gridDim.x * gridDim.y * gridDim.z;
    unsigned sum, cnt, mine, sp = 0u;
    for (;;) {
        sum = 0u; cnt = 0u; mine = 0u;
#pragma unroll
        for (unsigned j = 0; j < 16; ++j) { const unsigned c = xb_ld(&bar[XB_XCNT(j)]); sum += c; cnt += (c > 0u) ? 1u : 0u; mine = (j == x) ? c : mine; }
        if (sum == G) break;
        __builtin_amdgcn_s_sleep(1);
        if ((++sp & 255u) == 0u) { if (xb_ld(&bar[XB_TMO])) break; if (sp > XB_SPIN_CAP) { atomicAdd(&bar[XB_TMO], 1u); break; } }
    }
    nloc = mine > 0u ? mine : 1u; nx = cnt > 0u ? cnt : 1u;
}

__device__ __forceinline__ void xcd_barrier(const XcdBarrier& b) {
    asm volatile("s_waitcnt vmcnt(0)" ::: "memory");
    __syncthreads();
    if (threadIdx.x == 0) {
        unsigned* bar = b.bar;
        __builtin_amdgcn_s_waitcnt(0);
        unsigned nloc = b.st[0], nx = b.st[1];
        if (nloc == 0u) { xcd_barrier_complete(bar, b.x, nloc, nx); b.st[0] = nloc; b.st[1] = nx; }
        const unsigned old = xb_add(&bar[XB_XSUB(b.x)], 1u);
        const unsigned gen = old / nloc;
        if (old + 1u == (gen + 1u) * nloc) {
            __builtin_amdgcn_fence(__ATOMIC_RELEASE, "agent");
            asm volatile("s_waitcnt vmcnt(0)" ::: "memory");
            const unsigned og = xb_add(&bar[XB_TOP], 1u);
            const unsigned tg = og / nx;
            if (og + 1u == (tg + 1u) * nx) xb_add(&bar[XB_TOPGEN], 1u);
            else XB_SPIN(xb_ld(&bar[XB_TOPGEN]) == tg, bar);
            __builtin_amdgcn_fence(__ATOMIC_ACQUIRE, "agent");
            xb_add(&bar[XB_XGEN(b.x)], 1u);
            asm volatile("s_waitcnt vmcnt(0)" ::: "memory");
        } else {
            XB_SPIN(xb_ld(&bar[XB_XGEN(b.x)]) == gen, bar);
            __builtin_amdgcn_fence(__ATOMIC_ACQUIRE, "agent");
            asm volatile("s_waitcnt vmcnt(0)" ::: "memory");
        }
    }
    __syncthreads();
}

__device__ __forceinline__ void p0_transpose_item(const float* W, int ldw, int K, int N, bf16* WT, int row_off, LAS float* scr, int item, int lane) {
    const int nblk = N / 32, kb = item / nblk, nb = item % nblk, k0 = 64 * kb, n0 = 32 * nb;
#pragma unroll 8
    for (int i = 0; i < 32; ++i) { const int kk = 2 * i + (lane >> 5); scr[kk * 33 + (lane & 31)] = W[(size_t)(k0 + kk) * ldw + n0 + (lane & 31)]; }
    LDS_WAIT(); asm volatile("" ::: "memory");
    const int c = lane & 7;
#pragma unroll
    for (int j = 0; j < 4; ++j) { const int n = (lane >> 3) + 8 * j; const LAS float* s = scr + (8 * c) * 33 + n;
        v4u o; o.x = pk2(s[0 * 33], s[1 * 33]); o.y = pk2(s[2 * 33], s[3 * 33]); o.z = pk2(s[4 * 33], s[5 * 33]); o.w = pk2(s[6 * 33], s[7 * 33]);
        *(v4u*)(WT + (size_t)(row_off + n0 + n) * K + k0 + 8 * c) = o; }
    LDS_WAIT(); asm volatile("" ::: "memory");
}

__device__ __forceinline__ void phase_prologue(LAS unsigned char* lds, const float* xp, const float* xs, const float* nw, const float* w_in, const float* w_out, const float* w_gu, const float* w_dn,
                                               unsigned char* ws, int vcu, int G, int tid, int lane, int wave) {
    LAS float* scr = (LAS float*)(lds + wave * 8448);
    LAS float* W8T = (LAS float*)(lds + 67584);
    for (int k = tid; k < 1024; k += 512) {
        const f32x4 a = *(const f32x4*)(w_in + (size_t)k * INC + 2048), b = *(const f32x4*)(w_in + (size_t)k * INC + 2052);
        W8T[0 * 1024 + k] = a.x; W8T[1 * 1024 + k] = a.y; W8T[2 * 1024 + k] = a.z; W8T[3 * 1024 + k] = a.w;
        W8T[4 * 1024 + k] = b.x; W8T[5 * 1024 + k] = b.y; W8T[6 * 1024 + k] = b.z; W8T[7 * 1024 + k] = b.w;
    }
    __syncthreads();
    const int gw = vcu * NWAVES + wave, NGW = G * NWAVES;
    bf16* Win_t = (bf16*)(ws + WS_WIN); bf16* Wout_t = (bf16*)(ws + WS_WOUT); bf16* Wgu_t = (bf16*)(ws + WS_WGU); bf16* Wdn_t = (bf16*)(ws + WS_WDN);
    constexpr int I_A = 16 * 64, I_B = 16 * 48, I_O = 16 * 32, I_GU = 16 * 176, I_DN = 44 * 32;
    constexpr int NITEMS = I_A + I_B + I_O + I_GU + I_DN;
    for (int it = gw; it < NITEMS; it += NGW) {
        int r = it;
        if (r < I_A) { p0_transpose_item(w_in, INC, D, 2048, Win_t, 0, scr, r, lane); continue; } r -= I_A;
        if (r < I_B) { p0_transpose_item(w_in + 2056, INC, D, 1536, Win_t, 2048, scr, r, lane); continue; } r -= I_B;
        if (r < I_O) { p0_transpose_item(w_out, D, D, D, Wout_t, 0, scr, r, lane); continue; } r -= I_O;
        if (r < I_GU) { p0_transpose_item(w_gu, 2 * FF, D, 2 * FF, Wgu_t, 0, scr, r, lane); continue; } r -= I_GU;
        p0_transpose_item(w_dn, D, FF, D, Wdn_t, 0, scr, r, lane);
    }
    bf16* U = (bf16*)(ws + WS_U); float* AB = (float*)(ws + WS_AB);
    for (int m = gw; m < M; m += NGW) {
        const float* xrow = m < MP ? xp + (size_t)m * D : xs + (size_t)(m - MP) * D;
        f32x4 v[4]; float s = 0.f;
#pragma unroll
        for (int j = 0; j < 4; ++j) { v[j] = ((const f32x4*)xrow)[lane + 64 * j]; s += (v[j].x * v[j].x + v[j].y * v[j].y) + (v[j].z * v[j].z + v[j].w * v[j].w); }
        const float rstd = rsq_(wave_sum(s) * (1.f / D) + EPS);
        unsigned long long* o8 = (unsigned long long*)(U + (size_t)m * D) + lane;
#pragma unroll
        for (int j = 0; j < 4; ++j) { const f32x4 g = ((const f32x4*)nw)[lane + 64 * j]; v[j] = v[j] * rstd * g;
            o8[64 * j] = (unsigned long long)pk2(v[j].x, v[j].y) | ((unsigned long long)pk2(v[j].z, v[j].w) << 32); }
        float dv = 0.f;
#pragma unroll
        for (int jj = 0; jj < 8; ++jj) { float acc = 0.f;
#pragma unroll
            for (int j = 0; j < 4; ++j) { const f32x4 w = *(const LAS f32x4*)(W8T + jj * 1024 + 4 * lane + 256 * j); acc += (v[j].x * w.x + v[j].y * w.y) + (v[j].z * w.z + v[j].w * w.w); }
            acc = wave_sum(acc); if (lane == jj) dv = acc; }
        if (lane < 8) AB[(size_t)m * 8 + lane] = dv;
    }
}

__device__ __forceinline__ void phase_copy_outputs(const bf16* P, float* out, int gtid, int nth) {
    for (int e = gtid; e < 4 * 512 * 512; e += nth) { const int b = e >> 18, j = (e >> 9) & 511, c = e & 511; const size_t row = (size_t)(b * SEQ + 3584 + j) * NIN;
        out[O_BKP + e] = bf1(P[row + PC_KB + c]); out[O_BVP + e] = bf1(P[row + PC_VB + c]); }
    for (int e = gtid; e < 32 * 32 * 512; e += nth) { const int r = e >> 9, c = e & 511; const size_t row = (size_t)(MP + r) * NIN;
        out[O_BKS + e] = bf1(P[row + PC_KB + c]); out[O_BVS + e] = bf1(P[row + PC_VB + c]); }
    for (int e = gtid; e < 4 * 3 * 1536; e += nth) { const int b = e / 4608, i = (e / 1536) % 3, c = e % 1536; out[O_QCP + e] = bf1(P[(size_t)(b * SEQ + 4093 + i) * NIN + c]); }
    for (int e = gtid; e < 32 * 3 * 1536; e += nth) { const int b = e / 4608, i = (e / 1536) % 3, c = e % 1536; out[O_QCS + e] = bf1(P[(size_t)(MP + b * 32 + 29 + i) * NIN + c]); }
}

__device__ __forceinline__ bf16x8 pack8(const f32x4& a, const f32x4& b) { const v4u t = {pk2(a[0], a[1]), pk2(a[2], a[3]), pk2(b[0], b[1]), pk2(b[2], b[3])}; return __builtin_bit_cast(bf16x8, t); }
__device__ __forceinline__ int kperm(int k) { const int kk = k & 31; return (k & ~31) | (8 * ((kk & 15) >> 2) + (kk & 3) + 4 * (kk >> 4)); }
__device__ __forceinline__ void gdn_pre_unit(LAS unsigned char* lds, int u, const bf16* P, const float* AB, const float* st_qkv, const float* conv_w, const float* a_log, const float* dt_bias,
                                             bf16* gmain, bf16* gqk, bf16* gs, float* DL, int tid, int lane, int wave) {
    LAS float* RHS = (LAS float*)(lds + 0);
    LAS bf16* QB = (LAS bf16*)(lds + 65536);
    LAS bf16* KB = (LAS bf16*)(lds + 82944);
    LAS bf16* RAW = (LAS bf16*)(lds + 100352);
    LAS bf16* KGT = (LAS bf16*)(lds + 117760);
    LAS bf16* AMN = (LAS bf16*)(lds + 117760);
    LAS float* TD = (LAS float*)(lds + 117760 + 10240);
    LAS bf16* TB = (LAS bf16*)(lds + 117760 + 14336);
    LAS float* SMG = (LAS float*)(lds + 136192);
    const bool prompt = u < 1024;
    int b, h, n, m0, valid; bf16 *o_w, *o_qg, *o_kgt, *o_ut, *o_qk;
    if (prompt) { b = u >> 8; h = (u >> 6) & 3; n = u & 63; m0 = b * SEQ + n * 64; valid = 64; bf16* base = gmain + (size_t)u * 32768; o_w = base; o_qg = base + 8192; o_kgt = base + 16384; o_ut = base + 24576; o_qk = gqk + (size_t)u * 4096; }
    else { const int su = u - 1024; b = su >> 2; h = su & 3; n = 0; m0 = MP + b * 32; valid = 32; bf16* base = gs + (size_t)su * 36864; o_w = base; o_qg = base + 8192; o_kgt = base + 16384; o_ut = base + 24576; o_qk = base + 32768; }
    if (wave == 0) {
        const int i = lane; const bool v = i < valid;
        const float araw = v ? AB[(size_t)(m0 + i) * 8 + 4 + h] : 0.f, braw = v ? AB[(size_t)(m0 + i) * 8 + h] : 0.f;
        const float A = expf(a_log[h]); const float x = araw + dt_bias[h];
        const float sp = x > 20.f ? x : log1pf(expf(x));
        const float g = v ? -A * sp : 0.f; const float beta = v ? 1.f / (1.f + expf(-braw)) : 0.f;
        float Gc = g;
#pragma unroll
        for (int off = 1; off < 64; off <<= 1) { const float t = __shfl_up(Gc, off); if (lane >= off) Gc += t; }
        const float Gl = __shfl(Gc, 63);
        SMG[i] = Gc; SMG[64 + i] = beta; SMG[128 + i] = expf(Gc); SMG[192 + i] = expf(Gl - Gc);
        if (lane == 0) DL[u] = expf(Gl);
    }
    __syncthreads();
#pragma unroll 1
    for (int part = 0; part < 3; ++part) {
        const int pcol = (part == 0 ? 512 : part == 1 ? 0 : 1024) + h * 128;
#pragma unroll
        for (int pass = 0; pass < 3; ++pass) {
            const int rr = (tid >> 4) + 32 * pass, ch = tid & 15;
            if (rr < 67) {
                v4u val = {0u, 0u, 0u, 0u};
                if (prompt) { const int ts = n * 64 - 3 + rr; if (ts >= 0) val = *(const v4u*)(P + (size_t)(b * SEQ + ts) * NIN + pcol + ch * 8); }
                else { if (rr < 3) { const float* s = st_qkv + ((size_t)b * 3 + rr) * 1536 + pcol + ch * 8; const f32x4 a = *(const f32x4*)s, c = *(const f32x4*)(s + 4); val = (v4u){pk2(a.x, a.y), pk2(a.z, a.w), pk2(c.x, c.y), pk2(c.z, c.w)}; }
                       else if (rr - 3 < 32) val = *(const v4u*)(P + (size_t)(MP + b * 32 + rr - 3) * NIN + pcol + ch * 8); }
                *(LAS v4u*)(RAW + rr * 128 + ch * 8) = val;
            }
        }
        __syncthreads();
        float w0[4], w1[4];
#pragma unroll
        for (int i = 0; i < 4; ++i) { const f32x2 t = *(const f32x2*)(conv_w + i * 1536 + pcol + 2 * lane); w0[i] = t.x; w1[i] = t.y; }
#pragma unroll 2
        for (int rq = 0; rq < 8; ++rq) {
            const int r = wave * 8 + rq;
            float y0 = 0.f, y1 = 0.f;
#pragma unroll
            for (int i = 0; i < 4; ++i) { const unsigned xw = *(const LAS unsigned*)(RAW + (r + i) * 128 + 2 * lane); y0 += w0[i] * bflo(xw); y1 += w1[i] * bfhi(xw); }
            float s0 = y0 * sigmoidf_(y0), s1 = y1 * sigmoidf_(y1);
            if (r >= valid) { s0 = 0.f; s1 = 0.f; }
            if (part == 2) { const float be = SMG[64 + r]; *(LAS f32x2*)(RHS + r * 256 + 2 * lane) = (f32x2){s0 * be, s1 * be}; }
            else {
                const float rinv = rsq_(wave_sum(s0 * s0 + s1 * s1) + EPS);
                if (part == 0) { const float k0 = s0 * rinv, k1 = s1 * rinv; *(LAS unsigned*)(KB + r * 136 + 2 * lane) = pk2(k0, k1);
                    const float be = SMG[64 + r] * SMG[128 + r]; *(LAS f32x2*)(RHS + r * 256 + 128 + 2 * lane) = (f32x2){k0 * be, k1 * be};
                    const float egl = SMG[192 + r]; KGT[(2 * lane) * 64 + kperm(r)] = f2bf(k0 * egl); KGT[(2 * lane + 1) * 64 + kperm(r)] = f2bf(k1 * egl); }
                else { const float sc = rinv * 0.08838834764831845f; const float q0 = s0 * sc, q1 = s1 * sc; *(LAS unsigned*)(QB + r * 136 + 2 * lane) = pk2(q0, q1);
                    const float eg = SMG[128 + r]; *(unsigned*)(o_qg + r * 128 + kperm(2 * lane)) = pk2(q0 * eg, q1 * eg); }
            }
        }
        __syncthreads();
        if (part == 0) {
#pragma unroll
            for (int k = 0; k < 2; ++k) { const int pi = tid + 512 * k; *(v4u*)(o_kgt + pi * 8) = *(const LAS v4u*)(KGT + pi * 8); }
        }
    }
    {
        const int mat = wave >> 2, ti = (wave >> 1) & 1, tj = wave & 1, r32 = lane & 31, hi = lane >> 5;
        const LAS bf16* Ab = (mat == 0 ? KB : QB) + (32 * ti + r32) * 136 + 8 * hi;
        const LAS bf16* Bb = KB + (32 * tj + r32) * 136 + 8 * hi;
        f32x16 acc;
#pragma unroll
        for (int r = 0; r < 16; ++r) acc[r] = 0.f;
#pragma unroll
        for (int s = 0; s < 8; ++s) acc = MFMA32(*(const LAS bf16x8*)(Ab + 16 * s), *(const LAS bf16x8*)(Bb + 16 * s), acc);
        const int j = 32 * tj + r32; const float Gj = SMG[j];
#pragma unroll
        for (int r = 0; r < 16; ++r) { const int i = 32 * ti + crow(r, hi); const float dec = expf(fminf(SMG[i] - Gj, 0.f));
            if (mat == 0) { const float av = (i > j) ? acc[r] * SMG[64 + i] * dec : 0.f; AMN[i * 80 + kperm(j)] = f2bf(-av); if ((i >> 4) == (j >> 4)) TD[(i >> 4) * 256 + (i & 15) * 16 + (j & 15)] = av; }
            else o_qk[i * 64 + kperm(j)] = f2bf((i >= j) ? acc[r] * dec : 0.f); }
    }
    __syncthreads();
    if (wave == 0) {
        const int bb = lane >> 4, c = lane & 15; float y[16];
        const LAS float* tdp = TD + bb * 256;
#pragma unroll
        for (int i = 0; i < 16; ++i) { float a[16];
#pragma unroll
            for (int j4 = 0; j4 < 4; ++j4) if (4 * j4 < i) { const f32x4 t = *(const LAS f32x4*)(tdp + i * 16 + 4 * j4); a[4 * j4] = t.x; a[4 * j4 + 1] = t.y; a[4 * j4 + 2] = t.z; a[4 * j4 + 3] = t.w; }
            float s0 = (i == c) ? 1.f : 0.f, s1 = 0.f;
#pragma unroll
            for (int j = 0; j < i; ++j) { if (j & 1) s1 = fmaf(-a[j], y[j], s1); else s0 = fmaf(-a[j], y[j], s0); }
            y[i] = s0 + s1;
            const int pc = 8 * (c >> 2) + (c & 3);
            TB[(bb * 16 + i) * 32 + pc] = f2bf(y[i]); TB[(bb * 16 + i) * 32 + pc + 4] = 0; }
    }
    __syncthreads();
    {
        const int cl = lane & 15, q = lane >> 4;
        const f32x4 zero4 = {0.f, 0.f, 0.f, 0.f};
        const LAS unsigned char* amn = (const LAS unsigned char*)AMN + cl * 160 + q * 16;
        const LAS unsigned char* tbp = (const LAS unsigned char*)TB + cl * 64 + q * 16;
#pragma unroll 1
        for (int nt = 0; nt < 2; ++nt) {
            const int col = 32 * wave + 16 * nt + cl;
            f32x4 X[4];
#pragma unroll
            for (int b4 = 0; b4 < 4; ++b4) {
                f32x4 R;
#pragma unroll
                for (int r = 0; r < 4; ++r) R[r] = RHS[(16 * b4 + 4 * q + r) * 256 + col];
                if (b4 == 1) R = MFMA16(*(const LAS bf16x8*)(amn + 16 * 160), pack8(X[0], zero4), R);
                if (b4 == 2) R = MFMA16(*(const LAS bf16x8*)(amn + 32 * 160), pack8(X[0], X[1]), R);
                if (b4 == 3) { R = MFMA16(*(const LAS bf16x8*)(amn + 48 * 160), pack8(X[0], X[1]), R); R = MFMA16(*(const LAS bf16x8*)(amn + 48 * 160 + 64), pack8(X[2], zero4), R); }
                X[b4] = MFMA16(*(const LAS bf16x8*)(tbp + b4 * 16 * 64), pack8(R, zero4), zero4);
            }
            if (wave < 4) {
#pragma unroll
                for (int b4 = 0; b4 < 4; ++b4) *(v2u*)(o_ut + col * 64 + 16 * b4 + 4 * q) = (v2u){pk2(X[b4][0], X[b4][1]), pk2(X[b4][2], X[b4][3])};
            } else { const int pk = kperm(col - 128);
#pragma unroll
                for (int b4 = 0; b4 < 4; ++b4)
#pragma unroll
                    for (int r = 0; r < 4; ++r) o_w[(16 * b4 + 4 * q + r) * 128 + pk] = f2bf(X[b4][r]); }
        }
    }
    __syncthreads();
}

constexpr int SL_W = 0, SL_QG = 18432, SL_KGT = 36864, SL_UT = 57344, SL_QK = 75776, SL_Z = 86016, SL_ZSZ = 16896, SL_PS = 119808, SL_END = SL_PS + 4096;
__device__ __forceinline__ bf16x8 ldfrag(const LAS unsigned char* p) { return *(const LAS bf16x8*)p; }
__device__ __forceinline__ float dpp_sum16(float v) {
    v += __uint_as_float((unsigned)__builtin_amdgcn_update_dpp(0, (int)__float_as_uint(v), 0xB1, 0xF, 0xF, true));
    v += __uint_as_float((unsigned)__builtin_amdgcn_update_dpp(0, (int)__float_as_uint(v), 0x4E, 0xF, 0xF, true));
    v += __uint_as_float((unsigned)__builtin_amdgcn_update_dpp(0, (int)__float_as_uint(v), 0x141, 0xF, 0xF, true));
    v += __uint_as_float((unsigned)__builtin_amdgcn_update_dpp(0, (int)__float_as_uint(v), 0x140, 0xF, 0xF, true));
    return v;
}
__device__ __forceinline__ void scan_unit(LAS unsigned char* lds, int nsteps, int nrows, const bf16* gmain, size_t main_stride, const bf16* gqk, size_t qk_stride, const float* DLp,
                                          const float* S0, float* Sout, const bf16* Pz  , bf16* MX  , unsigned dumpoff  , gu32* prog  , const float* gnw, int tid, int lane, int wave) {
    const int cl = lane & 15, q = lane >> 4, c0 = wave * 16;
    f32x4 S[8];
#pragma unroll
    for (int mt = 0; mt < 8; ++mt)
#pragma unroll
        for (int r = 0; r < 4; ++r) S[mt][r] = S0 ? S0[(16 * mt + 4 * q + r) * 128 + c0 + cl] : 0.f;
    const float gwc = gnw[c0 + cl];
    const unsigned laneoff = (unsigned)q * (4u * D * 2u) + (unsigned)(c0 + cl) * 2u;
    dumpoff += (unsigned)lane * 2u;
    const unsigned voff16 = (unsigned)tid * 16u, voffz = (unsigned)(tid >> 4) * (unsigned)(NIN * 2) + (unsigned)(tid & 15) * 16u;
    v4u Ra[11];
    f32x4 OP[4];
#pragma unroll
    for (int mt = 0; mt < 4; ++mt) OP[mt] = (f32x4){0.f, 0.f, 0.f, 0.f};
#define SCAN_LOAD(R, nn) do { const char* mp_ = (const char*)(gmain + (size_t)(nn) * main_stride); _Pragma("unroll") for (int k = 0; k < 8; ++k) R[k] = *(const v4u*)(mp_ + k * 8192 + voff16); \
        R[8] = *(const v4u*)((const char*)(gqk + (size_t)(nn) * qk_stride) + voff16); \
        const char* zp_ = (const char*)(Pz + (size_t)(nn) * 64 * NIN); \
        _Pragma("unroll") for (int k = 0; k < 2; ++k) R[9 + k] = *(const v4u*)(zp_ + (size_t)k * 32 * NIN * 2 + voffz); } while (0)
#define SCAN_BAR() asm volatile("s_waitcnt lgkmcnt(0)\n\ts_barrier" ::: "memory")
#define SCAN_FINISH(PSP, ZP, nn) do { \
        _Pragma("unroll") for (int mt = 0; mt < 4; ++mt) { f32x4 tot_ = *(const LAS f32x4*)((PSP) + 16 * mt + 4 * q); \
            _Pragma("unroll") for (int w_ = 1; w_ < 8; ++w_) tot_ += *(const LAS f32x4*)((PSP) + w_ * 64 + 16 * mt + 4 * q); \
            _Pragma("unroll") for (int r = 0; r < 4; ++r) { const int row_ = 16 * mt + 4 * q + r; const float rstd_ = rsq_(tot_[r] * (1.f / 128.f) + EPS); \
                const float z_ = bf1(*(const LAS unsigned short*)((ZP) + row_ * 264 + (c0 + cl) * 2)); \
                const unsigned off_ = (row_ < nrows) ? (unsigned)(nn) * (64u * D * 2u) + (unsigned)(16 * mt + r) * (D * 2u) + laneoff : dumpoff; \
                *(bf16*)((char*)MX + off_) = f2bf(OP[mt][r] * rstd_ * gwc * z_ * sigmoidf_(z_)); } } } while (0)
#define SCAN_STEP(n, R, PSC, PSP, ZC, ZP) do { \
        SCAN_BAR();                                            \
        if (prog && tid == 0) __hip_atomic_store(prog, (unsigned)(n) + 1u, RLX_AGENT); \
        _Pragma("unroll") for (int k = 0; k < 8; ++k) { const int a_ = k >> 1, within_ = tid + 512 * (k & 1); int dst_; \
            if (a_ < 2) dst_ = (a_ == 0 ? SL_W : SL_QG) + (within_ >> 4) * 288 + (within_ & 15) * 16; else dst_ = (a_ == 2 ? SL_KGT + (within_ >> 3) * 160 : SL_UT + (within_ >> 3) * 144) + (within_ & 7) * 16; \
            *(LAS v4u*)(lds + dst_) = R[k]; } \
        *(LAS v4u*)(lds + SL_QK + (tid >> 3) * 160 + (tid & 7) * 16) = R[8]; \
        _Pragma("unroll") for (int k = 0; k < 2; ++k) { const int pi_ = tid + 512 * k; *(LAS v4u*)((ZC) + (pi_ >> 4) * 264 + (pi_ & 15) * 16) = R[9 + k]; } \
        asm volatile("" ::: "memory");                         \
        if ((n) + 1 < nsteps) SCAN_LOAD(R, (n) + 1); \
        const float dl_ = __uint_as_float(__builtin_amdgcn_readlane(dlbits, (n))); \
        SCAN_BAR(); \
        bf16x8 Sb_[4]; \
        _Pragma("unroll") for (int ks = 0; ks < 4; ++ks) Sb_[ks] = pack8(S[2 * ks], S[2 * ks + 1]); \
        f32x4 vn_[4], o_[4]; \
        _Pragma("unroll") for (int mt = 0; mt < 4; ++mt) { \
            f32x4 aw_ = {0.f, 0.f, 0.f, 0.f}, ao_ = {0.f, 0.f, 0.f, 0.f}; \
            const LAS unsigned char* wp_ = lds + SL_W + (16 * mt + cl) * 288 + q * 16; const LAS unsigned char* qp_ = lds + SL_QG + (16 * mt + cl) * 288 + q * 16; \
            _Pragma("unroll") for (int ks = 0; ks < 4; ++ks) { aw_ = MFMA16(ldfrag(wp_ + ks * 64), Sb_[ks], aw_); ao_ = MFMA16(ldfrag(qp_ + ks * 64), Sb_[ks], ao_); } \
            const v2u uu_ = *(const LAS v2u*)(lds + SL_UT + (c0 + cl) * 144 + (16 * mt + 4 * q) * 2); \
            vn_[mt] = (f32x4){bflo(uu_.x) - aw_[0], bfhi(uu_.x) - aw_[1], bflo(uu_.y) - aw_[2], bfhi(uu_.y) - aw_[3]}; \
            o_[mt] = ao_; } \
        bf16x8 Vb_[2]; \
        _Pragma("unroll") for (int ks = 0; ks < 2; ++ks) Vb_[ks] = pack8(vn_[2 * ks], vn_[2 * ks + 1]); \
        _Pragma("unroll") for (int mt = 0; mt < 4; ++mt) { const LAS unsigned char* kp_ = lds + SL_QK + (16 * mt + cl) * 160 + q * 16; \
            _Pragma("unroll") for (int ks = 0; ks < 2; ++ks) o_[mt] = MFMA16(ldfrag(kp_ + ks * 64), Vb_[ks], o_[mt]); } \
        _Pragma("unroll") for (int mt = 0; mt < 8; ++mt) { S[mt] = S[mt] * dl_; const LAS unsigned char* kp_ = lds + SL_KGT + (16 * mt + cl) * 160 + q * 16; \
            _Pragma("unroll") for (int ks = 0; ks < 2; ++ks) S[mt] = MFMA16(ldfrag(kp_ + ks * 64), Vb_[ks], S[mt]); } \
        if ((n) > 0) SCAN_FINISH(PSP, ZP, (n) - 1); \
        _Pragma("unroll") for (int mt = 0; mt < 4; ++mt) { f32x4 ps_; \
            _Pragma("unroll") for (int r = 0; r < 4; ++r) ps_[r] = dpp_sum16(o_[mt][r] * o_[mt][r]); \
            if (cl == 0) *(LAS f32x4*)((PSC) + wave * 64 + 16 * mt + 4 * q) = ps_; \
            OP[mt] = o_[mt]; } \
    } while (0)
    LAS float* PS0 = (LAS float*)(lds + SL_PS); LAS float* PS1 = (LAS float*)(lds + SL_PS + 2048);
    LAS unsigned char* Z0 = lds + SL_Z; LAS unsigned char* Z1 = lds + SL_Z + SL_ZSZ;
    const int dlbits = (int)__float_as_uint(lane < nsteps ? DLp[lane] : 1.f);
    SCAN_LOAD(Ra, 0);
#pragma unroll 1
    for (int n = 0; n < nsteps; n += 2) {
        SCAN_STEP(n, Ra, PS0, PS1, Z0, Z1);
        if (n + 1 < nsteps) SCAN_STEP(n + 1, Ra, PS1, PS0, Z1, Z0);
    }
    SCAN_BAR();
    if (nsteps & 1) SCAN_FINISH(PS0, Z0, nsteps - 1); else SCAN_FINISH(PS1, Z1, nsteps - 1);
#undef SCAN_LOAD
#undef SCAN_FINISH
#undef SCAN_STEP
#undef SCAN_BAR
#pragma unroll
    for (int mt = 0; mt < 8; ++mt)
#pragma unroll
        for (int r = 0; r < 4; ++r) Sout[(16 * mt + 4 * q + r) * 128 + c0 + cl] = S[mt][r];
    __syncthreads();
}


__device__ __forceinline__ void scan_helper(gu32* prog, const bf16* gmain, size_t main_stride, const bf16* gqk, size_t qk_stride, const bf16* Pz, float* sink, int tid, int lane) {
    constexpr int AHEAD = 6;
    unsigned acc = 0u;
    const unsigned vmain = (unsigned)tid * 128u, vz = (unsigned)((tid >> 1) & 63) * (unsigned)(NIN * 2) + (unsigned)(tid & 1) * 128u, vqk = (unsigned)(tid & 63) * 128u;
#pragma unroll 1
    for (int n = 0; n < 64; ++n) {
        if (n > AHEAD) {
            if (lane == 0) { unsigned sp = 0u; while ((int)__hip_atomic_load(prog, RLX_AGENT) < n - AHEAD && ++sp < 200000u) __builtin_amdgcn_s_sleep(16); }
        }
        const unsigned a = *(const unsigned*)((const char*)(gmain + (size_t)n * main_stride) + vmain);
        const unsigned b = *(const unsigned*)((const char*)(Pz + (size_t)n * 64 * NIN) + vz);
        const unsigned c = *(const unsigned*)((const char*)(gqk + (size_t)n * qk_stride) + vqk);
        acc ^= a ^ b ^ c;
    }
    if (acc == 0x9e3779b9u) *sink = 0.f;
}

constexpr int ATT_WAVE_LDS = 17920;
constexpr float LOG2E = 1.4426950408889634f;
typedef short v4i16_t __attribute__((ext_vector_type(4)));
__device__ __forceinline__ s16x4 vtr(const LAS unsigned char* p) { return __builtin_bit_cast(s16x4, __builtin_amdgcn_ds_read_tr16_b64_v4i16((LAS v4i16_t*)p)); }
__device__ __forceinline__ void attn_item(LAS unsigned char* wl, int it, const bf16* P, const float* ck, const float* cv, const float* relb, const float* anw, bf16* MIXIN, int lane) {
    LAS unsigned char* KL = wl; LAS unsigned char* VL = wl + 8192; LAS float* SC = (LAS float*)(wl + 16384); LAS float* BT = (LAS float*)(wl + 16640);
    const int r32 = lane & 31, hi = lane >> 5;
    const bool sample = it < 256;
    int b, h, n = 0, half = 0, mq, t0, t1;
    if (sample) { b = it >> 3; h = it & 7; mq = MP + b * 32; t0 = 0; t1 = 9; }
    else { const int idx = it - 256; half = idx & 1; n = (idx >> 1) & 63; h = (idx >> 7) & 7; b = idx >> 10; mq = b * SEQ + n * 64 + half * 32; t0 = n > 8 ? n - 8 : 0; t1 = n + 1; }
    for (int k = lane; k < 257; k += 64) BT[k] = relb[h * 257 + k] * LOG2E;
    bf16x8 qr[4];
#pragma unroll
    for (int d0 = 0; d0 < 4; ++d0) qr[d0] = *(const bf16x8*)(P + (size_t)(mq + r32) * NIN + PC_QB + h * 64 + d0 * 16 + hi * 8);
    float mrun = -1e30f, lrun = 0.f; f32x16 o0, o1;
#pragma unroll
    for (int r = 0; r < 16; ++r) { o0[r] = 0.f; o1[r] = 0.f; }
    const int ti = lane & 15, blk = (lane >> 4) & 1;
    const LAS unsigned char* vbase = VL + (4 * hi + (ti >> 2)) * 128 + (blk * 16 + 4 * (ti & 3)) * 2;
#pragma unroll 1
    for (int t = t0; t < t1; ++t) {
        int relbase; bool maskhalf = false;
        if (sample && t < 8) {
            relbase = 512 - 64 * t;
#pragma unroll
            for (int i8 = 0; i8 < 8; ++i8) { const int idx = i8 * 64 + lane, key = idx >> 3, c8 = idx & 7; const size_t off = (((size_t)b * 512 + 64 * t + key) * 8 + h) * 64 + c8 * 8;
                const f32x4 ka = *(const f32x4*)(ck + off), kb = *(const f32x4*)(ck + off + 4), va = *(const f32x4*)(cv + off), vb = *(const f32x4*)(cv + off + 4);
                *(LAS v4u*)(KL + (c8 * 64 + key) * 16) = (v4u){pk2(ka.x, ka.y), pk2(ka.z, ka.w), pk2(kb.x, kb.y), pk2(kb.z, kb.w)};
                *(LAS v4u*)(VL + key * 128 + c8 * 16) = (v4u){pk2(va.x, va.y), pk2(va.z, va.w), pk2(vb.x, vb.y), pk2(vb.z, vb.w)}; }
        } else {
            size_t rowbase; int nvalid;
            if (sample) { relbase = 0; maskhalf = true; rowbase = (size_t)MP + b * 32; nvalid = 32; }
            else { relbase = 64 * (n - t) + 32 * half; rowbase = (size_t)b * SEQ + t * 64; nvalid = 64; }
#pragma unroll
            for (int i8 = 0; i8 < 8; ++i8) { const int idx = i8 * 64 + lane, key = idx >> 3, c8 = idx & 7; v4u kv = {0u, 0u, 0u, 0u}, vv = {0u, 0u, 0u, 0u};
                if (key < nvalid) { const bf16* rp = P + (rowbase + key) * NIN + h * 64 + c8 * 8; kv = *(const v4u*)(rp + PC_KB); vv = *(const v4u*)(rp + PC_VB); }
                *(LAS v4u*)(KL + (c8 * 64 + key) * 16) = kv; *(LAS v4u*)(VL + key * 128 + c8 * 16) = vv; }
        }
        f32x16 p0, p1;
#pragma unroll
        for (int r = 0; r < 16; ++r) { p0[r] = 0.f; p1[r] = 0.f; }
#pragma unroll
        for (int d0 = 0; d0 < 4; ++d0) { const bf16x8 k0 = *(const LAS bf16x8*)(KL + (2 * d0 + hi) * 1024 + r32 * 16), k1 = *(const LAS bf16x8*)(KL + (2 * d0 + hi) * 1024 + 512 + r32 * 16);
            p0 = MFMA32(k0, qr[d0], p0); p1 = MFMA32(k1, qr[d0], p1); }
        const float SC2 = 0.125f * LOG2E;
        if (relbase - 63 >= 128) { const float bc = BT[256];
#pragma unroll
            for (int r = 0; r < 16; ++r) { p0[r] = p0[r] * SC2 + bc; p1[r] = p1[r] * SC2 + bc; } }
        else {
#pragma unroll
            for (int r = 0; r < 16; ++r) { const int rel = relbase + r32 - crow(r, hi); int i0 = (rel > 128 ? 128 : rel) + 128, i1 = (rel - 32 > 128 ? 128 : rel - 32) + 128; i0 = i0 < 0 ? 0 : i0; i1 = i1 < 0 ? 0 : i1;
                p0[r] = p0[r] * SC2 + BT[i0]; p1[r] = p1[r] * SC2 + BT[i1]; } }
        if (maskhalf) {
#pragma unroll
            for (int r = 0; r < 16; ++r) p1[r] = -INFINITY; }
        float mx = fmaxf(p0[0], p1[0]);
#pragma unroll
        for (int r = 1; r < 16; ++r) mx = fmaxf(mx, fmaxf(p0[r], p1[r]));
        mx = fmaxf(mx, __shfl_xor(mx, 32));
        const float mnew = fmaxf(mrun, mx); const float alpha = __builtin_amdgcn_exp2f(mrun - mnew); mrun = mnew;
        float sum = 0.f;
#pragma unroll
        for (int r = 0; r < 16; ++r) { p0[r] = __builtin_amdgcn_exp2f(p0[r] - mnew); p1[r] = __builtin_amdgcn_exp2f(p1[r] - mnew); sum += p0[r] + p1[r]; }
        lrun = lrun * alpha + sum;
        if (hi == 0) SC[r32] = alpha;
#pragma unroll
        for (int r = 0; r < 16; ++r) { const float a = SC[crow(r, hi)]; o0[r] *= a; o1[r] *= a; }
#pragma unroll
        for (int s = 0; s < 4; ++s) {
            v4u pw;
            if (s < 2) pw = (v4u){pk2(p0[8 * s + 0], p0[8 * s + 1]), pk2(p0[8 * s + 2], p0[8 * s + 3]), pk2(p0[8 * s + 4], p0[8 * s + 5]), pk2(p0[8 * s + 6], p0[8 * s + 7])};
            else { const int ss = s - 2; pw = (v4u){pk2(p1[8 * ss + 0], p1[8 * ss + 1]), pk2(p1[8 * ss + 2], p1[8 * ss + 3]), pk2(p1[8 * ss + 4], p1[8 * ss + 5]), pk2(p1[8 * ss + 6], p1[8 * ss + 7])}; }
            const bf16x8 pa = __builtin_bit_cast(bf16x8, pw);
            const LAS unsigned char* vp = vbase + (16 * s) * 128;
            const s16x4 a0 = vtr(vp), a1 = vtr(vp + 8 * 128), b0 = vtr(vp + 64), b1 = vtr(vp + 8 * 128 + 64);
            const bf16x8 v0 = {a0[0], a0[1], a0[2], a0[3], a1[0], a1[1], a1[2], a1[3]}, v1 = {b0[0], b0[1], b0[2], b0[3], b1[0], b1[1], b1[2], b1[3]};
            o0 = MFMA32(pa, v0, o0); o1 = MFMA32(pa, v1, o1);
        }
    }
    lrun += __shfl_xor(lrun, 32);
    if (hi == 0) SC[32 + r32] = 1.f / lrun;
    LAS float* OL = (LAS float*)wl;
#pragma unroll
    for (int r = 0; r < 16; ++r) { const int qq = crow(r, hi); const float inv = SC[32 + qq]; OL[qq * 66 + r32] = o0[r] * inv; OL[qq * 66 + 32 + r32] = o1[r] * inv; }
    {
        const int qq = lane >> 1, dh = (lane & 1) * 32; float vals[32]; float ss = 0.f;
#pragma unroll
        for (int k = 0; k < 32; ++k) { vals[k] = OL[qq * 66 + dh + k]; ss += vals[k] * vals[k]; }
        ss += __shfl_xor(ss, 1);
        const float rstd = rsq_(ss * (1.f / 64.f) + EPS);
        bf16* op = MIXIN + (size_t)(mq + qq) * D + 512 + h * 64 + dh;
#pragma unroll
        for (int k4 = 0; k4 < 4; ++k4) { v4u o;
            const f32x4 wa = *(const f32x4*)(anw + dh + 8 * k4), wb = *(const f32x4*)(anw + dh + 8 * k4 + 4);
            o.x = pk2(vals[8 * k4 + 0] * rstd * wa.x, vals[8 * k4 + 1] * rstd * wa.y); o.y = pk2(vals[8 * k4 + 2] * rstd * wa.z, vals[8 * k4 + 3] * rstd * wa.w);
            o.z = pk2(vals[8 * k4 + 4] * rstd * wb.x, vals[8 * k4 + 5] * rstd * wb.y); o.w = pk2(vals[8 * k4 + 6] * rstd * wb.z, vals[8 * k4 + 7] * rstd * wb.w);
            *(v4u*)(op + 8 * k4) = o; }
    }
}

__device__ __forceinline__ void phase_rows1(const float* xp, const float* xs, const float* mix, const float* w_post, const float* w_pre2, float* out, bf16* U, int gw, int NGW, int lane) {
    for (int m = gw; m < M; m += NGW) {
        const float* xrow = m < MP ? xp + (size_t)m * D : xs + (size_t)(m - MP) * D;
        f32x4 v[4], xv[4]; float s = 0.f;
#pragma unroll
        for (int j = 0; j < 4; ++j) { v[j] = ((const f32x4*)(mix + (size_t)m * D))[lane + 64 * j]; xv[j] = ((const f32x4*)xrow)[lane + 64 * j]; s += (v[j].x * v[j].x + v[j].y * v[j].y) + (v[j].z * v[j].z + v[j].w * v[j].w); }
        const float rstd = rsq_(wave_sum(s) * (1.f / D) + EPS); float s2 = 0.f;
#pragma unroll
        for (int j = 0; j < 4; ++j) { const f32x4 g = ((const f32x4*)w_post)[lane + 64 * j]; v[j] = xv[j] + v[j] * rstd * g; ((f32x4*)(out + (size_t)m * D))[lane + 64 * j] = v[j];
            s2 += (v[j].x * v[j].x + v[j].y * v[j].y) + (v[j].z * v[j].z + v[j].w * v[j].w); }
        const float rstd2 = rsq_(wave_sum(s2) * (1.f / D) + EPS);
        unsigned long long* o8 = (unsigned long long*)(U + (size_t)m * D) + lane;
#pragma unroll
        for (int j = 0; j < 4; ++j) { const f32x4 g = ((const f32x4*)w_pre2)[lane + 64 * j]; const f32x4 t = v[j] * rstd2 * g;
            o8[64 * j] = (unsigned long long)pk2(t.x, t.y) | ((unsigned long long)pk2(t.z, t.w) << 32); }
    }
}
__device__ __forceinline__ void phase_rows2(const float* dn, const float* w, float* out, int gw, int NGW, int lane) {
    for (int m = gw; m < M; m += NGW) {
        f32x4 v[4]; float s = 0.f;
#pragma unroll
        for (int j = 0; j < 4; ++j) { v[j] = ((const f32x4*)(dn + (size_t)m * D))[lane + 64 * j]; s += (v[j].x * v[j].x + v[j].y * v[j].y) + (v[j].z * v[j].z + v[j].w * v[j].w); }
        const float rstd = rsq_(wave_sum(s) * (1.f / D) + EPS);
#pragma unroll
        for (int j = 0; j < 4; ++j) { const f32x4 g = ((const f32x4*)w)[lane + 64 * j]; f32x4* op = (f32x4*)(out + (size_t)m * D) + lane + 64 * j; *op = *op + v[j] * rstd * g; }
    }
}
__device__ __forceinline__ float gelu_tanh(float x) { const float y = 0.7978845608028654f * (x + 0.044715f * x * x * x); const float t = 1.f - 2.f * __builtin_amdgcn_rcpf(1.f + __builtin_amdgcn_exp2f(2.8853900817779268f * y)); return 0.5f * x * (1.f + t); }
__device__ __forceinline__ void phase_h(const bf16* Gt, bf16* UP, const float* st_ffn, const float* cw, const float* cb, float* out, int gtid, int nth) {
    constexpr int CG = FF / 8;
    for (int idx = gtid; idx < M * CG; idx += nth) {
        const int m = idx / CG, c = (idx % CG) * 8;
        float g2[8], g1[8], g0[8];
        { const v4u t = *(const v4u*)(Gt + (size_t)m * FF + c); g2[0] = bflo(t.x); g2[1] = bfhi(t.x); g2[2] = bflo(t.y); g2[3] = bfhi(t.y); g2[4] = bflo(t.z); g2[5] = bfhi(t.z); g2[6] = bflo(t.w); g2[7] = bfhi(t.w); }
        int tpos, bsm = 0; const bool smp = m >= MP;
        if (smp) { tpos = (m - MP) & 31; bsm = (m - MP) >> 5; } else tpos = m & (SEQ - 1);
        if (tpos >= 1) { const v4u t = *(const v4u*)(Gt + (size_t)(m - 1) * FF + c); g1[0] = bflo(t.x); g1[1] = bfhi(t.x); g1[2] = bflo(t.y); g1[3] = bfhi(t.y); g1[4] = bflo(t.z); g1[5] = bfhi(t.z); g1[6] = bflo(t.w); g1[7] = bfhi(t.w); }
        else if (smp) { const float* s = st_ffn + ((size_t)bsm * 2 + 1) * FF + c;
#pragma unroll
            for (int e = 0; e < 8; ++e) g1[e] = s[e]; }
        else {
#pragma unroll
            for (int e = 0; e < 8; ++e) g1[e] = 0.f; }
        if (tpos >= 2) { const v4u t = *(const v4u*)(Gt + (size_t)(m - 2) * FF + c); g0[0] = bflo(t.x); g0[1] = bfhi(t.x); g0[2] = bflo(t.y); g0[3] = bfhi(t.y); g0[4] = bflo(t.z); g0[5] = bfhi(t.z); g0[6] = bflo(t.w); g0[7] = bfhi(t.w); }
        else if (smp) { const float* s = st_ffn + ((size_t)bsm * 2 + tpos) * FF + c;
#pragma unroll
            for (int e = 0; e < 8; ++e) g0[e] = s[e]; }
        else {
#pragma unroll
            for (int e = 0; e < 8; ++e) g0[e] = 0.f; }
        const v4u ut = *(const v4u*)(UP + (size_t)m * FF + c);
        float up[8] = {bflo(ut.x), bfhi(ut.x), bflo(ut.y), bfhi(ut.y), bflo(ut.z), bfhi(ut.z), bflo(ut.w), bfhi(ut.w)};
        float hv[8];
#pragma unroll
        for (int e = 0; e < 8; ++e) { const float x = cw[c + e] * g0[e] + cw[FF + c + e] * g1[e] + cw[2 * FF + c + e] * g2[e] + cb[c + e]; hv[e] = gelu_tanh(x) * up[e]; }
        const v4u o = {pk2(hv[0], hv[1]), pk2(hv[2], hv[3]), pk2(hv[4], hv[5]), pk2(hv[6], hv[7])};
        *(v4u*)(UP + (size_t)m * FF + c) = o;
        const int tl = smp ? 32 : SEQ;
        if (tpos >= tl - 2) { const int i = tpos - (tl - 2); float* op = smp ? out + O_FCS + ((size_t)bsm * 2 + i) * FF + c : out + O_FCP + ((size_t)(m >> 12) * 2 + i) * FF + c;
#pragma unroll
            for (int e = 0; e < 8; ++e) op[e] = g2[e]; }
    }
}

#ifndef MK_N_LAUNCHES
#define MK_N_LAUNCHES 1
#endif
constexpr int NPH = 10;
constexpr int N_LAUNCHES = MK_N_LAUNCHES;
struct Args { const float* in[23]; float* out; unsigned char* ws; int ph_lo, ph_hi, li, pad; };
__global__ void __launch_bounds__(NWAVES * 64, 2) hybrid_fwd(Args args) {
    extern __shared__ __attribute__((aligned(16))) unsigned char lds_raw[];
    LAS unsigned char* lds = (LAS unsigned char*)lds_raw;
    volatile LAS unsigned* MISC = (volatile LAS unsigned*)(lds + MISC_OFF);
    const int tid = threadIdx.x, lane = tid & 63, wave = __builtin_amdgcn_readfirstlane(tid >> 6);
    const int G = gridDim.x; const int bx = blockIdx.x; const int vcu = (G % 8 == 0) ? (bx % 8) * (G / 8) + bx / 8 : bx;
    unsigned char* ws = args.ws; float* out = args.out;
    gu32* ctl = (gu32*)(ws + WS_CTL);
#define x_prompt (args.in[0])
#define x_sample (args.in[1])
#define cache_k (args.in[2])
#define cache_v (args.in[3])
#define state_delta (args.in[4])
#define state_qkv (args.in[5])
#define state_ffn (args.in[6])
#define norm_mix_pre (args.in[7])
#define w_in (args.in[8])
#define qkv_conv_w (args.in[9])
#define a_log (args.in[10])
#define dt_bias (args.in[11])
#define gdn_norm_w (args.in[12])
#define rel_bias (args.in[13])
#define attn_norm_w (args.in[14])
#define w_out (args.in[15])
#define norm_mix_post (args.in[16])
#define norm_ffn_pre (args.in[17])
#define w_gate_up (args.in[18])
#define ffn_conv_w (args.in[19])
#define ffn_conv_b (args.in[20])
#define w_down (args.in[21])
#define norm_ffn_post (args.in[22])
#define Win_t ((bf16*)(ws + WS_WIN))
#define Wout_t ((bf16*)(ws + WS_WOUT))
#define Wgu_t ((bf16*)(ws + WS_WGU))
#define Wdn_t ((bf16*)(ws + WS_WDN))
#define AB ((float*)(ws + WS_AB))
#define DL ((float*)(ws + WS_DL))
#define U ((bf16*)(ws + WS_U))
#define GQK ((bf16*)(ws + WS_GQK))
#define GS ((bf16*)(ws + WS_GS))
#define P ((bf16*)(ws + WS_P))
#define MIXIN ((bf16*)(ws + WS_MIXIN))
#define MIXOUT ((float*)(ws + WS_P))
#define Gt ((bf16*)(ws + WS_G))
#define UP ((bf16*)(ws + WS_UP))
#define DOWN ((float*)(ws + WS_G))
#define GMAIN ((bf16*)out)

    for (int u = tid; u < 64; u += NWAVES * 64) ((LAS unsigned*)(lds + MISC_OFF))[u] = 0u;
    __syncthreads();
    XcdBarrier bar; bar.bar = (unsigned*)(ctl + CW_BAR); bar.x = 0; bar.st = nullptr;
    if (N_LAUNCHES == 1) bar = xcd_barrier_post((unsigned*)(ctl + CW_BAR), MISC + 8);
#define GRID_BAR() do { if (N_LAUNCHES == 1) xcd_barrier(bar); } while (0)
    const int lo = args.ph_lo, hi_ = args.ph_hi;
#define IN(k) (lo <= (k) && (k) < hi_)
#define BOTH(k) (IN(k) && IN((k) + 1))
    const int gw = vcu * NWAVES + wave, NGW = G * NWAVES, gtid = bx * (NWAVES * 64) + tid, nth = G * NWAVES * 64;

    if (IN(0)) { phase_prologue(lds, x_prompt, x_sample, norm_mix_pre, w_in, w_out, w_gate_up, w_down, ws, vcu, G, tid, lane, wave); if (BOTH(0)) GRID_BAR(); }

    if (IN(1)) {
        pg8::Gemm g{U, Win_t, M, NIN, D}; pg8::StaticOrder S; S.init(M, NIN, G, bx);
        pg8::EpiBf16<0> E{P, NIN, nullptr, 0, 0, 1.f};
        pg8::gemm_phase<pg8::EpiBf16<0>, pg8::StaticOrder, true, true>(lds, g, S, E);
        if (BOTH(1)) GRID_BAR();
    }

    if (IN(2)) {
        phase_copy_outputs(P, out, gtid, nth);
        for (int u = bx; u < 1152; u += G) gdn_pre_unit(lds, u, P, AB, state_qkv, qkv_conv_w, a_log, dt_bias, GMAIN, GQK, GS, DL, tid, lane, wave);
        if (BOTH(2)) GRID_BAR();
    }

    if (IN(3)) {
        if (bx < 16) {
            const int b = bx >> 2, h = bx & 3; const int u0 = b * 256 + h * 64; const size_t m0 = (size_t)b * SEQ;
            scan_unit(lds, 64, 64, GMAIN + (size_t)u0 * 32768, 32768, GQK + (size_t)u0 * 4096, 4096, DL + u0, nullptr, out + O_DP + (size_t)(b * 4 + h) * 16384,
                      P + m0 * NIN + PC_Z + h * 128, MIXIN + m0 * D + h * 128, (unsigned)(((size_t)M * D - (m0 * D + h * 128)) * 2), ctl + 1024 + 64 * bx, gdn_norm_w, tid, lane, wave);
        } else if (bx >= G - 16) {
            const int sidx = bx - (G - 16); const int b = sidx >> 2, h = sidx & 3; const int u0 = b * 256 + h * 64; const size_t m0 = (size_t)b * SEQ;
            scan_helper(ctl + 1024 + 64 * sidx, GMAIN + (size_t)u0 * 32768, 32768, GQK + (size_t)u0 * 4096, 4096, P + m0 * NIN + PC_Z + h * 128, (float*)(ws + WS_DL + 65536), tid, lane);
        } else {
            const int su = bx - 16;
            if (su < 128) {
                const int b = su >> 2, h = su & 3; const size_t m0 = (size_t)MP + b * 32; const bf16* base = GS + (size_t)su * 36864;
                scan_unit(lds, 1, 32, base, 0, base + 32768, 0, DL + 1024 + su, state_delta + (size_t)su * 16384, out + O_DS + (size_t)su * 16384,
                          P + m0 * NIN + PC_Z + h * 128, MIXIN + m0 * D + h * 128, (unsigned)(((size_t)M * D - (m0 * D + h * 128)) * 2), nullptr, gdn_norm_w, tid, lane, wave);
            }
            __syncthreads();
            LAS unsigned char* wl = lds + wave * ATT_WAVE_LDS;
            for (int it = (bx - 16) * NWAVES + wave; it < 4352; it += (G - 32) * NWAVES) attn_item(wl, it, P, cache_k, cache_v, rel_bias, attn_norm_w, MIXIN, lane);
        }
        if (BOTH(3)) GRID_BAR();
    }

    if (IN(4)) {
        pg8::Gemm g{MIXIN, Wout_t, M, D, D}; pg8::StaticOrder S; S.init(M, D, G, bx);
        pg8::EpiF32 E{MIXOUT, D};
        pg8::gemm_phase<pg8::EpiF32, pg8::StaticOrder, true, true>(lds, g, S, E);
        if (BOTH(4)) GRID_BAR();
    }

    if (IN(5)) { phase_rows1(x_prompt, x_sample, MIXOUT, norm_mix_post, norm_ffn_pre, out, U, gw, NGW, lane); if (BOTH(5)) GRID_BAR(); }

    if (IN(6)) {
        pg8::Gemm g{U, Wgu_t, M, 2 * FF, D}; pg8::StaticOrder S; S.init(M, 2 * FF, G, bx);
        pg8::EpiBf16<0> E{Gt, FF, nullptr, FF, (size_t)M * FF, 1.f};
        pg8::gemm_phase<pg8::EpiBf16<0>, pg8::StaticOrder, true, true>(lds, g, S, E);
        if (BOTH(6)) GRID_BAR();
    }

    if (IN(7)) { phase_h(Gt, UP, state_ffn, ffn_conv_w, ffn_conv_b, out, gtid, nth); if (BOTH(7)) GRID_BAR(); }

    if (IN(8)) {
        pg8::Gemm g{UP, Wdn_t, M, D, FF}; pg8::StaticOrder S; S.init(M, D, G, bx);
        pg8::EpiF32 E{DOWN, D};
        pg8::gemm_phase<pg8::EpiF32, pg8::StaticOrder, true, true>(lds, g, S, E);
        if (BOTH(8)) GRID_BAR();
    }

    if (IN(9)) phase_rows2(DOWN, norm_ffn_post, out, gw, NGW, lane);
#undef IN
#undef BOTH
#undef GRID_BAR
}

extern "C" void kernel_launch(void* const* d_in, const int* in_sizes, int n_in, void* d_out, int out_size, void* d_ws, size_t ws_size, hipStream_t stream) {
    static int grid = 0;
    if (grid == 0) {
        if (n_in != 23 || out_size != 23699456 || ws_size < WS_END) { fprintf(stderr, "kernel_launch: unexpected shapes (n_in %d, out %d, ws %zu); nothing launched\n", n_in, out_size, ws_size); grid = -1; return; }
        int dev = 0, cus = 0, per_cu = 0;
        if (hipGetDevice(&dev) != hipSuccess || hipDeviceGetAttribute(&cus, hipDeviceAttributeMultiprocessorCount, dev) != hipSuccess) { grid = -1; return; }
        if (hipFuncSetAttribute((const void*)hybrid_fwd, hipFuncAttributeMaxDynamicSharedMemorySize, LDS_BYTES) != hipSuccess) { fprintf(stderr, "kernel_launch: hipFuncSetAttribute failed\n"); grid = -1; return; }
        if (hipOccupancyMaxActiveBlocksPerMultiprocessor(&per_cu, (const void*)hybrid_fwd, NWAVES * 64, LDS_BYTES) != hipSuccess || per_cu < 1) fprintf(stderr, "kernel_launch: occupancy query reports %d\n", per_cu);
        (void)hipGetLastError();
        grid = cus;
    }
    if (grid < 0) return;
    if (hipMemsetAsync((char*)d_ws + WS_CTL, 0, CTL_ZERO_BYTES, stream) != hipSuccess) { fprintf(stderr, "kernel_launch: memset failed\n"); return; }
    Args a{};
    for (int i = 0; i < 23; ++i) a.in[i] = (const float*)d_in[i];
    a.out = (float*)d_out; a.ws = (unsigned char*)d_ws;
    if (N_LAUNCHES == 1) { a.ph_lo = 0; a.ph_hi = NPH; a.li = 0; hipLaunchKernelGGL(hybrid_fwd, dim3(grid), dim3(NWAVES * 64), LDS_BYTES, stream, a); }
    else for (int li = 0; li < NPH; ++li) { a.ph_lo = li; a.ph_hi = li + 1; a.li = li; hipLaunchKernelGGL(hybrid_fwd, dim3(grid), dim3(NWAVES * 64), LDS_BYTES, stream, a);
#ifdef PROBE_DUP
        if (li == PROBE_DUP) hipLaunchKernelGGL(hybrid_fwd, dim3(grid), dim3(NWAVES * 64), LDS_BYTES, stream, a);
#endif
    }
    const hipError_t le = hipPeekAtLastError();
    if (le != hipSuccess) fprintf(stderr, "kernel_launch: launch failed: %s\n", hipGetErrorName(le));
}
```

```cpp
#include <hip/hip_runtime.h>
#include <cstdio>
#include <cstdint>
namespace pg8 {
#define PG8_LAS __attribute__((address_space(3)))
typedef unsigned short bf16_t;
typedef short bf16x8 __attribute__((ext_vector_type(8)));
typedef float f32x4 __attribute__((ext_vector_type(4)));
typedef unsigned u32x4 __attribute__((ext_vector_type(4)));
constexpr int BM = 256, BK = 64, HALF = 128, HTB = HALF * BK * 2  , STAGE_BYTES = 8 * HTB, NXCD = 8, WGM = 8;

__host__ __device__ __forceinline__ int lds_byte(int r, int c) { const int st = (r >> 4) * 2 + (c >> 5), rr = r & 15, cc = c & 31, ob = rr * 64 + cc * 2; return st * 1024 + (ob ^ (((ob >> 9) & 1) << 5)); }
__host__ __device__ __forceinline__ void stage_rc(int b, int& R, int& C) { const int st = b / 1024, sb = b % 1024, swz = sb ^ (((sb >> 9) & 1) << 5); R = (st >> 1) * 16 + swz / 64; C = (st & 1) * 32 + (swz % 64) / 2; }
__host__ __device__ __forceinline__ int perm32(int rho) { const int n = rho >> 4, i = rho & 15; return 8 * (i >> 2) + 4 * n + (i & 3); }

struct Unit { int pm, pn, kq; };
struct Gemm { const bf16_t* A; const bf16_t* Bt; int M, N, K, ld; };

struct StaticOrder {
    int nM, nN, nwg, G, c;
    __host__ __device__ void init(int M, int N, int G_, int c_) { nM = M / BM; nN = N / BM; nwg = nM * nN; G = G_; c = c_; }
    __host__ __device__ bool next(int i, Unit& u) const {
        const long L = (long)i * G + c; if (L >= nwg) return false;
        int wgid = (int)L; { const int q = nwg / NXCD, r = nwg % NXCD, xcd = wgid % NXCD, off = wgid / NXCD; wgid = (xcd < r ? xcd * (q + 1) : r * (q + 1) + (xcd - r) * q) + off; }
        const int nig = WGM * nN, gid = wgid / nig, fm = gid * WGM, gsz = (nM - fm) < WGM ? (nM - fm) : WGM;
        u.pm = fm + ((wgid % nig) % gsz); u.pn = (wgid % nig) / gsz; u.kq = 0; return true;
    }
    __device__ __forceinline__ void a_ready(const Unit&) const {}
    __device__ __forceinline__ void done(const Unit&) const {}
};

struct SplitOrder {
    int pm0, nN, ns, np, c;
    __host__ __device__ void init(int pm0_, int nP, int nN_, int ns_, int c_) { pm0 = pm0_; nN = nN_; ns = ns_; np = nP * nN_ * ns_; c = c_; }
    __host__ __device__ bool next(int i, Unit& u) const { if (i > 0 || c >= np) return false; const int t = c / ns; u.pm = pm0 + t / nN; u.pn = t % nN; u.kq = c % ns; return true; }
    __device__ __forceinline__ void a_ready(const Unit&) const {}
    __device__ __forceinline__ void done(const Unit&) const {}
};

__device__ __forceinline__ unsigned cvt_pk_bf16(float lo, float hi) { unsigned r; asm volatile("v_cvt_pk_bf16_f32 %0, %1, %2" : "=v"(r) : "v"(lo), "v"(hi)); return r; }
typedef float f32x2 __attribute__((ext_vector_type(2)));
__device__ __forceinline__ f32x2 gelu_pk(f32x2 v) {
    const f32x2 av = __builtin_elementwise_abs(v), d = av * 0.2316418882f + 1.0f;
    f32x2 t; t.x = __builtin_amdgcn_rcpf(d.x); t.y = __builtin_amdgcn_rcpf(d.y);
    f32x2 q = t * 0.5307027145f + (-0.7265760135f); q = q * t + 0.7107068705f; q = q * t + (-0.142248368f); q = q * t + 0.127414796f; q = q * t;
    const f32x2 s = (v * v) * (-0.72134752044f);
    f32x2 e; e.x = __builtin_amdgcn_exp2f(s.x); e.y = __builtin_amdgcn_exp2f(s.y);
    const f32x2 m = v * (q * e), r = v - m;
    f32x2 o; o.x = v.x < 0.f ? m.x : r.x; o.y = v.y < 0.f ? m.y : r.y; return o;
}

template <int ACT  > struct EpiBf16 {
    static constexpr bool PERM = true, AFTER_DRAIN = false; static_assert(ACT == 0 || ACT == 1, "EpiBf16: ACT is 0 (none) or 1 (gelu_pk)");
    bf16_t* O; int ldc; const float* bias; int split_cols; size_t split_stride; float scale0;
    __device__ __forceinline__ void operator()(const f32x4 (&acc)[2][2][4][2], const Unit& u, int wr, int wc, int fr, int fq) const {
        const int row0 = u.pm * BM + wr * 64 + fr; int colt = u.pn * BM; bf16_t* base = O;
        float sc = 1.f; if (split_cols) { const int t = colt / split_cols; base += (size_t)t * split_stride; colt -= t * split_cols; if (t == 0) sc = scale0; }
        const int col0 = colt + wc * 32 + 8 * fq, bcol0 = u.pn * BM + wc * 32 + 8 * fq;
        f32x4 bv[2][2];
#pragma unroll
        for (int bj = 0; bj < 2; ++bj)
#pragma unroll
            for (int n = 0; n < 2; ++n) bv[bj][n] = bias ? *(const f32x4*)(bias + bcol0 + bj * HALF + 4 * n) : (f32x4){0.f, 0.f, 0.f, 0.f};
#pragma unroll
        for (int ai = 0; ai < 2; ++ai)
#pragma unroll
            for (int m = 0; m < 4; ++m) { bf16_t* rowp = base + (size_t)(row0 + ai * HALF + m * 16) * ldc + col0;
#pragma unroll
                for (int bj = 0; bj < 2; ++bj) { f32x4 v0 = acc[ai][bj][m][0] + bv[bj][0], v1 = acc[ai][bj][m][1] + bv[bj][1];
                    if (ACT == 1) { f32x2 a = gelu_pk((f32x2){v0[0], v0[1]}), b = gelu_pk((f32x2){v0[2], v0[3]}), c = gelu_pk((f32x2){v1[0], v1[1]}), d = gelu_pk((f32x2){v1[2], v1[3]});
                        v0 = (f32x4){a.x, a.y, b.x, b.y}; v1 = (f32x4){c.x, c.y, d.x, d.y}; }
                    v0 = v0 * sc; v1 = v1 * sc; u32x4 w; w.x = cvt_pk_bf16(v0[0], v0[1]); w.y = cvt_pk_bf16(v0[2], v0[3]); w.z = cvt_pk_bf16(v1[0], v1[1]); w.w = cvt_pk_bf16(v1[2], v1[3]);
                    *(u32x4*)(rowp + bj * HALF) = w; } }
    }
};

struct EpiF32 {
    static constexpr bool PERM = false, AFTER_DRAIN = false;
    float* O; int ldc; size_t kq_stride;
    __device__ __forceinline__ void operator()(const f32x4 (&acc)[2][2][4][2], const Unit& u, int wr, int wc, int fr, int fq) const {
        const int row0 = u.pm * BM + wr * 64 + fr, col0 = u.pn * BM + wc * 32 + 4 * fq;
#pragma unroll
        for (int ai = 0; ai < 2; ++ai)
#pragma unroll
            for (int m = 0; m < 4; ++m) { float* rowp = O + (size_t)u.kq * kq_stride + (size_t)(row0 + ai * HALF + m * 16) * ldc + col0;
#pragma unroll
                for (int bj = 0; bj < 2; ++bj)
#pragma unroll
                    for (int n = 0; n < 2; ++n) *(f32x4*)(rowp + bj * HALF + n * 16) = acc[ai][bj][m][n]; }
    }
};

template <class Epi, class Sched, bool ALIGN_EPI = false, bool SP2 = false>
__device__ __forceinline__ void gemm_phase(PG8_LAS unsigned char* lds, const Gemm g, const Sched& S, const Epi& E) {
    const int tid = threadIdx.x, wid = __builtin_amdgcn_readfirstlane(tid >> 6), lane = tid & 63, wr = wid >> 2, wc = wid & 3, fr = lane & 15, fq = lane >> 4;
    const int K = g.K, ld = g.ld, nt = K / BK;
    unsigned voffA[2], voffB[2];
#pragma unroll
    for (int i = 0; i < 2; ++i) { int R, C; stage_rc(tid * 16 + i * 8192, R, C); const int Rb = Epi::PERM ? ((R & ~31) + perm32(R & 31)) : R;
        voffA[i] = (unsigned)(R * ld + C) * 2u; voffB[i] = (unsigned)(Rb * ld + C) * 2u; }
    const size_t kstep = (size_t)(BK * 2);
    const size_t hstep = (size_t)HALF * ld * 2;
    const size_t tstep = 2 * hstep;
    const unsigned ldsw = (unsigned)wid * 1024u;
    const int aoff = lds_byte(wr * 64 + fr, fq * 8), boff = lds_byte(wc * 32 + fr, fq * 8);
#define PG8_SA(b, h) (((b) * 2 + (h)) * HTB)
#define PG8_SB(b, h) ((4 + (b) * 2 + (h)) * HTB)
#define PG8_STAGE(bufoff, gbase, voff) do { _Pragma("unroll") for (int _i = 0; _i < 2; ++_i) \
        __builtin_amdgcn_global_load_lds((const unsigned*)((const char*)(gbase) + (voff)[_i]), (PG8_LAS unsigned*)(lds + (bufoff) + ldsw + _i * 8192), 16, 0, 0); } while (0)
#define PG8_LDA(dst, b, h) do { _Pragma("unroll") for (int m = 0; m < 4; ++m) _Pragma("unroll") for (int k = 0; k < 2; ++k) dst[m][k] = *(const PG8_LAS bf16x8*)(lds + PG8_SA(b, h) + aoff + m * 2048 + k * 1024); } while (0)
#define PG8_LDB(dst, b, h) do { _Pragma("unroll") for (int n = 0; n < 2; ++n) _Pragma("unroll") for (int k = 0; k < 2; ++k) dst[n][k] = *(const PG8_LAS bf16x8*)(lds + PG8_SB(b, h) + boff + n * 2048 + k * 1024); } while (0)
#define PG8_MMA(ai, bj, At, Bt) do { __builtin_amdgcn_s_setprio(1); _Pragma("unroll") for (int m = 0; m < 4; ++m) _Pragma("unroll") for (int n = 0; n < 2; ++n) _Pragma("unroll") for (int k = 0; k < 2; ++k) \
        acc[ai][bj][m][n] = __builtin_amdgcn_mfma_f32_16x16x32_bf16(Bt[n][k], At[m][k], acc[ai][bj][m][n], 0, 0, 0); __builtin_amdgcn_s_setprio(0); } while (0)
#define PG8_WAIT_V(n) asm volatile("s_waitcnt vmcnt(" #n ")" ::: "memory")
#define PG8_WAIT_L(n) asm volatile("s_waitcnt lgkmcnt(" #n ")" ::: "memory")
#define PG8_BAR __builtin_amdgcn_s_barrier()
#define PG8_SCHED __builtin_amdgcn_sched_barrier(0)
    Unit cur, nxt; int ui = 0;
    if (!S.next(0, cur)) return;
    f32x4 acc[2][2][4][2];
#pragma unroll
    for (int a = 0; a < 2; ++a)
#pragma unroll
        for (int b = 0; b < 2; ++b)
#pragma unroll
            for (int m = 0; m < 4; ++m)
#pragma unroll
                for (int n = 0; n < 2; ++n) acc[a][b][m][n] = (f32x4){0.f, 0.f, 0.f, 0.f};
    bf16x8 At[4][2], B0[2][2], B1[2][2];
    const size_t kqb = (size_t)K * 2;
    const char* cA = (const char*)g.A + (size_t)cur.pm * tstep + cur.kq * kqb; const char* cB = (const char*)g.Bt + (size_t)cur.pn * tstep + cur.kq * kqb;
    S.a_ready(cur);
    if constexpr (SP2) {
        PG8_STAGE(PG8_SB(0, 0), cB, voffB); PG8_STAGE(PG8_SB(0, 1), cB + hstep, voffB); PG8_STAGE(PG8_SA(0, 0), cA, voffA); PG8_STAGE(PG8_SA(0, 1), cA + hstep, voffA);
        if (wr == 1) PG8_BAR;
        PG8_WAIT_V(2); PG8_BAR;
        PG8_STAGE(PG8_SB(1, 0), cB + kstep, voffB); PG8_STAGE(PG8_SA(1, 0), cA + kstep, voffA); PG8_STAGE(PG8_SB(1, 1), cB + hstep + kstep, voffB);
        PG8_WAIT_V(6); PG8_BAR;
    } else {
        PG8_STAGE(PG8_SB(0, 0), cB, voffB); PG8_STAGE(PG8_SA(0, 0), cA, voffA); PG8_STAGE(PG8_SB(0, 1), cB + hstep, voffB); PG8_STAGE(PG8_SA(0, 1), cA + hstep, voffA);
        if (wr == 1) PG8_BAR;
        PG8_WAIT_V(4); PG8_BAR;
        PG8_STAGE(PG8_SB(1, 0), cB + kstep, voffB); PG8_STAGE(PG8_SA(1, 0), cA + kstep, voffA); PG8_STAGE(PG8_SB(1, 1), cB + hstep + kstep, voffB);
        PG8_WAIT_V(6); PG8_BAR;
    }
    for (;;) {
        const bool has_next = S.next(ui + 1, nxt);
        const char* nA = has_next ? (const char*)g.A + (size_t)nxt.pm * tstep + nxt.kq * kqb : cA; const char* nB = has_next ? (const char*)g.Bt + (size_t)nxt.pn * tstep + nxt.kq * kqb : cB;
        for (int t = 0; t < nt; t += 2) {
            const bool last = (t == nt - 2);
            const char* a1 = cA + (size_t)(t + 1) * kstep;
            const char* a2 = last ? nA : cA + (size_t)(t + 2) * kstep; const char* b2 = last ? nB : cB + (size_t)(t + 2) * kstep;
            const char* a3 = a2 + kstep; const char* b3 = b2 + kstep;
            if (last && has_next) S.a_ready(nxt);
            if constexpr (SP2) {
            PG8_LDB(B0, 0, 0); PG8_LDB(B1, 0, 1); PG8_SCHED; PG8_LDA(At, 0, 0); PG8_STAGE(PG8_SA(1, 1), a1 + hstep, voffA);
            PG8_WAIT_V(8); PG8_WAIT_L(0); PG8_BAR; PG8_MMA(0, 0, At, B0); PG8_MMA(0, 1, At, B1); PG8_BAR; PG8_SCHED;
            PG8_LDA(At, 0, 1); PG8_STAGE(PG8_SB(0, 0), b2, voffB); PG8_STAGE(PG8_SB(0, 1), b2 + hstep, voffB); PG8_STAGE(PG8_SA(0, 0), a2, voffA);
            PG8_WAIT_V(8); PG8_WAIT_L(0); PG8_BAR; PG8_MMA(1, 0, At, B0); PG8_MMA(1, 1, At, B1); PG8_BAR; PG8_SCHED;
            PG8_LDB(B0, 1, 0); PG8_LDB(B1, 1, 1); PG8_SCHED; PG8_LDA(At, 1, 0); PG8_STAGE(PG8_SA(0, 1), a2 + hstep, voffA);
            PG8_WAIT_V(8); PG8_WAIT_L(0); PG8_BAR; PG8_MMA(0, 0, At, B0); PG8_MMA(0, 1, At, B1); PG8_BAR; PG8_SCHED;
            PG8_LDA(At, 1, 1); PG8_STAGE(PG8_SB(1, 0), b3, voffB); PG8_STAGE(PG8_SB(1, 1), b3 + hstep, voffB); PG8_STAGE(PG8_SA(1, 0), a3, voffA);
            PG8_WAIT_V(8); PG8_WAIT_L(0); PG8_BAR; PG8_MMA(1, 0, At, B0); PG8_MMA(1, 1, At, B1); PG8_BAR; PG8_SCHED;
            } else {
            PG8_LDB(B0, 0, 0); PG8_SCHED; PG8_LDA(At, 0, 0); PG8_STAGE(PG8_SA(1, 1), a1 + hstep, voffA);
            PG8_WAIT_L(8); PG8_BAR; PG8_WAIT_L(0); PG8_MMA(0, 0, At, B0); PG8_BAR; PG8_SCHED;
            PG8_LDB(B1, 0, 1); PG8_STAGE(PG8_SB(0, 0), b2, voffB);
            PG8_BAR; PG8_WAIT_L(0); PG8_MMA(0, 1, At, B1); PG8_BAR;
            PG8_LDA(At, 0, 1); PG8_STAGE(PG8_SA(0, 0), a2, voffA);
            PG8_BAR; PG8_WAIT_L(0); PG8_MMA(1, 0, At, B0); PG8_BAR; PG8_SCHED;
            PG8_STAGE(PG8_SB(0, 1), b2 + hstep, voffB);
            PG8_WAIT_V(6); PG8_BAR; PG8_MMA(1, 1, At, B1); PG8_BAR;
            PG8_LDB(B0, 1, 0); PG8_SCHED; PG8_LDA(At, 1, 0); PG8_STAGE(PG8_SA(0, 1), a2 + hstep, voffA);
            PG8_WAIT_L(8); PG8_BAR; PG8_WAIT_L(0); PG8_MMA(0, 0, At, B0); PG8_BAR; PG8_SCHED;
            PG8_LDB(B1, 1, 1); PG8_STAGE(PG8_SB(1, 0), b3, voffB);
            PG8_BAR; PG8_WAIT_L(0); PG8_MMA(0, 1, At, B1); PG8_BAR;
            PG8_LDA(At, 1, 1); PG8_STAGE(PG8_SA(1, 0), a3, voffA);
            PG8_BAR; PG8_WAIT_L(0); PG8_MMA(1, 0, At, B0); PG8_BAR; PG8_SCHED;
            PG8_STAGE(PG8_SB(1, 1), b3 + hstep, voffB);
            PG8_WAIT_V(6); PG8_BAR; PG8_MMA(1, 1, At, B1); PG8_BAR;
            }
        }
        if constexpr (ALIGN_EPI) { if (wr == 0) PG8_BAR; }
        if constexpr (!Epi::AFTER_DRAIN) { E(acc, cur, wr, wc, fr, fq); S.done(cur); }
        if (!has_next) break;
#pragma unroll
        for (int a = 0; a < 2; ++a)
#pragma unroll
            for (int b = 0; b < 2; ++b)
#pragma unroll
                for (int m = 0; m < 4; ++m)
#pragma unroll
                    for (int n = 0; n < 2; ++n) acc[a][b][m][n] = (f32x4){0.f, 0.f, 0.f, 0.f};
        cur = nxt; cA = nA; cB = nB; ++ui;
        if constexpr (ALIGN_EPI) { if (wr == 1) PG8_BAR; }
    }
    PG8_WAIT_V(0);
    if constexpr (!ALIGN_EPI) { if (wr == 0) PG8_BAR; }
    PG8_BAR;
    if constexpr (Epi::AFTER_DRAIN) { E.fused(acc, cur, wr, wc, fr, fq, lds, wid, lane); S.done(cur); }
#undef PG8_SA
#undef PG8_SB
#undef PG8_STAGE
#undef PG8_LDA
#undef PG8_LDB
#undef PG8_MMA
#undef PG8_WAIT_V
#undef PG8_WAIT_L
#undef PG8_BAR
#undef PG8_SCHED
}
}

constexpr int NWAVES = 8;
constexpr int D = 1024, SEQ = 4096, MP = 16384, MS = 1024, M = MP + MS;
constexpr int NIN = 3584, INC = 3592, FF = 2816;
constexpr int PC_Z = 1536, PC_QB = 2048, PC_KB = 2560, PC_VB = 3072;
constexpr float EPS = 1e-6f;
constexpr size_t O_YP = 0, O_YS = 16777216, O_BKP = 17825792, O_BVP = 18874368, O_DP = 19922944, O_QCP = 20185088, O_FCP = 20203520,
                 O_BKS = 20226048, O_BVS = 20750336, O_DS = 21274624, O_QCS = 23371776, O_FCS = 23519232;
constexpr size_t MiB = 1u << 20;
constexpr size_t WS_CTL = 0, CTL_ZERO_BYTES = 1 * MiB;
constexpr size_t WS_WIN = 1 * MiB, WS_WOUT = 8 * MiB, WS_WGU = 10 * MiB, WS_WDN = 21 * MiB;
constexpr size_t WS_AB = 27 * MiB, WS_DL = 27 * MiB + 768 * 1024;
constexpr size_t WS_U = 28 * MiB;
constexpr size_t WS_GQK = WS_U, WS_GS = WS_U + 8 * MiB;
constexpr size_t WS_P = 62 * MiB;
constexpr size_t WS_MIXIN = 181 * MiB;
constexpr size_t WS_G = WS_P, WS_UP = WS_P + (size_t)M * FF * 2;
constexpr size_t WS_END = 256 * MiB;
static_assert(WS_UP + (size_t)M * FF * 2 <= WS_END, "ws map");
constexpr int CW_BAR = 4096;

constexpr int LDS_BYTES = 163840;
constexpr int MISC_OFF = LDS_BYTES - 256;

#define GAS __attribute__((address_space(1)))
#define LAS __attribute__((address_space(3)))
typedef unsigned short bf16;
typedef unsigned v4u __attribute__((ext_vector_type(4)));
typedef unsigned v2u __attribute__((ext_vector_type(2)));
typedef float f32x2 __attribute__((ext_vector_type(2)));
typedef float f32x4 __attribute__((ext_vector_type(4)));
typedef float f32x16 __attribute__((ext_vector_type(16)));
typedef short bf16x8 __attribute__((ext_vector_type(8)));
typedef short s16x4 __attribute__((ext_vector_type(4)));
typedef __bf16 bf16x2_t __attribute__((ext_vector_type(2)));
typedef GAS unsigned gu32;
#define RLX_AGENT __ATOMIC_RELAXED, __HIP_MEMORY_SCOPE_AGENT
#define LDS_WAIT() asm volatile("s_waitcnt lgkmcnt(0)" ::: "memory")
#define VM_WAIT() asm volatile("s_waitcnt vmcnt(0)" ::: "memory")
__device__ __forceinline__ unsigned pk2(float lo, float hi) { f32x2 v = {lo, hi}; bf16x2_t b = __builtin_convertvector(v, bf16x2_t); return __builtin_bit_cast(unsigned, b); }
__device__ __forceinline__ float bflo(unsigned w) { return __uint_as_float(w << 16); }
__device__ __forceinline__ float bfhi(unsigned w) { return __uint_as_float(w & 0xffff0000u); }
__device__ __forceinline__ float bf1(bf16 b) { return __uint_as_float((unsigned)b << 16); }
__device__ __forceinline__ bf16 f2bf(float f) { return (bf16)(pk2(f, 0.f) & 0xffffu); }
__device__ __forceinline__ float wave_sum(float v) {
#pragma unroll
    for (int o = 1; o < 64; o <<= 1) v += __shfl_xor(v, o);
    return v;
}
__device__ __forceinline__ float sigmoidf_(float x) { return __builtin_amdgcn_rcpf(1.0f + __builtin_amdgcn_exp2f(-1.4426950408889634f * x)); }
__device__ __forceinline__ float rsq_(float x) { return __builtin_amdgcn_rsqf(x); }
__device__ __forceinline__ int crow(int r, int hi) { return (r & 3) + 8 * (r >> 2) + 4 * hi; }
#define MFMA32(a, b, c) __builtin_amdgcn_mfma_f32_32x32x16_bf16((a), (b), (c), 0, 0, 0)
#define MFMA16(a, b, c) __builtin_amdgcn_mfma_f32_16x16x32_bf16((a), (b), (c), 0, 0, 0)
#define XB_TMO      128
#define XB_XCNT(j)  (256  + 64 * (j))
#define XB_XSUB(j)  (1280 + 64 * (j))
#define XB_XGEN(j)  (2304 + 64 * (j))
#define XB_TOP      3328
#define XB_TOPGEN   3392
#define XCD_BAR_WORDS 3456
#define XB_SPIN_CAP (1u << 18)

__device__ __forceinline__ unsigned xb_ld(unsigned* p)              { return __hip_atomic_load(p, __ATOMIC_RELAXED, __HIP_MEMORY_SCOPE_AGENT); }
__device__ __forceinline__ unsigned xb_add(unsigned* p, unsigned v) { return __hip_atomic_fetch_add(p, v, __ATOMIC_RELAXED, __HIP_MEMORY_SCOPE_AGENT); }
__device__ __forceinline__ unsigned xb_xcc_id() { return (unsigned)__builtin_amdgcn_s_getreg((3 << 11) | 20) & 0xFu; }
#define XB_SPIN(cond, bar) do { unsigned _sp = 0; while (cond) { __builtin_amdgcn_s_sleep(1); \
    if ((++_sp & 255u) == 0u) { if (xb_ld(&(bar)[XB_TMO])) break; if (_sp > XB_SPIN_CAP) { atomicAdd(&(bar)[XB_TMO], 1u); break; } } } } while (0)

struct XcdBarrier {
    unsigned* bar; unsigned x;
    volatile LAS unsigned* st;
};

__device__ __forceinline__ XcdBarrier xcd_barrier_post(unsigned* bar, volatile LAS unsigned* st) {
    XcdBarrier b; b.bar = bar; b.x = xb_xcc_id(); b.st = st;
    if (threadIdx.x == 0) (void)xb_add(&bar[XB_XCNT(b.x)], 1u);
    return b;
}
__device__ __forceinline__ void xcd_barrier_complete(unsigned* bar, unsigned x, unsigned& nloc, unsigned& nx) {
    const unsigned G = gridDim.x * gridDim.y * gridDim.z;
    unsigned sum, cnt, mine, sp = 0u;
    for (;;) {
        sum = 0u; cnt = 0u; mine = 0u;
#pragma unroll
        for (unsigned j = 0; j < 16; ++j) { const unsigned c = xb_ld(&bar[XB_XCNT(j)]); sum += c; cnt += (c > 0u) ? 1u : 0u; mine = (j == x) ? c : mine; }
        if (sum == G) break;
        __builtin_amdgcn_s_sleep(1);
        if ((++sp & 255u) == 0u) { if (xb_ld(&bar[XB_TMO])) break; if (sp > XB_SPIN_CAP) { atomicAdd(&bar[XB_TMO], 1u); break; } }
    }
    nloc = mine > 0u ? mine : 1u; nx = cnt > 0u ? cnt : 1u;
}

__device__ __forceinline__ void xcd_barrier(const XcdBarrier& b) {
    asm volatile("s_waitcnt vmcnt(0)" ::: "memory");
    __syncthreads();
    if (threadIdx.x == 0) {
        unsigned* bar = b.bar;
        __builtin_amdgcn_s_waitcnt(0);
        unsigned nloc = b.st[0], nx = b.st[1];
        if (nloc == 0u) { xcd_barrier_complete(bar, b.x, nloc, nx); b.st[0] = nloc; b.st[1] = nx; }
        const unsigned old = xb_add(&bar[XB_XSUB(b.x)], 1u);
        const unsigned gen = old / nloc;
        if (old + 1u == (gen + 1u) * nloc) {
            __builtin_amdgcn_fence(__ATOMIC_RELEASE, "agent");
            asm volatile("s_waitcnt vmcnt(0)" ::: "memory");
            const unsigned og = xb_add(&bar[XB_TOP], 1u);
            const unsigned tg = og / nx;
            if (og + 1u == (tg + 1u) * nx) xb_add(&bar[XB_TOPGEN], 1u);
            else XB_SPIN(xb_ld(&bar[XB_TOPGEN]) == tg, bar);
            __builtin_amdgcn_fence(__ATOMIC_ACQUIRE, "agent");
            xb_add(&bar[XB_XGEN(b.x)], 1u);
            asm volatile("s_waitcnt vmcnt(0)" ::: "memory");
        } else {
            XB_SPIN(xb_ld(&bar[XB_XGEN(b.x)]) == gen, bar);
            __builtin_amdgcn_fence(__ATOMIC_ACQUIRE, "agent");
            asm volatile("s_waitcnt vmcnt(0)" ::: "memory");
        }
    }
    __syncthreads();
}

__device__ __forceinline__ void p0_transpose_item(const float* W, int ldw, int K, int N, bf16* WT, int row_off, LAS float* scr, int item, int lane) {
    const int nblk = N / 32, kb = item / nblk, nb = item % nblk, k0 = 64 * kb, n0 = 32 * nb;
#pragma unroll 8
    for (int i = 0; i < 32; ++i) { const int kk = 2 * i + (lane >> 5); scr[kk * 33 + (lane & 31)] = W[(size_t)(k0 + kk) * ldw + n0 + (lane & 31)]; }
    LDS_WAIT(); asm volatile("" ::: "memory");
    const int c = lane & 7;
#pragma unroll
    for (int j = 0; j < 4; ++j) { const int n = (lane >> 3) + 8 * j; const LAS float* s = scr + (8 * c) * 33 + n;
        v4u o; o.x = pk2(s[0 * 33], s[1 * 33]); o.y = pk2(s[2 * 33], s[3 * 33]); o.z = pk2(s[4 * 33], s[5 * 33]); o.w = pk2(s[6 * 33], s[7 * 33]);
        *(v4u*)(WT + (size_t)(row_off + n0 + n) * K + k0 + 8 * c) = o; }
    LDS_WAIT(); asm volatile("" ::: "memory");
}

__device__ __forceinline__ void phase_prologue(LAS unsigned char* lds, const float* xp, const float* xs, const float* nw, const float* w_in, const float* w_out, const float* w_gu, const float* w_dn,
                                               unsigned char* ws, int vcu, int G, int tid, int lane, int wave) {
    LAS float* scr = (LAS float*)(lds + wave * 8448);
    LAS float* W8T = (LAS float*)(lds + 67584);
    for (int k = tid; k < 1024; k += 512) {
        const f32x4 a = *(const f32x4*)(w_in + (size_t)k * INC + 2048), b = *(const f32x4*)(w_in + (size_t)k * INC + 2052);
        W8T[0 * 1024 + k] = a.x; W8T[1 * 1024 + k] = a.y; W8T[2 * 1024 + k] = a.z; W8T[3 * 1024 + k] = a.w;
        W8T[4 * 1024 + k] = b.x; W8T[5 * 1024 + k] = b.y; W8T[6 * 1024 + k] = b.z; W8T[7 * 1024 + k] = b.w;
    }
    __syncthreads();
    const int gw = vcu * NWAVES + wave, NGW = G * NWAVES;
    bf16* Win_t = (bf16*)(ws + WS_WIN); bf16* Wout_t = (bf16*)(ws + WS_WOUT); bf16* Wgu_t = (bf16*)(ws + WS_WGU); bf16* Wdn_t = (bf16*)(ws + WS_WDN);
    constexpr int I_A = 16 * 64, I_B = 16 * 48, I_O = 16 * 32, I_GU = 16 * 176, I_DN = 44 * 32;
    constexpr int NITEMS = I_A + I_B + I_O + I_GU + I_DN;
    for (int it = gw; it < NITEMS; it += NGW) {
        int r = it;
        if (r < I_A) { p0_transpose_item(w_in, INC, D, 2048, Win_t, 0, scr, r, lane); continue; } r -= I_A;
        if (r < I_B) { p0_transpose_item(w_in + 2056, INC, D, 1536, Win_t, 2048, scr, r, lane); continue; } r -= I_B;
        if (r < I_O) { p0_transpose_item(w_out, D, D, D, Wout_t, 0, scr, r, lane); continue; } r -= I_O;
        if (r < I_GU) { p0_transpose_item(w_gu, 2 * FF, D, 2 * FF, Wgu_t, 0, scr, r, lane); continue; } r -= I_GU;
        p0_transpose_item(w_dn, D, FF, D, Wdn_t, 0, scr, r, lane);
    }
    bf16* U = (bf16*)(ws + WS_U); float* AB = (float*)(ws + WS_AB);
    for (int m = gw; m < M; m += NGW) {
        const float* xrow = m < MP ? xp + (size_t)m * D : xs + (size_t)(m - MP) * D;
        f32x4 v[4]; float s = 0.f;
#pragma unroll
        for (int j = 0; j < 4; ++j) { v[j] = ((const f32x4*)xrow)[lane + 64 * j]; s += (v[j].x * v[j].x + v[j].y * v[j].y) + (v[j].z * v[j].z + v[j].w * v[j].w); }
        const float rstd = rsq_(wave_sum(s) * (1.f / D) + EPS);
        unsigned long long* o8 = (unsigned long long*)(U + (size_t)m * D) + lane;
#pragma unroll
        for (int j = 0; j < 4; ++j) { const f32x4 g = ((const f32x4*)nw)[lane + 64 * j]; v[j] = v[j] * rstd * g;
            o8[64 * j] = (unsigned long long)pk2(v[j].x, v[j].y) | ((unsigned long long)pk2(v[j].z, v[j].w) << 32); }
        float dv = 0.f;
#pragma unroll
        for (int jj = 0; jj < 8; ++jj) { float acc = 0.f;
#pragma unroll
            for (int j = 0; j < 4; ++j) { const f32x4 w = *(const LAS f32x4*)(W8T + jj * 1024 + 4 * lane + 256 * j); acc += (v[j].x * w.x + v[j].y * w.y) + (v[j].z * w.z + v[j].w * w.w); }
            acc = wave_sum(acc); if (lane == jj) dv = acc; }
        if (lane < 8) AB[(size_t)m * 8 + lane] = dv;
    }
}

__device__ __forceinline__ void phase_copy_outputs(const bf16* P, float* out, int gtid, int nth) {
    for (int e = gtid; e < 4 * 512 * 512; e += nth) { const int b = e >> 18, j = (e >> 9) & 511, c = e & 511; const size_t row = (size_t)(b * SEQ + 3584 + j) * NIN;
        out[O_BKP + e] = bf1(P[row + PC_KB + c]); out[O_BVP + e] = bf1(P[row + PC_VB + c]); }
    for (int e = gtid; e < 32 * 32 * 512; e += nth) { const int r = e >> 9, c = e & 511; const size_t row = (size_t)(MP + r) * NIN;
        out[O_BKS + e] = bf1(P[row + PC_KB + c]); out[O_BVS + e] = bf1(P[row + PC_VB + c]); }
    for (int e = gtid; e < 4 * 3 * 1536; e += nth) { const int b = e / 4608, i = (e / 1536) % 3, c = e % 1536; out[O_QCP + e] = bf1(P[(size_t)(b * SEQ + 4093 + i) * NIN + c]); }
    for (int e = gtid; e < 32 * 3 * 1536; e += nth) { const int b = e / 4608, i = (e / 1536) % 3, c = e % 1536; out[O_QCS + e] = bf1(P[(size_t)(MP + b * 32 + 29 + i) * NIN + c]); }
}

__device__ __forceinline__ bf16x8 pack8(const f32x4& a, const f32x4& b) { const v4u t = {pk2(a[0], a[1]), pk2(a[2], a[3]), pk2(b[0], b[1]), pk2(b[2], b[3])}; return __builtin_bit_cast(bf16x8, t); }
__device__ __forceinline__ int kperm(int k) { const int kk = k & 31; return (k & ~31) | (8 * ((kk & 15) >> 2) + (kk & 3) + 4 * (kk >> 4)); }
__device__ __forceinline__ void gdn_pre_unit(LAS unsigned char* lds, int u, const bf16* P, const float* AB, const float* st_qkv, const float* conv_w, const float* a_log, const float* dt_bias,
                                             bf16* gmain, bf16* gqk, bf16* gs, float* DL, int tid, int lane, int wave) {
    LAS float* RHS = (LAS float*)(lds + 0);
    LAS bf16* QB = (LAS bf16*)(lds + 65536);
    LAS bf16* KB = (LAS bf16*)(lds + 82944);
    LAS bf16* RAW = (LAS bf16*)(lds + 100352);
    LAS bf16* KGT = (LAS bf16*)(lds + 117760);
    LAS bf16* AMN = (LAS bf16*)(lds + 117760);
    LAS float* TD = (LAS float*)(lds + 117760 + 10240);
    LAS bf16* TB = (LAS bf16*)(lds + 117760 + 14336);
    LAS float* SMG = (LAS float*)(lds + 136192);
    const bool prompt = u < 1024;
    int b, h, n, m0, valid; bf16 *o_w, *o_qg, *o_kgt, *o_ut, *o_qk;
    if (prompt) { b = u >> 8; h = (u >> 6) & 3; n = u & 63; m0 = b * SEQ + n * 64; valid = 64; bf16* base = gmain + (size_t)u * 32768; o_w = base; o_qg = base + 8192; o_kgt = base + 16384; o_ut = base + 24576; o_qk = gqk + (size_t)u * 4096; }
    else { const int su = u - 1024; b = su >> 2; h = su & 3; n = 0; m0 = MP + b * 32; valid = 32; bf16* base = gs + (size_t)su * 36864; o_w = base; o_qg = base + 8192; o_kgt = base + 16384; o_ut = base + 24576; o_qk = base + 32768; }
    if (wave == 0) {
        const int i = lane; const bool v = i < valid;
        const float araw = v ? AB[(size_t)(m0 + i) * 8 + 4 + h] : 0.f, braw = v ? AB[(size_t)(m0 + i) * 8 + h] : 0.f;
        const float A = expf(a_log[h]); const float x = araw + dt_bias[h];
        const float sp = x > 20.f ? x : log1pf(expf(x));
        const float g = v ? -A * sp : 0.f; const float beta = v ? 1.f / (1.f + expf(-braw)) : 0.f;
        float Gc = g;
#pragma unroll
        for (int off = 1; off < 64; off <<= 1) { const float t = __shfl_up(Gc, off); if (lane >= off) Gc += t; }
        const float Gl = __shfl(Gc, 63);
        SMG[i] = Gc; SMG[64 + i] = beta; SMG[128 + i] = expf(Gc); SMG[192 + i] = expf(Gl - Gc);
        if (lane == 0) DL[u] = expf(Gl);
    }
    __syncthreads();
#pragma unroll 1
    for (int part = 0; part < 3; ++part) {
        const int pcol = (part == 0 ? 512 : part == 1 ? 0 : 1024) + h * 128;
#pragma unroll
        for (int pass = 0; pass < 3; ++pass) {
            const int rr = (tid >> 4) + 32 * pass, ch = tid & 15;
            if (rr < 67) {
                v4u val = {0u, 0u, 0u, 0u};
                if (prompt) { const int ts = n * 64 - 3 + rr; if (ts >= 0) val = *(const v4u*)(P + (size_t)(b * SEQ + ts) * NIN + pcol + ch * 8); }
                else { if (rr < 3) { const float* s = st_qkv + ((size_t)b * 3 + rr) * 1536 + pcol + ch * 8; const f32x4 a = *(const f32x4*)s, c = *(const f32x4*)(s + 4); val = (v4u){pk2(a.x, a.y), pk2(a.z, a.w), pk2(c.x, c.y), pk2(c.z, c.w)}; }
                       else if (rr - 3 < 32) val = *(const v4u*)(P + (size_t)(MP + b * 32 + rr - 3) * NIN + pcol + ch * 8); }
                *(LAS v4u*)(RAW + rr * 128 + ch * 8) = val;
            }
        }
        __syncthreads();
        float w0[4], w1[4];
#pragma unroll
        for (int i = 0; i < 4; ++i) { const f32x2 t = *(const f32x2*)(conv_w + i * 1536 + pcol + 2 * lane); w0[i] = t.x; w1[i] = t.y; }
#pragma unroll 2
        for (int rq = 0; rq < 8; ++rq) {
            const int r = wave * 8 + rq;
            float y0 = 0.f, y1 = 0.f;
#pragma unroll
            for (int i = 0; i < 4; ++i) { const unsigned xw = *(const LAS unsigned*)(RAW + (r + i) * 128 + 2 * lane); y0 += w0[i] * bflo(xw); y1 += w1[i] * bfhi(xw); }
            float s0 = y0 * sigmoidf_(y0), s1 = y1 * sigmoidf_(y1);
            if (r >= valid) { s0 = 0.f; s1 = 0.f; }
            if (part == 2) { const float be = SMG[64 + r]; *(LAS f32x2*)(RHS + r * 256 + 2 * lane) = (f32x2){s0 * be, s1 * be}; }
            else {
                const float rinv = rsq_(wave_sum(s0 * s0 + s1 * s1) + EPS);
                if (part == 0) { const float k0 = s0 * rinv, k1 = s1 * rinv; *(LAS unsigned*)(KB + r * 136 + 2 * lane) = pk2(k0, k1);
                    const float be = SMG[64 + r] * SMG[128 + r]; *(LAS f32x2*)(RHS + r * 256 + 128 + 2 * lane) = (f32x2){k0 * be, k1 * be};
                    const float egl = SMG[192 + r]; KGT[(2 * lane) * 64 + kperm(r)] = f2bf(k0 * egl); KGT[(2 * lane + 1) * 64 + kperm(r)] = f2bf(k1 * egl); }
                else { const float sc = rinv * 0.08838834764831845f; const float q0 = s0 * sc, q1 = s1 * sc; *(LAS unsigned*)(QB + r * 136 + 2 * lane) = pk2(q0, q1);
                    const float eg = SMG[128 + r]; *(unsigned*)(o_qg + r * 128 + kperm(2 * lane)) = pk2(q0 * eg, q1 * eg); }
            }
        }
        __syncthreads();
        if (part == 0) {
#pragma unroll
            for (int k = 0; k < 2; ++k) { const int pi = tid + 512 * k; *(v4u*)(o_kgt + pi * 8) = *(const LAS v4u*)(KGT + pi * 8); }
        }
    }
    {
        const int mat = wave >> 2, ti = (wave >> 1) & 1, tj = wave & 1, r32 = lane & 31, hi = lane >> 5;
        const LAS bf16* Ab = (mat == 0 ? KB : QB) + (32 * ti + r32) * 136 + 8 * hi;
        const LAS bf16* Bb = KB + (32 * tj + r32) * 136 + 8 * hi;
        f32x16 acc;
#pragma unroll
        for (int r = 0; r < 16; ++r) acc[r] = 0.f;
#pragma unroll
        for (int s = 0; s < 8; ++s) acc = MFMA32(*(const LAS bf16x8*)(Ab + 16 * s), *(const LAS bf16x8*)(Bb + 16 * s), acc);
        const int j = 32 * tj + r32; const float Gj = SMG[j];
#pragma unroll
        for (int r = 0; r < 16; ++r) { const int i = 32 * ti + crow(r, hi); const float dec = expf(fminf(SMG[i] - Gj, 0.f));
            if (mat == 0) { const float av = (i > j) ? acc[r] * SMG[64 + i] * dec : 0.f; AMN[i * 80 + kperm(j)] = f2bf(-av); if ((i >> 4) == (j >> 4)) TD[(i >> 4) * 256 + (i & 15) * 16 + (j & 15)] = av; }
            else o_qk[i * 64 + kperm(j)] = f2bf((i >= j) ? acc[r] * dec : 0.f); }
    }
    __syncthreads();
    if (wave == 0) {
        const int bb = lane >> 4, c = lane & 15; float y[16];
        const LAS float* tdp = TD + bb * 256;
#pragma unroll
        for (int i = 0; i < 16; ++i) { float a[16];
#pragma unroll
            for (int j4 = 0; j4 < 4; ++j4) if (4 * j4 < i) { const f32x4 t = *(const LAS f32x4*)(tdp + i * 16 + 4 * j4); a[4 * j4] = t.x; a[4 * j4 + 1] = t.y; a[4 * j4 + 2] = t.z; a[4 * j4 + 3] = t.w; }
            float s0 = (i == c) ? 1.f : 0.f, s1 = 0.f;
#pragma unroll
            for (int j = 0; j < i; ++j) { if (j & 1) s1 = fmaf(-a[j], y[j], s1); else s0 = fmaf(-a[j], y[j], s0); }
            y[i] = s0 + s1;
            const int pc = 8 * (c >> 2) + (c & 3);
            TB[(bb * 16 + i) * 32 + pc] = f2bf(y[i]); TB[(bb * 16 + i) * 32 + pc + 4] = 0; }
    }
    __syncthreads();
    {
        const int cl = lane & 15, q = lane >> 4;
        const f32x4 zero4 = {0.f, 0.f, 0.f, 0.f};
        const LAS unsigned char* amn = (const LAS unsigned char*)AMN + cl * 160 + q * 16;
        const LAS unsigned char* tbp = (const LAS unsigned char*)TB + cl * 64 + q * 16;
#pragma unroll 1
        for (int nt = 0; nt < 2; ++nt) {
            const int col = 32 * wave + 16 * nt + cl;
            f32x4 X[4];
#pragma unroll
            for (int b4 = 0; b4 < 4; ++b4) {
                f32x4 R;
#pragma unroll
                for (int r = 0; r < 4; ++r) R[r] = RHS[(16 * b4 + 4 * q + r) * 256 + col];
                if (b4 == 1) R = MFMA16(*(const LAS bf16x8*)(amn + 16 * 160), pack8(X[0], zero4), R);
                if (b4 == 2) R = MFMA16(*(const LAS bf16x8*)(amn + 32 * 160), pack8(X[0], X[1]), R);
                if (b4 == 3) { R = MFMA16(*(const LAS bf16x8*)(amn + 48 * 160), pack8(X[0], X[1]), R); R = MFMA16(*(const LAS bf16x8*)(amn + 48 * 160 + 64), pack8(X[2], zero4), R); }
                X[b4] = MFMA16(*(const LAS bf16x8*)(tbp + b4 * 16 * 64), pack8(R, zero4), zero4);
            }
            if (wave < 4) {
#pragma unroll
                for (int b4 = 0; b4 < 4; ++b4) *(v2u*)(o_ut + col * 64 + 16 * b4 + 4 * q) = (v2u){pk2(X[b4][0], X[b4][1]), pk2(X[b4][2], X[b4][3])};
            } else { const int pk = kperm(col - 128);
#pragma unroll
                for (int b4 = 0; b4 < 4; ++b4)
#pragma unroll
                    for (int r = 0; r < 4; ++r) o_w[(16 * b4 + 4 * q + r) * 128 + pk] = f2bf(X[b4][r]); }
        }
    }
    __syncthreads();
}

constexpr int SB_W = 0, SB_QG = 18432, SB_KGT = 36864, SB_QK = 57344, SB_UT = 67584, SB_SIZE = 76800;
__device__ __forceinline__ bf16x8 ldfrag(const LAS unsigned char* p) { return *(const LAS bf16x8*)p; }
#define SCAN_BAR() asm volatile("s_waitcnt lgkmcnt(0)\n\ts_barrier" ::: "memory")
__device__ __forceinline__ void scan_half(LAS unsigned char* lds, int half, int nsteps, int nrows, const bf16* gmain, size_t main_stride, const bf16* gqk, size_t qk_stride, const float* DLp,
                                          const float* S0, float* Sout, bf16* MX  , unsigned dumpoff  , gu32* prog, int tid, int lane, int wave) {
    if (wave >= 4) {
        const int lt = tid - 256;
        const unsigned v16 = (unsigned)lt * 16u;
        v4u A[16], B[16];
#define LD_LOAD(R, nn) do { const char* mp_ = (const char*)(gmain + (size_t)(nn) * main_stride); \
            _Pragma("unroll") for (int k = 0; k < 12; ++k) R[k] = *(const v4u*)(mp_ + k * 4096 + v16); \
            _Pragma("unroll") for (int k = 0; k < 2; ++k) R[12 + k] = *(const v4u*)((const char*)(gqk + (size_t)(nn) * qk_stride) + k * 4096 + v16); \
            _Pragma("unroll") for (int k = 0; k < 2; ++k) R[14 + k] = *(const v4u*)(mp_ + 49152 + half * 8192 + k * 4096 + v16); } while (0)
#define LD_WRITE(R, buf) do { LAS unsigned char* bb_ = lds + (buf) * SB_SIZE; \
            _Pragma("unroll") for (int k = 0; k < 12; ++k) { const int a_ = k >> 2, within_ = lt + 256 * (k & 3); \
                const int dst_ = (a_ == 0 ? SB_W + (within_ >> 4) * 288 + (within_ & 15) * 16 : a_ == 1 ? SB_QG + (within_ >> 4) * 288 + (within_ & 15) * 16 : SB_KGT + (within_ >> 3) * 160 + (within_ & 7) * 16); \
                *(LAS v4u*)(bb_ + dst_) = R[k]; } \
            _Pragma("unroll") for (int k = 0; k < 2; ++k) { const int within_ = lt + 256 * k; *(LAS v4u*)(bb_ + SB_QK + (within_ >> 3) * 160 + (within_ & 7) * 16) = R[12 + k]; } \
            _Pragma("unroll") for (int k = 0; k < 2; ++k) { const int within_ = lt + 256 * k; *(LAS v4u*)(bb_ + SB_UT + (within_ >> 3) * 144 + (within_ & 7) * 16) = R[14 + k]; } } while (0)
        LD_LOAD(A, 0);
        if (nsteps > 1) LD_LOAD(B, 1);
        LD_WRITE(A, 0);
        asm volatile("" ::: "memory");
        if (nsteps > 2) LD_LOAD(A, 2);
        SCAN_BAR();
#pragma unroll 1
        for (int n = 0; n < nsteps; n += 2) {
            if (n + 1 < nsteps) { LD_WRITE(B, 1); asm volatile("" ::: "memory"); if (n + 3 < nsteps) LD_LOAD(B, n + 3); SCAN_BAR(); }
            if (n + 2 < nsteps) { LD_WRITE(A, 0); asm volatile("" ::: "memory"); if (n + 4 < nsteps) LD_LOAD(A, n + 4); SCAN_BAR(); }
        }
#undef LD_LOAD
#undef LD_WRITE
    } else {
        const int cl = lane & 15, q = lane >> 4, cw = wave, c0 = 64 * half + 16 * cw;
        f32x4 S[8];
#pragma unroll
        for (int mt = 0; mt < 8; ++mt)
#pragma unroll
            for (int r = 0; r < 4; ++r) S[mt][r] = S0 ? S0[(16 * mt + 4 * q + r) * 128 + c0 + cl] : 0.f;
        const unsigned laneoff = (unsigned)q * (4u * D * 2u) + (unsigned)(c0 + cl) * 2u;
        dumpoff += (unsigned)lane * 2u;
        const int dlbits = (int)__float_as_uint(lane < nsteps ? DLp[lane] : 1.f);
#define SCAN_STEP(n, buf) do { \
        SCAN_BAR();                                            \
        if (prog && tid == 0) __hip_atomic_store(prog, (unsigned)(n) + 1u, RLX_AGENT); \
        const LAS unsigned char* bb_ = lds + (buf) * SB_SIZE; \
        const float dl_ = __uint_as_float(__builtin_amdgcn_readlane(dlbits, (n))); \
        bf16x8 Sb_[4]; \
        _Pragma("unroll") for (int ks = 0; ks < 4; ++ks) Sb_[ks] = pack8(S[2 * ks], S[2 * ks + 1]); \
        f32x4 vn_[4], o_[4]; \
        _Pragma("unroll") for (int mt = 0; mt < 4; ++mt) { \
            f32x4 aw_ = {0.f, 0.f, 0.f, 0.f}, ao_ = {0.f, 0.f, 0.f, 0.f}; \
            const LAS unsigned char* wp_ = bb_ + SB_W + (16 * mt + cl) * 288 + q * 16; const LAS unsigned char* qp_ = bb_ + SB_QG + (16 * mt + cl) * 288 + q * 16; \
            _Pragma("unroll") for (int ks = 0; ks < 4; ++ks) { aw_ = MFMA16(ldfrag(wp_ + ks * 64), Sb_[ks], aw_); ao_ = MFMA16(ldfrag(qp_ + ks * 64), Sb_[ks], ao_); } \
            const v2u uu_ = *(const LAS v2u*)(bb_ + SB_UT + (16 * cw + cl) * 144 + (16 * mt + 4 * q) * 2); \
            vn_[mt] = (f32x4){bflo(uu_.x) - aw_[0], bfhi(uu_.x) - aw_[1], bflo(uu_.y) - aw_[2], bfhi(uu_.y) - aw_[3]}; \
            o_[mt] = ao_; } \
        bf16x8 Vb_[2]; \
        _Pragma("unroll") for (int ks = 0; ks < 2; ++ks) Vb_[ks] = pack8(vn_[2 * ks], vn_[2 * ks + 1]); \
        _Pragma("unroll") for (int mt = 0; mt < 4; ++mt) { const LAS unsigned char* kp_ = bb_ + SB_QK + (16 * mt + cl) * 160 + q * 16; \
            _Pragma("unroll") for (int ks = 0; ks < 2; ++ks) o_[mt] = MFMA16(ldfrag(kp_ + ks * 64), Vb_[ks], o_[mt]); } \
        _Pragma("unroll") for (int mt = 0; mt < 8; ++mt) { S[mt] = S[mt] * dl_; const LAS unsigned char* kp_ = bb_ + SB_KGT + (16 * mt + cl) * 160 + q * 16; \
            _Pragma("unroll") for (int ks = 0; ks < 2; ++ks) S[mt] = MFMA16(ldfrag(kp_ + ks * 64), Vb_[ks], S[mt]); } \
        _Pragma("unroll") for (int mt = 0; mt < 4; ++mt) _Pragma("unroll") for (int r = 0; r < 4; ++r) { const int row_ = 16 * mt + 4 * q + r; \
            const unsigned off_ = (row_ < nrows) ? (unsigned)(n) * (64u * D * 2u) + (unsigned)(16 * mt + r) * (D * 2u) + laneoff : dumpoff; \
            *(bf16*)((char*)MX + off_) = f2bf(o_[mt][r]); } \
    } while (0)
#pragma unroll 1
        for (int n = 0; n < nsteps; n += 2) {
            SCAN_STEP(n, 0);
            if (n + 1 < nsteps) SCAN_STEP(n + 1, 1);
        }
#undef SCAN_STEP
#pragma unroll
        for (int mt = 0; mt < 8; ++mt)
#pragma unroll
            for (int r = 0; r < 4; ++r) Sout[(16 * mt + 4 * q + r) * 128 + c0 + cl] = S[mt][r];
    }
    __syncthreads();
}
#undef SCAN_BAR

__device__ __forceinline__ void scan_helper(gu32* prog, const bf16* gmain, size_t main_stride, const bf16* gqk, size_t qk_stride, float* sink, int tid, int lane) {
    constexpr int AHEAD = 6;
    unsigned acc = 0u;
    const unsigned vmain = (unsigned)tid * 128u, vqk = (unsigned)(tid & 63) * 128u;
#pragma unroll 1
    for (int n = 0; n < 64; ++n) {
        if (n > AHEAD) {
            if (lane == 0) { unsigned sp = 0u; while ((int)__hip_atomic_load(prog, RLX_AGENT) < n - AHEAD && ++sp < 200000u) __builtin_amdgcn_s_sleep(16); }
        }
        const unsigned a = *(const unsigned*)((const char*)(gmain + (size_t)n * main_stride) + vmain);
        const unsigned c = *(const unsigned*)((const char*)(gqk + (size_t)n * qk_stride) + vqk);
        acc ^= a ^ c;
    }
    if (acc == 0x9e3779b9u) *sink = 0.f;
}

__device__ __forceinline__ void phase_gdn_finish(const bf16* P, bf16* MIXIN, const float* gnw, int gw, int NGW, int lane) {
    const f32x2 gw2 = *(const f32x2*)(gnw + 2 * lane);
    for (int it = gw; it < M * 4; it += NGW) {
        const int m = it >> 2, h = it & 3;
        unsigned* op = (unsigned*)(MIXIN + (size_t)m * D + h * 128) + lane;
        const unsigned ow = *op, zw = *((const unsigned*)(P + (size_t)m * NIN + PC_Z + h * 128) + lane);
        const float o0 = bflo(ow), o1 = bfhi(ow), z0 = bflo(zw), z1 = bfhi(zw);
        const float rstd = rsq_(wave_sum(o0 * o0 + o1 * o1) * (1.f / 128.f) + EPS);
        *op = pk2(o0 * rstd * gw2.x * z0 * sigmoidf_(z0), o1 * rstd * gw2.y * z1 * sigmoidf_(z1));
    }
}

constexpr int ATT_WAVE_LDS = 17920;
constexpr float LOG2E = 1.4426950408889634f;
typedef short v4i16_t __attribute__((ext_vector_type(4)));
__device__ __forceinline__ s16x4 vtr(const LAS unsigned char* p) { return __builtin_bit_cast(s16x4, __builtin_amdgcn_ds_read_tr16_b64_v4i16((LAS v4i16_t*)p)); }
__device__ __forceinline__ void attn_item(LAS unsigned char* wl, int it, const bf16* P, const float* ck, const float* cv, const float* relb, const float* anw, bf16* MIXIN, int lane) {
    LAS unsigned char* KL = wl; LAS unsigned char* VL = wl + 8192; LAS float* SC = (LAS float*)(wl + 16384); LAS float* BT = (LAS float*)(wl + 16640);
    const int r32 = lane & 31, hi = lane >> 5;
    const bool sample = it < 256;
    int b, h, n = 0, half = 0, mq, t0, t1;
    if (sample) { b = it >> 3; h = it & 7; mq = MP + b * 32; t0 = 0; t1 = 9; }
    else { const int idx = it - 256; half = idx & 1; n = (idx >> 1) & 63; h = (idx >> 7) & 7; b = idx >> 10; mq = b * SEQ + n * 64 + half * 32; t0 = n > 8 ? n - 8 : 0; t1 = n + 1; }
    for (int k = lane; k < 257; k += 64) BT[k] = relb[h * 257 + k] * LOG2E;
    bf16x8 qr[4];
#pragma unroll
    for (int d0 = 0; d0 < 4; ++d0) qr[d0] = *(const bf16x8*)(P + (size_t)(mq + r32) * NIN + PC_QB + h * 64 + d0 * 16 + hi * 8);
    float mrun = -1e30f, lrun = 0.f; f32x16 o0, o1;
#pragma unroll
    for (int r = 0; r < 16; ++r) { o0[r] = 0.f; o1[r] = 0.f; }
    const int ti = lane & 15, blk = (lane >> 4) & 1;
    const LAS unsigned char* vbase = VL + (4 * hi + (ti >> 2)) * 128 + (blk * 16 + 4 * (ti & 3)) * 2;
#pragma unroll 1
    for (int t = t0; t < t1; ++t) {
        int relbase; bool maskhalf = false;
        if (sample && t < 8) {
            relbase = 512 - 64 * t;
#pragma unroll
            for (int i8 = 0; i8 < 8; ++i8) { const int idx = i8 * 64 + lane, key = idx >> 3, c8 = idx & 7; const size_t off = (((size_t)b * 512 + 64 * t + key) * 8 + h) * 64 + c8 * 8;
                const f32x4 ka = *(const f32x4*)(ck + off), kb = *(const f32x4*)(ck + off + 4), va = *(const f32x4*)(cv + off), vb = *(const f32x4*)(cv + off + 4);
                *(LAS v4u*)(KL + (c8 * 64 + key) * 16) = (v4u){pk2(ka.x, ka.y), pk2(ka.z, ka.w), pk2(kb.x, kb.y), pk2(kb.z, kb.w)};
                *(LAS v4u*)(VL + key * 128 + c8 * 16) = (v4u){pk2(va.x, va.y), pk2(va.z, va.w), pk2(vb.x, vb.y), pk2(vb.z, vb.w)}; }
        } else {
            size_t rowbase; int nvalid;
            if (sample) { relbase = 0; maskhalf = true; rowbase = (size_t)MP + b * 32; nvalid = 32; }
            else { relbase = 64 * (n - t) + 32 * half; rowbase = (size_t)b * SEQ + t * 64; nvalid = 64; }
#pragma unroll
            for (int i8 = 0; i8 < 8; ++i8) { const int idx = i8 * 64 + lane, key = idx >> 3, c8 = idx & 7; v4u kv = {0u, 0u, 0u, 0u}, vv = {0u, 0u, 0u, 0u};
                if (key < nvalid) { const bf16* rp = P + (rowbase + key) * NIN + h * 64 + c8 * 8; kv = *(const v4u*)(rp + PC_KB); vv = *(const v4u*)(rp + PC_VB); }
                *(LAS v4u*)(KL + (c8 * 64 + key) * 16) = kv; *(LAS v4u*)(VL + key * 128 + c8 * 16) = vv; }
        }
        f32x16 p0, p1;
#pragma unroll
        for (int r = 0; r < 16; ++r) { p0[r] = 0.f; p1[r] = 0.f; }
#pragma unroll
        for (int d0 = 0; d0 < 4; ++d0) { const bf16x8 k0 = *(const LAS bf16x8*)(KL + (2 * d0 + hi) * 1024 + r32 * 16), k1 = *(const LAS bf16x8*)(KL + (2 * d0 + hi) * 1024 + 512 + r32 * 16);
            p0 = MFMA32(k0, qr[d0], p0); p1 = MFMA32(k1, qr[d0], p1); }
        const float SC2 = 0.125f * LOG2E;
        if (relbase - 63 >= 128) { const float bc = BT[256];
#pragma unroll
            for (int r = 0; r < 16; ++r) { p0[r] = p0[r] * SC2 + bc; p1[r] = p1[r] * SC2 + bc; } }
        else {
#pragma unroll
            for (int r = 0; r < 16; ++r) { const int rel = relbase + r32 - crow(r, hi); int i0 = (rel > 128 ? 128 : rel) + 128, i1 = (rel - 32 > 128 ? 128 : rel - 32) + 128; i0 = i0 < 0 ? 0 : i0; i1 = i1 < 0 ? 0 : i1;
                p0[r] = p0[r] * SC2 + BT[i0]; p1[r] = p1[r] * SC2 + BT[i1]; } }
        if (maskhalf) {
#pragma unroll
            for (int r = 0; r < 16; ++r) p1[r] = -INFINITY; }
        float mx = fmaxf(p0[0], p1[0]);
#pragma unroll
        for (int r = 1; r < 16; ++r) mx = fmaxf(mx, fmaxf(p0[r], p1[r]));
        mx = fmaxf(mx, __shfl_xor(mx, 32));
        const float mnew = fmaxf(mrun, mx); const float alpha = __builtin_amdgcn_exp2f(mrun - mnew); mrun = mnew;
        float sum = 0.f;
#pragma unroll
        for (int r = 0; r < 16; ++r) { p0[r] = __builtin_amdgcn_exp2f(p0[r] - mnew); p1[r] = __builtin_amdgcn_exp2f(p1[r] - mnew); sum += p0[r] + p1[r]; }
        lrun = lrun * alpha + sum;
        if (hi == 0) SC[r32] = alpha;
#pragma unroll
        for (int r = 0; r < 16; ++r) { const float a = SC[crow(r, hi)]; o0[r] *= a; o1[r] *= a; }
#pragma unroll
        for (int s = 0; s < 4; ++s) {
            v4u pw;
            if (s < 2) pw = (v4u){pk2(p0[8 * s + 0], p0[8 * s + 1]), pk2(p0[8 * s + 2], p0[8 * s + 3]), pk2(p0[8 * s + 4], p0[8 * s + 5]), pk2(p0[8 * s + 6], p0[8 * s + 7])};
            else { const int ss = s - 2; pw = (v4u){pk2(p1[8 * ss + 0], p1[8 * ss + 1]), pk2(p1[8 * ss + 2], p1[8 * ss + 3]), pk2(p1[8 * ss + 4], p1[8 * ss + 5]), pk2(p1[8 * ss + 6], p1[8 * ss + 7])}; }
            const bf16x8 pa = __builtin_bit_cast(bf16x8, pw);
            const LAS unsigned char* vp = vbase + (16 * s) * 128;
            const s16x4 a0 = vtr(vp), a1 = vtr(vp + 8 * 128), b0 = vtr(vp + 64), b1 = vtr(vp + 8 * 128 + 64);
            const bf16x8 v0 = {a0[0], a0[1], a0[2], a0[3], a1[0], a1[1], a1[2], a1[3]}, v1 = {b0[0], b0[1], b0[2], b0[3], b1[0], b1[1], b1[2], b1[3]};
            o0 = MFMA32(pa, v0, o0); o1 = MFMA32(pa, v1, o1);
        }
    }
    lrun += __shfl_xor(lrun, 32);
    if (hi == 0) SC[32 + r32] = 1.f / lrun;
    LAS float* OL = (LAS float*)wl;
#pragma unroll
    for (int r = 0; r < 16; ++r) { const int qq = crow(r, hi); const float inv = SC[32 + qq]; OL[qq * 66 + r32] = o0[r] * inv; OL[qq * 66 + 32 + r32] = o1[r] * inv; }
    {
        const int qq = lane >> 1, dh = (lane & 1) * 32; float vals[32]; float ss = 0.f;
#pragma unroll
        for (int k = 0; k < 32; ++k) { vals[k] = OL[qq * 66 + dh + k]; ss += vals[k] * vals[k]; }
        ss += __shfl_xor(ss, 1);
        const float rstd = rsq_(ss * (1.f / 64.f) + EPS);
        bf16* op = MIXIN + (size_t)(mq + qq) * D + 512 + h * 64 + dh;
#pragma unroll
        for (int k4 = 0; k4 < 4; ++k4) { v4u o;
            const f32x4 wa = *(const f32x4*)(anw + dh + 8 * k4), wb = *(const f32x4*)(anw + dh + 8 * k4 + 4);
            o.x = pk2(vals[8 * k4 + 0] * rstd * wa.x, vals[8 * k4 + 1] * rstd * wa.y); o.y = pk2(vals[8 * k4 + 2] * rstd * wa.z, vals[8 * k4 + 3] * rstd * wa.w);
            o.z = pk2(vals[8 * k4 + 4] * rstd * wb.x, vals[8 * k4 + 5] * rstd * wb.y); o.w = pk2(vals[8 * k4 + 6] * rstd * wb.z, vals[8 * k4 + 7] * rstd * wb.w);
            *(v4u*)(op + 8 * k4) = o; }
    }
}

__device__ __forceinline__ void load_gemm_row(f32x4 (&v)[4], const bf16* Yb, const float* slab, int ns, int m, int lane) {
    if (m < MP) {
#pragma unroll
        for (int j = 0; j < 4; ++j) { const v2u t = ((const v2u*)(Yb + (size_t)m * D))[lane + 64 * j]; v[j] = (f32x4){bflo(t.x), bfhi(t.x), bflo(t.y), bfhi(t.y)}; }
    } else {
#pragma unroll
        for (int j = 0; j < 4; ++j) v[j] = (f32x4){0.f, 0.f, 0.f, 0.f};
        for (int k = 0; k < ns; ++k) {
#pragma unroll
            for (int j = 0; j < 4; ++j) v[j] += ((const f32x4*)(slab + ((size_t)k * MS + (m - MP)) * D))[lane + 64 * j]; }
    }
}
__device__ __forceinline__ void phase_rows1(const float* xp, const float* xs, const bf16* mixb, const float* slab, int ns, const float* w_post, const float* w_pre2, float* out, bf16* U, int gw, int NGW, int lane) {
    for (int m = gw; m < M; m += NGW) {
        const float* xrow = m < MP ? xp + (size_t)m * D : xs + (size_t)(m - MP) * D;
        f32x4 v[4], xv[4]; float s = 0.f;
        load_gemm_row(v, mixb, slab, ns, m, lane);
#pragma unroll
        for (int j = 0; j < 4; ++j) { xv[j] = ((const f32x4*)xrow)[lane + 64 * j]; s += (v[j].x * v[j].x + v[j].y * v[j].y) + (v[j].z * v[j].z + v[j].w * v[j].w); }
        const float rstd = rsq_(wave_sum(s) * (1.f / D) + EPS); float s2 = 0.f;
#pragma unroll
        for (int j = 0; j < 4; ++j) { const f32x4 g = ((const f32x4*)w_post)[lane + 64 * j]; v[j] = xv[j] + v[j] * rstd * g; ((f32x4*)(out + (size_t)m * D))[lane + 64 * j] = v[j];
            s2 += (v[j].x * v[j].x + v[j].y * v[j].y) + (v[j].z * v[j].z + v[j].w * v[j].w); }
        const float rstd2 = rsq_(wave_sum(s2) * (1.f / D) + EPS);
        unsigned long long* o8 = (unsigned long long*)(U + (size_t)m * D) + lane;
#pragma unroll
        for (int j = 0; j < 4; ++j) { const f32x4 g = ((const f32x4*)w_pre2)[lane + 64 * j]; const f32x4 t = v[j] * rstd2 * g;
            o8[64 * j] = (unsigned long long)pk2(t.x, t.y) | ((unsigned long long)pk2(t.z, t.w) << 32); }
    }
}
__device__ __forceinline__ void phase_rows2(const bf16* dnb, const float* slab, int ns, const float* w, float* out, int gw, int NGW, int lane) {
    for (int m = gw; m < M; m += NGW) {
        f32x4 v[4]; float s = 0.f;
        load_gemm_row(v, dnb, slab, ns, m, lane);
#pragma unroll
        for (int j = 0; j < 4; ++j) s += (v[j].x * v[j].x + v[j].y * v[j].y) + (v[j].z * v[j].z + v[j].w * v[j].w);
        const float rstd = rsq_(wave_sum(s) * (1.f / D) + EPS);
#pragma unroll
        for (int j = 0; j < 4; ++j) { const f32x4 g = ((const f32x4*)w)[lane + 64 * j]; f32x4* op = (f32x4*)(out + (size_t)m * D) + lane + 64 * j; *op = *op + v[j] * rstd * g; }
    }
}
__device__ __forceinline__ float gelu_tanh(float x) { const float y = 0.7978845608028654f * (x + 0.044715f * x * x * x); const float t = 1.f - 2.f * __builtin_amdgcn_rcpf(1.f + __builtin_amdgcn_exp2f(2.8853900817779268f * y)); return 0.5f * x * (1.f + t); }
__device__ __forceinline__ void unpack8(const v4u t, float (&g)[8]) { g[0] = bflo(t.x); g[1] = bfhi(t.x); g[2] = bflo(t.y); g[3] = bfhi(t.y); g[4] = bflo(t.z); g[5] = bfhi(t.z); g[6] = bflo(t.w); g[7] = bfhi(t.w); }
__device__ __forceinline__ void phase_h(const bf16* Gt, bf16* UP, const float* st_ffn, const float* cw, const float* cb, float* out, int gtid, int nth) {
    constexpr int CG = FF / 8, RB = 16, NRB = M / RB;
    for (int task = gtid; task < NRB * CG; task += nth) {
        const int rb = task / CG, c = (task % CG) * 8; const int m0 = rb * RB;
        const bool smp = m0 >= MP; const int tl = smp ? 32 : SEQ;
        int tpos = smp ? ((m0 - MP) & 31) : (m0 & (SEQ - 1)); const int bsm = smp ? ((m0 - MP) >> 5) : (m0 >> 12);
        float w0[8], w1[8], w2[8], bb[8];
        { const f32x4 a = *(const f32x4*)(cw + c), b2 = *(const f32x4*)(cw + c + 4); w0[0] = a.x; w0[1] = a.y; w0[2] = a.z; w0[3] = a.w; w0[4] = b2.x; w0[5] = b2.y; w0[6] = b2.z; w0[7] = b2.w; }
        { const f32x4 a = *(const f32x4*)(cw + FF + c), b2 = *(const f32x4*)(cw + FF + c + 4); w1[0] = a.x; w1[1] = a.y; w1[2] = a.z; w1[3] = a.w; w1[4] = b2.x; w1[5] = b2.y; w1[6] = b2.z; w1[7] = b2.w; }
        { const f32x4 a = *(const f32x4*)(cw + 2 * FF + c), b2 = *(const f32x4*)(cw + 2 * FF + c + 4); w2[0] = a.x; w2[1] = a.y; w2[2] = a.z; w2[3] = a.w; w2[4] = b2.x; w2[5] = b2.y; w2[6] = b2.z; w2[7] = b2.w; }
        { const f32x4 a = *(const f32x4*)(cb + c), b2 = *(const f32x4*)(cb + c + 4); bb[0] = a.x; bb[1] = a.y; bb[2] = a.z; bb[3] = a.w; bb[4] = b2.x; bb[5] = b2.y; bb[6] = b2.z; bb[7] = b2.w; }
        float g0[8], g1[8];
        if (tpos >= 2) { unpack8(*(const v4u*)(Gt + (size_t)(m0 - 2) * FF + c), g0); unpack8(*(const v4u*)(Gt + (size_t)(m0 - 1) * FF + c), g1); }
        else if (smp) {
#pragma unroll
            for (int e = 0; e < 8; ++e) { g0[e] = st_ffn[((size_t)bsm * 2 + 0) * FF + c + e]; g1[e] = st_ffn[((size_t)bsm * 2 + 1) * FF + c + e]; } }
        else {
#pragma unroll
            for (int e = 0; e < 8; ++e) { g0[e] = 0.f; g1[e] = 0.f; } }
#pragma unroll 4
        for (int i = 0; i < RB; ++i) {
            const int m = m0 + i;
            float g2[8], up[8], hv[8];
            unpack8(*(const v4u*)(Gt + (size_t)m * FF + c), g2); unpack8(*(const v4u*)(UP + (size_t)m * FF + c), up);
#pragma unroll
            for (int e = 0; e < 8; ++e) { const float x = w0[e] * g0[e] + w1[e] * g1[e] + w2[e] * g2[e] + bb[e]; hv[e] = gelu_tanh(x) * up[e]; }
            *(v4u*)(UP + (size_t)m * FF + c) = (v4u){pk2(hv[0], hv[1]), pk2(hv[2], hv[3]), pk2(hv[4], hv[5]), pk2(hv[6], hv[7])};
            if (tpos + i >= tl - 2) { const int k = tpos + i - (tl - 2); float* op = (smp ? out + O_FCS : out + O_FCP) + ((size_t)bsm * 2 + k) * FF + c;
#pragma unroll
                for (int e = 0; e < 8; ++e) op[e] = g2[e]; }
#pragma unroll
            for (int e = 0; e < 8; ++e) { g0[e] = g1[e]; g1[e] = g2[e]; }
        }
    }
}

#ifndef MK_N_LAUNCHES
#define MK_N_LAUNCHES 1
#endif
constexpr int NPH = 11;
constexpr int N_LAUNCHES = MK_N_LAUNCHES;
struct Args { const float* in[23]; float* out; unsigned char* ws; int ph_lo, ph_hi, li, pad; };
__global__ void __launch_bounds__(NWAVES * 64, 2) hybrid_fwd(Args args) {
    extern __shared__ __attribute__((aligned(16))) unsigned char lds_raw[];
    LAS unsigned char* lds = (LAS unsigned char*)lds_raw;
    volatile LAS unsigned* MISC = (volatile LAS unsigned*)(lds + MISC_OFF);
    const int tid = threadIdx.x, lane = tid & 63, wave = __builtin_amdgcn_readfirstlane(tid >> 6);
    const int G = gridDim.x; const int bx = blockIdx.x; const int vcu = (G % 8 == 0) ? (bx % 8) * (G / 8) + bx / 8 : bx;
    unsigned char* ws = args.ws; float* out = args.out;
    gu32* ctl = (gu32*)(ws + WS_CTL);
#define x_prompt (args.in[0])
#define x_sample (args.in[1])
#define cache_k (args.in[2])
#define cache_v (args.in[3])
#define state_delta (args.in[4])
#define state_qkv (args.in[5])
#define state_ffn (args.in[6])
#define norm_mix_pre (args.in[7])
#define w_in (args.in[8])
#define qkv_conv_w (args.in[9])
#define a_log (args.in[10])
#define dt_bias (args.in[11])
#define gdn_norm_w (args.in[12])
#define rel_bias (args.in[13])
#define attn_norm_w (args.in[14])
#define w_out (args.in[15])
#define norm_mix_post (args.in[16])
#define norm_ffn_pre (args.in[17])
#define w_gate_up (args.in[18])
#define ffn_conv_w (args.in[19])
#define ffn_conv_b (args.in[20])
#define w_down (args.in[21])
#define norm_ffn_post (args.in[22])
#define Win_t ((bf16*)(ws + WS_WIN))
#define Wout_t ((bf16*)(ws + WS_WOUT))
#define Wgu_t ((bf16*)(ws + WS_WGU))
#define Wdn_t ((bf16*)(ws + WS_WDN))
#define AB ((float*)(ws + WS_AB))
#define DL ((float*)(ws + WS_DL))
#define U ((bf16*)(ws + WS_U))
#define GQK ((bf16*)(ws + WS_GQK))
#define GS ((bf16*)(ws + WS_GS))
#define P ((bf16*)(ws + WS_P))
#define MIXIN ((bf16*)(ws + WS_MIXIN))
#define MIXB ((bf16*)(ws + WS_P))
#define SLAB1 ((float*)(ws + WS_P + 34 * MiB))
#define DOWNB ((bf16*)(ws + WS_U))
#define SLAB2 ((float*)(ws + WS_G))
#define Gt ((bf16*)(ws + WS_G))
#define UP ((bf16*)(ws + WS_UP))
#define GMAIN ((bf16*)out)

    for (int u = tid; u < 64; u += NWAVES * 64) ((LAS unsigned*)(lds + MISC_OFF))[u] = 0u;
    __syncthreads();
    XcdBarrier bar; bar.bar = (unsigned*)(ctl + CW_BAR); bar.x = 0; bar.st = nullptr;
    if (N_LAUNCHES == 1) bar = xcd_barrier_post((unsigned*)(ctl + CW_BAR), MISC + 8);
#define GRID_BAR() do { if (N_LAUNCHES == 1) xcd_barrier(bar); } while (0)
    const int lo = args.ph_lo, hi_ = args.ph_hi;
#define IN(k) (lo <= (k) && (k) < hi_)
#define BOTH(k) (IN(k) && IN((k) + 1))
    const int gw = vcu * NWAVES + wave, NGW = G * NWAVES, gtid = bx * (NWAVES * 64) + tid, nth = G * NWAVES * 64;

    if (IN(0)) { phase_prologue(lds, x_prompt, x_sample, norm_mix_pre, w_in, w_out, w_gate_up, w_down, ws, vcu, G, tid, lane, wave); if (BOTH(0)) GRID_BAR(); }

    if (IN(1)) {
        pg8::Gemm g{U, Win_t, M, NIN, D, D}; pg8::StaticOrder S; S.init(M, NIN, G, bx);
        pg8::EpiBf16<0> E{P, NIN, nullptr, 0, 0, 1.f};
        pg8::gemm_phase<pg8::EpiBf16<0>, pg8::StaticOrder, true, true>(lds, g, S, E);
        if (BOTH(1)) GRID_BAR();
    }

    if (IN(2)) {
        phase_copy_outputs(P, out, gtid, nth);
        for (int u = bx; u < 1152; u += G) gdn_pre_unit(lds, u, P, AB, state_qkv, qkv_conv_w, a_log, dt_bias, GMAIN, GQK, GS, DL, tid, lane, wave);
        if (BOTH(2)) GRID_BAR();
    }

    if (IN(3)) {
        if (bx < 32) {
            const int sidx = bx & 15, half = bx >> 4; const int b = sidx >> 2, h = sidx & 3; const int u0 = b * 256 + h * 64; const size_t m0 = (size_t)b * SEQ;
            scan_half(lds, half, 64, 64, GMAIN + (size_t)u0 * 32768, 32768, GQK + (size_t)u0 * 4096, 4096, DL + u0, nullptr, out + O_DP + (size_t)(b * 4 + h) * 16384,
                      MIXIN + m0 * D + h * 128, (unsigned)(((size_t)M * D - (m0 * D + h * 128)) * 2), half == 0 ? ctl + 1024 + 64 * sidx : (gu32*)nullptr, tid, lane, wave);
        } else if (bx >= G - 16) {
            const int sidx = bx - (G - 16); const int b = sidx >> 2, h = sidx & 3; const int u0 = b * 256 + h * 64;
            scan_helper(ctl + 1024 + 64 * sidx, GMAIN + (size_t)u0 * 32768, 32768, GQK + (size_t)u0 * 4096, 4096, (float*)(ws + WS_DL + 65536), tid, lane);
        } else {
            for (int hu = bx - 32; hu < 256; hu += (G - 48)) {
                const int su = hu >> 1, half = hu & 1; const int b = su >> 2, h = su & 3; const size_t m0 = (size_t)MP + b * 32; const bf16* base = GS + (size_t)su * 36864;
                scan_half(lds, half, 1, 32, base, 0, base + 32768, 0, DL + 1024 + su, state_delta + (size_t)su * 16384, out + O_DS + (size_t)su * 16384,
                          MIXIN + m0 * D + h * 128, (unsigned)(((size_t)M * D - (m0 * D + h * 128)) * 2), (gu32*)nullptr, tid, lane, wave);
            }
            LAS unsigned char* wl = lds + wave * ATT_WAVE_LDS;
            for (int it = (bx - 32) * NWAVES + wave; it < 4352; it += (G - 48) * NWAVES) attn_item(wl, it, P, cache_k, cache_v, rel_bias, attn_norm_w, MIXIN, lane);
        }
        if (BOTH(3)) GRID_BAR();
    }

    if (IN(4)) { phase_gdn_finish(P, MIXIN, gdn_norm_w, gw, NGW, lane); if (BOTH(4)) GRID_BAR(); }

    if (IN(5)) {
        { pg8::Gemm g{MIXIN, Wout_t, MP, D, D, D}; pg8::StaticOrder S; S.init(MP, D, G, bx);
          pg8::EpiBf16<0> E{MIXB, D, nullptr, 0, 0, 1.f};
          pg8::gemm_phase<pg8::EpiBf16<0>, pg8::StaticOrder, true, true>(lds, g, S, E); }
        { pg8::Gemm g{MIXIN, Wout_t, M, D, 256, D}; pg8::SplitOrder S; S.init(MP / 256, MS / 256, D / 256, 4, bx);
          pg8::EpiF32 E{SLAB1 - (size_t)MP * D, D, (size_t)MS * D};
          pg8::gemm_phase<pg8::EpiF32, pg8::SplitOrder, true, true>(lds, g, S, E); }
        if (BOTH(5)) GRID_BAR();
    }

    if (IN(6)) { phase_rows1(x_prompt, x_sample, MIXB, SLAB1, 4, norm_mix_post, norm_ffn_pre, out, U, gw, NGW, lane); if (BOTH(6)) GRID_BAR(); }

    if (IN(7)) {
        pg8::Gemm g{U, Wgu_t, M, 2 * FF, D, D}; pg8::StaticOrder S; S.init(M, 2 * FF, G, bx);
        pg8::EpiBf16<0> E{Gt, FF, nullptr, FF, (size_t)M * FF, 1.f};
        pg8::gemm_phase<pg8::EpiBf16<0>, pg8::StaticOrder, true, true>(lds, g, S, E);
        if (BOTH(7)) GRID_BAR();
    }

    if (IN(8)) { phase_h(Gt, UP, state_ffn, ffn_conv_w, ffn_conv_b, out, gtid, nth); if (BOTH(8)) GRID_BAR(); }

    if (IN(9)) {
        { pg8::Gemm g{UP, Wdn_t, MP, D, FF, FF}; pg8::StaticOrder S; S.init(MP, D, G, bx);
          pg8::EpiBf16<0> E{DOWNB, D, nullptr, 0, 0, 1.f};
          pg8::gemm_phase<pg8::EpiBf16<0>, pg8::StaticOrder, true, true>(lds, g, S, E); }
        { pg8::Gemm g{UP, Wdn_t, M, D, 256, FF}; pg8::SplitOrder S; S.init(MP / 256, MS / 256, D / 256, 11, bx);
          pg8::EpiF32 E{SLAB2 - (size_t)MP * D, D, (size_t)MS * D};
          pg8::gemm_phase<pg8::EpiF32, pg8::SplitOrder, true, true>(lds, g, S, E); }
        if (BOTH(9)) GRID_BAR();
    }

    if (IN(10)) phase_rows2(DOWNB, SLAB2, 11, norm_ffn_post, out, gw, NGW, lane);
#undef IN
#undef BOTH
#undef GRID_BAR
}

extern "C" void kernel_launch(void* const* d_in, const int* in_sizes, int n_in, void* d_out, int out_size, void* d_ws, size_t ws_size, hipStream_t stream) {
    static int grid = 0;
    if (grid == 0) {
        if (n_in != 23 || out_size != 23699456 || ws_size < WS_END) { fprintf(stderr, "kernel_launch: unexpected shapes (n_in %d, out %d, ws %zu); nothing launched\n", n_in, out_size, ws_size); grid = -1; return; }
        int dev = 0, cus = 0, per_cu = 0;
        if (hipGetDevice(&dev) != hipSuccess || hipDeviceGetAttribute(&cus, hipDeviceAttributeMultiprocessorCount, dev) != hipSuccess) { grid = -1; return; }
        if (hipFuncSetAttribute((const void*)hybrid_fwd, hipFuncAttributeMaxDynamicSharedMemorySize, LDS_BYTES) != hipSuccess) { fprintf(stderr, "kernel_launch: hipFuncSetAttribute failed\n"); grid = -1; return; }
        if (hipOccupancyMaxActiveBlocksPerMultiprocessor(&per_cu, (const void*)hybrid_fwd, NWAVES * 64, LDS_BYTES) != hipSuccess || per_cu < 1) fprintf(stderr, "kernel_launch: occupancy query reports %d\n", per_cu);
        (void)hipGetLastError();
        grid = cus;
    }
    if (grid < 0) return;
    if (hipMemsetAsync((char*)d_ws + WS_CTL, 0, CTL_ZERO_BYTES, stream) != hipSuccess) { fprintf(stderr, "kernel_launch: memset failed\n"); return; }
    Args a{};
    for (int i = 0; i < 23; ++i) a.in[i] = (const float*)d_in[i];
    a.out = (float*)d_out; a.ws = (unsigned char*)d_ws;
    if (N_LAUNCHES == 1) { a.ph_lo = 0; a.ph_hi = NPH; a.li = 0; hipLaunchKernelGGL(hybrid_fwd, dim3(grid), dim3(NWAVES * 64), LDS_BYTES, stream, a); }
    else for (int li = 0; li < NPH; ++li) { a.ph_lo = li; a.ph_hi = li + 1; a.li = li; hipLaunchKernelGGL(hybrid_fwd, dim3(grid), dim3(NWAVES * 64), LDS_BYTES, stream, a);
#ifdef PROBE_DUP
        if (li == PROBE_DUP) hipLaunchKernelGGL(hybrid_fwd, dim3(grid), dim3(NWAVES * 64), LDS_BYTES, stream, a);
#endif
    }
    const hipError_t le = hipPeekAtLastError();
    if (le != hipSuccess) fprintf(stderr, "kernel_launch: launch failed: %s\n", hipGetErrorName(le));
}
```

```cpp
#include <hip/hip_runtime.h>
#include <cstdio>
#include <cstdint>
namespace pg8 {
#define PG8_LAS __attribute__((address_space(3)))
typedef unsigned short bf16_t;
typedef short bf16x8 __attribute__((ext_vector_type(8)));
typedef float f32x4 __attribute__((ext_vector_type(4)));
typedef unsigned u32x4 __attribute__((ext_vector_type(4)));
constexpr int BM = 256, BK = 64, HALF = 128, HTB = HALF * BK * 2  , STAGE_BYTES = 8 * HTB, NXCD = 8, WGM = 8;

__host__ __device__ __forceinline__ int lds_byte(int r, int c) { const int st = (r >> 4) * 2 + (c >> 5), rr = r & 15, cc = c & 31, ob = rr * 64 + cc * 2; return st * 1024 + (ob ^ (((ob >> 9) & 1) << 5)); }
__host__ __device__ __forceinline__ void stage_rc(int b, int& R, int& C) { const int st = b / 1024, sb = b % 1024, swz = sb ^ (((sb >> 9) & 1) << 5); R = (st >> 1) * 16 + swz / 64; C = (st & 1) * 32 + (swz % 64) / 2; }
__host__ __device__ __forceinline__ int perm32(int rho) { const int n = rho >> 4, i = rho & 15; return 8 * (i >> 2) + 4 * n + (i & 3); }

struct Unit { int pm, pn, kq; };
struct Gemm { const bf16_t* A; const bf16_t* Bt; int M, N, K, ld; };

struct StaticOrder {
    int nM, nN, nwg, G, c;
    __host__ __device__ void init(int M, int N, int G_, int c_) { nM = M / BM; nN = N / BM; nwg = nM * nN; G = G_; c = c_; }
    __host__ __device__ bool next(int i, Unit& u) const {
        const long L = (long)i * G + c; if (L >= nwg) return false;
        int wgid = (int)L; { const int q = nwg / NXCD, r = nwg % NXCD, xcd = wgid % NXCD, off = wgid / NXCD; wgid = (xcd < r ? xcd * (q + 1) : r * (q + 1) + (xcd - r) * q) + off; }
        const int nig = WGM * nN, gid = wgid / nig, fm = gid * WGM, gsz = (nM - fm) < WGM ? (nM - fm) : WGM;
        u.pm = fm + ((wgid % nig) % gsz); u.pn = (wgid % nig) / gsz; u.kq = 0; return true;
    }
    __device__ __forceinline__ void a_ready(const Unit&) const {}
    __device__ __forceinline__ void done(const Unit&) const {}
};

struct SplitOrder {
    int pm0, nN, ns, np, c;
    __host__ __device__ void init(int pm0_, int nP, int nN_, int ns_, int c_) { pm0 = pm0_; nN = nN_; ns = ns_; np = nP * nN_ * ns_; c = c_; }
    __host__ __device__ bool next(int i, Unit& u) const { if (i > 0 || c >= np) return false; const int t = c / ns; u.pm = pm0 + t / nN; u.pn = t % nN; u.kq = c % ns; return true; }
    __device__ __forceinline__ void a_ready(const Unit&) const {}
    __device__ __forceinline__ void done(const Unit&) const {}
};

__device__ __forceinline__ unsigned cvt_pk_bf16(float lo, float hi) { unsigned r; asm volatile("v_cvt_pk_bf16_f32 %0, %1, %2" : "=v"(r) : "v"(lo), "v"(hi)); return r; }
typedef float f32x2 __attribute__((ext_vector_type(2)));
__device__ __forceinline__ f32x2 gelu_pk(f32x2 v) {
    const f32x2 av = __builtin_elementwise_abs(v), d = av * 0.2316418882f + 1.0f;
    f32x2 t; t.x = __builtin_amdgcn_rcpf(d.x); t.y = __builtin_amdgcn_rcpf(d.y);
    f32x2 q = t * 0.5307027145f + (-0.7265760135f); q = q * t + 0.7107068705f; q = q * t + (-0.142248368f); q = q * t + 0.127414796f; q = q * t;
    const f32x2 s = (v * v) * (-0.72134752044f);
    f32x2 e; e.x = __builtin_amdgcn_exp2f(s.x); e.y = __builtin_amdgcn_exp2f(s.y);
    const f32x2 m = v * (q * e), r = v - m;
    f32x2 o; o.x = v.x < 0.f ? m.x : r.x; o.y = v.y < 0.f ? m.y : r.y; return o;
}

template <int ACT  > struct EpiBf16 {
    static constexpr bool PERM = true, AFTER_DRAIN = false; static_assert(ACT == 0 || ACT == 1, "EpiBf16: ACT is 0 (none) or 1 (gelu_pk)");
    bf16_t* O; int ldc; const float* bias; int split_cols; size_t split_stride; float scale0;
    __device__ __forceinline__ void operator()(const f32x4 (&acc)[2][2][4][2], const Unit& u, int wr, int wc, int fr, int fq) const {
        const int row0 = u.pm * BM + wr * 64 + fr; int colt = u.pn * BM; bf16_t* base = O;
        float sc = 1.f; if (split_cols) { const int t = colt / split_cols; base += (size_t)t * split_stride; colt -= t * split_cols; if (t == 0) sc = scale0; }
        const int col0 = colt + wc * 32 + 8 * fq, bcol0 = u.pn * BM + wc * 32 + 8 * fq;
        f32x4 bv[2][2];
#pragma unroll
        for (int bj = 0; bj < 2; ++bj)
#pragma unroll
            for (int n = 0; n < 2; ++n) bv[bj][n] = bias ? *(const f32x4*)(bias + bcol0 + bj * HALF + 4 * n) : (f32x4){0.f, 0.f, 0.f, 0.f};
#pragma unroll
        for (int ai = 0; ai < 2; ++ai)
#pragma unroll
            for (int m = 0; m < 4; ++m) { bf16_t* rowp = base + (size_t)(row0 + ai * HALF + m * 16) * ldc + col0;
#pragma unroll
                for (int bj = 0; bj < 2; ++bj) { f32x4 v0 = acc[ai][bj][m][0] + bv[bj][0], v1 = acc[ai][bj][m][1] + bv[bj][1];
                    if (ACT == 1) { f32x2 a = gelu_pk((f32x2){v0[0], v0[1]}), b = gelu_pk((f32x2){v0[2], v0[3]}), c = gelu_pk((f32x2){v1[0], v1[1]}), d = gelu_pk((f32x2){v1[2], v1[3]});
                        v0 = (f32x4){a.x, a.y, b.x, b.y}; v1 = (f32x4){c.x, c.y, d.x, d.y}; }
                    v0 = v0 * sc; v1 = v1 * sc; u32x4 w; w.x = cvt_pk_bf16(v0[0], v0[1]); w.y = cvt_pk_bf16(v0[2], v0[3]); w.z = cvt_pk_bf16(v1[0], v1[1]); w.w = cvt_pk_bf16(v1[2], v1[3]);
                    *(u32x4*)(rowp + bj * HALF) = w; } }
    }
};

struct EpiF32 {
    static constexpr bool PERM = false, AFTER_DRAIN = false;
    float* O; int ldc; size_t kq_stride;
    __device__ __forceinline__ void operator()(const f32x4 (&acc)[2][2][4][2], const Unit& u, int wr, int wc, int fr, int fq) const {
        const int row0 = u.pm * BM + wr * 64 + fr, col0 = u.pn * BM + wc * 32 + 4 * fq;
#pragma unroll
        for (int ai = 0; ai < 2; ++ai)
#pragma unroll
            for (int m = 0; m < 4; ++m) { float* rowp = O + (size_t)u.kq * kq_stride + (size_t)(row0 + ai * HALF + m * 16) * ldc + col0;
#pragma unroll
                for (int bj = 0; bj < 2; ++bj)
#pragma unroll
                    for (int n = 0; n < 2; ++n) *(f32x4*)(rowp + bj * HALF + n * 16) = acc[ai][bj][m][n]; }
    }
};

template <class Epi, class Sched, bool ALIGN_EPI = false, bool SP2 = false>
__device__ __forceinline__ void gemm_phase(PG8_LAS unsigned char* lds, const Gemm g, const Sched& S, const Epi& E) {
    const int tid = threadIdx.x, wid = __builtin_amdgcn_readfirstlane(tid >> 6), lane = tid & 63, wr = wid >> 2, wc = wid & 3, fr = lane & 15, fq = lane >> 4;
    const int K = g.K, ld = g.ld, nt = K / BK;
    unsigned voffA[2], voffB[2];
#pragma unroll
    for (int i = 0; i < 2; ++i) { int R, C; stage_rc(tid * 16 + i * 8192, R, C); const int Rb = Epi::PERM ? ((R & ~31) + perm32(R & 31)) : R;
        voffA[i] = (unsigned)(R * ld + C) * 2u; voffB[i] = (unsigned)(Rb * ld + C) * 2u; }
    const size_t kstep = (size_t)(BK * 2);
    const size_t hstep = (size_t)HALF * ld * 2;
    const size_t tstep = 2 * hstep;
    const unsigned ldsw = (unsigned)wid * 1024u;
    const int aoff = lds_byte(wr * 64 + fr, fq * 8), boff = lds_byte(wc * 32 + fr, fq * 8);
#define PG8_SA(b, h) (((b) * 2 + (h)) * HTB)
#define PG8_SB(b, h) ((4 + (b) * 2 + (h)) * HTB)
#define PG8_STAGE(bufoff, gbase, voff) do { _Pragma("unroll") for (int _i = 0; _i < 2; ++_i) \
        __builtin_amdgcn_global_load_lds((const unsigned*)((const char*)(gbase) + (voff)[_i]), (PG8_LAS unsigned*)(lds + (bufoff) + ldsw + _i * 8192), 16, 0, 0); } while (0)
#define PG8_LDA(dst, b, h) do { _Pragma("unroll") for (int m = 0; m < 4; ++m) _Pragma("unroll") for (int k = 0; k < 2; ++k) dst[m][k] = *(const PG8_LAS bf16x8*)(lds + PG8_SA(b, h) + aoff + m * 2048 + k * 1024); } while (0)
#define PG8_LDB(dst, b, h) do { _Pragma("unroll") for (int n = 0; n < 2; ++n) _Pragma("unroll") for (int k = 0; k < 2; ++k) dst[n][k] = *(const PG8_LAS bf16x8*)(lds + PG8_SB(b, h) + boff + n * 2048 + k * 1024); } while (0)
#define PG8_MMA(ai, bj, At, Bt) do { __builtin_amdgcn_s_setprio(1); _Pragma("unroll") for (int m = 0; m < 4; ++m) _Pragma("unroll") for (int n = 0; n < 2; ++n) _Pragma("unroll") for (int k = 0; k < 2; ++k) \
        acc[ai][bj][m][n] = __builtin_amdgcn_mfma_f32_16x16x32_bf16(Bt[n][k], At[m][k], acc[ai][bj][m][n], 0, 0, 0); __builtin_amdgcn_s_setprio(0); } while (0)
#define PG8_WAIT_V(n) asm volatile("s_waitcnt vmcnt(" #n ")" ::: "memory")
#define PG8_WAIT_L(n) asm volatile("s_waitcnt lgkmcnt(" #n ")" ::: "memory")
#define PG8_BAR __builtin_amdgcn_s_barrier()
#define PG8_SCHED __builtin_amdgcn_sched_barrier(0)
    Unit cur, nxt; int ui = 0;
    if (!S.next(0, cur)) return;
    f32x4 acc[2][2][4][2];
#pragma unroll
    for (int a = 0; a < 2; ++a)
#pragma unroll
        for (int b = 0; b < 2; ++b)
#pragma unroll
            for (int m = 0; m < 4; ++m)
#pragma unroll
                for (int n = 0; n < 2; ++n) acc[a][b][m][n] = (f32x4){0.f, 0.f, 0.f, 0.f};
    bf16x8 At[4][2], B0[2][2], B1[2][2];
    const size_t kqb = (size_t)K * 2;
    const char* cA = (const char*)g.A + (size_t)cur.pm * tstep + cur.kq * kqb; const char* cB = (const char*)g.Bt + (size_t)cur.pn * tstep + cur.kq * kqb;
    S.a_ready(cur);
    if constexpr (SP2) {
        PG8_STAGE(PG8_SB(0, 0), cB, voffB); PG8_STAGE(PG8_SB(0, 1), cB + hstep, voffB); PG8_STAGE(PG8_SA(0, 0), cA, voffA); PG8_STAGE(PG8_SA(0, 1), cA + hstep, voffA);
        if (wr == 1) PG8_BAR;
        PG8_WAIT_V(2); PG8_BAR;
        PG8_STAGE(PG8_SB(1, 0), cB + kstep, voffB); PG8_STAGE(PG8_SA(1, 0), cA + kstep, voffA); PG8_STAGE(PG8_SB(1, 1), cB + hstep + kstep, voffB);
        PG8_WAIT_V(6); PG8_BAR;
    } else {
        PG8_STAGE(PG8_SB(0, 0), cB, voffB); PG8_STAGE(PG8_SA(0, 0), cA, voffA); PG8_STAGE(PG8_SB(0, 1), cB + hstep, voffB); PG8_STAGE(PG8_SA(0, 1), cA + hstep, voffA);
        if (wr == 1) PG8_BAR;
        PG8_WAIT_V(4); PG8_BAR;
        PG8_STAGE(PG8_SB(1, 0), cB + kstep, voffB); PG8_STAGE(PG8_SA(1, 0), cA + kstep, voffA); PG8_STAGE(PG8_SB(1, 1), cB + hstep + kstep, voffB);
        PG8_WAIT_V(6); PG8_BAR;
    }
    for (;;) {
        const bool has_next = S.next(ui + 1, nxt);
        const char* nA = has_next ? (const char*)g.A + (size_t)nxt.pm * tstep + nxt.kq * kqb : cA; const char* nB = has_next ? (const char*)g.Bt + (size_t)nxt.pn * tstep + nxt.kq * kqb : cB;
        for (int t = 0; t < nt; t += 2) {
            const bool last = (t == nt - 2);
            const char* a1 = cA + (size_t)(t + 1) * kstep;
            const char* a2 = last ? nA : cA + (size_t)(t + 2) * kstep; const char* b2 = last ? nB : cB + (size_t)(t + 2) * kstep;
            const char* a3 = a2 + kstep; const char* b3 = b2 + kstep;
            if (last && has_next) S.a_ready(nxt);
            if constexpr (SP2) {
            PG8_LDB(B0, 0, 0); PG8_LDB(B1, 0, 1); PG8_SCHED; PG8_LDA(At, 0, 0); PG8_STAGE(PG8_SA(1, 1), a1 + hstep, voffA);
            PG8_WAIT_V(8); PG8_WAIT_L(0); PG8_BAR; PG8_MMA(0, 0, At, B0); PG8_MMA(0, 1, At, B1); PG8_BAR; PG8_SCHED;
            PG8_LDA(At, 0, 1); PG8_STAGE(PG8_SB(0, 0), b2, voffB); PG8_STAGE(PG8_SB(0, 1), b2 + hstep, voffB); PG8_STAGE(PG8_SA(0, 0), a2, voffA);
            PG8_WAIT_V(8); PG8_WAIT_L(0); PG8_BAR; PG8_MMA(1, 0, At, B0); PG8_MMA(1, 1, At, B1); PG8_BAR; PG8_SCHED;
            PG8_LDB(B0, 1, 0); PG8_LDB(B1, 1, 1); PG8_SCHED; PG8_LDA(At, 1, 0); PG8_STAGE(PG8_SA(0, 1), a2 + hstep, voffA);
            PG8_WAIT_V(8); PG8_WAIT_L(0); PG8_BAR; PG8_MMA(0, 0, At, B0); PG8_MMA(0, 1, At, B1); PG8_BAR; PG8_SCHED;
            PG8_LDA(At, 1, 1); PG8_STAGE(PG8_SB(1, 0), b3, voffB); PG8_STAGE(PG8_SB(1, 1), b3 + hstep, voffB); PG8_STAGE(PG8_SA(1, 0), a3, voffA);
            PG8_WAIT_V(8); PG8_WAIT_L(0); PG8_BAR; PG8_MMA(1, 0, At, B0); PG8_MMA(1, 1, At, B1); PG8_BAR; PG8_SCHED;
            } else {
            PG8_LDB(B0, 0, 0); PG8_SCHED; PG8_LDA(At, 0, 0); PG8_STAGE(PG8_SA(1, 1), a1 + hstep, voffA);
            PG8_WAIT_L(8); PG8_BAR; PG8_WAIT_L(0); PG8_MMA(0, 0, At, B0); PG8_BAR; PG8_SCHED;
            PG8_LDB(B1, 0, 1); PG8_STAGE(PG8_SB(0, 0), b2, voffB);
            PG8_BAR; PG8_WAIT_L(0); PG8_MMA(0, 1, At, B1); PG8_BAR;
            PG8_LDA(At, 0, 1); PG8_STAGE(PG8_SA(0, 0), a2, voffA);
            PG8_BAR; PG8_WAIT_L(0); PG8_MMA(1, 0, At, B0); PG8_BAR; PG8_SCHED;
            PG8_STAGE(PG8_SB(0, 1), b2 + hstep, voffB);
            PG8_WAIT_V(6); PG8_BAR; PG8_MMA(1, 1, At, B1); PG8_BAR;
            PG8_LDB(B0, 1, 0); PG8_SCHED; PG8_LDA(At, 1, 0); PG8_STAGE(PG8_SA(0, 1), a2 + hstep, voffA);
            PG8_WAIT_L(8); PG8_BAR; PG8_WAIT_L(0); PG8_MMA(0, 0, At, B0); PG8_BAR; PG8_SCHED;
            PG8_LDB(B1, 1, 1); PG8_STAGE(PG8_SB(1, 0), b3, voffB);
            PG8_BAR; PG8_WAIT_L(0); PG8_MMA(0, 1, At, B1); PG8_BAR;
            PG8_LDA(At, 1, 1); PG8_STAGE(PG8_SA(1, 0), a3, voffA);
            PG8_BAR; PG8_WAIT_L(0); PG8_MMA(1, 0, At, B0); PG8_BAR; PG8_SCHED;
            PG8_STAGE(PG8_SB(1, 1), b3 + hstep, voffB);
            PG8_WAIT_V(6); PG8_BAR; PG8_MMA(1, 1, At, B1); PG8_BAR;
            }
        }
        if constexpr (ALIGN_EPI) { if (wr == 0) PG8_BAR; }
        if constexpr (!Epi::AFTER_DRAIN) { E(acc, cur, wr, wc, fr, fq); S.done(cur); }
        if (!has_next) break;
#pragma unroll
        for (int a = 0; a < 2; ++a)
#pragma unroll
            for (int b = 0; b < 2; ++b)
#pragma unroll
                for (int m = 0; m < 4; ++m)
#pragma unroll
                    for (int n = 0; n < 2; ++n) acc[a][b][m][n] = (f32x4){0.f, 0.f, 0.f, 0.f};
        cur = nxt; cA = nA; cB = nB; ++ui;
        if constexpr (ALIGN_EPI) { if (wr == 1) PG8_BAR; }
    }
    PG8_WAIT_V(0);
    if constexpr (!ALIGN_EPI) { if (wr == 0) PG8_BAR; }
    PG8_BAR;
    if constexpr (Epi::AFTER_DRAIN) { E.fused(acc, cur, wr, wc, fr, fq, lds, wid, lane); S.done(cur); }
#undef PG8_SA
#undef PG8_SB
#undef PG8_STAGE
#undef PG8_LDA
#undef PG8_LDB
#undef PG8_MMA
#undef PG8_WAIT_V
#undef PG8_WAIT_L
#undef PG8_BAR
#undef PG8_SCHED
}
}

constexpr int NWAVES = 8;
constexpr int D = 1024, SEQ = 4096, MP = 16384, MS = 1024, M = MP + MS;
constexpr int NIN = 3584, INC = 3592, FF = 2816;
constexpr int PC_Z = 1536, PC_QB = 2048, PC_KB = 2560, PC_VB = 3072;
constexpr float EPS = 1e-6f;
constexpr size_t O_YP = 0, O_YS = 16777216, O_BKP = 17825792, O_BVP = 18874368, O_DP = 19922944, O_QCP = 20185088, O_FCP = 20203520,
                 O_BKS = 20226048, O_BVS = 20750336, O_DS = 21274624, O_QCS = 23371776, O_FCS = 23519232;
constexpr size_t MiB = 1u << 20;
constexpr size_t WS_CTL = 0, CTL_ZERO_BYTES = 1 * MiB;
constexpr size_t WS_WIN = 1 * MiB, WS_WOUT = 8 * MiB, WS_WGU = 10 * MiB, WS_WDN = 21 * MiB;
constexpr size_t WS_AB = 27 * MiB, WS_DL = 27 * MiB + 768 * 1024;
constexpr size_t WS_U = 28 * MiB;
constexpr size_t WS_GQK = WS_U, WS_GS = WS_U + 8 * MiB;
constexpr size_t WS_P = 62 * MiB;
constexpr size_t WS_MIXIN = 181 * MiB;
constexpr size_t WS_G = WS_P, WS_UP = WS_P + (size_t)M * FF * 2;
constexpr size_t WS_END = 256 * MiB;
static_assert(WS_UP + (size_t)M * FF * 2 <= WS_END, "ws map");
constexpr int CW_BAR = 4096;

constexpr int LDS_BYTES = 163840;
constexpr int MISC_OFF = LDS_BYTES - 256;

#define GAS __attribute__((address_space(1)))
#define LAS __attribute__((address_space(3)))
typedef unsigned short bf16;
typedef unsigned v4u __attribute__((ext_vector_type(4)));
typedef unsigned v2u __attribute__((ext_vector_type(2)));
typedef float f32x2 __attribute__((ext_vector_type(2)));
typedef float f32x4 __attribute__((ext_vector_type(4)));
typedef float f32x16 __attribute__((ext_vector_type(16)));
typedef short bf16x8 __attribute__((ext_vector_type(8)));
typedef short s16x4 __attribute__((ext_vector_type(4)));
typedef __bf16 bf16x2_t __attribute__((ext_vector_type(2)));
typedef GAS unsigned gu32;
#define RLX_AGENT __ATOMIC_RELAXED, __HIP_MEMORY_SCOPE_AGENT
#define LDS_WAIT() asm volatile("s_waitcnt lgkmcnt(0)" ::: "memory")
#define VM_WAIT() asm volatile("s_waitcnt vmcnt(0)" ::: "memory")
__device__ __forceinline__ unsigned pk2(float lo, float hi) { f32x2 v = {lo, hi}; bf16x2_t b = __builtin_convertvector(v, bf16x2_t); return __builtin_bit_cast(unsigned, b); }
__device__ __forceinline__ float bflo(unsigned w) { return __uint_as_float(w << 16); }
__device__ __forceinline__ float bfhi(unsigned w) { return __uint_as_float(w & 0xffff0000u); }
__device__ __forceinline__ float bf1(bf16 b) { return __uint_as_float((unsigned)b << 16); }
__device__ __forceinline__ bf16 f2bf(float f) { return (bf16)(pk2(f, 0.f) & 0xffffu); }
__device__ __forceinline__ float wave_sum(float v) {
#pragma unroll
    for (int o = 1; o < 64; o <<= 1) v += __shfl_xor(v, o);
    return v;
}
__device__ __forceinline__ float sigmoidf_(float x) { return __builtin_amdgcn_rcpf(1.0f + __builtin_amdgcn_exp2f(-1.4426950408889634f * x)); }
__device__ __forceinline__ float rsq_(float x) { return __builtin_amdgcn_rsqf(x); }
__device__ __forceinline__ int crow(int r, int hi) { return (r & 3) + 8 * (r >> 2) + 4 * hi; }
#define MFMA32(a, b, c) __builtin_amdgcn_mfma_f32_32x32x16_bf16((a), (b), (c), 0, 0, 0)
#define MFMA16(a, b, c) __builtin_amdgcn_mfma_f32_16x16x32_bf16((a), (b), (c), 0, 0, 0)
#define XB_TMO      128
#define XB_XCNT(j)  (256  + 64 * (j))
#define XB_XSUB(j)  (1280 + 64 * (j))
#define XB_XGEN(j)  (2304 + 64 * (j))
#define XB_TOP      3328
#define XB_TOPGEN   3392
#define XCD_BAR_WORDS 3456
#define XB_SPIN_CAP (1u << 18)

__device__ __forceinline__ unsigned xb_ld(unsigned* p)              { return __hip_atomic_load(p, __ATOMIC_RELAXED, __HIP_MEMORY_SCOPE_AGENT); }
__device__ __forceinline__ unsigned xb_add(unsigned* p, unsigned v) { return __hip_atomic_fetch_add(p, v, __ATOMIC_RELAXED, __HIP_MEMORY_SCOPE_AGENT); }
__device__ __forceinline__ unsigned xb_xcc_id() { return (unsigned)__builtin_amdgcn_s_getreg((3 << 11) | 20) & 0xFu; }
#define XB_SPIN(cond, bar) do { unsigned _sp = 0; while (cond) { __builtin_amdgcn_s_sleep(1); \
    if ((++_sp & 255u) == 0u) { if (xb_ld(&(bar)[XB_TMO])) break; if (_sp > XB_SPIN_CAP) { atomicAdd(&(bar)[XB_TMO], 1u); break; } } } } while (0)

struct XcdBarrier {
    unsigned* bar; unsigned x;
    volatile LAS unsigned* st;
};

__device__ __forceinline__ XcdBarrier xcd_barrier_post(unsigned* bar, volatile LAS unsigned* st) {
    XcdBarrier b; b.bar = bar; b.x = xb_xcc_id(); b.st = st;
    if (threadIdx.x == 0) (void)xb_add(&bar[XB_XCNT(b.x)], 1u);
    return b;
}
__device__ __forceinline__ void xcd_barrier_complete(unsigned* bar, unsigned x, unsigned& nloc, unsigned& nx) {
    const unsigned G = gridDim.x * gridDim.y * gridDim.z;
    unsigned sum, cnt, mine, sp = 0u;
    for (;;) {
        sum = 0u; cnt = 0u; mine = 0u;
#pragma unroll
        for (unsigned j = 0; j < 16; ++j) { const unsigned c = xb_ld(&bar[XB_XCNT(j)]); sum += c; cnt += (c > 0u) ? 1u : 0u; mine = (j == x) ? c : mine; }
        if (sum == G) break;
        __builtin_amdgcn_s_sleep(1);
        if ((++sp & 255u) == 0u) { if (xb_ld(&bar[XB_TMO])) break; if (sp > XB_SPIN_CAP) { atomicAdd(&bar[XB_TMO], 1u); break; } }
    }
    nloc = mine > 0u ? mine : 1u; nx = cnt > 0u ? cnt : 1u;
}

__device__ __forceinline__ void xcd_barrier(const XcdBarrier& b) {
    asm volatile("s_waitcnt vmcnt(0)" ::: "memory");
    __syncthreads();
    if (threadIdx.x == 0) {
        unsigned* bar = b.bar;
        __builtin_amdgcn_s_waitcnt(0);
        unsigned nloc = b.st[0], nx = b.st[1];
        if (nloc == 0u) { xcd_barrier_complete(bar, b.x, nloc, nx); b.st[0] = nloc; b.st[1] = nx; }
        const unsigned old = xb_add(&bar[XB_XSUB(b.x)], 1u);
        const unsigned gen = old / nloc;
        if (old + 1u == (gen + 1u) * nloc) {
            __builtin_amdgcn_fence(__ATOMIC_RELEASE, "agent");
            asm volatile("s_waitcnt vmcnt(0)" ::: "memory");
            const unsigned og = xb_add(&bar[XB_TOP], 1u);
            const unsigned tg = og / nx;
            if (og + 1u == (tg + 1u) * nx) xb_add(&bar[XB_TOPGEN], 1u);
            else XB_SPIN(xb_ld(&bar[XB_TOPGEN]) == tg, bar);
            __builtin_amdgcn_fence(__ATOMIC_ACQUIRE, "agent");
            xb_add(&bar[XB_XGEN(b.x)], 1u);
            asm volatile("s_waitcnt vmcnt(0)" ::: "memory");
        } else {
            XB_SPIN(xb_ld(&bar[XB_XGEN(b.x)]) == gen, bar);
            __builtin_amdgcn_fence(__ATOMIC_ACQUIRE, "agent");
            asm volatile("s_waitcnt vmcnt(0)" ::: "memory");
        }
    }
    __syncthreads();
}

__device__ __forceinline__ void p0_transpose_item(const float* W, int ldw, int K, int N, bf16* WT, int row_off, LAS float* scr, int item, int lane) {
    const int nblk = N / 32, kb = item / nblk, nb = item % nblk, k0 = 64 * kb, n0 = 32 * nb;
#pragma unroll 8
    for (int i = 0; i < 32; ++i) { const int kk = 2 * i + (lane >> 5); scr[kk * 33 + (lane & 31)] = W[(size_t)(k0 + kk) * ldw + n0 + (lane & 31)]; }
    LDS_WAIT(); asm volatile("" ::: "memory");
    const int c = lane & 7;
#pragma unroll
    for (int j = 0; j < 4; ++j) { const int n = (lane >> 3) + 8 * j; const LAS float* s = scr + (8 * c) * 33 + n;
        v4u o; o.x = pk2(s[0 * 33], s[1 * 33]); o.y = pk2(s[2 * 33], s[3 * 33]); o.z = pk2(s[4 * 33], s[5 * 33]); o.w = pk2(s[6 * 33], s[7 * 33]);
        *(v4u*)(WT + (size_t)(row_off + n0 + n) * K + k0 + 8 * c) = o; }
    LDS_WAIT(); asm volatile("" ::: "memory");
}

__device__ __forceinline__ void phase_prologue(LAS unsigned char* lds, const float* xp, const float* xs, const float* nw, const float* w_in, const float* w_out, const float* w_gu, const float* w_dn,
                                               unsigned char* ws, int vcu, int G, int tid, int lane, int wave) {
    LAS float* scr = (LAS float*)(lds + wave * 8448);
    LAS float* W8T = (LAS float*)(lds + 67584);
    for (int k = tid; k < 1024; k += 512) {
        const f32x4 a = *(const f32x4*)(w_in + (size_t)k * INC + 2048), b = *(const f32x4*)(w_in + (size_t)k * INC + 2052);
        W8T[0 * 1024 + k] = a.x; W8T[1 * 1024 + k] = a.y; W8T[2 * 1024 + k] = a.z; W8T[3 * 1024 + k] = a.w;
        W8T[4 * 1024 + k] = b.x; W8T[5 * 1024 + k] = b.y; W8T[6 * 1024 + k] = b.z; W8T[7 * 1024 + k] = b.w;
    }
    __syncthreads();
    const int gw = vcu * NWAVES + wave, NGW = G * NWAVES;
    bf16* Win_t = (bf16*)(ws + WS_WIN); bf16* Wout_t = (bf16*)(ws + WS_WOUT); bf16* Wgu_t = (bf16*)(ws + WS_WGU); bf16* Wdn_t = (bf16*)(ws + WS_WDN);
    constexpr int I_A = 16 * 64, I_B = 16 * 48, I_O = 16 * 32, I_GU = 16 * 176, I_DN = 44 * 32;
    constexpr int NITEMS = I_A + I_B + I_O + I_GU + I_DN;
    for (int it = gw; it < NITEMS; it += NGW) {
        int r = it;
        if (r < I_A) { p0_transpose_item(w_in, INC, D, 2048, Win_t, 0, scr, r, lane); continue; } r -= I_A;
        if (r < I_B) { p0_transpose_item(w_in + 2056, INC, D, 1536, Win_t, 2048, scr, r, lane); continue; } r -= I_B;
        if (r < I_O) { p0_transpose_item(w_out, D, D, D, Wout_t, 0, scr, r, lane); continue; } r -= I_O;
        if (r < I_GU) { p0_transpose_item(w_gu, 2 * FF, D, 2 * FF, Wgu_t, 0, scr, r, lane); continue; } r -= I_GU;
        p0_transpose_item(w_dn, D, FF, D, Wdn_t, 0, scr, r, lane);
    }
    bf16* U = (bf16*)(ws + WS_U); float* AB = (float*)(ws + WS_AB);
    for (int m = gw; m < M; m += NGW) {
        const float* xrow = m < MP ? xp + (size_t)m * D : xs + (size_t)(m - MP) * D;
        f32x4 v[4]; float s = 0.f;
#pragma unroll
        for (int j = 0; j < 4; ++j) { v[j] = ((const f32x4*)xrow)[lane + 64 * j]; s += (v[j].x * v[j].x + v[j].y * v[j].y) + (v[j].z * v[j].z + v[j].w * v[j].w); }
        const float rstd = rsq_(wave_sum(s) * (1.f / D) + EPS);
        unsigned long long* o8 = (unsigned long long*)(U + (size_t)m * D) + lane;
#pragma unroll
        for (int j = 0; j < 4; ++j) { const f32x4 g = ((const f32x4*)nw)[lane + 64 * j]; v[j] = v[j] * rstd * g;
            o8[64 * j] = (unsigned long long)pk2(v[j].x, v[j].y) | ((unsigned long long)pk2(v[j].z, v[j].w) << 32); }
        float dv = 0.f;
#pragma unroll
        for (int jj = 0; jj < 8; ++jj) { float acc = 0.f;
#pragma unroll
            for (int j = 0; j < 4; ++j) { const f32x4 w = *(const LAS f32x4*)(W8T + jj * 1024 + 4 * lane + 256 * j); acc += (v[j].x * w.x + v[j].y * w.y) + (v[j].z * w.z + v[j].w * w.w); }
            acc = wave_sum(acc); if (lane == jj) dv = acc; }
        if (lane < 8) AB[(size_t)m * 8 + lane] = dv;
    }
}

__device__ __forceinline__ void phase_copy_outputs(const bf16* P, float* out, int gtid, int nth) {
    for (int e = gtid; e < 4 * 512 * 512; e += nth) { const int b = e >> 18, j = (e >> 9) & 511, c = e & 511; const size_t row = (size_t)(b * SEQ + 3584 + j) * NIN;
        out[O_BKP + e] = bf1(P[row + PC_KB + c]); out[O_BVP + e] = bf1(P[row + PC_VB + c]); }
    for (int e = gtid; e < 32 * 32 * 512; e += nth) { const int r = e >> 9, c = e & 511; const size_t row = (size_t)(MP + r) * NIN;
        out[O_BKS + e] = bf1(P[row + PC_KB + c]); out[O_BVS + e] = bf1(P[row + PC_VB + c]); }
    for (int e = gtid; e < 4 * 3 * 1536; e += nth) { const int b = e / 4608, i = (e / 1536) % 3, c = e % 1536; out[O_QCP + e] = bf1(P[(size_t)(b * SEQ + 4093 + i) * NIN + c]); }
    for (int e = gtid; e < 32 * 3 * 1536; e += nth) { const int b = e / 4608, i = (e / 1536) % 3, c = e % 1536; out[O_QCS + e] = bf1(P[(size_t)(MP + b * 32 + 29 + i) * NIN + c]); }
}

__device__ __forceinline__ bf16x8 pack8(const f32x4& a, const f32x4& b) { const v4u t = {pk2(a[0], a[1]), pk2(a[2], a[3]), pk2(b[0], b[1]), pk2(b[2], b[3])}; return __builtin_bit_cast(bf16x8, t); }
__device__ __forceinline__ int kperm(int k) { const int kk = k & 31; return (k & ~31) | (8 * ((kk & 15) >> 2) + (kk & 3) + 4 * (kk >> 4)); }
__device__ __forceinline__ void gdn_pre_unit(LAS unsigned char* lds, int u, const bf16* P, const float* AB, const float* st_qkv, const float* conv_w, const float* a_log, const float* dt_bias,
                                             bf16* gmain, bf16* gqk, bf16* gs, float* DL, int tid, int lane, int wave) {
    LAS float* RHS = (LAS float*)(lds + 0);
    LAS bf16* QB = (LAS bf16*)(lds + 65536);
    LAS bf16* KB = (LAS bf16*)(lds + 82944);
    LAS bf16* RAW = (LAS bf16*)(lds + 100352);
    LAS bf16* KGT = (LAS bf16*)(lds + 117760);
    LAS bf16* AMN = (LAS bf16*)(lds + 117760);
    LAS float* TD = (LAS float*)(lds + 117760 + 10240);
    LAS bf16* TB = (LAS bf16*)(lds + 117760 + 14336);
    LAS float* SMG = (LAS float*)(lds + 136192);
    const bool prompt = u < 1024;
    int b, h, n, m0, valid; bf16 *o_w, *o_qg, *o_kgt, *o_ut, *o_qk;
    if (prompt) { b = u >> 8; h = (u >> 6) & 3; n = u & 63; m0 = b * SEQ + n * 64; valid = 64; bf16* base = gmain + (size_t)u * 32768; o_w = base; o_qg = base + 8192; o_kgt = base + 16384; o_ut = base + 24576; o_qk = gqk + (size_t)u * 4096; }
    else { const int su = u - 1024; b = su >> 2; h = su & 3; n = 0; m0 = MP + b * 32; valid = 32; bf16* base = gs + (size_t)su * 36864; o_w = base; o_qg = base + 8192; o_kgt = base + 16384; o_ut = base + 24576; o_qk = base + 32768; }
    if (wave == 0) {
        const int i = lane; const bool v = i < valid;
        const float araw = v ? AB[(size_t)(m0 + i) * 8 + 4 + h] : 0.f, braw = v ? AB[(size_t)(m0 + i) * 8 + h] : 0.f;
        const float A = expf(a_log[h]); const float x = araw + dt_bias[h];
        const float sp = x > 20.f ? x : log1pf(expf(x));
        const float g = v ? -A * sp : 0.f; const float beta = v ? 1.f / (1.f + expf(-braw)) : 0.f;
        float Gc = g;
#pragma unroll
        for (int off = 1; off < 64; off <<= 1) { const float t = __shfl_up(Gc, off); if (lane >= off) Gc += t; }
        const float Gl = __shfl(Gc, 63);
        SMG[i] = Gc; SMG[64 + i] = beta; SMG[128 + i] = expf(Gc); SMG[192 + i] = expf(Gl - Gc);
        if (lane == 0) DL[u] = expf(Gl);
    }
    __syncthreads();
#pragma unroll 1
    for (int part = 0; part < 3; ++part) {
        const int pcol = (part == 0 ? 512 : part == 1 ? 0 : 1024) + h * 128;
#pragma unroll
        for (int pass = 0; pass < 3; ++pass) {
            const int rr = (tid >> 4) + 32 * pass, ch = tid & 15;
            if (rr < 67) {
                v4u val = {0u, 0u, 0u, 0u};
                if (prompt) { const int ts = n * 64 - 3 + rr; if (ts >= 0) val = *(const v4u*)(P + (size_t)(b * SEQ + ts) * NIN + pcol + ch * 8); }
                else { if (rr < 3) { const float* s = st_qkv + ((size_t)b * 3 + rr) * 1536 + pcol + ch * 8; const f32x4 a = *(const f32x4*)s, c = *(const f32x4*)(s + 4); val = (v4u){pk2(a.x, a.y), pk2(a.z, a.w), pk2(c.x, c.y), pk2(c.z, c.w)}; }
                       else if (rr - 3 < 32) val = *(const v4u*)(P + (size_t)(MP + b * 32 + rr - 3) * NIN + pcol + ch * 8); }
                *(LAS v4u*)(RAW + rr * 128 + ch * 8) = val;
            }
        }
        __syncthreads();
        float w0[4], w1[4];
#pragma unroll
        for (int i = 0; i < 4; ++i) { const f32x2 t = *(const f32x2*)(conv_w + i * 1536 + pcol + 2 * lane); w0[i] = t.x; w1[i] = t.y; }
#pragma unroll 2
        for (int rq = 0; rq < 8; ++rq) {
            const int r = wave * 8 + rq;
            float y0 = 0.f, y1 = 0.f;
#pragma unroll
            for (int i = 0; i < 4; ++i) { const unsigned xw = *(const LAS unsigned*)(RAW + (r + i) * 128 + 2 * lane); y0 += w0[i] * bflo(xw); y1 += w1[i] * bfhi(xw); }
            float s0 = y0 * sigmoidf_(y0), s1 = y1 * sigmoidf_(y1);
            if (r >= valid) { s0 = 0.f; s1 = 0.f; }
            if (part == 2) { const float be = SMG[64 + r]; *(LAS f32x2*)(RHS + r * 256 + 2 * lane) = (f32x2){s0 * be, s1 * be}; }
            else {
                const float rinv = rsq_(wave_sum(s0 * s0 + s1 * s1) + EPS);
                if (part == 0) { const float k0 = s0 * rinv, k1 = s1 * rinv; *(LAS unsigned*)(KB + r * 136 + 2 * lane) = pk2(k0, k1);
                    const float be = SMG[64 + r] * SMG[128 + r]; *(LAS f32x2*)(RHS + r * 256 + 128 + 2 * lane) = (f32x2){k0 * be, k1 * be};
                    const float egl = SMG[192 + r]; KGT[(2 * lane) * 64 + kperm(r)] = f2bf(k0 * egl); KGT[(2 * lane + 1) * 64 + kperm(r)] = f2bf(k1 * egl); }
                else { const float sc = rinv * 0.08838834764831845f; const float q0 = s0 * sc, q1 = s1 * sc; *(LAS unsigned*)(QB + r * 136 + 2 * lane) = pk2(q0, q1);
                    const float eg = SMG[128 + r]; *(unsigned*)(o_qg + r * 128 + kperm(2 * lane)) = pk2(q0 * eg, q1 * eg); }
            }
        }
        __syncthreads();
        if (part == 0) {
#pragma unroll
            for (int k = 0; k < 2; ++k) { const int pi = tid + 512 * k; *(v4u*)(o_kgt + pi * 8) = *(const LAS v4u*)(KGT + pi * 8); }
        }
    }
    {
        const int mat = wave >> 2, ti = (wave >> 1) & 1, tj = wave & 1, r32 = lane & 31, hi = lane >> 5;
        const LAS bf16* Ab = (mat == 0 ? KB : QB) + (32 * ti + r32) * 136 + 8 * hi;
        const LAS bf16* Bb = KB + (32 * tj + r32) * 136 + 8 * hi;
        f32x16 acc;
#pragma unroll
        for (int r = 0; r < 16; ++r) acc[r] = 0.f;
#pragma unroll
        for (int s = 0; s < 8; ++s) acc = MFMA32(*(const LAS bf16x8*)(Ab + 16 * s), *(const LAS bf16x8*)(Bb + 16 * s), acc);
        const int j = 32 * tj + r32; const float Gj = SMG[j];
#pragma unroll
        for (int r = 0; r < 16; ++r) { const int i = 32 * ti + crow(r, hi); const float dec = expf(fminf(SMG[i] - Gj, 0.f));
            if (mat == 0) { const float av = (i > j) ? acc[r] * SMG[64 + i] * dec : 0.f; AMN[i * 80 + kperm(j)] = f2bf(-av); if ((i >> 4) == (j >> 4)) TD[(i >> 4) * 256 + (i & 15) * 16 + (j & 15)] = av; }
            else o_qk[i * 64 + kperm(j)] = f2bf((i >= j) ? acc[r] * dec : 0.f); }
    }
    __syncthreads();
    if (wave == 0) {
        const int bb = lane >> 4, c = lane & 15; float y[16];
        const LAS float* tdp = TD + bb * 256;
#pragma unroll
        for (int i = 0; i < 16; ++i) { float a[16];
#pragma unroll
            for (int j4 = 0; j4 < 4; ++j4) if (4 * j4 < i) { const f32x4 t = *(const LAS f32x4*)(tdp + i * 16 + 4 * j4); a[4 * j4] = t.x; a[4 * j4 + 1] = t.y; a[4 * j4 + 2] = t.z; a[4 * j4 + 3] = t.w; }
            float s0 = (i == c) ? 1.f : 0.f, s1 = 0.f;
#pragma unroll
            for (int j = 0; j < i; ++j) { if (j & 1) s1 = fmaf(-a[j], y[j], s1); else s0 = fmaf(-a[j], y[j], s0); }
            y[i] = s0 + s1;
            const int pc = 8 * (c >> 2) + (c & 3);
            TB[(bb * 16 + i) * 32 + pc] = f2bf(y[i]); TB[(bb * 16 + i) * 32 + pc + 4] = 0; }
    }
    __syncthreads();
    {
        const int cl = lane & 15, q = lane >> 4;
        const f32x4 zero4 = {0.f, 0.f, 0.f, 0.f};
        const LAS unsigned char* amn = (const LAS unsigned char*)AMN + cl * 160 + q * 16;
        const LAS unsigned char* tbp = (const LAS unsigned char*)TB + cl * 64 + q * 16;
#pragma unroll 1
        for (int nt = 0; nt < 2; ++nt) {
            const int col = 32 * wave + 16 * nt + cl;
            f32x4 X[4];
#pragma unroll
            for (int b4 = 0; b4 < 4; ++b4) {
                f32x4 R;
#pragma unroll
                for (int r = 0; r < 4; ++r) R[r] = RHS[(16 * b4 + 4 * q + r) * 256 + col];
                if (b4 == 1) R = MFMA16(*(const LAS bf16x8*)(amn + 16 * 160), pack8(X[0], zero4), R);
                if (b4 == 2) R = MFMA16(*(const LAS bf16x8*)(amn + 32 * 160), pack8(X[0], X[1]), R);
                if (b4 == 3) { R = MFMA16(*(const LAS bf16x8*)(amn + 48 * 160), pack8(X[0], X[1]), R); R = MFMA16(*(const LAS bf16x8*)(amn + 48 * 160 + 64), pack8(X[2], zero4), R); }
                X[b4] = MFMA16(*(const LAS bf16x8*)(tbp + b4 * 16 * 64), pack8(R, zero4), zero4);
            }
            if (wave < 4) {
#pragma unroll
                for (int b4 = 0; b4 < 4; ++b4) *(v2u*)(o_ut + col * 64 + 16 * b4 + 4 * q) = (v2u){pk2(X[b4][0], X[b4][1]), pk2(X[b4][2], X[b4][3])};
            } else { const int pk = kperm(col - 128);
#pragma unroll
                for (int b4 = 0; b4 < 4; ++b4)
#pragma unroll
                    for (int r = 0; r < 4; ++r) o_w[(16 * b4 + 4 * q + r) * 128 + pk] = f2bf(X[b4][r]); }
        }
    }
    __syncthreads();
}

constexpr int SB_W = 0, SB_QG = 18432, SB_KGT = 36864, SB_QK = 57344, SB_UT = 67584, SB_SIZE = 76800;
__device__ __forceinline__ bf16x8 ldfrag(const LAS unsigned char* p) { return *(const LAS bf16x8*)p; }
#define SCAN_BAR() asm volatile("s_waitcnt lgkmcnt(0)\n\ts_barrier" ::: "memory")
__device__ __forceinline__ void scan_half(LAS unsigned char* lds, int half, int nsteps, int nrows, const bf16* gmain, size_t main_stride, const bf16* gqk, size_t qk_stride, const float* DLp,
                                          const float* S0, float* Sout, bf16* MX  , unsigned dumpoff  , gu32* prog, int tid, int lane, int wave) {
    if (wave >= 4) {
        const int lt = tid - 256;
        const unsigned v16 = (unsigned)lt * 16u;
        v4u A[16], B[16];
#define LD_LOAD(R, nn) do { const char* mp_ = (const char*)(gmain + (size_t)(nn) * main_stride); \
            _Pragma("unroll") for (int k = 0; k < 12; ++k) R[k] = *(const v4u*)(mp_ + k * 4096 + v16); \
            _Pragma("unroll") for (int k = 0; k < 2; ++k) R[12 + k] = *(const v4u*)((const char*)(gqk + (size_t)(nn) * qk_stride) + k * 4096 + v16); \
            _Pragma("unroll") for (int k = 0; k < 2; ++k) R[14 + k] = *(const v4u*)(mp_ + 49152 + half * 8192 + k * 4096 + v16); } while (0)
#define LD_WRITE(R, buf) do { LAS unsigned char* bb_ = lds + (buf) * SB_SIZE; \
            _Pragma("unroll") for (int k = 0; k < 12; ++k) { const int a_ = k >> 2, within_ = lt + 256 * (k & 3); \
                const int dst_ = (a_ == 0 ? SB_W + (within_ >> 4) * 288 + (within_ & 15) * 16 : a_ == 1 ? SB_QG + (within_ >> 4) * 288 + (within_ & 15) * 16 : SB_KGT + (within_ >> 3) * 160 + (within_ & 7) * 16); \
                *(LAS v4u*)(bb_ + dst_) = R[k]; } \
            _Pragma("unroll") for (int k = 0; k < 2; ++k) { const int within_ = lt + 256 * k; *(LAS v4u*)(bb_ + SB_QK + (within_ >> 3) * 160 + (within_ & 7) * 16) = R[12 + k]; } \
            _Pragma("unroll") for (int k = 0; k < 2; ++k) { const int within_ = lt + 256 * k; *(LAS v4u*)(bb_ + SB_UT + (within_ >> 3) * 144 + (within_ & 7) * 16) = R[14 + k]; } } while (0)
        LD_LOAD(A, 0);
        if (nsteps > 1) LD_LOAD(B, 1);
        LD_WRITE(A, 0);
        asm volatile("" ::: "memory");
        if (nsteps > 2) LD_LOAD(A, 2);
        SCAN_BAR();
#pragma unroll 1
        for (int n = 0; n < nsteps; n += 2) {
            if (n + 1 < nsteps) { LD_WRITE(B, 1); asm volatile("" ::: "memory"); if (n + 3 < nsteps) LD_LOAD(B, n + 3); SCAN_BAR(); }
            if (n + 2 < nsteps) { LD_WRITE(A, 0); asm volatile("" ::: "memory"); if (n + 4 < nsteps) LD_LOAD(A, n + 4); SCAN_BAR(); }
        }
#undef LD_LOAD
#undef LD_WRITE
    } else {
        const int cl = lane & 15, q = lane >> 4, cw = wave, c0 = 64 * half + 16 * cw;
        f32x4 S[8];
#pragma unroll
        for (int mt = 0; mt < 8; ++mt)
#pragma unroll
            for (int r = 0; r < 4; ++r) S[mt][r] = S0 ? S0[(16 * mt + 4 * q + r) * 128 + c0 + cl] : 0.f;
        const unsigned laneoff = (unsigned)q * (4u * D * 2u) + (unsigned)(c0 + cl) * 2u;
        dumpoff += (unsigned)lane * 2u;
        const int dlbits = (int)__float_as_uint(lane < nsteps ? DLp[lane] : 1.f);
#define SCAN_STEP(n, buf) do { \
        SCAN_BAR();                                            \
        if (prog && tid == 0) __hip_atomic_store(prog, (unsigned)(n) + 1u, RLX_AGENT); \
        const LAS unsigned char* bb_ = lds + (buf) * SB_SIZE; \
        const float dl_ = __uint_as_float(__builtin_amdgcn_readlane(dlbits, (n))); \
        bf16x8 Sb_[4]; \
        _Pragma("unroll") for (int ks = 0; ks < 4; ++ks) Sb_[ks] = pack8(S[2 * ks], S[2 * ks + 1]); \
        f32x4 vn_[4], o_[4]; \
        _Pragma("unroll") for (int mt = 0; mt < 4; ++mt) { \
            f32x4 aw_ = {0.f, 0.f, 0.f, 0.f}, ao_ = {0.f, 0.f, 0.f, 0.f}; \
            const LAS unsigned char* wp_ = bb_ + SB_W + (16 * mt + cl) * 288 + q * 16; const LAS unsigned char* qp_ = bb_ + SB_QG + (16 * mt + cl) * 288 + q * 16; \
            _Pragma("unroll") for (int ks = 0; ks < 4; ++ks) { aw_ = MFMA16(ldfrag(wp_ + ks * 64), Sb_[ks], aw_); ao_ = MFMA16(ldfrag(qp_ + ks * 64), Sb_[ks], ao_); } \
            const v2u uu_ = *(const LAS v2u*)(bb_ + SB_UT + (16 * cw + cl) * 144 + (16 * mt + 4 * q) * 2); \
            vn_[mt] = (f32x4){bflo(uu_.x) - aw_[0], bfhi(uu_.x) - aw_[1], bflo(uu_.y) - aw_[2], bfhi(uu_.y) - aw_[3]}; \
            o_[mt] = ao_; } \
        bf16x8 Vb_[2]; \
        _Pragma("unroll") for (int ks = 0; ks < 2; ++ks) Vb_[ks] = pack8(vn_[2 * ks], vn_[2 * ks + 1]); \
        _Pragma("unroll") for (int mt = 0; mt < 4; ++mt) { const LAS unsigned char* kp_ = bb_ + SB_QK + (16 * mt + cl) * 160 + q * 16; \
            _Pragma("unroll") for (int ks = 0; ks < 2; ++ks) o_[mt] = MFMA16(ldfrag(kp_ + ks * 64), Vb_[ks], o_[mt]); } \
        _Pragma("unroll") for (int mt = 0; mt < 8; ++mt) { S[mt] = S[mt] * dl_; const LAS unsigned char* kp_ = bb_ + SB_KGT + (16 * mt + cl) * 160 + q * 16; \
            _Pragma("unroll") for (int ks = 0; ks < 2; ++ks) S[mt] = MFMA16(ldfrag(kp_ + ks * 64), Vb_[ks], S[mt]); } \
        _Pragma("unroll") for (int mt = 0; mt < 4; ++mt) _Pragma("unroll") for (int r = 0; r < 4; ++r) { const int row_ = 16 * mt + 4 * q + r; \
            const unsigned off_ = (row_ < nrows) ? (unsigned)(n) * (64u * D * 2u) + (unsigned)(16 * mt + r) * (D * 2u) + laneoff : dumpoff; \
            *(bf16*)((char*)MX + off_) = f2bf(o_[mt][r]); } \
    } while (0)
#pragma unroll 1
        for (int n = 0; n < nsteps; n += 2) {
            SCAN_STEP(n, 0);
            if (n + 1 < nsteps) SCAN_STEP(n + 1, 1);
        }
#undef SCAN_STEP
#pragma unroll
        for (int mt = 0; mt < 8; ++mt)
#pragma unroll
            for (int r = 0; r < 4; ++r) Sout[(16 * mt + 4 * q + r) * 128 + c0 + cl] = S[mt][r];
    }
    __syncthreads();
}
#undef SCAN_BAR

__device__ __forceinline__ void scan_helper(gu32* prog, const bf16* gmain, size_t main_stride, const bf16* gqk, size_t qk_stride, float* sink, int tid, int lane) {
    constexpr int AHEAD = 6;
    unsigned acc = 0u;
    const unsigned vmain = (unsigned)tid * 128u, vqk = (unsigned)(tid & 63) * 128u;
#pragma unroll 1
    for (int n = 0; n < 64; ++n) {
        if (n > AHEAD) {
            if (lane == 0) { unsigned sp = 0u; while ((int)__hip_atomic_load(prog, RLX_AGENT) < n - AHEAD && ++sp < 200000u) __builtin_amdgcn_s_sleep(16); }
        }
        const unsigned a = *(const unsigned*)((const char*)(gmain + (size_t)n * main_stride) + vmain);
        const unsigned c = *(const unsigned*)((const char*)(gqk + (size_t)n * qk_stride) + vqk);
        acc ^= a ^ c;
    }
    if (acc == 0x9e3779b9u) *sink = 0.f;
}

__device__ __forceinline__ void phase_gdn_finish(const bf16* P, bf16* MIXIN, const float* gnw, int gw, int NGW, int lane) {
    const f32x2 gw2 = *(const f32x2*)(gnw + 2 * lane);
    for (int it = gw; it < M * 4; it += NGW) {
        const int m = it >> 2, h = it & 3;
        unsigned* op = (unsigned*)(MIXIN + (size_t)m * D + h * 128) + lane;
        const unsigned ow = *op, zw = *((const unsigned*)(P + (size_t)m * NIN + PC_Z + h * 128) + lane);
        const float o0 = bflo(ow), o1 = bfhi(ow), z0 = bflo(zw), z1 = bfhi(zw);
        const float rstd = rsq_(wave_sum(o0 * o0 + o1 * o1) * (1.f / 128.f) + EPS);
        *op = pk2(o0 * rstd * gw2.x * z0 * sigmoidf_(z0), o1 * rstd * gw2.y * z1 * sigmoidf_(z1));
    }
}

constexpr int ATT_WAVE_LDS = 18944;
constexpr float LOG2E = 1.4426950408889634f;
typedef short v4i16_t __attribute__((ext_vector_type(4)));
__device__ __forceinline__ s16x4 vtr(const LAS unsigned char* p) { return __builtin_bit_cast(s16x4, __builtin_amdgcn_ds_read_tr16_b64_v4i16((LAS v4i16_t*)p)); }
__device__ __forceinline__ void attn_item(LAS unsigned char* wl, int it, int& bt_h, const bf16* P, const float* ck, const float* cv, const float* relb, const float* anw, bf16* MIXIN, int lane) {
    LAS unsigned char* KL = wl; LAS unsigned char* VL = wl + 9216; LAS float* SC = (LAS float*)(wl + 17408); LAS float* BT = (LAS float*)(wl + 17664);
    const int r32 = lane & 31, hi = lane >> 5;
    const bool sample = it < 256;
    int b, h, n = 0, half = 0, mq, t0, t1;
    if (sample) { b = it >> 3; h = it & 7; mq = MP + b * 32; t0 = 0; t1 = 9; }
    else { const int idx = it - 256; half = idx & 1; n = (idx >> 1) & 63; h = (idx >> 7) & 7; b = idx >> 10; mq = b * SEQ + n * 64 + half * 32; t0 = n > 8 ? n - 8 : 0; t1 = n + 1; }
    if (h != bt_h) { for (int k = lane; k < 257; k += 64) BT[k] = relb[h * 257 + k] * LOG2E; bt_h = h; }
    bf16x8 qr[4];
#pragma unroll
    for (int d0 = 0; d0 < 4; ++d0) qr[d0] = *(const bf16x8*)(P + (size_t)(mq + r32) * NIN + PC_QB + h * 64 + d0 * 16 + hi * 8);
    float mrun = -1e30f, lrun = 0.f; f32x16 o0, o1;
#pragma unroll
    for (int r = 0; r < 16; ++r) { o0[r] = 0.f; o1[r] = 0.f; }
    const int ti = lane & 15, blk = (lane >> 4) & 1;
    const LAS unsigned char* vbase = VL + (4 * hi + (ti >> 2)) * 128 + (blk * 16 + 4 * (ti & 3)) * 2;
    v4u kvr[8], vvr[8];
#define ATT_LOADT(tt) do { const char* tb_ = (const char*)(P + (sample ? (size_t)MP + b * 32 : (size_t)b * SEQ + (size_t)(tt) * 64) * NIN + h * 64); \
        _Pragma("unroll") for (int i8 = 0; i8 < 8; ++i8) { kvr[i8] = *(const v4u*)(tb_ + i8 * (8 * NIN * 2) + PC_KB * 2 + loff); vvr[i8] = *(const v4u*)(tb_ + i8 * (8 * NIN * 2) + PC_VB * 2 + loff); \
            if (sample && i8 >= 4) { kvr[i8] = (v4u){0u, 0u, 0u, 0u}; vvr[i8] = (v4u){0u, 0u, 0u, 0u}; } } } while (0)
    const unsigned loff = (unsigned)(lane >> 3) * (unsigned)(NIN * 2) + (unsigned)(lane & 7) * 16u;
    if (!sample) ATT_LOADT(t0);
#pragma unroll 1
    for (int t = t0; t < t1; ++t) {
        int relbase; bool maskhalf = false;
        if (sample && t < 8) {
            relbase = 512 - 64 * t;
            int lq_ = lane; asm volatile("" : "+v"(lq_));
#pragma unroll
            for (int i8 = 0; i8 < 8; ++i8) { const int idx = i8 * 64 + lq_, key = idx >> 3, c8 = idx & 7; const size_t off = (((size_t)b * 512 + 64 * t + key) * 8 + h) * 64 + c8 * 8;
                const f32x4 ka = *(const f32x4*)(ck + off), kb = *(const f32x4*)(ck + off + 4), va = *(const f32x4*)(cv + off), vb = *(const f32x4*)(cv + off + 4);
                *(LAS v4u*)(KL + key * 144 + c8 * 16) = (v4u){pk2(ka.x, ka.y), pk2(ka.z, ka.w), pk2(kb.x, kb.y), pk2(kb.z, kb.w)};
                *(LAS v4u*)(VL + key * 128 + c8 * 16) = (v4u){pk2(va.x, va.y), pk2(va.z, va.w), pk2(vb.x, vb.y), pk2(vb.z, vb.w)}; }
        } else {
            if (sample) { relbase = 0; maskhalf = true; ATT_LOADT(t); }
            else relbase = 64 * (n - t) + 32 * half;
            int ln_ = lane; asm volatile("" : "+v"(ln_));
            LAS unsigned char* kw_ = KL + (ln_ >> 3) * 144 + (ln_ & 7) * 16; LAS unsigned char* vw_ = VL + (ln_ >> 3) * 128 + (ln_ & 7) * 16;
#pragma unroll
            for (int i8 = 0; i8 < 8; ++i8) { *(LAS v4u*)(kw_ + i8 * 1152) = kvr[i8]; *(LAS v4u*)(vw_ + i8 * 1024) = vvr[i8]; }
            asm volatile("" ::: "memory");
            if (!sample && t + 1 < t1) ATT_LOADT(t + 1);
        }
        f32x16 p0, p1;
#pragma unroll
        for (int r = 0; r < 16; ++r) { p0[r] = 0.f; p1[r] = 0.f; }
#pragma unroll
        for (int d0 = 0; d0 < 4; ++d0) { const bf16x8 k0 = *(const LAS bf16x8*)(KL + r32 * 144 + (2 * d0 + hi) * 16), k1 = *(const LAS bf16x8*)(KL + (32 + r32) * 144 + (2 * d0 + hi) * 16);
            p0 = MFMA32(k0, qr[d0], p0); p1 = MFMA32(k1, qr[d0], p1); }
        const float SC2 = 0.125f * LOG2E;
        if (relbase - 63 >= 128) { const float bc = BT[256];
#pragma unroll
            for (int r = 0; r < 16; ++r) { p0[r] = p0[r] * SC2 + bc; p1[r] = p1[r] * SC2 + bc; } }
        else {
#pragma unroll
            for (int r = 0; r < 16; ++r) { const int rel = relbase + r32 - crow(r, hi); int i0 = (rel > 128 ? 128 : rel) + 128, i1 = (rel - 32 > 128 ? 128 : rel - 32) + 128; i0 = i0 < 0 ? 0 : i0; i1 = i1 < 0 ? 0 : i1;
                p0[r] = p0[r] * SC2 + BT[i0]; p1[r] = p1[r] * SC2 + BT[i1]; } }
        if (maskhalf) {
#pragma unroll
            for (int r = 0; r < 16; ++r) p1[r] = -INFINITY; }
        float mx = fmaxf(p0[0], p1[0]);
#pragma unroll
        for (int r = 1; r < 16; ++r) mx = fmaxf(mx, fmaxf(p0[r], p1[r]));
        mx = fmaxf(mx, __shfl_xor(mx, 32));
        const float mnew = fmaxf(mrun, mx); const float alpha = __builtin_amdgcn_exp2f(mrun - mnew); mrun = mnew;
        float sum = 0.f;
#pragma unroll
        for (int r = 0; r < 16; ++r) { p0[r] = __builtin_amdgcn_exp2f(p0[r] - mnew); p1[r] = __builtin_amdgcn_exp2f(p1[r] - mnew); sum += p0[r] + p1[r]; }
        lrun = lrun * alpha + sum;
        if (hi == 0) SC[r32] = alpha;
#pragma unroll
        for (int r = 0; r < 16; ++r) { const float a = SC[crow(r, hi)]; o0[r] *= a; o1[r] *= a; }
#pragma unroll
        for (int s = 0; s < 4; ++s) {
            v4u pw;
            if (s < 2) pw = (v4u){pk2(p0[8 * s + 0], p0[8 * s + 1]), pk2(p0[8 * s + 2], p0[8 * s + 3]), pk2(p0[8 * s + 4], p0[8 * s + 5]), pk2(p0[8 * s + 6], p0[8 * s + 7])};
            else { const int ss = s - 2; pw = (v4u){pk2(p1[8 * ss + 0], p1[8 * ss + 1]), pk2(p1[8 * ss + 2], p1[8 * ss + 3]), pk2(p1[8 * ss + 4], p1[8 * ss + 5]), pk2(p1[8 * ss + 6], p1[8 * ss + 7])}; }
            const bf16x8 pa = __builtin_bit_cast(bf16x8, pw);
            const LAS unsigned char* vp = vbase + (16 * s) * 128;
            const s16x4 a0 = vtr(vp), a1 = vtr(vp + 8 * 128), b0 = vtr(vp + 64), b1 = vtr(vp + 8 * 128 + 64);
            const bf16x8 v0 = {a0[0], a0[1], a0[2], a0[3], a1[0], a1[1], a1[2], a1[3]}, v1 = {b0[0], b0[1], b0[2], b0[3], b1[0], b1[1], b1[2], b1[3]};
            o0 = MFMA32(pa, v0, o0); o1 = MFMA32(pa, v1, o1);
        }
    }
#undef ATT_LOADT
    lrun += __shfl_xor(lrun, 32);
    if (hi == 0) SC[32 + r32] = 1.f / lrun;
    LAS float* OL = (LAS float*)wl;
#pragma unroll
    for (int r = 0; r < 16; ++r) { const int qq = crow(r, hi); const float inv = SC[32 + qq]; OL[qq * 66 + r32] = o0[r] * inv; OL[qq * 66 + 32 + r32] = o1[r] * inv; }
    {
        const int qq = lane >> 1, dh = (lane & 1) * 32; float vals[32]; float ss = 0.f;
#pragma unroll
        for (int k = 0; k < 32; ++k) { vals[k] = OL[qq * 66 + dh + k]; ss += vals[k] * vals[k]; }
        ss += __shfl_xor(ss, 1);
        const float rstd = rsq_(ss * (1.f / 64.f) + EPS);
        bf16* op = MIXIN + (size_t)(mq + qq) * D + 512 + h * 64 + dh;
#pragma unroll
        for (int k4 = 0; k4 < 4; ++k4) { v4u o;
            const f32x4 wa = *(const f32x4*)(anw + dh + 8 * k4), wb = *(const f32x4*)(anw + dh + 8 * k4 + 4);
            o.x = pk2(vals[8 * k4 + 0] * rstd * wa.x, vals[8 * k4 + 1] * rstd * wa.y); o.y = pk2(vals[8 * k4 + 2] * rstd * wa.z, vals[8 * k4 + 3] * rstd * wa.w);
            o.z = pk2(vals[8 * k4 + 4] * rstd * wb.x, vals[8 * k4 + 5] * rstd * wb.y); o.w = pk2(vals[8 * k4 + 6] * rstd * wb.z, vals[8 * k4 + 7] * rstd * wb.w);
            *(v4u*)(op + 8 * k4) = o; }
    }
}

__device__ __forceinline__ void load_gemm_row(f32x4 (&v)[4], const bf16* Yb, const float* slab, int ns, int m, int lane) {
    if (m < MP) {
#pragma unroll
        for (int j = 0; j < 4; ++j) { const v2u t = ((const v2u*)(Yb + (size_t)m * D))[lane + 64 * j]; v[j] = (f32x4){bflo(t.x), bfhi(t.x), bflo(t.y), bfhi(t.y)}; }
    } else {
#pragma unroll
        for (int j = 0; j < 4; ++j) v[j] = (f32x4){0.f, 0.f, 0.f, 0.f};
        for (int k = 0; k < ns; ++k) {
#pragma unroll
            for (int j = 0; j < 4; ++j) v[j] += ((const f32x4*)(slab + ((size_t)k * MS + (m - MP)) * D))[lane + 64 * j]; }
    }
}
__device__ __forceinline__ void phase_rows1(const float* xp, const float* xs, const bf16* mixb, const float* slab, int ns, const float* w_post, const float* w_pre2, float* out, bf16* U, int gw, int NGW, int lane) {
    for (int m = gw; m < M; m += NGW) {
        const float* xrow = m < MP ? xp + (size_t)m * D : xs + (size_t)(m - MP) * D;
        f32x4 v[4], xv[4]; float s = 0.f;
        load_gemm_row(v, mixb, slab, ns, m, lane);
#pragma unroll
        for (int j = 0; j < 4; ++j) { xv[j] = ((const f32x4*)xrow)[lane + 64 * j]; s += (v[j].x * v[j].x + v[j].y * v[j].y) + (v[j].z * v[j].z + v[j].w * v[j].w); }
        const float rstd = rsq_(wave_sum(s) * (1.f / D) + EPS); float s2 = 0.f;
#pragma unroll
        for (int j = 0; j < 4; ++j) { const f32x4 g = ((const f32x4*)w_post)[lane + 64 * j]; v[j] = xv[j] + v[j] * rstd * g; ((f32x4*)(out + (size_t)m * D))[lane + 64 * j] = v[j];
            s2 += (v[j].x * v[j].x + v[j].y * v[j].y) + (v[j].z * v[j].z + v[j].w * v[j].w); }
        const float rstd2 = rsq_(wave_sum(s2) * (1.f / D) + EPS);
        unsigned long long* o8 = (unsigned long long*)(U + (size_t)m * D) + lane;
#pragma unroll
        for (int j = 0; j < 4; ++j) { const f32x4 g = ((const f32x4*)w_pre2)[lane + 64 * j]; const f32x4 t = v[j] * rstd2 * g;
            o8[64 * j] = (unsigned long long)pk2(t.x, t.y) | ((unsigned long long)pk2(t.z, t.w) << 32); }
    }
}
__device__ __forceinline__ void phase_rows2(const bf16* dnb, const float* slab, int ns, const float* w, float* out, int gw, int NGW, int lane) {
    for (int m = gw; m < M; m += NGW) {
        f32x4 v[4]; float s = 0.f;
        load_gemm_row(v, dnb, slab, ns, m, lane);
#pragma unroll
        for (int j = 0; j < 4; ++j) s += (v[j].x * v[j].x + v[j].y * v[j].y) + (v[j].z * v[j].z + v[j].w * v[j].w);
        const float rstd = rsq_(wave_sum(s) * (1.f / D) + EPS);
#pragma unroll
        for (int j = 0; j < 4; ++j) { const f32x4 g = ((const f32x4*)w)[lane + 64 * j]; f32x4* op = (f32x4*)(out + (size_t)m * D) + lane + 64 * j; *op = *op + v[j] * rstd * g; }
    }
}
__device__ __forceinline__ float gelu_tanh(float x) { const float y = 0.7978845608028654f * (x + 0.044715f * x * x * x); const float t = 1.f - 2.f * __builtin_amdgcn_rcpf(1.f + __builtin_amdgcn_exp2f(2.8853900817779268f * y)); return 0.5f * x * (1.f + t); }
__device__ __forceinline__ void unpack8(const v4u t, float (&g)[8]) { g[0] = bflo(t.x); g[1] = bfhi(t.x); g[2] = bflo(t.y); g[3] = bfhi(t.y); g[4] = bflo(t.z); g[5] = bfhi(t.z); g[6] = bflo(t.w); g[7] = bfhi(t.w); }
__device__ __forceinline__ void phase_h(const bf16* Gt, bf16* UP, const float* st_ffn, const float* cw, const float* cb, float* out, int gtid, int nth) {
    constexpr int CG = FF / 8, RB = 16, NRB = M / RB;
    for (int task = gtid; task < NRB * CG; task += nth) {
        const int rb = task / CG, c = (task % CG) * 8; const int m0 = rb * RB;
        const bool smp = m0 >= MP; const int tl = smp ? 32 : SEQ;
        int tpos = smp ? ((m0 - MP) & 31) : (m0 & (SEQ - 1)); const int bsm = smp ? ((m0 - MP) >> 5) : (m0 >> 12);
        float w0[8], w1[8], w2[8], bb[8];
        { const f32x4 a = *(const f32x4*)(cw + c), b2 = *(const f32x4*)(cw + c + 4); w0[0] = a.x; w0[1] = a.y; w0[2] = a.z; w0[3] = a.w; w0[4] = b2.x; w0[5] = b2.y; w0[6] = b2.z; w0[7] = b2.w; }
        { const f32x4 a = *(const f32x4*)(cw + FF + c), b2 = *(const f32x4*)(cw + FF + c + 4); w1[0] = a.x; w1[1] = a.y; w1[2] = a.z; w1[3] = a.w; w1[4] = b2.x; w1[5] = b2.y; w1[6] = b2.z; w1[7] = b2.w; }
        { const f32x4 a = *(const f32x4*)(cw + 2 * FF + c), b2 = *(const f32x4*)(cw + 2 * FF + c + 4); w2[0] = a.x; w2[1] = a.y; w2[2] = a.z; w2[3] = a.w; w2[4] = b2.x; w2[5] = b2.y; w2[6] = b2.z; w2[7] = b2.w; }
        { const f32x4 a = *(const f32x4*)(cb + c), b2 = *(const f32x4*)(cb + c + 4); bb[0] = a.x; bb[1] = a.y; bb[2] = a.z; bb[3] = a.w; bb[4] = b2.x; bb[5] = b2.y; bb[6] = b2.z; bb[7] = b2.w; }
        float g0[8], g1[8];
        if (tpos >= 2) { unpack8(*(const v4u*)(Gt + (size_t)(m0 - 2) * FF + c), g0); unpack8(*(const v4u*)(Gt + (size_t)(m0 - 1) * FF + c), g1); }
        else if (smp) {
#pragma unroll
            for (int e = 0; e < 8; ++e) { g0[e] = st_ffn[((size_t)bsm * 2 + 0) * FF + c + e]; g1[e] = st_ffn[((size_t)bsm * 2 + 1) * FF + c + e]; } }
        else {
#pragma unroll
            for (int e = 0; e < 8; ++e) { g0[e] = 0.f; g1[e] = 0.f; } }
#pragma unroll 4
        for (int i = 0; i < RB; ++i) {
            const int m = m0 + i;
            float g2[8], up[8], hv[8];
            unpack8(*(const v4u*)(Gt + (size_t)m * FF + c), g2); unpack8(*(const v4u*)(UP + (size_t)m * FF + c), up);
#pragma unroll
            for (int e = 0; e < 8; ++e) { const float x = w0[e] * g0[e] + w1[e] * g1[e] + w2[e] * g2[e] + bb[e]; hv[e] = gelu_tanh(x) * up[e]; }
            *(v4u*)(UP + (size_t)m * FF + c) = (v4u){pk2(hv[0], hv[1]), pk2(hv[2], hv[3]), pk2(hv[4], hv[5]), pk2(hv[6], hv[7])};
            if (tpos + i >= tl - 2) { const int k = tpos + i - (tl - 2); float* op = (smp ? out + O_FCS : out + O_FCP) + ((size_t)bsm * 2 + k) * FF + c;
#pragma unroll
                for (int e = 0; e < 8; ++e) op[e] = g2[e]; }
#pragma unroll
            for (int e = 0; e < 8; ++e) { g0[e] = g1[e]; g1[e] = g2[e]; }
        }
    }
}

#ifndef MK_N_LAUNCHES
#define MK_N_LAUNCHES 1
#endif
constexpr int NPH = 11;
constexpr int N_LAUNCHES = MK_N_LAUNCHES;
struct Args { const float* in[23]; float* out; unsigned char* ws; int ph_lo, ph_hi, li, pad; };
__global__ void __launch_bounds__(NWAVES * 64, 2) hybrid_fwd(Args args) {
    extern __shared__ __attribute__((aligned(16))) unsigned char lds_raw[];
    LAS unsigned char* lds = (LAS unsigned char*)lds_raw;
    volatile LAS unsigned* MISC = (volatile LAS unsigned*)(lds + MISC_OFF);
    const int tid = threadIdx.x, lane = tid & 63, wave = __builtin_amdgcn_readfirstlane(tid >> 6);
    const int G = gridDim.x; const int bx = blockIdx.x; const int vcu = (G % 8 == 0) ? (bx % 8) * (G / 8) + bx / 8 : bx;
    unsigned char* ws = args.ws; float* out = args.out;
    gu32* ctl = (gu32*)(ws + WS_CTL);
#define x_prompt (args.in[0])
#define x_sample (args.in[1])
#define cache_k (args.in[2])
#define cache_v (args.in[3])
#define state_delta (args.in[4])
#define state_qkv (args.in[5])
#define state_ffn (args.in[6])
#define norm_mix_pre (args.in[7])
#define w_in (args.in[8])
#define qkv_conv_w (args.in[9])
#define a_log (args.in[10])
#define dt_bias (args.in[11])
#define gdn_norm_w (args.in[12])
#define rel_bias (args.in[13])
#define attn_norm_w (args.in[14])
#define w_out (args.in[15])
#define norm_mix_post (args.in[16])
#define norm_ffn_pre (args.in[17])
#define w_gate_up (args.in[18])
#define ffn_conv_w (args.in[19])
#define ffn_conv_b (args.in[20])
#define w_down (args.in[21])
#define norm_ffn_post (args.in[22])
#define Win_t ((bf16*)(ws + WS_WIN))
#define Wout_t ((bf16*)(ws + WS_WOUT))
#define Wgu_t ((bf16*)(ws + WS_WGU))
#define Wdn_t ((bf16*)(ws + WS_WDN))
#define AB ((float*)(ws + WS_AB))
#define DL ((float*)(ws + WS_DL))
#define U ((bf16*)(ws + WS_U))
#define GQK ((bf16*)(ws + WS_GQK))
#define GS ((bf16*)(ws + WS_GS))
#define P ((bf16*)(ws + WS_P))
#define MIXIN ((bf16*)(ws + WS_MIXIN))
#define MIXB ((bf16*)(ws + WS_P))
#define SLAB1 ((float*)(ws + WS_P + 34 * MiB))
#define DOWNB ((bf16*)(ws + WS_U))
#define SLAB2 ((float*)(ws + WS_G))
#define Gt ((bf16*)(ws + WS_G))
#define UP ((bf16*)(ws + WS_UP))
#define GMAIN ((bf16*)out)

    for (int u = tid; u < 64; u += NWAVES * 64) ((LAS unsigned*)(lds + MISC_OFF))[u] = 0u;
    __syncthreads();
    XcdBarrier bar; bar.bar = (unsigned*)(ctl + CW_BAR); bar.x = 0; bar.st = nullptr;
    if (N_LAUNCHES == 1) bar = xcd_barrier_post((unsigned*)(ctl + CW_BAR), MISC + 8);
#define GRID_BAR() do { if (N_LAUNCHES == 1) xcd_barrier(bar); } while (0)
    const int lo = args.ph_lo, hi_ = args.ph_hi;
#define IN(k) (lo <= (k) && (k) < hi_)
#define BOTH(k) (IN(k) && IN((k) + 1))
    const int gw = vcu * NWAVES + wave, NGW = G * NWAVES, gtid = bx * (NWAVES * 64) + tid, nth = G * NWAVES * 64;

    if (IN(0)) { phase_prologue(lds, x_prompt, x_sample, norm_mix_pre, w_in, w_out, w_gate_up, w_down, ws, vcu, G, tid, lane, wave); if (BOTH(0)) GRID_BAR(); }

    if (IN(1)) {
        pg8::Gemm g{U, Win_t, M, NIN, D, D}; pg8::StaticOrder S; S.init(M, NIN, G, bx);
        pg8::EpiBf16<0> E{P, NIN, nullptr, 0, 0, 1.f};
        pg8::gemm_phase<pg8::EpiBf16<0>, pg8::StaticOrder, true, true>(lds, g, S, E);
        if (BOTH(1)) GRID_BAR();
    }

    if (IN(2)) {
        phase_copy_outputs(P, out, gtid, nth);
        for (int u = bx; u < 1152; u += G) gdn_pre_unit(lds, u, P, AB, state_qkv, qkv_conv_w, a_log, dt_bias, GMAIN, GQK, GS, DL, tid, lane, wave);
        if (BOTH(2)) GRID_BAR();
    }

    if (IN(3)) {
        if (bx < 32) {
            const int sidx = bx & 15, half = bx >> 4; const int b = sidx >> 2, h = sidx & 3; const int u0 = b * 256 + h * 64; const size_t m0 = (size_t)b * SEQ;
            scan_half(lds, half, 64, 64, GMAIN + (size_t)u0 * 32768, 32768, GQK + (size_t)u0 * 4096, 4096, DL + u0, nullptr, out + O_DP + (size_t)(b * 4 + h) * 16384,
                      MIXIN + m0 * D + h * 128, (unsigned)(((size_t)M * D - (m0 * D + h * 128)) * 2), half == 0 ? ctl + 1024 + 64 * sidx : (gu32*)nullptr, tid, lane, wave);
        } else if (bx >= G - 16) {
            const int sidx = bx - (G - 16); const int b = sidx >> 2, h = sidx & 3; const int u0 = b * 256 + h * 64;
            scan_helper(ctl + 1024 + 64 * sidx, GMAIN + (size_t)u0 * 32768, 32768, GQK + (size_t)u0 * 4096, 4096, (float*)(ws + WS_DL + 65536), tid, lane);
        } else {
            for (int hu = bx - 32; hu < 256; hu += (G - 48)) {
                const int su = hu >> 1, half = hu & 1; const int b = su >> 2, h = su & 3; const size_t m0 = (size_t)MP + b * 32; const bf16* base = GS + (size_t)su * 36864;
                scan_half(lds, half, 1, 32, base, 0, base + 32768, 0, DL + 1024 + su, state_delta + (size_t)su * 16384, out + O_DS + (size_t)su * 16384,
                          MIXIN + m0 * D + h * 128, (unsigned)(((size_t)M * D - (m0 * D + h * 128)) * 2), (gu32*)nullptr, tid, lane, wave);
            }
            LAS unsigned char* wl = lds + wave * ATT_WAVE_LDS;
            int bt_h = -1;
            for (int it = (bx - 32) * NWAVES + wave; it < 4352; it += (G - 48) * NWAVES) attn_item(wl, it, bt_h, P, cache_k, cache_v, rel_bias, attn_norm_w, MIXIN, lane);
        }
        if (BOTH(3)) GRID_BAR();
    }

    if (IN(4)) { phase_gdn_finish(P, MIXIN, gdn_norm_w, gw, NGW, lane); if (BOTH(4)) GRID_BAR(); }

    if (IN(5)) {
        { pg8::Gemm g{MIXIN, Wout_t, MP, D, D, D}; pg8::StaticOrder S; S.init(MP, D, G, bx);
          pg8::EpiBf16<0> E{MIXB, D, nullptr, 0, 0, 1.f};
          pg8::gemm_phase<pg8::EpiBf16<0>, pg8::StaticOrder, true, true>(lds, g, S, E); }
        { pg8::Gemm g{MIXIN, Wout_t, M, D, 256, D}; pg8::SplitOrder S; S.init(MP / 256, MS / 256, D / 256, 4, bx);
          pg8::EpiF32 E{SLAB1 - (size_t)MP * D, D, (size_t)MS * D};
          pg8::gemm_phase<pg8::EpiF32, pg8::SplitOrder, true, true>(lds, g, S, E); }
        if (BOTH(5)) GRID_BAR();
    }

    if (IN(6)) { phase_rows1(x_prompt, x_sample, MIXB, SLAB1, 4, norm_mix_post, norm_ffn_pre, out, U, gw, NGW, lane); if (BOTH(6)) GRID_BAR(); }

    if (IN(7)) {
        pg8::Gemm g{U, Wgu_t, M, 2 * FF, D, D}; pg8::StaticOrder S; S.init(M, 2 * FF, G, bx);
        pg8::EpiBf16<0> E{Gt, FF, nullptr, FF, (size_t)M * FF, 1.f};
        pg8::gemm_phase<pg8::EpiBf16<0>, pg8::StaticOrder, true, true>(lds, g, S, E);
        if (BOTH(7)) GRID_BAR();
    }

    if (IN(8)) { phase_h(Gt, UP, state_ffn, ffn_conv_w, ffn_conv_b, out, gtid, nth); if (BOTH(8)) GRID_BAR(); }

    if (IN(9)) {
        { pg8::Gemm g{UP, Wdn_t, MP, D, FF, FF}; pg8::StaticOrder S; S.init(MP, D, G, bx);
          pg8::EpiBf16<0> E{DOWNB, D, nullptr, 0, 0, 1.f};
          pg8::gemm_phase<pg8::EpiBf16<0>, pg8::StaticOrder, true, true>(lds, g, S, E); }
        { pg8::Gemm g{UP, Wdn_t, M, D, 256, FF}; pg8::SplitOrder S; S.init(MP / 256, MS / 256, D / 256, 11, bx);
          pg8::EpiF32 E{SLAB2 - (size_t)MP * D, D, (size_t)MS * D};
          pg8::gemm_phase<pg8::EpiF32, pg8::SplitOrder, true, true>(lds, g, S, E); }
        if (BOTH(9)) GRID_BAR();
    }

    if (IN(10)) phase_rows2(DOWNB, SLAB2, 11, norm_ffn_post, out, gw, NGW, lane);
#undef IN
#undef BOTH
#undef GRID_BAR
}

extern "C" void kernel_launch(void* const* d_in, const int* in_sizes, int n_in, void* d_out, int out_size, void* d_ws, size_t ws_size, hipStream_t stream) {
    static int grid = 0;
    if (grid == 0) {
        if (n_in != 23 || out_size != 23699456 || ws_size < WS_END) { fprintf(stderr, "kernel_launch: unexpected shapes (n_in %d, out %d, ws %zu); nothing launched\n", n_in, out_size, ws_size); grid = -1; return; }
        int dev = 0, cus = 0, per_cu = 0;
        if (hipGetDevice(&dev) != hipSuccess || hipDeviceGetAttribute(&cus, hipDeviceAttributeMultiprocessorCount, dev) != hipSuccess) { grid = -1; return; }
        if (hipFuncSetAttribute((const void*)hybrid_fwd, hipFuncAttributeMaxDynamicSharedMemorySize, LDS_BYTES) != hipSuccess) { fprintf(stderr, "kernel_launch: hipFuncSetAttribute failed\n"); grid = -1; return; }
        if (hipOccupancyMaxActiveBlocksPerMultiprocessor(&per_cu, (const void*)hybrid_fwd, NWAVES * 64, LDS_BYTES) != hipSuccess || per_cu < 1) fprintf(stderr, "kernel_launch: occupancy query reports %d\n", per_cu);
        (void)hipGetLastError();
        grid = cus;
    }
    if (grid < 0) return;
    if (hipMemsetAsync((char*)d_ws + WS_CTL, 0, CTL_ZERO_BYTES, stream) != hipSuccess) { fprintf(stderr, "kernel_launch: memset failed\n"); return; }
    Args a{};
    for (int i = 0; i < 23; ++i) a.in[i] = (const float*)d_in[i];
    a.out = (float*)d_out; a.ws = (unsigned char*)d_ws;
    if (N_LAUNCHES == 1) { a.ph_lo = 0; a.ph_hi = NPH; a.li = 0; hipLaunchKernelGGL(hybrid_fwd, dim3(grid), dim3(NWAVES * 64), LDS_BYTES, stream, a); }
    else for (int li = 0; li < NPH; ++li) { a.ph_lo = li; a.ph_hi = li + 1; a.li = li; hipLaunchKernelGGL(hybrid_fwd, dim3(grid), dim3(NWAVES * 64), LDS_BYTES, stream, a);
#ifdef PROBE_DUP
        if (li == PROBE_DUP) hipLaunchKernelGGL(hybrid_fwd, dim3(grid), dim3(NWAVES * 64), LDS_BYTES, stream, a);
#endif
    }
    const hipError_t le = hipPeekAtLastError();
    if (le != hipSuccess) fprintf(stderr, "kernel_launch: launch failed: %s\n", hipGetErrorName(le));
}
```

```cpp
#include <hip/hip_runtime.h>
#include <cstdio>
#include <cstdint>
namespace pg8 {
#define PG8_LAS __attribute__((address_space(3)))
typedef unsigned short bf16_t;
typedef short bf16x8 __attribute__((ext_vector_type(8)));
typedef float f32x4 __attribute__((ext_vector_type(4)));
typedef unsigned u32x4 __attribute__((ext_vector_type(4)));
constexpr int BM = 256, BK = 64, HALF = 128, HTB = HALF * BK * 2  , STAGE_BYTES = 8 * HTB, NXCD = 8, WGM = 8;

__host__ __device__ __forceinline__ int lds_byte(int r, int c) { const int st = (r >> 4) * 2 + (c >> 5), rr = r & 15, cc = c & 31, ob = rr * 64 + cc * 2; return st * 1024 + (ob ^ (((ob >> 9) & 1) << 5)); }
__host__ __device__ __forceinline__ void stage_rc(int b, int& R, int& C) { const int st = b / 1024, sb = b % 1024, swz = sb ^ (((sb >> 9) & 1) << 5); R = (st >> 1) * 16 + swz / 64; C = (st & 1) * 32 + (swz % 64) / 2; }
__host__ __device__ __forceinline__ int perm32(int rho) { const int n = rho >> 4, i = rho & 15; return 8 * (i >> 2) + 4 * n + (i & 3); }

struct Unit { int pm, pn, kq; };
struct Gemm { const bf16_t* A; const bf16_t* Bt; int M, N, K, ld; };

struct StaticOrder {
    int nM, nN, nwg, G, c;
    __host__ __device__ void init(int M, int N, int G_, int c_) { nM = M / BM; nN = N / BM; nwg = nM * nN; G = G_; c = c_; }
    __host__ __device__ bool next(int i, Unit& u) const {
        const long L = (long)i * G + c; if (L >= nwg) return false;
        int wgid = (int)L; { const int q = nwg / NXCD, r = nwg % NXCD, xcd = wgid % NXCD, off = wgid / NXCD; wgid = (xcd < r ? xcd * (q + 1) : r * (q + 1) + (xcd - r) * q) + off; }
        const int nig = WGM * nN, gid = wgid / nig, fm = gid * WGM, gsz = (nM - fm) < WGM ? (nM - fm) : WGM;
        u.pm = fm + ((wgid % nig) % gsz); u.pn = (wgid % nig) / gsz; u.kq = 0; return true;
    }
    __device__ __forceinline__ void a_ready(const Unit&) const {}
    __device__ __forceinline__ void done(const Unit&) const {}
};

struct SplitOrder {
    int pm0, nN, ns, np, c;
    __host__ __device__ void init(int pm0_, int nP, int nN_, int ns_, int c_) { pm0 = pm0_; nN = nN_; ns = ns_; np = nP * nN_ * ns_; c = c_; }
    __host__ __device__ bool next(int i, Unit& u) const { if (i > 0 || c >= np) return false; const int t = c / ns; u.pm = pm0 + t / nN; u.pn = t % nN; u.kq = c % ns; return true; }
    __device__ __forceinline__ void a_ready(const Unit&) const {}
    __device__ __forceinline__ void done(const Unit&) const {}
};

__device__ __forceinline__ unsigned cvt_pk_bf16(float lo, float hi) { unsigned r; asm volatile("v_cvt_pk_bf16_f32 %0, %1, %2" : "=v"(r) : "v"(lo), "v"(hi)); return r; }
typedef float f32x2 __attribute__((ext_vector_type(2)));
__device__ __forceinline__ f32x2 gelu_pk(f32x2 v) {
    const f32x2 av = __builtin_elementwise_abs(v), d = av * 0.2316418882f + 1.0f;
    f32x2 t; t.x = __builtin_amdgcn_rcpf(d.x); t.y = __builtin_amdgcn_rcpf(d.y);
    f32x2 q = t * 0.5307027145f + (-0.7265760135f); q = q * t + 0.7107068705f; q = q * t + (-0.142248368f); q = q * t + 0.127414796f; q = q * t;
    const f32x2 s = (v * v) * (-0.72134752044f);
    f32x2 e; e.x = __builtin_amdgcn_exp2f(s.x); e.y = __builtin_amdgcn_exp2f(s.y);
    const f32x2 m = v * (q * e), r = v - m;
    f32x2 o; o.x = v.x < 0.f ? m.x : r.x; o.y = v.y < 0.f ? m.y : r.y; return o;
}

template <int ACT  > struct EpiBf16 {
    static constexpr bool PERM = true, AFTER_DRAIN = false; static_assert(ACT == 0 || ACT == 1, "EpiBf16: ACT is 0 (none) or 1 (gelu_pk)");
    bf16_t* O; int ldc; const float* bias; int split_cols; size_t split_stride; float scale0;
    __device__ __forceinline__ void operator()(const f32x4 (&acc)[2][2][4][2], const Unit& u, int wr, int wc, int fr, int fq) const {
        const int row0 = u.pm * BM + wr * 64 + fr; int colt = u.pn * BM; bf16_t* base = O;
        float sc = 1.f; if (split_cols) { const int t = colt / split_cols; base += (size_t)t * split_stride; colt -= t * split_cols; if (t == 0) sc = scale0; }
        const int col0 = colt + wc * 32 + 8 * fq, bcol0 = u.pn * BM + wc * 32 + 8 * fq;
        f32x4 bv[2][2];
#pragma unroll
        for (int bj = 0; bj < 2; ++bj)
#pragma unroll
            for (int n = 0; n < 2; ++n) bv[bj][n] = bias ? *(const f32x4*)(bias + bcol0 + bj * HALF + 4 * n) : (f32x4){0.f, 0.f, 0.f, 0.f};
#pragma unroll
        for (int ai = 0; ai < 2; ++ai)
#pragma unroll
            for (int m = 0; m < 4; ++m) { bf16_t* rowp = base + (size_t)(row0 + ai * HALF + m * 16) * ldc + col0;
#pragma unroll
                for (int bj = 0; bj < 2; ++bj) { f32x4 v0 = acc[ai][bj][m][0] + bv[bj][0], v1 = acc[ai][bj][m][1] + bv[bj][1];
                    if (ACT == 1) { f32x2 a = gelu_pk((f32x2){v0[0], v0[1]}), b = gelu_pk((f32x2){v0[2], v0[3]}), c = gelu_pk((f32x2){v1[0], v1[1]}), d = gelu_pk((f32x2){v1[2], v1[3]});
                        v0 = (f32x4){a.x, a.y, b.x, b.y}; v1 = (f32x4){c.x, c.y, d.x, d.y}; }
                    v0 = v0 * sc; v1 = v1 * sc; u32x4 w; w.x = cvt_pk_bf16(v0[0], v0[1]); w.y = cvt_pk_bf16(v0[2], v0[3]); w.z = cvt_pk_bf16(v1[0], v1[1]); w.w = cvt_pk_bf16(v1[2], v1[3]);
                    *(u32x4*)(rowp + bj * HALF) = w; } }
    }
};

struct EpiF32 {
    static constexpr bool PERM = false, AFTER_DRAIN = false;
    float* O; int ldc; size_t kq_stride;
    __device__ __forceinline__ void operator()(const f32x4 (&acc)[2][2][4][2], const Unit& u, int wr, int wc, int fr, int fq) const {
        const int row0 = u.pm * BM + wr * 64 + fr, col0 = u.pn * BM + wc * 32 + 4 * fq;
#pragma unroll
        for (int ai = 0; ai < 2; ++ai)
#pragma unroll
            for (int m = 0; m < 4; ++m) { float* rowp = O + (size_t)u.kq * kq_stride + (size_t)(row0 + ai * HALF + m * 16) * ldc + col0;
#pragma unroll
                for (int bj = 0; bj < 2; ++bj)
#pragma unroll
                    for (int n = 0; n < 2; ++n) *(f32x4*)(rowp + bj * HALF + n * 16) = acc[ai][bj][m][n]; }
    }
};

template <class Epi, class Sched, bool ALIGN_EPI = false, bool SP2 = false>
__device__ __forceinline__ void gemm_phase(PG8_LAS unsigned char* lds, const Gemm g, const Sched& S, const Epi& E) {
    const int tid = threadIdx.x, wid = __builtin_amdgcn_readfirstlane(tid >> 6), lane = tid & 63, wr = wid >> 2, wc = wid & 3, fr = lane & 15, fq = lane >> 4;
    const int K = g.K, ld = g.ld, nt = K / BK;
    unsigned voffA[2], voffB[2];
#pragma unroll
    for (int i = 0; i < 2; ++i) { int R, C; stage_rc(tid * 16 + i * 8192, R, C); const int Rb = Epi::PERM ? ((R & ~31) + perm32(R & 31)) : R;
        voffA[i] = (unsigned)(R * ld + C) * 2u; voffB[i] = (unsigned)(Rb * ld + C) * 2u; }
    const size_t kstep = (size_t)(BK * 2);
    const size_t hstep = (size_t)HALF * ld * 2;
    const size_t tstep = 2 * hstep;
    const unsigned ldsw = (unsigned)wid * 1024u;
    const int aoff = lds_byte(wr * 64 + fr, fq * 8), boff = lds_byte(wc * 32 + fr, fq * 8);
#define PG8_SA(b, h) (((b) * 2 + (h)) * HTB)
#define PG8_SB(b, h) ((4 + (b) * 2 + (h)) * HTB)
#define PG8_STAGE(bufoff, gbase, voff) do { _Pragma("unroll") for (int _i = 0; _i < 2; ++_i) \
        __builtin_amdgcn_global_load_lds((const unsigned*)((const char*)(gbase) + (voff)[_i]), (PG8_LAS unsigned*)(lds + (bufoff) + ldsw + _i * 8192), 16, 0, 0); } while (0)
#define PG8_LDA(dst, b, h) do { _Pragma("unroll") for (int m = 0; m < 4; ++m) _Pragma("unroll") for (int k = 0; k < 2; ++k) dst[m][k] = *(const PG8_LAS bf16x8*)(lds + PG8_SA(b, h) + aoff + m * 2048 + k * 1024); } while (0)
#define PG8_LDB(dst, b, h) do { _Pragma("unroll") for (int n = 0; n < 2; ++n) _Pragma("unroll") for (int k = 0; k < 2; ++k) dst[n][k] = *(const PG8_LAS bf16x8*)(lds + PG8_SB(b, h) + boff + n * 2048 + k * 1024); } while (0)
#define PG8_MMA(ai, bj, At, Bt) do { __builtin_amdgcn_s_setprio(1); _Pragma("unroll") for (int m = 0; m < 4; ++m) _Pragma("unroll") for (int n = 0; n < 2; ++n) _Pragma("unroll") for (int k = 0; k < 2; ++k) \
        acc[ai][bj][m][n] = __builtin_amdgcn_mfma_f32_16x16x32_bf16(Bt[n][k], At[m][k], acc[ai][bj][m][n], 0, 0, 0); __builtin_amdgcn_s_setprio(0); } while (0)
#define PG8_WAIT_V(n) asm volatile("s_waitcnt vmcnt(" #n ")" ::: "memory")
#define PG8_WAIT_L(n) asm volatile("s_waitcnt lgkmcnt(" #n ")" ::: "memory")
#define PG8_BAR __builtin_amdgcn_s_barrier()
#define PG8_SCHED __builtin_amdgcn_sched_barrier(0)
    Unit cur, nxt; int ui = 0;
    if (!S.next(0, cur)) return;
    f32x4 acc[2][2][4][2];
#pragma unroll
    for (int a = 0; a < 2; ++a)
#pragma unroll
        for (int b = 0; b < 2; ++b)
#pragma unroll
            for (int m = 0; m < 4; ++m)
#pragma unroll
                for (int n = 0; n < 2; ++n) acc[a][b][m][n] = (f32x4){0.f, 0.f, 0.f, 0.f};
    bf16x8 At[4][2], B0[2][2], B1[2][2];
    const size_t kqb = (size_t)K * 2;
    const char* cA = (const char*)g.A + (size_t)cur.pm * tstep + cur.kq * kqb; const char* cB = (const char*)g.Bt + (size_t)cur.pn * tstep + cur.kq * kqb;
    S.a_ready(cur);
    if constexpr (SP2) {
        PG8_STAGE(PG8_SB(0, 0), cB, voffB); PG8_STAGE(PG8_SB(0, 1), cB + hstep, voffB); PG8_STAGE(PG8_SA(0, 0), cA, voffA); PG8_STAGE(PG8_SA(0, 1), cA + hstep, voffA);
        if (wr == 1) PG8_BAR;
        PG8_WAIT_V(2); PG8_BAR;
        PG8_STAGE(PG8_SB(1, 0), cB + kstep, voffB); PG8_STAGE(PG8_SA(1, 0), cA + kstep, voffA); PG8_STAGE(PG8_SB(1, 1), cB + hstep + kstep, voffB);
        PG8_WAIT_V(6); PG8_BAR;
    } else {
        PG8_STAGE(PG8_SB(0, 0), cB, voffB); PG8_STAGE(PG8_SA(0, 0), cA, voffA); PG8_STAGE(PG8_SB(0, 1), cB + hstep, voffB); PG8_STAGE(PG8_SA(0, 1), cA + hstep, voffA);
        if (wr == 1) PG8_BAR;
        PG8_WAIT_V(4); PG8_BAR;
        PG8_STAGE(PG8_SB(1, 0), cB + kstep, voffB); PG8_STAGE(PG8_SA(1, 0), cA + kstep, voffA); PG8_STAGE(PG8_SB(1, 1), cB + hstep + kstep, voffB);
        PG8_WAIT_V(6); PG8_BAR;
    }
    for (;;) {
        const bool has_next = S.next(ui + 1, nxt);
        const char* nA = has_next ? (const char*)g.A + (size_t)nxt.pm * tstep + nxt.kq * kqb : cA; const char* nB = has_next ? (const char*)g.Bt + (size_t)nxt.pn * tstep + nxt.kq * kqb : cB;
        for (int t = 0; t < nt; t += 2) {
            const bool last = (t == nt - 2);
            const char* a1 = cA + (size_t)(t + 1) * kstep;
            const char* a2 = last ? nA : cA + (size_t)(t + 2) * kstep; const char* b2 = last ? nB : cB + (size_t)(t + 2) * kstep;
            const char* a3 = a2 + kstep; const char* b3 = b2 + kstep;
            if (last && has_next) S.a_ready(nxt);
            if constexpr (SP2) {
            PG8_LDB(B0, 0, 0); PG8_LDB(B1, 0, 1); PG8_SCHED; PG8_LDA(At, 0, 0); PG8_STAGE(PG8_SA(1, 1), a1 + hstep, voffA);
            PG8_WAIT_V(8); PG8_WAIT_L(0); PG8_BAR; PG8_MMA(0, 0, At, B0); PG8_MMA(0, 1, At, B1); PG8_BAR; PG8_SCHED;
            PG8_LDA(At, 0, 1); PG8_STAGE(PG8_SB(0, 0), b2, voffB); PG8_STAGE(PG8_SB(0, 1), b2 + hstep, voffB); PG8_STAGE(PG8_SA(0, 0), a2, voffA);
            PG8_WAIT_V(8); PG8_WAIT_L(0); PG8_BAR; PG8_MMA(1, 0, At, B0); PG8_MMA(1, 1, At, B1); PG8_BAR; PG8_SCHED;
            PG8_LDB(B0, 1, 0); PG8_LDB(B1, 1, 1); PG8_SCHED; PG8_LDA(At, 1, 0); PG8_STAGE(PG8_SA(0, 1), a2 + hstep, voffA);
            PG8_WAIT_V(8); PG8_WAIT_L(0); PG8_BAR; PG8_MMA(0, 0, At, B0); PG8_MMA(0, 1, At, B1); PG8_BAR; PG8_SCHED;
            PG8_LDA(At, 1, 1); PG8_STAGE(PG8_SB(1, 0), b3, voffB); PG8_STAGE(PG8_SB(1, 1), b3 + hstep, voffB); PG8_STAGE(PG8_SA(1, 0), a3, voffA);
            PG8_WAIT_V(8); PG8_WAIT_L(0); PG8_BAR; PG8_MMA(1, 0, At, B0); PG8_MMA(1, 1, At, B1); PG8_BAR; PG8_SCHED;
            } else {
            PG8_LDB(B0, 0, 0); PG8_SCHED; PG8_LDA(At, 0, 0); PG8_STAGE(PG8_SA(1, 1), a1 + hstep, voffA);
            PG8_WAIT_L(8); PG8_BAR; PG8_WAIT_L(0); PG8_MMA(0, 0, At, B0); PG8_BAR; PG8_SCHED;
            PG8_LDB(B1, 0, 1); PG8_STAGE(PG8_SB(0, 0), b2, voffB);
            PG8_BAR; PG8_WAIT_L(0); PG8_MMA(0, 1, At, B1); PG8_BAR;
            PG8_LDA(At, 0, 1); PG8_STAGE(PG8_SA(0, 0), a2, voffA);
            PG8_BAR; PG8_WAIT_L(0); PG8_MMA(1, 0, At, B0); PG8_BAR; PG8_SCHED;
            PG8_STAGE(PG8_SB(0, 1), b2 + hstep, voffB);
            PG8_WAIT_V(6); PG8_BAR; PG8_MMA(1, 1, At, B1); PG8_BAR;
            PG8_LDB(B0, 1, 0); PG8_SCHED; PG8_LDA(At, 1, 0); PG8_STAGE(PG8_SA(0, 1), a2 + hstep, voffA);
            PG8_WAIT_L(8); PG8_BAR; PG8_WAIT_L(0); PG8_MMA(0, 0, At, B0); PG8_BAR; PG8_SCHED;
            PG8_LDB(B1, 1, 1); PG8_STAGE(PG8_SB(1, 0), b3, voffB);
            PG8_BAR; PG8_WAIT_L(0); PG8_MMA(0, 1, At, B1); PG8_BAR;
            PG8_LDA(At, 1, 1); PG8_STAGE(PG8_SA(1, 0), a3, voffA);
            PG8_BAR; PG8_WAIT_L(0); PG8_MMA(1, 0, At, B0); PG8_BAR; PG8_SCHED;
            PG8_STAGE(PG8_SB(1, 1), b3 + hstep, voffB);
            PG8_WAIT_V(6); PG8_BAR; PG8_MMA(1, 1, At, B1); PG8_BAR;
            }
        }
        if constexpr (ALIGN_EPI) { if (wr == 0) PG8_BAR; }
        if constexpr (!Epi::AFTER_DRAIN) { E(acc, cur, wr, wc, fr, fq); S.done(cur); }
        if (!has_next) break;
#pragma unroll
        for (int a = 0; a < 2; ++a)
#pragma unroll
            for (int b = 0; b < 2; ++b)
#pragma unroll
                for (int m = 0; m < 4; ++m)
#pragma unroll
                    for (int n = 0; n < 2; ++n) acc[a][b][m][n] = (f32x4){0.f, 0.f, 0.f, 0.f};
        cur = nxt; cA = nA; cB = nB; ++ui;
        if constexpr (ALIGN_EPI) { if (wr == 1) PG8_BAR; }
    }
    PG8_WAIT_V(0);
    if constexpr (!ALIGN_EPI) { if (wr == 0) PG8_BAR; }
    PG8_BAR;
    if constexpr (Epi::AFTER_DRAIN) { E.fused(acc, cur, wr, wc, fr, fq, lds, wid, lane); S.done(cur); }
#undef PG8_SA
#undef PG8_SB
#undef PG8_STAGE
#undef PG8_LDA
#undef PG8_LDB
#undef PG8_MMA
#undef PG8_WAIT_V
#undef PG8_WAIT_L
#undef PG8_BAR
#undef PG8_SCHED
}
}

constexpr int NWAVES = 8;
constexpr int D = 1024, SEQ = 4096, MP = 16384, MS = 1024, M = MP + MS;
constexpr int NIN = 3584, INC = 3592, FF = 2816;
constexpr int PC_Z = 1536, PC_QB = 2048, PC_KB = 2560, PC_VB = 3072;
constexpr float EPS = 1e-6f;
constexpr size_t O_YP = 0, O_YS = 16777216, O_BKP = 17825792, O_BVP = 18874368, O_DP = 19922944, O_QCP = 20185088, O_FCP = 20203520,
                 O_BKS = 20226048, O_BVS = 20750336, O_DS = 21274624, O_QCS = 23371776, O_FCS = 23519232;
constexpr size_t MiB = 1u << 20;
constexpr size_t WS_CTL = 0, CTL_ZERO_BYTES = 1 * MiB;
constexpr size_t WS_WIN = 1 * MiB, WS_WOUT = 8 * MiB, WS_WGU = 10 * MiB, WS_WDN = 21 * MiB;
constexpr size_t WS_AB = 27 * MiB, WS_DL = 27 * MiB + 768 * 1024;
constexpr size_t WS_U = 28 * MiB;
constexpr size_t WS_GQK = WS_U, WS_GS = WS_U + 8 * MiB;
constexpr size_t WS_P = 62 * MiB;
constexpr size_t WS_MIXIN = 181 * MiB;
constexpr size_t WS_G = WS_P, WS_UP = WS_P + (size_t)M * FF * 2;
constexpr size_t WS_END = 256 * MiB;
static_assert(WS_UP + (size_t)M * FF * 2 <= WS_END, "ws map");
constexpr int CW_BAR = 4096;

constexpr int LDS_BYTES = 163840;
constexpr int MISC_OFF = LDS_BYTES - 256;

#define GAS __attribute__((address_space(1)))
#define LAS __attribute__((address_space(3)))
typedef unsigned short bf16;
typedef unsigned v4u __attribute__((ext_vector_type(4)));
typedef unsigned v2u __attribute__((ext_vector_type(2)));
typedef float f32x2 __attribute__((ext_vector_type(2)));
typedef float f32x4 __attribute__((ext_vector_type(4)));
typedef float f32x16 __attribute__((ext_vector_type(16)));
typedef short bf16x8 __attribute__((ext_vector_type(8)));
typedef short s16x4 __attribute__((ext_vector_type(4)));
typedef __bf16 bf16x2_t __attribute__((ext_vector_type(2)));
typedef GAS unsigned gu32;
#define RLX_AGENT __ATOMIC_RELAXED, __HIP_MEMORY_SCOPE_AGENT
#define LDS_WAIT() asm volatile("s_waitcnt lgkmcnt(0)" ::: "memory")
#define VM_WAIT() asm volatile("s_waitcnt vmcnt(0)" ::: "memory")
__device__ __forceinline__ unsigned pk2(float lo, float hi) { f32x2 v = {lo, hi}; bf16x2_t b = __builtin_convertvector(v, bf16x2_t); return __builtin_bit_cast(unsigned, b); }
__device__ __forceinline__ float bflo(unsigned w) { return __uint_as_float(w << 16); }
__device__ __forceinline__ float bfhi(unsigned w) { return __uint_as_float(w & 0xffff0000u); }
__device__ __forceinline__ float bf1(bf16 b) { return __uint_as_float((unsigned)b << 16); }
__device__ __forceinline__ bf16 f2bf(float f) { return (bf16)(pk2(f, 0.f) & 0xffffu); }
__device__ __forceinline__ float wave_sum(float v) {
#pragma unroll
    for (int o = 1; o < 64; o <<= 1) v += __shfl_xor(v, o);
    return v;
}
__device__ __forceinline__ float sigmoidf_(float x) { return __builtin_amdgcn_rcpf(1.0f + __builtin_amdgcn_exp2f(-1.4426950408889634f * x)); }
__device__ __forceinline__ float rsq_(float x) { return __builtin_amdgcn_rsqf(x); }
__device__ __forceinline__ int crow(int r, int hi) { return (r & 3) + 8 * (r >> 2) + 4 * hi; }
#define MFMA32(a, b, c) __builtin_amdgcn_mfma_f32_32x32x16_bf16((a), (b), (c), 0, 0, 0)
#define MFMA16(a, b, c) __builtin_amdgcn_mfma_f32_16x16x32_bf16((a), (b), (c), 0, 0, 0)
#define XB_TMO      128
#define XB_XCNT(j)  (256  + 64 * (j))
#define XB_XSUB(j)  (1280 + 64 * (j))
#define XB_XGEN(j)  (2304 + 64 * (j))
#define XB_TOP      3328
#define XB_TOPGEN   3392
#define XCD_BAR_WORDS 3456
#define XB_SPIN_CAP (1u << 18)

__device__ __forceinline__ unsigned xb_ld(unsigned* p)              { return __hip_atomic_load(p, __ATOMIC_RELAXED, __HIP_MEMORY_SCOPE_AGENT); }
__device__ __forceinline__ unsigned xb_add(unsigned* p, unsigned v) { return __hip_atomic_fetch_add(p, v, __ATOMIC_RELAXED, __HIP_MEMORY_SCOPE_AGENT); }
__device__ __forceinline__ unsigned xb_xcc_id() { return (unsigned)__builtin_amdgcn_s_getreg((3 << 11) | 20) & 0xFu; }
#define XB_SPIN(cond, bar) do { unsigned _sp = 0; while (cond) { __builtin_amdgcn_s_sleep(1); \
    if ((++_sp & 255u) == 0u) { if (xb_ld(&(bar)[XB_TMO])) break; if (_sp > XB_SPIN_CAP) { atomicAdd(&(bar)[XB_TMO], 1u); break; } } } } while (0)

struct XcdBarrier {
    unsigned* bar; unsigned x;
    volatile LAS unsigned* st;
};

__device__ __forceinline__ XcdBarrier xcd_barrier_post(unsigned* bar, volatile LAS unsigned* st) {
    XcdBarrier b; b.bar = bar; b.x = xb_xcc_id(); b.st = st;
    if (threadIdx.x == 0) (void)xb_add(&bar[XB_XCNT(b.x)], 1u);
    return b;
}
__device__ __forceinline__ void xcd_barrier_complete(unsigned* bar, unsigned x, unsigned& nloc, unsigned& nx) {
    const unsigned G = gridDim.x * gridDim.y * gridDim.z;
    unsigned sum, cnt, mine, sp = 0u;
    for (;;) {
        sum = 0u; cnt = 0u; mine = 0u;
#pragma unroll
        for (unsigned j = 0; j < 16; ++j) { const unsigned c = xb_ld(&bar[XB_XCNT(j)]); sum += c; cnt += (c > 0u) ? 1u : 0u; mine = (j == x) ? c : mine; }
        if (sum == G) break;
        __builtin_amdgcn_s_sleep(1);
        if ((++sp & 255u) == 0u) { if (xb_ld(&bar[XB_TMO])) break; if (sp > XB_SPIN_CAP) { atomicAdd(&bar[XB_TMO], 1u); break; } }
    }
    nloc = mine > 0u ? mine : 1u; nx = cnt > 0u ? cnt : 1u;
}

__device__ __forceinline__ void xcd_barrier(const XcdBarrier& b) {
    asm volatile("s_waitcnt vmcnt(0)" ::: "memory");
    __syncthreads();
    if (threadIdx.x == 0) {
        unsigned* bar = b.bar;
        __builtin_amdgcn_s_waitcnt(0);
        unsigned nloc = b.st[0], nx = b.st[1];
        if (nloc == 0u) { xcd_barrier_complete(bar, b.x, nloc, nx); b.st[0] = nloc; b.st[1] = nx; }
        const unsigned old = xb_add(&bar[XB_XSUB(b.x)], 1u);
        const unsigned gen = old / nloc;
        if (old + 1u == (gen + 1u) * nloc) {
            __builtin_amdgcn_fence(__ATOMIC_RELEASE, "agent");
            asm volatile("s_waitcnt vmcnt(0)" ::: "memory");
            const unsigned og = xb_add(&bar[XB_TOP], 1u);
            const unsigned tg = og / nx;
            if (og + 1u == (tg + 1u) * nx) xb_add(&bar[XB_TOPGEN], 1u);
            else XB_SPIN(xb_ld(&bar[XB_TOPGEN]) == tg, bar);
            __builtin_amdgcn_fence(__ATOMIC_ACQUIRE, "agent");
            xb_add(&bar[XB_XGEN(b.x)], 1u);
            asm volatile("s_waitcnt vmcnt(0)" ::: "memory");
        } else {
            XB_SPIN(xb_ld(&bar[XB_XGEN(b.x)]) == gen, bar);
            __builtin_amdgcn_fence(__ATOMIC_ACQUIRE, "agent");
            asm volatile("s_waitcnt vmcnt(0)" ::: "memory");
        }
    }
    __syncthreads();
}

__device__ __forceinline__ void p0_transpose_item(const float* W, int ldw, int K, int N, bf16* WT, int row_off, LAS float* scr, int item, int lane) {
    const int nblk = N / 32, kb = item / nblk, nb = item % nblk, k0 = 64 * kb, n0 = 32 * nb;
#pragma unroll 8
    for (int i = 0; i < 32; ++i) { const int kk = 2 * i + (lane >> 5); scr[kk * 33 + (lane & 31)] = W[(size_t)(k0 + kk) * ldw + n0 + (lane & 31)]; }
    LDS_WAIT(); asm volatile("" ::: "memory");
    const int c = lane & 7;
#pragma unroll
    for (int j = 0; j < 4; ++j) { const int n = (lane >> 3) + 8 * j; const LAS float* s = scr + (8 * c) * 33 + n;
        v4u o; o.x = pk2(s[0 * 33], s[1 * 33]); o.y = pk2(s[2 * 33], s[3 * 33]); o.z = pk2(s[4 * 33], s[5 * 33]); o.w = pk2(s[6 * 33], s[7 * 33]);
        *(v4u*)(WT + (size_t)(row_off + n0 + n) * K + k0 + 8 * c) = o; }
    LDS_WAIT(); asm volatile("" ::: "memory");
}

__device__ __forceinline__ void phase_prologue(LAS unsigned char* lds, const float* xp, const float* xs, const float* nw, const float* w_in, const float* w_out, const float* w_gu, const float* w_dn,
                                               unsigned char* ws, int vcu, int G, int tid, int lane, int wave) {
    LAS float* scr = (LAS float*)(lds + wave * 8448);
    LAS float* W8T = (LAS float*)(lds + 67584);
    for (int k = tid; k < 1024; k += 512) {
        const f32x4 a = *(const f32x4*)(w_in + (size_t)k * INC + 2048), b = *(const f32x4*)(w_in + (size_t)k * INC + 2052);
        W8T[0 * 1024 + k] = a.x; W8T[1 * 1024 + k] = a.y; W8T[2 * 1024 + k] = a.z; W8T[3 * 1024 + k] = a.w;
        W8T[4 * 1024 + k] = b.x; W8T[5 * 1024 + k] = b.y; W8T[6 * 1024 + k] = b.z; W8T[7 * 1024 + k] = b.w;
    }
    __syncthreads();
    const int gw = vcu * NWAVES + wave, NGW = G * NWAVES;
    bf16* Win_t = (bf16*)(ws + WS_WIN); bf16* Wout_t = (bf16*)(ws + WS_WOUT); bf16* Wgu_t = (bf16*)(ws + WS_WGU); bf16* Wdn_t = (bf16*)(ws + WS_WDN);
    constexpr int I_A = 16 * 64, I_B = 16 * 48, I_O = 16 * 32, I_GU = 16 * 176, I_DN = 44 * 32;
    constexpr int NITEMS = I_A + I_B + I_O + I_GU + I_DN;
    for (int it = gw; it < NITEMS; it += NGW) {
        int r = it;
        if (r < I_A) { p0_transpose_item(w_in, INC, D, 2048, Win_t, 0, scr, r, lane); continue; } r -= I_A;
        if (r < I_B) { p0_transpose_item(w_in + 2056, INC, D, 1536, Win_t, 2048, scr, r, lane); continue; } r -= I_B;
        if (r < I_O) { p0_transpose_item(w_out, D, D, D, Wout_t, 0, scr, r, lane); continue; } r -= I_O;
        if (r < I_GU) { p0_transpose_item(w_gu, 2 * FF, D, 2 * FF, Wgu_t, 0, scr, r, lane); continue; } r -= I_GU;
        p0_transpose_item(w_dn, D, FF, D, Wdn_t, 0, scr, r, lane);
    }
    bf16* U = (bf16*)(ws + WS_U); float* AB = (float*)(ws + WS_AB);
    for (int m = gw; m < M; m += NGW) {
        const float* xrow = m < MP ? xp + (size_t)m * D : xs + (size_t)(m - MP) * D;
        f32x4 v[4]; float s = 0.f;
#pragma unroll
        for (int j = 0; j < 4; ++j) { v[j] = ((const f32x4*)xrow)[lane + 64 * j]; s += (v[j].x * v[j].x + v[j].y * v[j].y) + (v[j].z * v[j].z + v[j].w * v[j].w); }
        const float rstd = rsq_(wave_sum(s) * (1.f / D) + EPS);
        unsigned long long* o8 = (unsigned long long*)(U + (size_t)m * D) + lane;
#pragma unroll
        for (int j = 0; j < 4; ++j) { const f32x4 g = ((const f32x4*)nw)[lane + 64 * j]; v[j] = v[j] * rstd * g;
            o8[64 * j] = (unsigned long long)pk2(v[j].x, v[j].y) | ((unsigned long long)pk2(v[j].z, v[j].w) << 32); }
        float dv = 0.f;
#pragma unroll
        for (int jj = 0; jj < 8; ++jj) { float acc = 0.f;
#pragma unroll
            for (int j = 0; j < 4; ++j) { const f32x4 w = *(const LAS f32x4*)(W8T + jj * 1024 + 4 * lane + 256 * j); acc += (v[j].x * w.x + v[j].y * w.y) + (v[j].z * w.z + v[j].w * w.w); }
            acc = wave_sum(acc); if (lane == jj) dv = acc; }
        if (lane < 8) AB[(size_t)m * 8 + lane] = dv;
    }
}

__device__ __forceinline__ void phase_copy_outputs(const bf16* P, float* out, int gtid, int nth) {
    for (int e = gtid; e < 4 * 512 * 512; e += nth) { const int b = e >> 18, j = (e >> 9) & 511, c = e & 511; const size_t row = (size_t)(b * SEQ + 3584 + j) * NIN;
        out[O_BKP + e] = bf1(P[row + PC_KB + c]); out[O_BVP + e] = bf1(P[row + PC_VB + c]); }
    for (int e = gtid; e < 32 * 32 * 512; e += nth) { const int r = e >> 9, c = e & 511; const size_t row = (size_t)(MP + r) * NIN;
        out[O_BKS + e] = bf1(P[row + PC_KB + c]); out[O_BVS + e] = bf1(P[row + PC_VB + c]); }
    for (int e = gtid; e < 4 * 3 * 1536; e += nth) { const int b = e / 4608, i = (e / 1536) % 3, c = e % 1536; out[O_QCP + e] = bf1(P[(size_t)(b * SEQ + 4093 + i) * NIN + c]); }
    for (int e = gtid; e < 32 * 3 * 1536; e += nth) { const int b = e / 4608, i = (e / 1536) % 3, c = e % 1536; out[O_QCS + e] = bf1(P[(size_t)(MP + b * 32 + 29 + i) * NIN + c]); }
}

__device__ __forceinline__ bf16x8 pack8(const f32x4& a, const f32x4& b) { const v4u t = {pk2(a[0], a[1]), pk2(a[2], a[3]), pk2(b[0], b[1]), pk2(b[2], b[3])}; return __builtin_bit_cast(bf16x8, t); }
__device__ __forceinline__ float dpp_sum16(float v) {
    v += __uint_as_float((unsigned)__builtin_amdgcn_update_dpp(0, (int)__float_as_uint(v), 0xB1, 0xF, 0xF, true));
    v += __uint_as_float((unsigned)__builtin_amdgcn_update_dpp(0, (int)__float_as_uint(v), 0x4E, 0xF, 0xF, true));
    v += __uint_as_float((unsigned)__builtin_amdgcn_update_dpp(0, (int)__float_as_uint(v), 0x141, 0xF, 0xF, true));
    v += __uint_as_float((unsigned)__builtin_amdgcn_update_dpp(0, (int)__float_as_uint(v), 0x140, 0xF, 0xF, true));
    return v;
}
__device__ __forceinline__ int kperm(int k) { const int kk = k & 31; return (k & ~31) | (8 * ((kk & 15) >> 2) + (kk & 3) + 4 * (kk >> 4)); }
__device__ __forceinline__ void gdn_pre_unit(LAS unsigned char* lds, int u, const bf16* P, const float* AB, const float* st_qkv, const float* conv_w, const float* a_log, const float* dt_bias,
                                             bf16* gmain, bf16* gqk, bf16* gs, float* DL, int tid, int lane, int wave) {
    LAS float* RHS = (LAS float*)(lds + 0);
    LAS bf16* QB = (LAS bf16*)(lds + 65536);
    LAS bf16* KB = (LAS bf16*)(lds + 82944);
    LAS bf16* RAW = (LAS bf16*)(lds + 100352);
    LAS bf16* KGT = (LAS bf16*)(lds + 117760);
    LAS bf16* AMN = (LAS bf16*)(lds + 117760);
    LAS float* TD = (LAS float*)(lds + 117760 + 10240);
    LAS bf16* TB = (LAS bf16*)(lds + 117760 + 14336);
    LAS float* SMG = (LAS float*)(lds + 136192);
    const bool prompt = u < 1024;
    int b, h, n, m0, valid; bf16 *o_w, *o_qg, *o_kgt, *o_ut, *o_qk;
    if (prompt) { b = u >> 8; h = (u >> 6) & 3; n = u & 63; m0 = b * SEQ + n * 64; valid = 64; bf16* base = gmain + (size_t)u * 32768; o_w = base; o_qg = base + 8192; o_kgt = base + 16384; o_ut = base + 24576; o_qk = gqk + (size_t)u * 4096; }
    else { const int su = u - 1024; b = su >> 2; h = su & 3; n = 0; m0 = MP + b * 32; valid = 32; bf16* base = gs + (size_t)su * 36864; o_w = base; o_qg = base + 8192; o_kgt = base + 16384; o_ut = base + 24576; o_qk = base + 32768; }
    unsigned xr[3][11];
    if (prompt) {
#pragma unroll
        for (int part = 0; part < 3; ++part) { const int pcol = (part == 0 ? 512 : part == 1 ? 0 : 1024) + h * 128 + 2 * lane;
#pragma unroll
            for (int j = 0; j < 11; ++j) { const int ts = n * 64 - 3 + wave * 8 + j; const unsigned val = *(const unsigned*)(P + (size_t)(b * SEQ + (ts < 0 ? 0 : ts)) * NIN + pcol); xr[part][j] = ts < 0 ? 0u : val; } }
    } else {
#pragma unroll
        for (int part = 0; part < 3; ++part) { const int pcol = (part == 0 ? 512 : part == 1 ? 0 : 1024) + h * 128 + 2 * lane;
#pragma unroll
            for (int j = 0; j < 11; ++j) { const int pr = wave * 8 + j - 3; const int prc = pr < 0 ? 0 : (pr > 31 ? 31 : pr); const unsigned val = *(const unsigned*)(P + (size_t)(MP + b * 32 + prc) * NIN + pcol); xr[part][j] = (pr < 0 || pr > 31) ? 0u : val; }
#pragma unroll
            for (int j = 0; j < 3; ++j) { const int rr = wave * 8 + j; const f32x2 sv = *(const f32x2*)(st_qkv + ((size_t)b * 3 + (rr > 2 ? 2 : rr)) * 1536 + pcol); if (rr < 3) xr[part][j] = pk2(sv.x, sv.y); } }
    }
    float cw0[3][4], cw1[3][4];
#pragma unroll
    for (int part = 0; part < 3; ++part)
#pragma unroll
        for (int i = 0; i < 4; ++i) { const f32x2 t = *(const f32x2*)(conv_w + i * 1536 + (part == 0 ? 512 : part == 1 ? 0 : 1024) + h * 128 + 2 * lane); cw0[part][i] = t.x; cw1[part][i] = t.y; }
    if (wave == 0) {
        const int i = lane; const bool v = i < valid;
        const float araw = v ? AB[(size_t)(m0 + i) * 8 + 4 + h] : 0.f, braw = v ? AB[(size_t)(m0 + i) * 8 + h] : 0.f;
        const float A = expf(a_log[h]); const float x = araw + dt_bias[h];
        const float sp = x > 20.f ? x : log1pf(expf(x));
        const float g = v ? -A * sp : 0.f; const float beta = v ? 1.f / (1.f + expf(-braw)) : 0.f;
        float Gc = g;
#pragma unroll
        for (int off = 1; off < 64; off <<= 1) { const float t = __shfl_up(Gc, off); if (lane >= off) Gc += t; }
        const float Gl = __shfl(Gc, 63);
        SMG[i] = Gc; SMG[64 + i] = beta; SMG[128 + i] = expf(Gc); SMG[192 + i] = expf(Gl - Gc);
        if (lane == 0) DL[u] = expf(Gl);
    }
    __syncthreads();
    const int r0 = wave * 8;
#pragma unroll
    for (int part = 0; part < 3; ++part) {
        float s0[8], s1[8], rinv[8];
#pragma unroll
        for (int rq = 0; rq < 8; ++rq) { float y0 = 0.f, y1 = 0.f;
#pragma unroll
            for (int i = 0; i < 4; ++i) { const unsigned xw = xr[part][rq + i]; y0 += cw0[part][i] * bflo(xw); y1 += cw1[part][i] * bfhi(xw); }
            s0[rq] = y0 * sigmoidf_(y0); s1[rq] = y1 * sigmoidf_(y1);
            if (r0 + rq >= valid) { s0[rq] = 0.f; s1[rq] = 0.f; } }
        if (part != 2) {
#pragma unroll
            for (int rq = 0; rq < 8; ++rq) { const int tb = (int)__float_as_uint(dpp_sum16(s0[rq] * s0[rq] + s1[rq] * s1[rq]));
                const float tot = (__uint_as_float(__builtin_amdgcn_readlane(tb, 0)) + __uint_as_float(__builtin_amdgcn_readlane(tb, 16))) + (__uint_as_float(__builtin_amdgcn_readlane(tb, 32)) + __uint_as_float(__builtin_amdgcn_readlane(tb, 48)));
                rinv[rq] = rsq_(tot + EPS); }
        }
        if (part == 2) {
#pragma unroll
            for (int rq = 0; rq < 8; ++rq) { const int r = r0 + rq; const float be = SMG[64 + r]; *(LAS f32x2*)(RHS + r * 256 + 2 * lane) = (f32x2){s0[rq] * be, s1[rq] * be}; }
        } else if (part == 0) {
            float kg0[8], kg1[8];
#pragma unroll
            for (int rq = 0; rq < 8; ++rq) { const int r = r0 + rq; const float k0 = s0[rq] * rinv[rq], k1 = s1[rq] * rinv[rq]; *(LAS unsigned*)(KB + r * 136 + 2 * lane) = pk2(k0, k1);
                const float be = SMG[64 + r] * SMG[128 + r]; *(LAS f32x2*)(RHS + r * 256 + 128 + 2 * lane) = (f32x2){k0 * be, k1 * be};
                const float egl = SMG[192 + r]; kg0[rq] = k0 * egl; kg1[rq] = k1 * egl; }
            const int pa = kperm(r0), pb = kperm(r0 + 4);
            *(LAS v2u*)(KGT + (2 * lane) * 64 + pa) = (v2u){pk2(kg0[0], kg0[1]), pk2(kg0[2], kg0[3])}; *(LAS v2u*)(KGT + (2 * lane) * 64 + pb) = (v2u){pk2(kg0[4], kg0[5]), pk2(kg0[6], kg0[7])};
            *(LAS v2u*)(KGT + (2 * lane + 1) * 64 + pa) = (v2u){pk2(kg1[0], kg1[1]), pk2(kg1[2], kg1[3])}; *(LAS v2u*)(KGT + (2 * lane + 1) * 64 + pb) = (v2u){pk2(kg1[4], kg1[5]), pk2(kg1[6], kg1[7])};
        } else {
#pragma unroll
            for (int rq = 0; rq < 8; ++rq) { const int r = r0 + rq; const float sc = rinv[rq] * 0.08838834764831845f; const float q0 = s0[rq] * sc, q1 = s1[rq] * sc; *(LAS unsigned*)(QB + r * 136 + 2 * lane) = pk2(q0, q1);
                const float eg = SMG[128 + r]; *(unsigned*)(o_qg + r * 128 + kperm(2 * lane)) = pk2(q0 * eg, q1 * eg); }
        }
    }
    __syncthreads();
#pragma unroll
    for (int k = 0; k < 2; ++k) { const int pi = tid + 512 * k; *(v4u*)(o_kgt + pi * 8) = *(const LAS v4u*)(KGT + pi * 8); }
    __syncthreads();
    {
        const int mat = wave >> 2, ti = (wave >> 1) & 1, tj = wave & 1, r32 = lane & 31, hi = lane >> 5;
        const LAS bf16* Ab = (mat == 0 ? KB : QB) + (32 * ti + r32) * 136 + 8 * hi;
        const LAS bf16* Bb = KB + (32 * tj + r32) * 136 + 8 * hi;
        f32x16 acc;
#pragma unroll
        for (int r = 0; r < 16; ++r) acc[r] = 0.f;
#pragma unroll
        for (int s = 0; s < 8; ++s) acc = MFMA32(*(const LAS bf16x8*)(Ab + 16 * s), *(const LAS bf16x8*)(Bb + 16 * s), acc);
        const int j = 32 * tj + r32; const float Gj = SMG[j];
#pragma unroll
        for (int r = 0; r < 16; ++r) { const int i = 32 * ti + crow(r, hi); const float dec = __builtin_amdgcn_exp2f(1.4426950408889634f * fminf(SMG[i] - Gj, 0.f));
            if (mat == 0) { const float av = (i > j) ? acc[r] * SMG[64 + i] * dec : 0.f; AMN[i * 80 + kperm(j)] = f2bf(-av); if ((i >> 4) == (j >> 4)) TD[(i >> 4) * 256 + (i & 15) * 16 + (j & 15)] = av; }
            else o_qk[i * 64 + kperm(j)] = f2bf((i >= j) ? acc[r] * dec : 0.f); }
    }
    __syncthreads();
    if (wave == 0) {
        const int bb = lane >> 4, c = lane & 15; float y[16];
        const LAS float* tdp = TD + bb * 256;
#pragma unroll
        for (int i = 0; i < 16; ++i) { float a[16];
#pragma unroll
            for (int j4 = 0; j4 < 4; ++j4) if (4 * j4 < i) { const f32x4 t = *(const LAS f32x4*)(tdp + i * 16 + 4 * j4); a[4 * j4] = t.x; a[4 * j4 + 1] = t.y; a[4 * j4 + 2] = t.z; a[4 * j4 + 3] = t.w; }
            float s0 = (i == c) ? 1.f : 0.f, s1 = 0.f;
#pragma unroll
            for (int j = 0; j < i; ++j) { if (j & 1) s1 = fmaf(-a[j], y[j], s1); else s0 = fmaf(-a[j], y[j], s0); }
            y[i] = s0 + s1;
            const int pc = 8 * (c >> 2) + (c & 3);
            TB[(bb * 16 + i) * 32 + pc] = f2bf(y[i]); TB[(bb * 16 + i) * 32 + pc + 4] = 0; }
    }
    __syncthreads();
    {
        const int cl = lane & 15, q = lane >> 4;
        const f32x4 zero4 = {0.f, 0.f, 0.f, 0.f};
        const LAS unsigned char* amn = (const LAS unsigned char*)AMN + cl * 160 + q * 16;
        const LAS unsigned char* tbp = (const LAS unsigned char*)TB + cl * 64 + q * 16;
#pragma unroll 1
        for (int nt = 0; nt < 2; ++nt) {
            const int col = 32 * wave + 16 * nt + cl;
            f32x4 X[4];
#pragma unroll
            for (int b4 = 0; b4 < 4; ++b4) {
                f32x4 R;
#pragma unroll
                for (int r = 0; r < 4; ++r) R[r] = RHS[(16 * b4 + 4 * q + r) * 256 + col];
                if (b4 == 1) R = MFMA16(*(const LAS bf16x8*)(amn + 16 * 160), pack8(X[0], zero4), R);
                if (b4 == 2) R = MFMA16(*(const LAS bf16x8*)(amn + 32 * 160), pack8(X[0], X[1]), R);
                if (b4 == 3) { R = MFMA16(*(const LAS bf16x8*)(amn + 48 * 160), pack8(X[0], X[1]), R); R = MFMA16(*(const LAS bf16x8*)(amn + 48 * 160 + 64), pack8(X[2], zero4), R); }
                X[b4] = MFMA16(*(const LAS bf16x8*)(tbp + b4 * 16 * 64), pack8(R, zero4), zero4);
            }
            if (wave < 4) {
#pragma unroll
                for (int b4 = 0; b4 < 4; ++b4) *(v2u*)(o_ut + col * 64 + 16 * b4 + 4 * q) = (v2u){pk2(X[b4][0], X[b4][1]), pk2(X[b4][2], X[b4][3])};
            } else { const int pk = kperm(col - 128);
#pragma unroll
                for (int b4 = 0; b4 < 4; ++b4)
#pragma unroll
                    for (int r = 0; r < 4; ++r) o_w[(16 * b4 + 4 * q + r) * 128 + pk] = f2bf(X[b4][r]); }
        }
    }
    __syncthreads();
}

constexpr int SB_W = 0, SB_QG = 18432, SB_KGT = 36864, SB_QK = 57344, SB_UT = 67584, SB_SIZE = 76800;
__device__ __forceinline__ bf16x8 ldfrag(const LAS unsigned char* p) { return *(const LAS bf16x8*)p; }
#define SCAN_BAR() asm volatile("s_waitcnt lgkmcnt(0)\n\ts_barrier" ::: "memory")
__device__ __forceinline__ void scan_half(LAS unsigned char* lds, int half, int nsteps, int nrows, const bf16* gmain, size_t main_stride, const bf16* gqk, size_t qk_stride, const float* DLp,
                                          const float* S0, float* Sout, bf16* MX  , unsigned dumpoff  , gu32* prog, int tid, int lane, int wave) {
    if (wave >= 4) {
        const int lt = tid - 256;
        const unsigned v16 = (unsigned)lt * 16u;
        v4u A[16], B[16];
#define LD_LOAD(R, nn) do { const char* mp_ = (const char*)(gmain + (size_t)(nn) * main_stride); \
            _Pragma("unroll") for (int k = 0; k < 12; ++k) R[k] = *(const v4u*)(mp_ + k * 4096 + v16); \
            _Pragma("unroll") for (int k = 0; k < 2; ++k) R[12 + k] = *(const v4u*)((const char*)(gqk + (size_t)(nn) * qk_stride) + k * 4096 + v16); \
            _Pragma("unroll") for (int k = 0; k < 2; ++k) R[14 + k] = *(const v4u*)(mp_ + 49152 + half * 8192 + k * 4096 + v16); } while (0)
#define LD_WRITE(R, buf) do { LAS unsigned char* bb_ = lds + (buf) * SB_SIZE; \
            _Pragma("unroll") for (int k = 0; k < 12; ++k) { const int a_ = k >> 2, within_ = lt + 256 * (k & 3); \
                const int dst_ = (a_ == 0 ? SB_W + (within_ >> 4) * 288 + (within_ & 15) * 16 : a_ == 1 ? SB_QG + (within_ >> 4) * 288 + (within_ & 15) * 16 : SB_KGT + (within_ >> 3) * 160 + (within_ & 7) * 16); \
                *(LAS v4u*)(bb_ + dst_) = R[k]; } \
            _Pragma("unroll") for (int k = 0; k < 2; ++k) { const int within_ = lt + 256 * k; *(LAS v4u*)(bb_ + SB_QK + (within_ >> 3) * 160 + (within_ & 7) * 16) = R[12 + k]; } \
            _Pragma("unroll") for (int k = 0; k < 2; ++k) { const int within_ = lt + 256 * k; *(LAS v4u*)(bb_ + SB_UT + (within_ >> 3) * 144 + (within_ & 7) * 16) = R[14 + k]; } } while (0)
        LD_LOAD(A, 0);
        if (nsteps > 1) LD_LOAD(B, 1);
        LD_WRITE(A, 0);
        asm volatile("" ::: "memory");
        if (nsteps > 2) LD_LOAD(A, 2);
        SCAN_BAR();
#pragma unroll 1
        for (int n = 0; n < nsteps; n += 2) {
            if (n + 1 < nsteps) { LD_WRITE(B, 1); asm volatile("" ::: "memory"); if (n + 3 < nsteps) LD_LOAD(B, n + 3); SCAN_BAR(); }
            if (n + 2 < nsteps) { LD_WRITE(A, 0); asm volatile("" ::: "memory"); if (n + 4 < nsteps) LD_LOAD(A, n + 4); SCAN_BAR(); }
        }
#undef LD_LOAD
#undef LD_WRITE
    } else {
        const int cl = lane & 15, q = lane >> 4, cw = wave, c0 = 64 * half + 16 * cw;
        f32x4 S[8];
#pragma unroll
        for (int mt = 0; mt < 8; ++mt)
#pragma unroll
            for (int r = 0; r < 4; ++r) S[mt][r] = S0 ? S0[(16 * mt + 4 * q + r) * 128 + c0 + cl] : 0.f;
        const unsigned laneoff = (unsigned)q * (4u * D * 2u) + (unsigned)(c0 + cl) * 2u;
        dumpoff += (unsigned)lane * 2u;
        const int dlbits = (int)__float_as_uint(lane < nsteps ? DLp[lane] : 1.f);
#define SCAN_STEP(n, buf) do { \
        SCAN_BAR();                                            \
        if (prog && tid == 0) __hip_atomic_store(prog, (unsigned)(n) + 1u, RLX_AGENT); \
        const LAS unsigned char* bb_ = lds + (buf) * SB_SIZE; \
        const float dl_ = __uint_as_float(__builtin_amdgcn_readlane(dlbits, (n))); \
        bf16x8 Sb_[4]; \
        _Pragma("unroll") for (int ks = 0; ks < 4; ++ks) Sb_[ks] = pack8(S[2 * ks], S[2 * ks + 1]); \
        f32x4 vn_[4], o_[4]; \
        _Pragma("unroll") for (int mt = 0; mt < 4; ++mt) { \
            f32x4 aw_ = {0.f, 0.f, 0.f, 0.f}, ao_ = {0.f, 0.f, 0.f, 0.f}; \
            const LAS unsigned char* wp_ = bb_ + SB_W + (16 * mt + cl) * 288 + q * 16; const LAS unsigned char* qp_ = bb_ + SB_QG + (16 * mt + cl) * 288 + q * 16; \
            _Pragma("unroll") for (int ks = 0; ks < 4; ++ks) { aw_ = MFMA16(ldfrag(wp_ + ks * 64), Sb_[ks], aw_); ao_ = MFMA16(ldfrag(qp_ + ks * 64), Sb_[ks], ao_); } \
            const v2u uu_ = *(const LAS v2u*)(bb_ + SB_UT + (16 * cw + cl) * 144 + (16 * mt + 4 * q) * 2); \
            vn_[mt] = (f32x4){bflo(uu_.x) - aw_[0], bfhi(uu_.x) - aw_[1], bflo(uu_.y) - aw_[2], bfhi(uu_.y) - aw_[3]}; \
            o_[mt] = ao_; } \
        bf16x8 Vb_[2]; \
        _Pragma("unroll") for (int ks = 0; ks < 2; ++ks) Vb_[ks] = pack8(vn_[2 * ks], vn_[2 * ks + 1]); \
        _Pragma("unroll") for (int mt = 0; mt < 4; ++mt) { const LAS unsigned char* kp_ = bb_ + SB_QK + (16 * mt + cl) * 160 + q * 16; \
            _Pragma("unroll") for (int ks = 0; ks < 2; ++ks) o_[mt] = MFMA16(ldfrag(kp_ + ks * 64), Vb_[ks], o_[mt]); } \
        _Pragma("unroll") for (int mt = 0; mt < 8; ++mt) { S[mt] = S[mt] * dl_; const LAS unsigned char* kp_ = bb_ + SB_KGT + (16 * mt + cl) * 160 + q * 16; \
            _Pragma("unroll") for (int ks = 0; ks < 2; ++ks) S[mt] = MFMA16(ldfrag(kp_ + ks * 64), Vb_[ks], S[mt]); } \
        _Pragma("unroll") for (int mt = 0; mt < 4; ++mt) _Pragma("unroll") for (int r = 0; r < 4; ++r) { const int row_ = 16 * mt + 4 * q + r; \
            const unsigned off_ = (row_ < nrows) ? (unsigned)(n) * (64u * D * 2u) + (unsigned)(16 * mt + r) * (D * 2u) + laneoff : dumpoff; \
            *(bf16*)((char*)MX + off_) = f2bf(o_[mt][r]); } \
    } while (0)
#pragma unroll 1
        for (int n = 0; n < nsteps; n += 2) {
            SCAN_STEP(n, 0);
            if (n + 1 < nsteps) SCAN_STEP(n + 1, 1);
        }
#undef SCAN_STEP
#pragma unroll
        for (int mt = 0; mt < 8; ++mt)
#pragma unroll
            for (int r = 0; r < 4; ++r) Sout[(16 * mt + 4 * q + r) * 128 + c0 + cl] = S[mt][r];
    }
    __syncthreads();
}
#undef SCAN_BAR

__device__ __forceinline__ void scan_helper(gu32* prog, const bf16* gmain, size_t main_stride, const bf16* gqk, size_t qk_stride, float* sink, int tid, int lane) {
    constexpr int AHEAD = 8, RND = 4;
    unsigned acc = 0u;
    const unsigned vmain = (unsigned)tid * 128u, vqk = (unsigned)(tid & 63) * 128u;
#pragma unroll 1
    for (int n = 0; n < 64; n += RND) {
        if (n > AHEAD) {
            if (lane == 0) { unsigned sp = 0u; while ((int)__hip_atomic_load(prog, RLX_AGENT) < n - AHEAD && ++sp < 200000u) __builtin_amdgcn_s_sleep(16); }
        }
        unsigned a[RND], c[RND];
#pragma unroll
        for (int k = 0; k < RND; ++k) { a[k] = *(const unsigned*)((const char*)(gmain + (size_t)(n + k) * main_stride) + vmain); c[k] = *(const unsigned*)((const char*)(gqk + (size_t)(n + k) * qk_stride) + vqk); }
#pragma unroll
        for (int k = 0; k < RND; ++k) acc ^= a[k] ^ c[k];
    }
    if (acc == 0x9e3779b9u) *sink = 0.f;
}

__device__ __forceinline__ void phase_gdn_finish(const bf16* P, bf16* MIXIN, const float* gnw, int gw, int NGW, int lane) {
    const f32x2 gw2 = *(const f32x2*)(gnw + 2 * lane);
    for (int it = gw; it < M * 4; it += NGW) {
        const int m = it >> 2, h = it & 3;
        unsigned* op = (unsigned*)(MIXIN + (size_t)m * D + h * 128) + lane;
        const unsigned ow = *op, zw = *((const unsigned*)(P + (size_t)m * NIN + PC_Z + h * 128) + lane);
        const float o0 = bflo(ow), o1 = bfhi(ow), z0 = bflo(zw), z1 = bfhi(zw);
        const float rstd = rsq_(wave_sum(o0 * o0 + o1 * o1) * (1.f / 128.f) + EPS);
        *op = pk2(o0 * rstd * gw2.x * z0 * sigmoidf_(z0), o1 * rstd * gw2.y * z1 * sigmoidf_(z1));
    }
}

constexpr int ATT_WAVE_LDS = 18944;
constexpr float LOG2E = 1.4426950408889634f;
typedef short v4i16_t __attribute__((ext_vector_type(4)));
__device__ __forceinline__ s16x4 vtr(const LAS unsigned char* p) { return __builtin_bit_cast(s16x4, __builtin_amdgcn_ds_read_tr16_b64_v4i16((LAS v4i16_t*)p)); }
__device__ __forceinline__ void attn_item(LAS unsigned char* wl, int it, int& bt_h, const bf16* P, const float* ck, const float* cv, const float* relb, const float* anw, bf16* MIXIN, int lane) {
    LAS unsigned char* KL = wl; LAS unsigned char* VL = wl + 9216; LAS float* SC = (LAS float*)(wl + 17408); LAS float* BT = (LAS float*)(wl + 17664);
    const int r32 = lane & 31, hi = lane >> 5;
    const bool sample = it < 256;
    int b, h, n = 0, half = 0, mq, t0, t1;
    if (sample) { b = it >> 3; h = it & 7; mq = MP + b * 32; t0 = 0; t1 = 9; }
    else { const int idx = it - 256; half = idx & 1; n = (idx >> 1) & 63; h = (idx >> 7) & 7; b = idx >> 10; mq = b * SEQ + n * 64 + half * 32; t0 = n > 8 ? n - 8 : 0; t1 = n + 1; }
    if (h != bt_h) { for (int k = lane; k < 257; k += 64) BT[k] = relb[h * 257 + k] * LOG2E; bt_h = h; }
    bf16x8 qr[4];
#pragma unroll
    for (int d0 = 0; d0 < 4; ++d0) qr[d0] = *(const bf16x8*)(P + (size_t)(mq + r32) * NIN + PC_QB + h * 64 + d0 * 16 + hi * 8);
    float mrun = -1e30f, lrun = 0.f; f32x16 o0, o1;
#pragma unroll
    for (int r = 0; r < 16; ++r) { o0[r] = 0.f; o1[r] = 0.f; }
    const int ti = lane & 15, blk = (lane >> 4) & 1;
    const LAS unsigned char* vbase = VL + (4 * hi + (ti >> 2)) * 128 + (blk * 16 + 4 * (ti & 3)) * 2;
    v4u kvr[8], vvr[8];
#define ATT_LOADT(tt) do { const char* tb_ = (const char*)(P + (sample ? (size_t)MP + b * 32 : (size_t)b * SEQ + (size_t)(tt) * 64) * NIN + h * 64); \
        _Pragma("unroll") for (int i8 = 0; i8 < 8; ++i8) { kvr[i8] = *(const v4u*)(tb_ + i8 * (8 * NIN * 2) + PC_KB * 2 + loff); vvr[i8] = *(const v4u*)(tb_ + i8 * (8 * NIN * 2) + PC_VB * 2 + loff); \
            if (sample && i8 >= 4) { kvr[i8] = (v4u){0u, 0u, 0u, 0u}; vvr[i8] = (v4u){0u, 0u, 0u, 0u}; } } } while (0)
    const unsigned loff = (unsigned)(lane >> 3) * (unsigned)(NIN * 2) + (unsigned)(lane & 7) * 16u;
    if (!sample) ATT_LOADT(t0);
#pragma unroll 1
    for (int t = t0; t < t1; ++t) {
        int relbase; bool maskhalf = false;
        if (sample && t < 8) {
            relbase = 512 - 64 * t;
            int lq_ = lane; asm volatile("" : "+v"(lq_));
#pragma unroll
            for (int i8 = 0; i8 < 8; ++i8) { const int idx = i8 * 64 + lq_, key = idx >> 3, c8 = idx & 7; const size_t off = (((size_t)b * 512 + 64 * t + key) * 8 + h) * 64 + c8 * 8;
                const f32x4 ka = *(const f32x4*)(ck + off), kb = *(const f32x4*)(ck + off + 4), va = *(const f32x4*)(cv + off), vb = *(const f32x4*)(cv + off + 4);
                *(LAS v4u*)(KL + key * 144 + c8 * 16) = (v4u){pk2(ka.x, ka.y), pk2(ka.z, ka.w), pk2(kb.x, kb.y), pk2(kb.z, kb.w)};
                *(LAS v4u*)(VL + key * 128 + c8 * 16) = (v4u){pk2(va.x, va.y), pk2(va.z, va.w), pk2(vb.x, vb.y), pk2(vb.z, vb.w)}; }
        } else {
            if (sample) { relbase = 0; maskhalf = true; ATT_LOADT(t); }
            else relbase = 64 * (n - t) + 32 * half;
            int ln_ = lane; asm volatile("" : "+v"(ln_));
            LAS unsigned char* kw_ = KL + (ln_ >> 3) * 144 + (ln_ & 7) * 16; LAS unsigned char* vw_ = VL + (ln_ >> 3) * 128 + (ln_ & 7) * 16;
#pragma unroll
            for (int i8 = 0; i8 < 8; ++i8) { *(LAS v4u*)(kw_ + i8 * 1152) = kvr[i8]; *(LAS v4u*)(vw_ + i8 * 1024) = vvr[i8]; }
            asm volatile("" ::: "memory");
            if (!sample && t + 1 < t1) ATT_LOADT(t + 1);
        }
        f32x16 p0, p1;
#pragma unroll
        for (int r = 0; r < 16; ++r) { p0[r] = 0.f; p1[r] = 0.f; }
#pragma unroll
        for (int d0 = 0; d0 < 4; ++d0) { const bf16x8 k0 = *(const LAS bf16x8*)(KL + r32 * 144 + (2 * d0 + hi) * 16), k1 = *(const LAS bf16x8*)(KL + (32 + r32) * 144 + (2 * d0 + hi) * 16);
            p0 = MFMA32(k0, qr[d0], p0); p1 = MFMA32(k1, qr[d0], p1); }
        const float SC2 = 0.125f * LOG2E;
        if (relbase - 63 >= 128) { const float bc = BT[256];
#pragma unroll
            for (int r = 0; r < 16; ++r) { p0[r] = p0[r] * SC2 + bc; p1[r] = p1[r] * SC2 + bc; } }
        else {
#pragma unroll
            for (int r = 0; r < 16; ++r) { const int rel = relbase + r32 - crow(r, hi); int i0 = (rel > 128 ? 128 : rel) + 128, i1 = (rel - 32 > 128 ? 128 : rel - 32) + 128; i0 = i0 < 0 ? 0 : i0; i1 = i1 < 0 ? 0 : i1;
                p0[r] = p0[r] * SC2 + BT[i0]; p1[r] = p1[r] * SC2 + BT[i1]; } }
        if (maskhalf) {
#pragma unroll
            for (int r = 0; r < 16; ++r) p1[r] = -INFINITY; }
        float mx = fmaxf(p0[0], p1[0]);
#pragma unroll
        for (int r = 1; r < 16; ++r) mx = fmaxf(mx, fmaxf(p0[r], p1[r]));
        mx = fmaxf(mx, __shfl_xor(mx, 32));
        const float mnew = fmaxf(mrun, mx); const float alpha = __builtin_amdgcn_exp2f(mrun - mnew); mrun = mnew;
        float sum = 0.f;
#pragma unroll
        for (int r = 0; r < 16; ++r) { p0[r] = __builtin_amdgcn_exp2f(p0[r] - mnew); p1[r] = __builtin_amdgcn_exp2f(p1[r] - mnew); sum += p0[r] + p1[r]; }
        lrun = lrun * alpha + sum;
        if (hi == 0) SC[r32] = alpha;
#pragma unroll
        for (int r = 0; r < 16; ++r) { const float a = SC[crow(r, hi)]; o0[r] *= a; o1[r] *= a; }
#pragma unroll
        for (int s = 0; s < 4; ++s) {
            v4u pw;
            if (s < 2) pw = (v4u){pk2(p0[8 * s + 0], p0[8 * s + 1]), pk2(p0[8 * s + 2], p0[8 * s + 3]), pk2(p0[8 * s + 4], p0[8 * s + 5]), pk2(p0[8 * s + 6], p0[8 * s + 7])};
            else { const int ss = s - 2; pw = (v4u){pk2(p1[8 * ss + 0], p1[8 * ss + 1]), pk2(p1[8 * ss + 2], p1[8 * ss + 3]), pk2(p1[8 * ss + 4], p1[8 * ss + 5]), pk2(p1[8 * ss + 6], p1[8 * ss + 7])}; }
            const bf16x8 pa = __builtin_bit_cast(bf16x8, pw);
            const LAS unsigned char* vp = vbase + (16 * s) * 128;
            const s16x4 a0 = vtr(vp), a1 = vtr(vp + 8 * 128), b0 = vtr(vp + 64), b1 = vtr(vp + 8 * 128 + 64);
            const bf16x8 v0 = {a0[0], a0[1], a0[2], a0[3], a1[0], a1[1], a1[2], a1[3]}, v1 = {b0[0], b0[1], b0[2], b0[3], b1[0], b1[1], b1[2], b1[3]};
            o0 = MFMA32(pa, v0, o0); o1 = MFMA32(pa, v1, o1);
        }
    }
#undef ATT_LOADT
    lrun += __shfl_xor(lrun, 32);
    if (hi == 0) SC[32 + r32] = 1.f / lrun;
    LAS float* OL = (LAS float*)wl;
#pragma unroll
    for (int r = 0; r < 16; ++r) { const int qq = crow(r, hi); const float inv = SC[32 + qq]; OL[qq * 66 + r32] = o0[r] * inv; OL[qq * 66 + 32 + r32] = o1[r] * inv; }
    {
        const int qq = lane >> 1, dh = (lane & 1) * 32; float vals[32]; float ss = 0.f;
#pragma unroll
        for (int k = 0; k < 32; ++k) { vals[k] = OL[qq * 66 + dh + k]; ss += vals[k] * vals[k]; }
        ss += __shfl_xor(ss, 1);
        const float rstd = rsq_(ss * (1.f / 64.f) + EPS);
        bf16* op = MIXIN + (size_t)(mq + qq) * D + 512 + h * 64 + dh;
#pragma unroll
        for (int k4 = 0; k4 < 4; ++k4) { v4u o;
            const f32x4 wa = *(const f32x4*)(anw + dh + 8 * k4), wb = *(const f32x4*)(anw + dh + 8 * k4 + 4);
            o.x = pk2(vals[8 * k4 + 0] * rstd * wa.x, vals[8 * k4 + 1] * rstd * wa.y); o.y = pk2(vals[8 * k4 + 2] * rstd * wa.z, vals[8 * k4 + 3] * rstd * wa.w);
            o.z = pk2(vals[8 * k4 + 4] * rstd * wb.x, vals[8 * k4 + 5] * rstd * wb.y); o.w = pk2(vals[8 * k4 + 6] * rstd * wb.z, vals[8 * k4 + 7] * rstd * wb.w);
            *(v4u*)(op + 8 * k4) = o; }
    }
}

__device__ __forceinline__ void load_gemm_row(f32x4 (&v)[4], const bf16* Yb, const float* slab, int ns, int m, int lane) {
    if (m < MP) {
#pragma unroll
        for (int j = 0; j < 4; ++j) { const v2u t = ((const v2u*)(Yb + (size_t)m * D))[lane + 64 * j]; v[j] = (f32x4){bflo(t.x), bfhi(t.x), bflo(t.y), bfhi(t.y)}; }
    } else {
#pragma unroll
        for (int j = 0; j < 4; ++j) v[j] = (f32x4){0.f, 0.f, 0.f, 0.f};
        for (int k = 0; k < ns; ++k) {
#pragma unroll
            for (int j = 0; j < 4; ++j) v[j] += ((const f32x4*)(slab + ((size_t)k * MS + (m - MP)) * D))[lane + 64 * j]; }
    }
}
__device__ __forceinline__ void phase_rows1(const float* xp, const float* xs, const bf16* mixb, const float* slab, int ns, const float* w_post, const float* w_pre2, float* out, bf16* U, int gw, int NGW, int lane) {
    for (int m = gw; m < M; m += NGW) {
        const float* xrow = m < MP ? xp + (size_t)m * D : xs + (size_t)(m - MP) * D;
        f32x4 v[4], xv[4]; float s = 0.f;
        load_gemm_row(v, mixb, slab, ns, m, lane);
#pragma unroll
        for (int j = 0; j < 4; ++j) { xv[j] = ((const f32x4*)xrow)[lane + 64 * j]; s += (v[j].x * v[j].x + v[j].y * v[j].y) + (v[j].z * v[j].z + v[j].w * v[j].w); }
        const float rstd = rsq_(wave_sum(s) * (1.f / D) + EPS); float s2 = 0.f;
#pragma unroll
        for (int j = 0; j < 4; ++j) { const f32x4 g = ((const f32x4*)w_post)[lane + 64 * j]; v[j] = xv[j] + v[j] * rstd * g; ((f32x4*)(out + (size_t)m * D))[lane + 64 * j] = v[j];
            s2 += (v[j].x * v[j].x + v[j].y * v[j].y) + (v[j].z * v[j].z + v[j].w * v[j].w); }
        const float rstd2 = rsq_(wave_sum(s2) * (1.f / D) + EPS);
        unsigned long long* o8 = (unsigned long long*)(U + (size_t)m * D) + lane;
#pragma unroll
        for (int j = 0; j < 4; ++j) { const f32x4 g = ((const f32x4*)w_pre2)[lane + 64 * j]; const f32x4 t = v[j] * rstd2 * g;
            o8[64 * j] = (unsigned long long)pk2(t.x, t.y) | ((unsigned long long)pk2(t.z, t.w) << 32); }
    }
}
__device__ __forceinline__ void phase_rows2(const bf16* dnb, const float* slab, int ns, const float* w, float* out, int gw, int NGW, int lane) {
    for (int m = gw; m < M; m += NGW) {
        f32x4 v[4]; float s = 0.f;
        load_gemm_row(v, dnb, slab, ns, m, lane);
#pragma unroll
        for (int j = 0; j < 4; ++j) s += (v[j].x * v[j].x + v[j].y * v[j].y) + (v[j].z * v[j].z + v[j].w * v[j].w);
        const float rstd = rsq_(wave_sum(s) * (1.f / D) + EPS);
#pragma unroll
        for (int j = 0; j < 4; ++j) { const f32x4 g = ((const f32x4*)w)[lane + 64 * j]; f32x4* op = (f32x4*)(out + (size_t)m * D) + lane + 64 * j; *op = *op + v[j] * rstd * g; }
    }
}
__device__ __forceinline__ float gelu_tanh(float x) { const float y = 0.7978845608028654f * (x + 0.044715f * x * x * x); const float t = 1.f - 2.f * __builtin_amdgcn_rcpf(1.f + __builtin_amdgcn_exp2f(2.8853900817779268f * y)); return 0.5f * x * (1.f + t); }
__device__ __forceinline__ void unpack8(const v4u t, float (&g)[8]) { g[0] = bflo(t.x); g[1] = bfhi(t.x); g[2] = bflo(t.y); g[3] = bfhi(t.y); g[4] = bflo(t.z); g[5] = bfhi(t.z); g[6] = bflo(t.w); g[7] = bfhi(t.w); }
__device__ __forceinline__ void phase_h(const bf16* Gt, bf16* UP, const float* st_ffn, const float* cw, const float* cb, float* out, int gtid, int nth) {
    constexpr int CG = FF / 8, RB = 16, NRB = M / RB;
    for (int task = gtid; task < NRB * CG; task += nth) {
        const int rb = task / CG, c = (task % CG) * 8; const int m0 = rb * RB;
        const bool smp = m0 >= MP; const int tl = smp ? 32 : SEQ;
        int tpos = smp ? ((m0 - MP) & 31) : (m0 & (SEQ - 1)); const int bsm = smp ? ((m0 - MP) >> 5) : (m0 >> 12);
        float w0[8], w1[8], w2[8], bb[8];
        { const f32x4 a = *(const f32x4*)(cw + c), b2 = *(const f32x4*)(cw + c + 4); w0[0] = a.x; w0[1] = a.y; w0[2] = a.z; w0[3] = a.w; w0[4] = b2.x; w0[5] = b2.y; w0[6] = b2.z; w0[7] = b2.w; }
        { const f32x4 a = *(const f32x4*)(cw + FF + c), b2 = *(const f32x4*)(cw + FF + c + 4); w1[0] = a.x; w1[1] = a.y; w1[2] = a.z; w1[3] = a.w; w1[4] = b2.x; w1[5] = b2.y; w1[6] = b2.z; w1[7] = b2.w; }
        { const f32x4 a = *(const f32x4*)(cw + 2 * FF + c), b2 = *(const f32x4*)(cw + 2 * FF + c + 4); w2[0] = a.x; w2[1] = a.y; w2[2] = a.z; w2[3] = a.w; w2[4] = b2.x; w2[5] = b2.y; w2[6] = b2.z; w2[7] = b2.w; }
        { const f32x4 a = *(const f32x4*)(cb + c), b2 = *(const f32x4*)(cb + c + 4); bb[0] = a.x; bb[1] = a.y; bb[2] = a.z; bb[3] = a.w; bb[4] = b2.x; bb[5] = b2.y; bb[6] = b2.z; bb[7] = b2.w; }
        float g0[8], g1[8];
        if (tpos >= 2) { unpack8(*(const v4u*)(Gt + (size_t)(m0 - 2) * FF + c), g0); unpack8(*(const v4u*)(Gt + (size_t)(m0 - 1) * FF + c), g1); }
        else if (smp) {
#pragma unroll
            for (int e = 0; e < 8; ++e) { g0[e] = st_ffn[((size_t)bsm * 2 + 0) * FF + c + e]; g1[e] = st_ffn[((size_t)bsm * 2 + 1) * FF + c + e]; } }
        else {
#pragma unroll
            for (int e = 0; e < 8; ++e) { g0[e] = 0.f; g1[e] = 0.f; } }
#pragma unroll 8
        for (int i = 0; i < RB; ++i) {
            const int m = m0 + i;
            float g2[8], up[8], hv[8];
            unpack8(*(const v4u*)(Gt + (size_t)m * FF + c), g2); unpack8(*(const v4u*)(UP + (size_t)m * FF + c), up);
#pragma unroll
            for (int e = 0; e < 8; ++e) { const float x = w0[e] * g0[e] + w1[e] * g1[e] + w2[e] * g2[e] + bb[e]; hv[e] = gelu_tanh(x) * up[e]; }
            *(v4u*)(UP + (size_t)m * FF + c) = (v4u){pk2(hv[0], hv[1]), pk2(hv[2], hv[3]), pk2(hv[4], hv[5]), pk2(hv[6], hv[7])};
            if (tpos + i >= tl - 2) { const int k = tpos + i - (tl - 2); float* op = (smp ? out + O_FCS : out + O_FCP) + ((size_t)bsm * 2 + k) * FF + c;
#pragma unroll
                for (int e = 0; e < 8; ++e) op[e] = g2[e]; }
#pragma unroll
            for (int e = 0; e < 8; ++e) { g0[e] = g1[e]; g1[e] = g2[e]; }
        }
    }
}

#ifndef MK_N_LAUNCHES
#define MK_N_LAUNCHES 1
#endif
constexpr int NPH = 11;
constexpr int N_LAUNCHES = MK_N_LAUNCHES;
struct Args { const float* in[23]; float* out; unsigned char* ws; int ph_lo, ph_hi, li, pad; };
__global__ void __launch_bounds__(NWAVES * 64, 2) hybrid_fwd(Args args) {
    extern __shared__ __attribute__((aligned(16))) unsigned char lds_raw[];
    LAS unsigned char* lds = (LAS unsigned char*)lds_raw;
    volatile LAS unsigned* MISC = (volatile LAS unsigned*)(lds + MISC_OFF);
    const int tid = threadIdx.x, lane = tid & 63, wave = __builtin_amdgcn_readfirstlane(tid >> 6);
    const int G = gridDim.x; const int bx = blockIdx.x; const int vcu = (G % 8 == 0) ? (bx % 8) * (G / 8) + bx / 8 : bx;
    unsigned char* ws = args.ws; float* out = args.out;
    gu32* ctl = (gu32*)(ws + WS_CTL);
#define x_prompt (args.in[0])
#define x_sample (args.in[1])
#define cache_k (args.in[2])
#define cache_v (args.in[3])
#define state_delta (args.in[4])
#define state_qkv (args.in[5])
#define state_ffn (args.in[6])
#define norm_mix_pre (args.in[7])
#define w_in (args.in[8])
#define qkv_conv_w (args.in[9])
#define a_log (args.in[10])
#define dt_bias (args.in[11])
#define gdn_norm_w (args.in[12])
#define rel_bias (args.in[13])
#define attn_norm_w (args.in[14])
#define w_out (args.in[15])
#define norm_mix_post (args.in[16])
#define norm_ffn_pre (args.in[17])
#define w_gate_up (args.in[18])
#define ffn_conv_w (args.in[19])
#define ffn_conv_b (args.in[20])
#define w_down (args.in[21])
#define norm_ffn_post (args.in[22])
#define Win_t ((bf16*)(ws + WS_WIN))
#define Wout_t ((bf16*)(ws + WS_WOUT))
#define Wgu_t ((bf16*)(ws + WS_WGU))
#define Wdn_t ((bf16*)(ws + WS_WDN))
#define AB ((float*)(ws + WS_AB))
#define DL ((float*)(ws + WS_DL))
#define U ((bf16*)(ws + WS_U))
#define GQK ((bf16*)(ws + WS_GQK))
#define GS ((bf16*)(ws + WS_GS))
#define P ((bf16*)(ws + WS_P))
#define MIXIN ((bf16*)(ws + WS_MIXIN))
#define MIXB ((bf16*)(ws + WS_P))
#define SLAB1 ((float*)(ws + WS_P + 34 * MiB))
#define DOWNB ((bf16*)(ws + WS_U))
#define SLAB2 ((float*)(ws + WS_G))
#define Gt ((bf16*)(ws + WS_G))
#define UP ((bf16*)(ws + WS_UP))
#define GMAIN ((bf16*)out)

    for (int u = tid; u < 64; u += NWAVES * 64) ((LAS unsigned*)(lds + MISC_OFF))[u] = 0u;
    __syncthreads();
    XcdBarrier bar; bar.bar = (unsigned*)(ctl + CW_BAR); bar.x = 0; bar.st = nullptr;
    if (N_LAUNCHES == 1) bar = xcd_barrier_post((unsigned*)(ctl + CW_BAR), MISC + 8);
#define GRID_BAR() do { if (N_LAUNCHES == 1) xcd_barrier(bar); } while (0)
    const int lo = args.ph_lo, hi_ = args.ph_hi;
#define IN(k) (lo <= (k) && (k) < hi_)
#define BOTH(k) (IN(k) && IN((k) + 1))
    const int gw = vcu * NWAVES + wave, NGW = G * NWAVES, gtid = bx * (NWAVES * 64) + tid, nth = G * NWAVES * 64;

    if (IN(0)) { phase_prologue(lds, x_prompt, x_sample, norm_mix_pre, w_in, w_out, w_gate_up, w_down, ws, vcu, G, tid, lane, wave); if (BOTH(0)) GRID_BAR(); }

    if (IN(1)) {
        pg8::Gemm g{U, Win_t, M, NIN, D, D}; pg8::StaticOrder S; S.init(M, NIN, G, bx);
        pg8::EpiBf16<0> E{P, NIN, nullptr, 0, 0, 1.f};
        pg8::gemm_phase<pg8::EpiBf16<0>, pg8::StaticOrder, true, true>(lds, g, S, E);
        if (BOTH(1)) GRID_BAR();
    }

    if (IN(2)) {
        phase_copy_outputs(P, out, gtid, nth);
        for (int u = bx; u < 1152; u += G) gdn_pre_unit(lds, u, P, AB, state_qkv, qkv_conv_w, a_log, dt_bias, GMAIN, GQK, GS, DL, tid, lane, wave);
        if (BOTH(2)) GRID_BAR();
    }

    if (IN(3)) {
        if (bx < 32) {
            const int sidx = bx & 15, half = bx >> 4; const int b = sidx >> 2, h = sidx & 3; const int u0 = b * 256 + h * 64; const size_t m0 = (size_t)b * SEQ;
            scan_half(lds, half, 64, 64, GMAIN + (size_t)u0 * 32768, 32768, GQK + (size_t)u0 * 4096, 4096, DL + u0, nullptr, out + O_DP + (size_t)(b * 4 + h) * 16384,
                      MIXIN + m0 * D + h * 128, (unsigned)(((size_t)M * D - (m0 * D + h * 128)) * 2), half == 0 ? ctl + 1024 + 64 * sidx : (gu32*)nullptr, tid, lane, wave);
        } else if (bx >= G - 16) {
            const int sidx = bx - (G - 16); const int b = sidx >> 2, h = sidx & 3; const int u0 = b * 256 + h * 64;
            scan_helper(ctl + 1024 + 64 * sidx, GMAIN + (size_t)u0 * 32768, 32768, GQK + (size_t)u0 * 4096, 4096, (float*)(ws + WS_DL + 65536), tid, lane);
        } else {
            for (int hu = bx - 32; hu < 256; hu += (G - 48)) {
                const int su = hu >> 1, half = hu & 1; const int b = su >> 2, h = su & 3; const size_t m0 = (size_t)MP + b * 32; const bf16* base = GS + (size_t)su * 36864;
                scan_half(lds, half, 1, 32, base, 0, base + 32768, 0, DL + 1024 + su, state_delta + (size_t)su * 16384, out + O_DS + (size_t)su * 16384,
                          MIXIN + m0 * D + h * 128, (unsigned)(((size_t)M * D - (m0 * D + h * 128)) * 2), (gu32*)nullptr, tid, lane, wave);
            }
            LAS unsigned char* wl = lds + wave * ATT_WAVE_LDS;
            int bt_h = -1;
            for (int it = (bx - 32) * NWAVES + wave; it < 4352; it += (G - 48) * NWAVES) attn_item(wl, it, bt_h, P, cache_k, cache_v, rel_bias, attn_norm_w, MIXIN, lane);
        }
        if (BOTH(3)) GRID_BAR();
    }

    if (IN(4)) { phase_gdn_finish(P, MIXIN, gdn_norm_w, gw, NGW, lane); if (BOTH(4)) GRID_BAR(); }

    if (IN(5)) {
        { pg8::Gemm g{MIXIN, Wout_t, MP, D, D, D}; pg8::StaticOrder S; S.init(MP, D, G, bx);
          pg8::EpiBf16<0> E{MIXB, D, nullptr, 0, 0, 1.f};
          pg8::gemm_phase<pg8::EpiBf16<0>, pg8::StaticOrder, true, true>(lds, g, S, E); }
        { pg8::Gemm g{MIXIN, Wout_t, M, D, 256, D}; pg8::SplitOrder S; S.init(MP / 256, MS / 256, D / 256, 4, bx);
          pg8::EpiF32 E{SLAB1 - (size_t)MP * D, D, (size_t)MS * D};
          pg8::gemm_phase<pg8::EpiF32, pg8::SplitOrder, true, true>(lds, g, S, E); }
        if (BOTH(5)) GRID_BAR();
    }

    if (IN(6)) { phase_rows1(x_prompt, x_sample, MIXB, SLAB1, 4, norm_mix_post, norm_ffn_pre, out, U, gw, NGW, lane); if (BOTH(6)) GRID_BAR(); }

    if (IN(7)) {
        pg8::Gemm g{U, Wgu_t, M, 2 * FF, D, D}; pg8::StaticOrder S; S.init(M, 2 * FF, G, bx);
        pg8::EpiBf16<0> E{Gt, FF, nullptr, FF, (size_t)M * FF, 1.f};
        pg8::gemm_phase<pg8::EpiBf16<0>, pg8::StaticOrder, true, true>(lds, g, S, E);
        if (BOTH(7)) GRID_BAR();
    }

    if (IN(8)) { phase_h(Gt, UP, state_ffn, ffn_conv_w, ffn_conv_b, out, gtid, nth); if (BOTH(8)) GRID_BAR(); }

    if (IN(9)) {
        { pg8::Gemm g{UP, Wdn_t, MP, D, FF, FF}; pg8::StaticOrder S; S.init(MP, D, G, bx);
          pg8::EpiBf16<0> E{DOWNB, D, nullptr, 0, 0, 1.f};
          pg8::gemm_phase<pg8::EpiBf16<0>, pg8::StaticOrder, true, true>(lds, g, S, E); }
        { pg8::Gemm g{UP, Wdn_t, M, D, 256, FF}; pg8::SplitOrder S; S.init(MP / 256, MS / 256, D / 256, 11, bx);
          pg8::EpiF32 E{SLAB2 - (size_t)MP * D, D, (size_t)MS * D};
          pg8::gemm_phase<pg8::EpiF32, pg8::SplitOrder, true, true>(lds, g, S, E); }
        if (BOTH(9)) GRID_BAR();
    }

    if (IN(10)) phase_rows2(DOWNB, SLAB2, 11, norm_ffn_post, out, gw, NGW, lane);
#undef IN
#undef BOTH
#undef GRID_BAR
}

extern "C" void kernel_launch(void* const* d_in, const int* in_sizes, int n_in, void* d_out, int out_size, void* d_ws, size_t ws_size, hipStream_t stream) {
    static int grid = 0;
    if (grid == 0) {
        if (n_in != 23 || out_size != 23699456 || ws_size < WS_END) { fprintf(stderr, "kernel_launch: unexpected shapes (n_in %d, out %d, ws %zu); nothing launched\n", n_in, out_size, ws_size); grid = -1; return; }
        int dev = 0, cus = 0, per_cu = 0;
        if (hipGetDevice(&dev) != hipSuccess || hipDeviceGetAttribute(&cus, hipDeviceAttributeMultiprocessorCount, dev) != hipSuccess) { grid = -1; return; }
        if (hipFuncSetAttribute((const void*)hybrid_fwd, hipFuncAttributeMaxDynamicSharedMemorySize, LDS_BYTES) != hipSuccess) { fprintf(stderr, "kernel_launch: hipFuncSetAttribute failed\n"); grid = -1; return; }
        if (hipOccupancyMaxActiveBlocksPerMultiprocessor(&per_cu, (const void*)hybrid_fwd, NWAVES * 64, LDS_BYTES) != hipSuccess || per_cu < 1) fprintf(stderr, "kernel_launch: occupancy query reports %d\n", per_cu);
        (void)hipGetLastError();
        grid = cus;
    }
    if (grid < 0) return;
    if (hipMemsetAsync((char*)d_ws + WS_CTL, 0, CTL_ZERO_BYTES, stream) != hipSuccess) { fprintf(stderr, "kernel_launch: memset failed\n"); return; }
    Args a{};
    for (int i = 0; i < 23; ++i) a.in[i] = (const float*)d_in[i];
    a.out = (float*)d_out; a.ws = (unsigned char*)d_ws;
    if (N_LAUNCHES == 1) { a.ph_lo = 0; a.ph_hi = NPH; a.li = 0; hipLaunchKernelGGL(hybrid_fwd, dim3(grid), dim3(NWAVES * 64), LDS_BYTES, stream, a); }
    else for (int li = 0; li < NPH; ++li) { a.ph_lo = li; a.ph_hi = li + 1; a.li = li; hipLaunchKernelGGL(hybrid_fwd, dim3(grid), dim3(NWAVES * 64), LDS_BYTES, stream, a);
#ifdef PROBE_DUP
        if (li == PROBE_DUP) hipLaunchKernelGGL(hybrid_fwd, dim3(grid), dim3(NWAVES * 64), LDS_BYTES, stream, a);
#endif
    }
    const hipError_t le = hipPeekAtLastError();
    if (le != hipSuccess) fprintf(stderr, "kernel_launch: launch failed: %s\n", hipGetErrorName(le));
}
```

```cpp
#include <hip/hip_runtime.h>
#include <cstdio>
#include <cstdint>
namespace pg8 {
#define PG8_LAS __attribute__((address_space(3)))
typedef unsigned short bf16_t;
typedef short bf16x8 __attribute__((ext_vector_type(8)));
typedef float f32x4 __attribute__((ext_vector_type(4)));
typedef unsigned u32x4 __attribute__((ext_vector_type(4)));
constexpr int BM = 256, BK = 64, HALF = 128, HTB = HALF * BK * 2  , STAGE_BYTES = 8 * HTB, NXCD = 8, WGM = 8;

__host__ __device__ __forceinline__ int lds_byte(int r, int c) { const int st = (r >> 4) * 2 + (c >> 5), rr = r & 15, cc = c & 31, ob = rr * 64 + cc * 2; return st * 1024 + (ob ^ (((ob >> 9) & 1) << 5)); }
__host__ __device__ __forceinline__ void stage_rc(int b, int& R, int& C) { const int st = b / 1024, sb = b % 1024, swz = sb ^ (((sb >> 9) & 1) << 5); R = (st >> 1) * 16 + swz / 64; C = (st & 1) * 32 + (swz % 64) / 2; }
__host__ __device__ __forceinline__ int perm32(int rho) { const int n = rho >> 4, i = rho & 15; return 8 * (i >> 2) + 4 * n + (i & 3); }

struct Unit { int pm, pn, kq; };
struct Gemm { const bf16_t* A; const bf16_t* Bt; int M, N, K, ld; };

struct StaticOrder {
    int nM, nN, nwg, G, c;
    __host__ __device__ void init(int M, int N, int G_, int c_) { nM = M / BM; nN = N / BM; nwg = nM * nN; G = G_; c = c_; }
    __host__ __device__ bool next(int i, Unit& u) const {
        const long L = (long)i * G + c; if (L >= nwg) return false;
        int wgid = (int)L; { const int q = nwg / NXCD, r = nwg % NXCD, xcd = wgid % NXCD, off = wgid / NXCD; wgid = (xcd < r ? xcd * (q + 1) : r * (q + 1) + (xcd - r) * q) + off; }
        const int nig = WGM * nN, gid = wgid / nig, fm = gid * WGM, gsz = (nM - fm) < WGM ? (nM - fm) : WGM;
        u.pm = fm + ((wgid % nig) % gsz); u.pn = (wgid % nig) / gsz; u.kq = 0; return true;
    }
    __device__ __forceinline__ void a_ready(const Unit&) const {}
    __device__ __forceinline__ void done(const Unit&) const {}
};

struct SplitOrder {
    int pm0, nN, ns, np, c;
    __host__ __device__ void init(int pm0_, int nP, int nN_, int ns_, int c_) { pm0 = pm0_; nN = nN_; ns = ns_; np = nP * nN_ * ns_; c = c_; }
    __host__ __device__ bool next(int i, Unit& u) const { if (i > 0 || c >= np) return false; const int t = c / ns; u.pm = pm0 + t / nN; u.pn = t % nN; u.kq = c % ns; return true; }
    __device__ __forceinline__ void a_ready(const Unit&) const {}
    __device__ __forceinline__ void done(const Unit&) const {}
};

__device__ __forceinline__ unsigned cvt_pk_bf16(float lo, float hi) { unsigned r; asm volatile("v_cvt_pk_bf16_f32 %0, %1, %2" : "=v"(r) : "v"(lo), "v"(hi)); return r; }
typedef float f32x2 __attribute__((ext_vector_type(2)));
__device__ __forceinline__ f32x2 gelu_pk(f32x2 v) {
    const f32x2 av = __builtin_elementwise_abs(v), d = av * 0.2316418882f + 1.0f;
    f32x2 t; t.x = __builtin_amdgcn_rcpf(d.x); t.y = __builtin_amdgcn_rcpf(d.y);
    f32x2 q = t * 0.5307027145f + (-0.7265760135f); q = q * t + 0.7107068705f; q = q * t + (-0.142248368f); q = q * t + 0.127414796f; q = q * t;
    const f32x2 s = (v * v) * (-0.72134752044f);
    f32x2 e; e.x = __builtin_amdgcn_exp2f(s.x); e.y = __builtin_amdgcn_exp2f(s.y);
    const f32x2 m = v * (q * e), r = v - m;
    f32x2 o; o.x = v.x < 0.f ? m.x : r.x; o.y = v.y < 0.f ? m.y : r.y; return o;
}

template <int ACT  > struct EpiBf16 {
    static constexpr bool PERM = true, AFTER_DRAIN = false; static_assert(ACT == 0 || ACT == 1, "EpiBf16: ACT is 0 (none) or 1 (gelu_pk)");
    bf16_t* O; int ldc; const float* bias; int split_cols; size_t split_stride; float scale0;
    __device__ __forceinline__ void operator()(const f32x4 (&acc)[2][2][4][2], const Unit& u, int wr, int wc, int fr, int fq) const {
        const int row0 = u.pm * BM + wr * 64 + fr; int colt = u.pn * BM; bf16_t* base = O;
        float sc = 1.f; if (split_cols) { const int t = colt / split_cols; base += (size_t)t * split_stride; colt -= t * split_cols; if (t == 0) sc = scale0; }
        const int col0 = colt + wc * 32 + 8 * fq, bcol0 = u.pn * BM + wc * 32 + 8 * fq;
        f32x4 bv[2][2];
#pragma unroll
        for (int bj = 0; bj < 2; ++bj)
#pragma unroll
            for (int n = 0; n < 2; ++n) bv[bj][n] = bias ? *(const f32x4*)(bias + bcol0 + bj * HALF + 4 * n) : (f32x4){0.f, 0.f, 0.f, 0.f};
#pragma unroll
        for (int ai = 0; ai < 2; ++ai)
#pragma unroll
            for (int m = 0; m < 4; ++m) { bf16_t* rowp = base + (size_t)(row0 + ai * HALF + m * 16) * ldc + col0;
#pragma unroll
                for (int bj = 0; bj < 2; ++bj) { f32x4 v0 = acc[ai][bj][m][0] + bv[bj][0], v1 = acc[ai][bj][m][1] + bv[bj][1];
                    if (ACT == 1) { f32x2 a = gelu_pk((f32x2){v0[0], v0[1]}), b = gelu_pk((f32x2){v0[2], v0[3]}), c = gelu_pk((f32x2){v1[0], v1[1]}), d = gelu_pk((f32x2){v1[2], v1[3]});
                        v0 = (f32x4){a.x, a.y, b.x, b.y}; v1 = (f32x4){c.x, c.y, d.x, d.y}; }
                    v0 = v0 * sc; v1 = v1 * sc; u32x4 w; w.x = cvt_pk_bf16(v0[0], v0[1]); w.y = cvt_pk_bf16(v0[2], v0[3]); w.z = cvt_pk_bf16(v1[0], v1[1]); w.w = cvt_pk_bf16(v1[2], v1[3]);
                    *(u32x4*)(rowp + bj * HALF) = w; } }
    }
};

struct EpiF32 {
    static constexpr bool PERM = false, AFTER_DRAIN = false;
    float* O; int ldc; size_t kq_stride;
    __device__ __forceinline__ void operator()(const f32x4 (&acc)[2][2][4][2], const Unit& u, int wr, int wc, int fr, int fq) const {
        const int row0 = u.pm * BM + wr * 64 + fr, col0 = u.pn * BM + wc * 32 + 4 * fq;
#pragma unroll
        for (int ai = 0; ai < 2; ++ai)
#pragma unroll
            for (int m = 0; m < 4; ++m) { float* rowp = O + (size_t)u.kq * kq_stride + (size_t)(row0 + ai * HALF + m * 16) * ldc + col0;
#pragma unroll
                for (int bj = 0; bj < 2; ++bj)
#pragma unroll
                    for (int n = 0; n < 2; ++n) *(f32x4*)(rowp + bj * HALF + n * 16) = acc[ai][bj][m][n]; }
    }
};
__device__ __forceinline__ float dpp_ror(float v, int ctrl_is_2) { return ctrl_is_2 ? __uint_as_float((unsigned)__builtin_amdgcn_update_dpp(0, (int)__float_as_uint(v), 0x122, 0xF, 0xF, false))
                                                                               : __uint_as_float((unsigned)__builtin_amdgcn_update_dpp(0, (int)__float_as_uint(v), 0x121, 0xF, 0xF, false)); }
__device__ __forceinline__ float gelu_tanh_f(float x) { const float y = 0.7978845608028654f * (x + 0.044715f * x * x * x); const float t = 1.f - 2.f * __builtin_amdgcn_rcpf(1.f + __builtin_amdgcn_exp2f(2.8853900817779268f * y)); return 0.5f * x * (1.f + t); }
typedef PG8_LAS float PG8_LAS_F;
struct EpiGlu {
    static constexpr bool PERM = true, AFTER_DRAIN = false;
    bf16_t* H; int ff; const float* cw; const float* cb; bf16_t* SB; float* fcp; float* fcs; int mp; PG8_LAS_F* XB;
    __device__ __forceinline__ void operator()(const f32x4 (&acc)[2][2][4][2], const Unit& u, int wr, int wc, int fr, int fq) const {
        const int hl = wc * 32 + 8 * fq, hc = 128 * u.pn + hl;
        float w0[8], w1[8], w2[8], bb[8];
#pragma unroll
        for (int n = 0; n < 2; ++n) { const f32x4 a = *(const f32x4*)(cw + hc + 4 * n), b = *(const f32x4*)(cw + ff + hc + 4 * n), c = *(const f32x4*)(cw + 2 * ff + hc + 4 * n), d = *(const f32x4*)(cb + hc + 4 * n);
#pragma unroll
            for (int e = 0; e < 4; ++e) { w0[4 * n + e] = a[e]; w1[4 * n + e] = b[e]; w2[4 * n + e] = c[e]; bb[4 * n + e] = d[e]; } }
        if (fr >= 14) {
#pragma unroll
            for (int ai = 0; ai < 2; ++ai)
#pragma unroll
                for (int n = 0; n < 2; ++n) *(PG8_LAS f32x4*)(XB + (((ai * 2 + wr) * 2 + (fr - 14)) * 128 + hl + 4 * n)) = acc[ai][0][3][n];
        }
        asm volatile("s_waitcnt lgkmcnt(0)\n\ts_barrier" ::: "memory");
#pragma unroll
        for (int ai = 0; ai < 2; ++ai) {
            float pm1[8], pm2[8];
            if (wr == 1 || ai == 1) { const PG8_LAS float* src = XB + ((wr == 1 ? ai * 2 + 0 : 0 * 2 + 1) * 2) * 128 + hl;
#pragma unroll
                for (int n = 0; n < 2; ++n) { const f32x4 a = *(const PG8_LAS f32x4*)(src + 4 * n), b = *(const PG8_LAS f32x4*)(src + 128 + 4 * n);
#pragma unroll
                    for (int e = 0; e < 4; ++e) { pm2[4 * n + e] = a[e]; pm1[4 * n + e] = b[e]; } } }
            else {
#pragma unroll
                for (int c = 0; c < 8; ++c) { pm1[c] = 0.f; pm2[c] = 0.f; } }
            float q1[8], q2[8];
#pragma unroll
            for (int m = 0; m < 4; ++m) {
                const int row = u.pm * BM + ai * HALF + wr * 64 + m * 16 + fr;
                float hv[8];
#pragma unroll
                for (int c = 0; c < 8; ++c) {
                    const float g = acc[ai][0][m][c >> 2][c & 3], up = acc[ai][1][m][c >> 2][c & 3];
                    const float r1 = dpp_ror(g, 0), r2 = dpp_ror(g, 1);
                    const float g1 = (fr >= 1) ? r1 : (m > 0 ? q1[c] : pm1[c]);
                    const float g0 = (fr >= 2) ? r2 : (m > 0 ? q2[c] : (fr == 1 ? pm1[c] : pm2[c]));
                    q1[c] = r1; q2[c] = r2;
                    hv[c] = gelu_tanh_f(w0[c] * g0 + w1[c] * g1 + w2[c] * g + bb[c]) * up;
                }
                u32x4 w; w.x = cvt_pk_bf16(hv[0], hv[1]); w.y = cvt_pk_bf16(hv[2], hv[3]); w.z = cvt_pk_bf16(hv[4], hv[5]); w.w = cvt_pk_bf16(hv[6], hv[7]);
                *(u32x4*)(H + (size_t)row * ff + hc) = w;
                const bool t01 = ((m & 1) == 0) && fr < 2, t3031 = ((m & 1) == 1) && fr >= 14;
                if (t01 || t3031) {
                    const int slot = t01 ? fr : fr - 12; bf16_t* sp = SB + (((size_t)(row >> 5) * 4 + slot) * 2) * ff + hc;
                    u32x4 gw; gw.x = cvt_pk_bf16(acc[ai][0][m][0][0], acc[ai][0][m][0][1]); gw.y = cvt_pk_bf16(acc[ai][0][m][0][2], acc[ai][0][m][0][3]); gw.z = cvt_pk_bf16(acc[ai][0][m][1][0], acc[ai][0][m][1][1]); gw.w = cvt_pk_bf16(acc[ai][0][m][1][2], acc[ai][0][m][1][3]);
                    u32x4 uw; uw.x = cvt_pk_bf16(acc[ai][1][m][0][0], acc[ai][1][m][0][1]); uw.y = cvt_pk_bf16(acc[ai][1][m][0][2], acc[ai][1][m][0][3]); uw.z = cvt_pk_bf16(acc[ai][1][m][1][0], acc[ai][1][m][1][1]); uw.w = cvt_pk_bf16(acc[ai][1][m][1][2], acc[ai][1][m][1][3]);
                    *(u32x4*)sp = gw; *(u32x4*)(sp + ff) = uw;
                    if (t3031) {
                        float* op = nullptr;
                        if (row >= mp) op = fcs + ((size_t)((row - mp) >> 5) * 2 + (fr - 14)) * ff + hc;
                        else if ((row & 4095) >= 4094) op = fcp + ((size_t)(row >> 12) * 2 + (fr - 14)) * ff + hc;
                        if (op) { *(f32x4*)op = acc[ai][0][m][0]; *(f32x4*)(op + 4) = acc[ai][0][m][1]; }
                    }
                }
            }
        }
    }
};

template <class Epi, class Sched, bool ALIGN_EPI = false, bool SP2 = false>
__device__ __forceinline__ void gemm_phase(PG8_LAS unsigned char* lds, const Gemm g, const Sched& S, const Epi& E) {
    const int tid = threadIdx.x, wid = __builtin_amdgcn_readfirstlane(tid >> 6), lane = tid & 63, wr = wid >> 2, wc = wid & 3, fr = lane & 15, fq = lane >> 4;
    const int K = g.K, ld = g.ld, nt = K / BK;
    unsigned voffA[2], voffB[2];
#pragma unroll
    for (int i = 0; i < 2; ++i) { int R, C; stage_rc(tid * 16 + i * 8192, R, C); const int Rb = Epi::PERM ? ((R & ~31) + perm32(R & 31)) : R;
        voffA[i] = (unsigned)(R * ld + C) * 2u; voffB[i] = (unsigned)(Rb * ld + C) * 2u; }
    const size_t kstep = (size_t)(BK * 2);
    const size_t hstep = (size_t)HALF * ld * 2;
    const size_t tstep = 2 * hstep;
    const unsigned ldsw = (unsigned)wid * 1024u;
    const int aoff = lds_byte(wr * 64 + fr, fq * 8), boff = lds_byte(wc * 32 + fr, fq * 8);
#define PG8_SA(b, h) (((b) * 2 + (h)) * HTB)
#define PG8_SB(b, h) ((4 + (b) * 2 + (h)) * HTB)
#define PG8_STAGE(bufoff, gbase, voff) do { _Pragma("unroll") for (int _i = 0; _i < 2; ++_i) \
        __builtin_amdgcn_global_load_lds((const unsigned*)((const char*)(gbase) + (voff)[_i]), (PG8_LAS unsigned*)(lds + (bufoff) + ldsw + _i * 8192), 16, 0, 0); } while (0)
#define PG8_LDA(dst, b, h) do { _Pragma("unroll") for (int m = 0; m < 4; ++m) _Pragma("unroll") for (int k = 0; k < 2; ++k) dst[m][k] = *(const PG8_LAS bf16x8*)(lds + PG8_SA(b, h) + aoff + m * 2048 + k * 1024); } while (0)
#define PG8_LDB(dst, b, h) do { _Pragma("unroll") for (int n = 0; n < 2; ++n) _Pragma("unroll") for (int k = 0; k < 2; ++k) dst[n][k] = *(const PG8_LAS bf16x8*)(lds + PG8_SB(b, h) + boff + n * 2048 + k * 1024); } while (0)
#define PG8_MMA(ai, bj, At, Bt) do { __builtin_amdgcn_s_setprio(1); _Pragma("unroll") for (int m = 0; m < 4; ++m) _Pragma("unroll") for (int n = 0; n < 2; ++n) _Pragma("unroll") for (int k = 0; k < 2; ++k) \
        acc[ai][bj][m][n] = __builtin_amdgcn_mfma_f32_16x16x32_bf16(Bt[n][k], At[m][k], acc[ai][bj][m][n], 0, 0, 0); __builtin_amdgcn_s_setprio(0); } while (0)
#define PG8_WAIT_V(n) asm volatile("s_waitcnt vmcnt(" #n ")" ::: "memory")
#define PG8_WAIT_L(n) asm volatile("s_waitcnt lgkmcnt(" #n ")" ::: "memory")
#define PG8_BAR __builtin_amdgcn_s_barrier()
#define PG8_SCHED __builtin_amdgcn_sched_barrier(0)
    Unit cur, nxt; int ui = 0;
    if (!S.next(0, cur)) return;
    f32x4 acc[2][2][4][2];
#pragma unroll
    for (int a = 0; a < 2; ++a)
#pragma unroll
        for (int b = 0; b < 2; ++b)
#pragma unroll
            for (int m = 0; m < 4; ++m)
#pragma unroll
                for (int n = 0; n < 2; ++n) acc[a][b][m][n] = (f32x4){0.f, 0.f, 0.f, 0.f};
    bf16x8 At[4][2], B0[2][2], B1[2][2];
    const size_t kqb = (size_t)K * 2;
    const char* cA = (const char*)g.A + (size_t)cur.pm * tstep + cur.kq * kqb; const char* cB = (const char*)g.Bt + (size_t)cur.pn * tstep + cur.kq * kqb;
    S.a_ready(cur);
    if constexpr (SP2) {
        PG8_STAGE(PG8_SB(0, 0), cB, voffB); PG8_STAGE(PG8_SB(0, 1), cB + hstep, voffB); PG8_STAGE(PG8_SA(0, 0), cA, voffA); PG8_STAGE(PG8_SA(0, 1), cA + hstep, voffA);
        if (wr == 1) PG8_BAR;
        PG8_WAIT_V(2); PG8_BAR;
        PG8_STAGE(PG8_SB(1, 0), cB + kstep, voffB); PG8_STAGE(PG8_SA(1, 0), cA + kstep, voffA); PG8_STAGE(PG8_SB(1, 1), cB + hstep + kstep, voffB);
        PG8_WAIT_V(6); PG8_BAR;
    } else {
        PG8_STAGE(PG8_SB(0, 0), cB, voffB); PG8_STAGE(PG8_SA(0, 0), cA, voffA); PG8_STAGE(PG8_SB(0, 1), cB + hstep, voffB); PG8_STAGE(PG8_SA(0, 1), cA + hstep, voffA);
        if (wr == 1) PG8_BAR;
        PG8_WAIT_V(4); PG8_BAR;
        PG8_STAGE(PG8_SB(1, 0), cB + kstep, voffB); PG8_STAGE(PG8_SA(1, 0), cA + kstep, voffA); PG8_STAGE(PG8_SB(1, 1), cB + hstep + kstep, voffB);
        PG8_WAIT_V(6); PG8_BAR;
    }
    for (;;) {
        const bool has_next = S.next(ui + 1, nxt);
        const char* nA = has_next ? (const char*)g.A + (size_t)nxt.pm * tstep + nxt.kq * kqb : cA; const char* nB = has_next ? (const char*)g.Bt + (size_t)nxt.pn * tstep + nxt.kq * kqb : cB;
        for (int t = 0; t < nt; t += 2) {
            const bool last = (t == nt - 2);
            const char* a1 = cA + (size_t)(t + 1) * kstep;
            const char* a2 = last ? nA : cA + (size_t)(t + 2) * kstep; const char* b2 = last ? nB : cB + (size_t)(t + 2) * kstep;
            const char* a3 = a2 + kstep; const char* b3 = b2 + kstep;
            if (last && has_next) S.a_ready(nxt);
            if constexpr (SP2) {
            PG8_LDB(B0, 0, 0); PG8_LDB(B1, 0, 1); PG8_SCHED; PG8_LDA(At, 0, 0); PG8_STAGE(PG8_SA(1, 1), a1 + hstep, voffA);
            PG8_WAIT_V(8); PG8_WAIT_L(0); PG8_BAR; PG8_MMA(0, 0, At, B0); PG8_MMA(0, 1, At, B1); PG8_BAR; PG8_SCHED;
            PG8_LDA(At, 0, 1); PG8_STAGE(PG8_SB(0, 0), b2, voffB); PG8_STAGE(PG8_SB(0, 1), b2 + hstep, voffB); PG8_STAGE(PG8_SA(0, 0), a2, voffA);
            PG8_WAIT_V(8); PG8_WAIT_L(0); PG8_BAR; PG8_MMA(1, 0, At, B0); PG8_MMA(1, 1, At, B1); PG8_BAR; PG8_SCHED;
            PG8_LDB(B0, 1, 0); PG8_LDB(B1, 1, 1); PG8_SCHED; PG8_LDA(At, 1, 0); PG8_STAGE(PG8_SA(0, 1), a2 + hstep, voffA);
            PG8_WAIT_V(8); PG8_WAIT_L(0); PG8_BAR; PG8_MMA(0, 0, At, B0); PG8_MMA(0, 1, At, B1); PG8_BAR; PG8_SCHED;
            PG8_LDA(At, 1, 1); PG8_STAGE(PG8_SB(1, 0), b3, voffB); PG8_STAGE(PG8_SB(1, 1), b3 + hstep, voffB); PG8_STAGE(PG8_SA(1, 0), a3, voffA);
            PG8_WAIT_V(8); PG8_WAIT_L(0); PG8_BAR; PG8_MMA(1, 0, At, B0); PG8_MMA(1, 1, At, B1); PG8_BAR; PG8_SCHED;
            } else {
            PG8_LDB(B0, 0, 0); PG8_SCHED; PG8_LDA(At, 0, 0); PG8_STAGE(PG8_SA(1, 1), a1 + hstep, voffA);
            PG8_WAIT_L(8); PG8_BAR; PG8_WAIT_L(0); PG8_MMA(0, 0, At, B0); PG8_BAR; PG8_SCHED;
            PG8_LDB(B1, 0, 1); PG8_STAGE(PG8_SB(0, 0), b2, voffB);
            PG8_BAR; PG8_WAIT_L(0); PG8_MMA(0, 1, At, B1); PG8_BAR;
            PG8_LDA(At, 0, 1); PG8_STAGE(PG8_SA(0, 0), a2, voffA);
            PG8_BAR; PG8_WAIT_L(0); PG8_MMA(1, 0, At, B0); PG8_BAR; PG8_SCHED;
            PG8_STAGE(PG8_SB(0, 1), b2 + hstep, voffB);
            PG8_WAIT_V(6); PG8_BAR; PG8_MMA(1, 1, At, B1); PG8_BAR;
            PG8_LDB(B0, 1, 0); PG8_SCHED; PG8_LDA(At, 1, 0); PG8_STAGE(PG8_SA(0, 1), a2 + hstep, voffA);
            PG8_WAIT_L(8); PG8_BAR; PG8_WAIT_L(0); PG8_MMA(0, 0, At, B0); PG8_BAR; PG8_SCHED;
            PG8_LDB(B1, 1, 1); PG8_STAGE(PG8_SB(1, 0), b3, voffB);
            PG8_BAR; PG8_WAIT_L(0); PG8_MMA(0, 1, At, B1); PG8_BAR;
            PG8_LDA(At, 1, 1); PG8_STAGE(PG8_SA(1, 0), a3, voffA);
            PG8_BAR; PG8_WAIT_L(0); PG8_MMA(1, 0, At, B0); PG8_BAR; PG8_SCHED;
            PG8_STAGE(PG8_SB(1, 1), b3 + hstep, voffB);
            PG8_WAIT_V(6); PG8_BAR; PG8_MMA(1, 1, At, B1); PG8_BAR;
            }
        }
        if constexpr (ALIGN_EPI) { if (wr == 0) PG8_BAR; }
        if constexpr (!Epi::AFTER_DRAIN) { E(acc, cur, wr, wc, fr, fq); S.done(cur); }
        if (!has_next) break;
#pragma unroll
        for (int a = 0; a < 2; ++a)
#pragma unroll
            for (int b = 0; b < 2; ++b)
#pragma unroll
                for (int m = 0; m < 4; ++m)
#pragma unroll
                    for (int n = 0; n < 2; ++n) acc[a][b][m][n] = (f32x4){0.f, 0.f, 0.f, 0.f};
        cur = nxt; cA = nA; cB = nB; ++ui;
        if constexpr (ALIGN_EPI) { if (wr == 1) PG8_BAR; }
    }
    PG8_WAIT_V(0);
    if constexpr (!ALIGN_EPI) { if (wr == 0) PG8_BAR; }
    PG8_BAR;
    if constexpr (Epi::AFTER_DRAIN) { E.fused(acc, cur, wr, wc, fr, fq, lds, wid, lane); S.done(cur); }
#undef PG8_SA
#undef PG8_SB
#undef PG8_STAGE
#undef PG8_LDA
#undef PG8_LDB
#undef PG8_MMA
#undef PG8_WAIT_V
#undef PG8_WAIT_L
#undef PG8_BAR
#undef PG8_SCHED
}
}

constexpr int NWAVES = 8;
constexpr int D = 1024, SEQ = 4096, MP = 16384, MS = 1024, M = MP + MS;
constexpr int NIN = 3584, INC = 3592, FF = 2816;
constexpr int PC_Z = 1536, PC_QB = 2048, PC_KB = 2560, PC_VB = 3072;
constexpr float EPS = 1e-6f;
constexpr size_t O_YP = 0, O_YS = 16777216, O_BKP = 17825792, O_BVP = 18874368, O_DP = 19922944, O_QCP = 20185088, O_FCP = 20203520,
                 O_BKS = 20226048, O_BVS = 20750336, O_DS = 21274624, O_QCS = 23371776, O_FCS = 23519232;
constexpr size_t MiB = 1u << 20;
constexpr size_t WS_CTL = 0, CTL_ZERO_BYTES = 1 * MiB;
constexpr size_t WS_WIN = 1 * MiB, WS_WOUT = 8 * MiB, WS_WGU = 10 * MiB, WS_WDN = 21 * MiB;
constexpr size_t WS_AB = 27 * MiB, WS_DL = 27 * MiB + 768 * 1024;
constexpr size_t WS_U = 28 * MiB;
constexpr size_t WS_GQK = WS_U, WS_GS = WS_U + 8 * MiB;
constexpr size_t WS_P = 62 * MiB;
constexpr size_t WS_MIXIN = 181 * MiB;
constexpr size_t WS_G = WS_P, WS_UP = WS_P + (size_t)M * FF * 2;
constexpr size_t WS_END = 256 * MiB;
static_assert(WS_UP + (size_t)M * FF * 2 <= WS_END, "ws map");
constexpr int CW_BAR = 4096;

constexpr int LDS_BYTES = 163840;
constexpr int MISC_OFF = LDS_BYTES - 256;

#define GAS __attribute__((address_space(1)))
#define LAS __attribute__((address_space(3)))
typedef unsigned short bf16;
typedef unsigned v4u __attribute__((ext_vector_type(4)));
typedef unsigned v2u __attribute__((ext_vector_type(2)));
typedef float f32x2 __attribute__((ext_vector_type(2)));
typedef float f32x4 __attribute__((ext_vector_type(4)));
typedef float f32x16 __attribute__((ext_vector_type(16)));
typedef short bf16x8 __attribute__((ext_vector_type(8)));
typedef short s16x4 __attribute__((ext_vector_type(4)));
typedef __bf16 bf16x2_t __attribute__((ext_vector_type(2)));
typedef GAS unsigned gu32;
#define RLX_AGENT __ATOMIC_RELAXED, __HIP_MEMORY_SCOPE_AGENT
#define LDS_WAIT() asm volatile("s_waitcnt lgkmcnt(0)" ::: "memory")
#define VM_WAIT() asm volatile("s_waitcnt vmcnt(0)" ::: "memory")
__device__ __forceinline__ unsigned pk2(float lo, float hi) { f32x2 v = {lo, hi}; bf16x2_t b = __builtin_convertvector(v, bf16x2_t); return __builtin_bit_cast(unsigned, b); }
__device__ __forceinline__ float bflo(unsigned w) { return __uint_as_float(w << 16); }
__device__ __forceinline__ float bfhi(unsigned w) { return __uint_as_float(w & 0xffff0000u); }
__device__ __forceinline__ float bf1(bf16 b) { return __uint_as_float((unsigned)b << 16); }
__device__ __forceinline__ bf16 f2bf(float f) { return (bf16)(pk2(f, 0.f) & 0xffffu); }
__device__ __forceinline__ float wave_sum(float v) {
#pragma unroll
    for (int o = 1; o < 64; o <<= 1) v += __shfl_xor(v, o);
    return v;
}
__device__ __forceinline__ float sigmoidf_(float x) { return __builtin_amdgcn_rcpf(1.0f + __builtin_amdgcn_exp2f(-1.4426950408889634f * x)); }
__device__ __forceinline__ float rsq_(float x) { return __builtin_amdgcn_rsqf(x); }
__device__ __forceinline__ int crow(int r, int hi) { return (r & 3) + 8 * (r >> 2) + 4 * hi; }
#define MFMA32(a, b, c) __builtin_amdgcn_mfma_f32_32x32x16_bf16((a), (b), (c), 0, 0, 0)
#define MFMA16(a, b, c) __builtin_amdgcn_mfma_f32_16x16x32_bf16((a), (b), (c), 0, 0, 0)
#define XB_TMO      128
#define XB_XCNT(j)  (256  + 64 * (j))
#define XB_XSUB(j)  (1280 + 64 * (j))
#define XB_XGEN(j)  (2304 + 64 * (j))
#define XB_TOP      3328
#define XB_TOPGEN   3392
#define XCD_BAR_WORDS 3456
#define XB_SPIN_CAP (1u << 18)

__device__ __forceinline__ unsigned xb_ld(unsigned* p)              { return __hip_atomic_load(p, __ATOMIC_RELAXED, __HIP_MEMORY_SCOPE_AGENT); }
__device__ __forceinline__ unsigned xb_add(unsigned* p, unsigned v) { return __hip_atomic_fetch_add(p, v, __ATOMIC_RELAXED, __HIP_MEMORY_SCOPE_AGENT); }
__device__ __forceinline__ unsigned xb_xcc_id() { return (unsigned)__builtin_amdgcn_s_getreg((3 << 11) | 20) & 0xFu; }
#define XB_SPIN(cond, bar) do { unsigned _sp = 0; while (cond) { __builtin_amdgcn_s_sleep(1); \
    if ((++_sp & 255u) == 0u) { if (xb_ld(&(bar)[XB_TMO])) break; if (_sp > XB_SPIN_CAP) { atomicAdd(&(bar)[XB_TMO], 1u); break; } } } } while (0)

struct XcdBarrier {
    unsigned* bar; unsigned x;
    volatile LAS unsigned* st;
};

__device__ __forceinline__ XcdBarrier xcd_barrier_post(unsigned* bar, volatile LAS unsigned* st) {
    XcdBarrier b; b.bar = bar; b.x = xb_xcc_id(); b.st = st;
    if (threadIdx.x == 0) (void)xb_add(&bar[XB_XCNT(b.x)], 1u);
    return b;
}
__device__ __forceinline__ void xcd_barrier_complete(unsigned* bar, unsigned x, unsigned& nloc, unsigned& nx) {
    const unsigned G = gridDim.x * gridDim.y * gridDim.z;
    unsigned sum, cnt, mine, sp = 0u;
    for (;;) {
        sum = 0u; cnt = 0u; mine = 0u;
#pragma unroll
        for (unsigned j = 0; j < 16; ++j) { const unsigned c = xb_ld(&bar[XB_XCNT(j)]); sum += c; cnt += (c > 0u) ? 1u : 0u; mine = (j == x) ? c : mine; }
        if (sum == G) break;
        __builtin_amdgcn_s_sleep(1);
        if ((++sp & 255u) == 0u) { if (xb_ld(&bar[XB_TMO])) break; if (sp > XB_SPIN_CAP) { atomicAdd(&bar[XB_TMO], 1u); break; } }
    }
    nloc = mine > 0u ? mine : 1u; nx = cnt > 0u ? cnt : 1u;
}

__device__ __forceinline__ void xcd_barrier(const XcdBarrier& b) {
    asm volatile("s_waitcnt vmcnt(0)" ::: "memory");
    __syncthreads();
    if (threadIdx.x == 0) {
        unsigned* bar = b.bar;
        __builtin_amdgcn_s_waitcnt(0);
        unsigned nloc = b.st[0], nx = b.st[1];
        if (nloc == 0u) { xcd_barrier_complete(bar, b.x, nloc, nx); b.st[0] = nloc; b.st[1] = nx; }
        const unsigned old = xb_add(&bar[XB_XSUB(b.x)], 1u);
        const unsigned gen = old / nloc;
        if (old + 1u == (gen + 1u) * nloc) {
            __builtin_amdgcn_fence(__ATOMIC_RELEASE, "agent");
            asm volatile("s_waitcnt vmcnt(0)" ::: "memory");
            const unsigned og = xb_add(&bar[XB_TOP], 1u);
            const unsigned tg = og / nx;
            if (og + 1u == (tg + 1u) * nx) xb_add(&bar[XB_TOPGEN], 1u);
            else XB_SPIN(xb_ld(&bar[XB_TOPGEN]) == tg, bar);
            __builtin_amdgcn_fence(__ATOMIC_ACQUIRE, "agent");
            xb_add(&bar[XB_XGEN(b.x)], 1u);
            asm volatile("s_waitcnt vmcnt(0)" ::: "memory");
        } else {
            XB_SPIN(xb_ld(&bar[XB_XGEN(b.x)]) == gen, bar);
            __builtin_amdgcn_fence(__ATOMIC_ACQUIRE, "agent");
            asm volatile("s_waitcnt vmcnt(0)" ::: "memory");
        }
    }
    __syncthreads();
}

__device__ __forceinline__ void p0_transpose_item(const float* W, int ldw, int K, int N, bf16* WT, int row_off, LAS float* scr, int item, int lane) {
    const int nblk = N / 32, kb = item / nblk, nb = item % nblk, k0 = 64 * kb, n0 = 32 * nb;
#pragma unroll 8
    for (int i = 0; i < 32; ++i) { const int kk = 2 * i + (lane >> 5); scr[kk * 33 + (lane & 31)] = W[(size_t)(k0 + kk) * ldw + n0 + (lane & 31)]; }
    LDS_WAIT(); asm volatile("" ::: "memory");
    const int c = lane & 7;
#pragma unroll
    for (int j = 0; j < 4; ++j) { const int n = (lane >> 3) + 8 * j; const LAS float* s = scr + (8 * c) * 33 + n;
        v4u o; o.x = pk2(s[0 * 33], s[1 * 33]); o.y = pk2(s[2 * 33], s[3 * 33]); o.z = pk2(s[4 * 33], s[5 * 33]); o.w = pk2(s[6 * 33], s[7 * 33]);
        *(v4u*)(WT + (size_t)(row_off + n0 + n) * K + k0 + 8 * c) = o; }
    LDS_WAIT(); asm volatile("" ::: "memory");
}

__device__ __forceinline__ void phase_prologue(LAS unsigned char* lds, const float* xp, const float* xs, const float* nw, const float* w_in, const float* w_out, const float* w_gu, const float* w_dn,
                                               unsigned char* ws, int vcu, int G, int tid, int lane, int wave) {
    LAS float* scr = (LAS float*)(lds + wave * 8448);
    LAS float* W8T = (LAS float*)(lds + 67584);
    for (int k = tid; k < 1024; k += 512) {
        const f32x4 a = *(const f32x4*)(w_in + (size_t)k * INC + 2048), b = *(const f32x4*)(w_in + (size_t)k * INC + 2052);
        W8T[0 * 1024 + k] = a.x; W8T[1 * 1024 + k] = a.y; W8T[2 * 1024 + k] = a.z; W8T[3 * 1024 + k] = a.w;
        W8T[4 * 1024 + k] = b.x; W8T[5 * 1024 + k] = b.y; W8T[6 * 1024 + k] = b.z; W8T[7 * 1024 + k] = b.w;
    }
    __syncthreads();
    const int gw = vcu * NWAVES + wave, NGW = G * NWAVES;
    bf16* Win_t = (bf16*)(ws + WS_WIN); bf16* Wout_t = (bf16*)(ws + WS_WOUT); bf16* Wgu_t = (bf16*)(ws + WS_WGU); bf16* Wdn_t = (bf16*)(ws + WS_WDN);
    constexpr int I_A = 16 * 64, I_B = 16 * 48, I_O = 16 * 32, I_GU = 16 * 176, I_DN = 44 * 32;
    constexpr int NITEMS = I_A + I_B + I_O + I_GU + I_DN;
    for (int it = gw; it < NITEMS; it += NGW) {
        int r = it;
        if (r < I_A) { p0_transpose_item(w_in, INC, D, 2048, Win_t, 0, scr, r, lane); continue; } r -= I_A;
        if (r < I_B) { p0_transpose_item(w_in + 2056, INC, D, 1536, Win_t, 2048, scr, r, lane); continue; } r -= I_B;
        if (r < I_O) { p0_transpose_item(w_out, D, D, D, Wout_t, 0, scr, r, lane); continue; } r -= I_O;
        if (r < I_GU) { const int blk = r >> 6, sub = r & 63;
            if (blk < 22) p0_transpose_item(w_gu + 128 * blk, 2 * FF, D, 128, Wgu_t, 256 * blk, scr, sub, lane);
            else p0_transpose_item(w_gu + FF + 128 * (blk - 22), 2 * FF, D, 128, Wgu_t, 256 * (blk - 22) + 128, scr, sub, lane);
            continue; } r -= I_GU;
        p0_transpose_item(w_dn, D, FF, D, Wdn_t, 0, scr, r, lane);
    }
    bf16* U = (bf16*)(ws + WS_U); float* AB = (float*)(ws + WS_AB);
    for (int m = gw; m < M; m += NGW) {
        const float* xrow = m < MP ? xp + (size_t)m * D : xs + (size_t)(m - MP) * D;
        f32x4 v[4]; float s = 0.f;
#pragma unroll
        for (int j = 0; j < 4; ++j) { v[j] = ((const f32x4*)xrow)[lane + 64 * j]; s += (v[j].x * v[j].x + v[j].y * v[j].y) + (v[j].z * v[j].z + v[j].w * v[j].w); }
        const float rstd = rsq_(wave_sum(s) * (1.f / D) + EPS);
        unsigned long long* o8 = (unsigned long long*)(U + (size_t)m * D) + lane;
#pragma unroll
        for (int j = 0; j < 4; ++j) { const f32x4 g = ((const f32x4*)nw)[lane + 64 * j]; v[j] = v[j] * rstd * g;
            o8[64 * j] = (unsigned long long)pk2(v[j].x, v[j].y) | ((unsigned long long)pk2(v[j].z, v[j].w) << 32); }
        float dv = 0.f;
#pragma unroll
        for (int jj = 0; jj < 8; ++jj) { float acc = 0.f;
#pragma unroll
            for (int j = 0; j < 4; ++j) { const f32x4 w = *(const LAS f32x4*)(W8T + jj * 1024 + 4 * lane + 256 * j); acc += (v[j].x * w.x + v[j].y * w.y) + (v[j].z * w.z + v[j].w * w.w); }
            acc = wave_sum(acc); if (lane == jj) dv = acc; }
        if (lane < 8) AB[(size_t)m * 8 + lane] = dv;
    }
}

__device__ __forceinline__ void phase_copy_outputs(const bf16* P, float* out, int gtid, int nth) {
    for (int e = gtid; e < 4 * 512 * 512; e += nth) { const int b = e >> 18, j = (e >> 9) & 511, c = e & 511; const size_t row = (size_t)(b * SEQ + 3584 + j) * NIN;
        out[O_BKP + e] = bf1(P[row + PC_KB + c]); out[O_BVP + e] = bf1(P[row + PC_VB + c]); }
    for (int e = gtid; e < 32 * 32 * 512; e += nth) { const int r = e >> 9, c = e & 511; const size_t row = (size_t)(MP + r) * NIN;
        out[O_BKS + e] = bf1(P[row + PC_KB + c]); out[O_BVS + e] = bf1(P[row + PC_VB + c]); }
    for (int e = gtid; e < 4 * 3 * 1536; e += nth) { const int b = e / 4608, i = (e / 1536) % 3, c = e % 1536; out[O_QCP + e] = bf1(P[(size_t)(b * SEQ + 4093 + i) * NIN + c]); }
    for (int e = gtid; e < 32 * 3 * 1536; e += nth) { const int b = e / 4608, i = (e / 1536) % 3, c = e % 1536; out[O_QCS + e] = bf1(P[(size_t)(MP + b * 32 + 29 + i) * NIN + c]); }
}

__device__ __forceinline__ bf16x8 pack8(const f32x4& a, const f32x4& b) { const v4u t = {pk2(a[0], a[1]), pk2(a[2], a[3]), pk2(b[0], b[1]), pk2(b[2], b[3])}; return __builtin_bit_cast(bf16x8, t); }
__device__ __forceinline__ float dpp_sum16(float v) {
    v += __uint_as_float((unsigned)__builtin_amdgcn_update_dpp(0, (int)__float_as_uint(v), 0xB1, 0xF, 0xF, true));
    v += __uint_as_float((unsigned)__builtin_amdgcn_update_dpp(0, (int)__float_as_uint(v), 0x4E, 0xF, 0xF, true));
    v += __uint_as_float((unsigned)__builtin_amdgcn_update_dpp(0, (int)__float_as_uint(v), 0x141, 0xF, 0xF, true));
    v += __uint_as_float((unsigned)__builtin_amdgcn_update_dpp(0, (int)__float_as_uint(v), 0x140, 0xF, 0xF, true));
    return v;
}
__device__ __forceinline__ int kperm(int k) { const int kk = k & 31; return (k & ~31) | (8 * ((kk & 15) >> 2) + (kk & 3) + 4 * (kk >> 4)); }
__device__ __forceinline__ void gdn_pre_unit(LAS unsigned char* lds, int u, const bf16* P, const float* AB, const float* st_qkv, const float* conv_w, const float* a_log, const float* dt_bias,
                                             bf16* gmain, bf16* gqk, bf16* gs, float* DL, int tid, int lane, int wave) {
    LAS float* RHS = (LAS float*)(lds + 0);
    LAS bf16* QB = (LAS bf16*)(lds + 65536);
    LAS bf16* KB = (LAS bf16*)(lds + 82944);
    LAS bf16* RAW = (LAS bf16*)(lds + 100352);
    LAS bf16* KGT = (LAS bf16*)(lds + 117760);
    LAS bf16* AMN = (LAS bf16*)(lds + 117760);
    LAS float* TD = (LAS float*)(lds + 117760 + 10240);
    LAS bf16* TB = (LAS bf16*)(lds + 117760 + 14336);
    LAS float* SMG = (LAS float*)(lds + 136192);
    const bool prompt = u < 1024;
    int b, h, n, m0, valid; bf16 *o_w, *o_qg, *o_kgt, *o_ut, *o_qk;
    if (prompt) { b = u >> 8; h = (u >> 6) & 3; n = u & 63; m0 = b * SEQ + n * 64; valid = 64; bf16* base = gmain + (size_t)u * 32768; o_w = base; o_qg = base + 8192; o_kgt = base + 16384; o_ut = base + 24576; o_qk = gqk + (size_t)u * 4096; }
    else { const int su = u - 1024; b = su >> 2; h = su & 3; n = 0; m0 = MP + b * 32; valid = 32; bf16* base = gs + (size_t)su * 36864; o_w = base; o_qg = base + 8192; o_kgt = base + 16384; o_ut = base + 24576; o_qk = base + 32768; }
    unsigned xr[3][11];
    if (prompt) {
#pragma unroll
        for (int part = 0; part < 3; ++part) { const int pcol = (part == 0 ? 512 : part == 1 ? 0 : 1024) + h * 128 + 2 * lane;
#pragma unroll
            for (int j = 0; j < 11; ++j) { const int ts = n * 64 - 3 + wave * 8 + j; const unsigned val = *(const unsigned*)(P + (size_t)(b * SEQ + (ts < 0 ? 0 : ts)) * NIN + pcol); xr[part][j] = ts < 0 ? 0u : val; } }
    } else {
#pragma unroll
        for (int part = 0; part < 3; ++part) { const int pcol = (part == 0 ? 512 : part == 1 ? 0 : 1024) + h * 128 + 2 * lane;
#pragma unroll
            for (int j = 0; j < 11; ++j) { const int pr = wave * 8 + j - 3; const int prc = pr < 0 ? 0 : (pr > 31 ? 31 : pr); const unsigned val = *(const unsigned*)(P + (size_t)(MP + b * 32 + prc) * NIN + pcol); xr[part][j] = (pr < 0 || pr > 31) ? 0u : val; }
#pragma unroll
            for (int j = 0; j < 3; ++j) { const int rr = wave * 8 + j; const f32x2 sv = *(const f32x2*)(st_qkv + ((size_t)b * 3 + (rr > 2 ? 2 : rr)) * 1536 + pcol); if (rr < 3) xr[part][j] = pk2(sv.x, sv.y); } }
    }
    float cw0[3][4], cw1[3][4];
#pragma unroll
    for (int part = 0; part < 3; ++part)
#pragma unroll
        for (int i = 0; i < 4; ++i) { const f32x2 t = *(const f32x2*)(conv_w + i * 1536 + (part == 0 ? 512 : part == 1 ? 0 : 1024) + h * 128 + 2 * lane); cw0[part][i] = t.x; cw1[part][i] = t.y; }
    if (wave == 0) {
        const int i = lane; const bool v = i < valid;
        const float araw = v ? AB[(size_t)(m0 + i) * 8 + 4 + h] : 0.f, braw = v ? AB[(size_t)(m0 + i) * 8 + h] : 0.f;
        const float A = expf(a_log[h]); const float x = araw + dt_bias[h];
        const float sp = x > 20.f ? x : log1pf(expf(x));
        const float g = v ? -A * sp : 0.f; const float beta = v ? 1.f / (1.f + expf(-braw)) : 0.f;
        float Gc = g;
#pragma unroll
        for (int off = 1; off < 64; off <<= 1) { const float t = __shfl_up(Gc, off); if (lane >= off) Gc += t; }
        const float Gl = __shfl(Gc, 63);
        SMG[i] = Gc; SMG[64 + i] = beta; SMG[128 + i] = expf(Gc); SMG[192 + i] = expf(Gl - Gc);
        if (lane == 0) DL[u] = expf(Gl);
    }
    __syncthreads();
    const int r0 = wave * 8;
#pragma unroll
    for (int part = 0; part < 3; ++part) {
        float s0[8], s1[8], rinv[8];
#pragma unroll
        for (int rq = 0; rq < 8; ++rq) { float y0 = 0.f, y1 = 0.f;
#pragma unroll
            for (int i = 0; i < 4; ++i) { const unsigned xw = xr[part][rq + i]; y0 += cw0[part][i] * bflo(xw); y1 += cw1[part][i] * bfhi(xw); }
            s0[rq] = y0 * sigmoidf_(y0); s1[rq] = y1 * sigmoidf_(y1);
            if (r0 + rq >= valid) { s0[rq] = 0.f; s1[rq] = 0.f; } }
        if (part != 2) {
#pragma unroll
            for (int rq = 0; rq < 8; ++rq) { const int tb = (int)__float_as_uint(dpp_sum16(s0[rq] * s0[rq] + s1[rq] * s1[rq]));
                const float tot = (__uint_as_float(__builtin_amdgcn_readlane(tb, 0)) + __uint_as_float(__builtin_amdgcn_readlane(tb, 16))) + (__uint_as_float(__builtin_amdgcn_readlane(tb, 32)) + __uint_as_float(__builtin_amdgcn_readlane(tb, 48)));
                rinv[rq] = rsq_(tot + EPS); }
        }
        if (part == 2) {
#pragma unroll
            for (int rq = 0; rq < 8; ++rq) { const int r = r0 + rq; const float be = SMG[64 + r]; *(LAS f32x2*)(RHS + r * 256 + 2 * lane) = (f32x2){s0[rq] * be, s1[rq] * be}; }
        } else if (part == 0) {
            float kg0[8], kg1[8];
#pragma unroll
            for (int rq = 0; rq < 8; ++rq) { const int r = r0 + rq; const float k0 = s0[rq] * rinv[rq], k1 = s1[rq] * rinv[rq]; *(LAS unsigned*)(KB + r * 136 + 2 * lane) = pk2(k0, k1);
                const float be = SMG[64 + r] * SMG[128 + r]; *(LAS f32x2*)(RHS + r * 256 + 128 + 2 * lane) = (f32x2){k0 * be, k1 * be};
                const float egl = SMG[192 + r]; kg0[rq] = k0 * egl; kg1[rq] = k1 * egl; }
            const int pa = kperm(r0), pb = kperm(r0 + 4);
            *(LAS v2u*)(KGT + (2 * lane) * 64 + pa) = (v2u){pk2(kg0[0], kg0[1]), pk2(kg0[2], kg0[3])}; *(LAS v2u*)(KGT + (2 * lane) * 64 + pb) = (v2u){pk2(kg0[4], kg0[5]), pk2(kg0[6], kg0[7])};
            *(LAS v2u*)(KGT + (2 * lane + 1) * 64 + pa) = (v2u){pk2(kg1[0], kg1[1]), pk2(kg1[2], kg1[3])}; *(LAS v2u*)(KGT + (2 * lane + 1) * 64 + pb) = (v2u){pk2(kg1[4], kg1[5]), pk2(kg1[6], kg1[7])};
        } else {
#pragma unroll
            for (int rq = 0; rq < 8; ++rq) { const int r = r0 + rq; const float sc = rinv[rq] * 0.08838834764831845f; const float q0 = s0[rq] * sc, q1 = s1[rq] * sc; *(LAS unsigned*)(QB + r * 136 + 2 * lane) = pk2(q0, q1);
                const float eg = SMG[128 + r]; *(unsigned*)(o_qg + r * 128 + kperm(2 * lane)) = pk2(q0 * eg, q1 * eg); }
        }
    }
    __syncthreads();
#pragma unroll
    for (int k = 0; k < 2; ++k) { const int pi = tid + 512 * k; *(v4u*)(o_kgt + pi * 8) = *(const LAS v4u*)(KGT + pi * 8); }
    __syncthreads();
    {
        const int mat = wave >> 2, ti = (wave >> 1) & 1, tj = wave & 1, r32 = lane & 31, hi = lane >> 5;
        const LAS bf16* Ab = (mat == 0 ? KB : QB) + (32 * ti + r32) * 136 + 8 * hi;
        const LAS bf16* Bb = KB + (32 * tj + r32) * 136 + 8 * hi;
        f32x16 acc;
#pragma unroll
        for (int r = 0; r < 16; ++r) acc[r] = 0.f;
#pragma unroll
        for (int s = 0; s < 8; ++s) acc = MFMA32(*(const LAS bf16x8*)(Ab + 16 * s), *(const LAS bf16x8*)(Bb + 16 * s), acc);
        const int j = 32 * tj + r32; const float Gj = SMG[j];
#pragma unroll
        for (int r = 0; r < 16; ++r) { const int i = 32 * ti + crow(r, hi); const float dec = __builtin_amdgcn_exp2f(1.4426950408889634f * fminf(SMG[i] - Gj, 0.f));
            if (mat == 0) { const float av = (i > j) ? acc[r] * SMG[64 + i] * dec : 0.f; AMN[i * 80 + kperm(j)] = f2bf(-av); if ((i >> 4) == (j >> 4)) TD[(i >> 4) * 256 + (i & 15) * 16 + (j & 15)] = av; }
            else o_qk[i * 64 + kperm(j)] = f2bf((i >= j) ? acc[r] * dec : 0.f); }
    }
    __syncthreads();
    if (wave == 0) {
        const int bb = lane >> 4, c = lane & 15; float y[16];
        const LAS float* tdp = TD + bb * 256;
#pragma unroll
        for (int i = 0; i < 16; ++i) { float a[16];
#pragma unroll
            for (int j4 = 0; j4 < 4; ++j4) if (4 * j4 < i) { const f32x4 t = *(const LAS f32x4*)(tdp + i * 16 + 4 * j4); a[4 * j4] = t.x; a[4 * j4 + 1] = t.y; a[4 * j4 + 2] = t.z; a[4 * j4 + 3] = t.w; }
            float s0 = (i == c) ? 1.f : 0.f, s1 = 0.f;
#pragma unroll
            for (int j = 0; j < i; ++j) { if (j & 1) s1 = fmaf(-a[j], y[j], s1); else s0 = fmaf(-a[j], y[j], s0); }
            y[i] = s0 + s1;
            const int pc = 8 * (c >> 2) + (c & 3);
            TB[(bb * 16 + i) * 32 + pc] = f2bf(y[i]); TB[(bb * 16 + i) * 32 + pc + 4] = 0; }
    }
    __syncthreads();
    {
        const int cl = lane & 15, q = lane >> 4;
        const f32x4 zero4 = {0.f, 0.f, 0.f, 0.f};
        const LAS unsigned char* amn = (const LAS unsigned char*)AMN + cl * 160 + q * 16;
        const LAS unsigned char* tbp = (const LAS unsigned char*)TB + cl * 64 + q * 16;
#pragma unroll 1
        for (int nt = 0; nt < 2; ++nt) {
            const int col = 32 * wave + 16 * nt + cl;
            f32x4 X[4];
#pragma unroll
            for (int b4 = 0; b4 < 4; ++b4) {
                f32x4 R;
#pragma unroll
                for (int r = 0; r < 4; ++r) R[r] = RHS[(16 * b4 + 4 * q + r) * 256 + col];
                if (b4 == 1) R = MFMA16(*(const LAS bf16x8*)(amn + 16 * 160), pack8(X[0], zero4), R);
                if (b4 == 2) R = MFMA16(*(const LAS bf16x8*)(amn + 32 * 160), pack8(X[0], X[1]), R);
                if (b4 == 3) { R = MFMA16(*(const LAS bf16x8*)(amn + 48 * 160), pack8(X[0], X[1]), R); R = MFMA16(*(const LAS bf16x8*)(amn + 48 * 160 + 64), pack8(X[2], zero4), R); }
                X[b4] = MFMA16(*(const LAS bf16x8*)(tbp + b4 * 16 * 64), pack8(R, zero4), zero4);
            }
            if (wave < 4) {
#pragma unroll
                for (int b4 = 0; b4 < 4; ++b4) *(v2u*)(o_ut + col * 64 + 16 * b4 + 4 * q) = (v2u){pk2(X[b4][0], X[b4][1]), pk2(X[b4][2], X[b4][3])};
            } else { const int pk = kperm(col - 128);
#pragma unroll
                for (int b4 = 0; b4 < 4; ++b4)
#pragma unroll
                    for (int r = 0; r < 4; ++r) o_w[(16 * b4 + 4 * q + r) * 128 + pk] = f2bf(X[b4][r]); }
        }
    }
    __syncthreads();
}

constexpr int SB_W = 0, SB_QG = 18432, SB_KGT = 36864, SB_QK = 57344, SB_UT = 67584, SB_SIZE = 76800;
__device__ __forceinline__ bf16x8 ldfrag(const LAS unsigned char* p) { return *(const LAS bf16x8*)p; }
#define SCAN_BAR() asm volatile("s_waitcnt lgkmcnt(0)\n\ts_barrier" ::: "memory")
__device__ __forceinline__ void scan_half(LAS unsigned char* lds, int half, int nsteps, int nrows, const bf16* gmain, size_t main_stride, const bf16* gqk, size_t qk_stride, const float* DLp,
                                          const float* S0, float* Sout, bf16* MX  , unsigned dumpoff  , gu32* prog, int tid, int lane, int wave) {
    if (wave >= 4) {
        const int lt = tid - 256;
        const unsigned v16 = (unsigned)lt * 16u;
        v4u A[16], B[16];
#define LD_LOAD(R, nn) do { const char* mp_ = (const char*)(gmain + (size_t)(nn) * main_stride); \
            _Pragma("unroll") for (int k = 0; k < 12; ++k) R[k] = *(const v4u*)(mp_ + k * 4096 + v16); \
            _Pragma("unroll") for (int k = 0; k < 2; ++k) R[12 + k] = *(const v4u*)((const char*)(gqk + (size_t)(nn) * qk_stride) + k * 4096 + v16); \
            _Pragma("unroll") for (int k = 0; k < 2; ++k) R[14 + k] = *(const v4u*)(mp_ + 49152 + half * 8192 + k * 4096 + v16); } while (0)
#define LD_WRITE(R, buf) do { LAS unsigned char* bb_ = lds + (buf) * SB_SIZE; \
            _Pragma("unroll") for (int k = 0; k < 12; ++k) { const int a_ = k >> 2, within_ = lt + 256 * (k & 3); \
                const int dst_ = (a_ == 0 ? SB_W + (within_ >> 4) * 288 + (within_ & 15) * 16 : a_ == 1 ? SB_QG + (within_ >> 4) * 288 + (within_ & 15) * 16 : SB_KGT + (within_ >> 3) * 160 + (within_ & 7) * 16); \
                *(LAS v4u*)(bb_ + dst_) = R[k]; } \
            _Pragma("unroll") for (int k = 0; k < 2; ++k) { const int within_ = lt + 256 * k; *(LAS v4u*)(bb_ + SB_QK + (within_ >> 3) * 160 + (within_ & 7) * 16) = R[12 + k]; } \
            _Pragma("unroll") for (int k = 0; k < 2; ++k) { const int within_ = lt + 256 * k; *(LAS v4u*)(bb_ + SB_UT + (within_ >> 3) * 144 + (within_ & 7) * 16) = R[14 + k]; } } while (0)
        LD_LOAD(A, 0);
        if (nsteps > 1) LD_LOAD(B, 1);
        LD_WRITE(A, 0);
        asm volatile("" ::: "memory");
        if (nsteps > 2) LD_LOAD(A, 2);
        SCAN_BAR();
#pragma unroll 1
        for (int n = 0; n < nsteps; n += 2) {
            if (n + 1 < nsteps) { LD_WRITE(B, 1); asm volatile("" ::: "memory"); if (n + 3 < nsteps) LD_LOAD(B, n + 3); SCAN_BAR(); }
            if (n + 2 < nsteps) { LD_WRITE(A, 0); asm volatile("" ::: "memory"); if (n + 4 < nsteps) LD_LOAD(A, n + 4); SCAN_BAR(); }
        }
#undef LD_LOAD
#undef LD_WRITE
    } else {
        const int cl = lane & 15, q = lane >> 4, cw = wave, c0 = 64 * half + 16 * cw;
        f32x4 S[8];
#pragma unroll
        for (int mt = 0; mt < 8; ++mt)
#pragma unroll
            for (int r = 0; r < 4; ++r) S[mt][r] = S0 ? S0[(16 * mt + 4 * q + r) * 128 + c0 + cl] : 0.f;
        const unsigned laneoff = (unsigned)q * (4u * D * 2u) + (unsigned)(c0 + cl) * 2u;
        dumpoff += (unsigned)lane * 2u;
        const int dlbits = (int)__float_as_uint(lane < nsteps ? DLp[lane] : 1.f);
#define SCAN_STEP(n, buf) do { \
        SCAN_BAR();                                            \
        if (prog && tid == 0) __hip_atomic_store(prog, (unsigned)(n) + 1u, RLX_AGENT); \
        const LAS unsigned char* bb_ = lds + (buf) * SB_SIZE; \
        const float dl_ = __uint_as_float(__builtin_amdgcn_readlane(dlbits, (n))); \
        bf16x8 Sb_[4]; \
        _Pragma("unroll") for (int ks = 0; ks < 4; ++ks) Sb_[ks] = pack8(S[2 * ks], S[2 * ks + 1]); \
        f32x4 vn_[4], o_[4]; \
        _Pragma("unroll") for (int mt = 0; mt < 4; ++mt) { \
            f32x4 aw_ = {0.f, 0.f, 0.f, 0.f}, ao_ = {0.f, 0.f, 0.f, 0.f}; \
            const LAS unsigned char* wp_ = bb_ + SB_W + (16 * mt + cl) * 288 + q * 16; const LAS unsigned char* qp_ = bb_ + SB_QG + (16 * mt + cl) * 288 + q * 16; \
            _Pragma("unroll") for (int ks = 0; ks < 4; ++ks) { aw_ = MFMA16(ldfrag(wp_ + ks * 64), Sb_[ks], aw_); ao_ = MFMA16(ldfrag(qp_ + ks * 64), Sb_[ks], ao_); } \
            const v2u uu_ = *(const LAS v2u*)(bb_ + SB_UT + (16 * cw + cl) * 144 + (16 * mt + 4 * q) * 2); \
            vn_[mt] = (f32x4){bflo(uu_.x) - aw_[0], bfhi(uu_.x) - aw_[1], bflo(uu_.y) - aw_[2], bfhi(uu_.y) - aw_[3]}; \
            o_[mt] = ao_; } \
        bf16x8 Vb_[2]; \
        _Pragma("unroll") for (int ks = 0; ks < 2; ++ks) Vb_[ks] = pack8(vn_[2 * ks], vn_[2 * ks + 1]); \
        _Pragma("unroll") for (int mt = 0; mt < 4; ++mt) { const LAS unsigned char* kp_ = bb_ + SB_QK + (16 * mt + cl) * 160 + q * 16; \
            _Pragma("unroll") for (int ks = 0; ks < 2; ++ks) o_[mt] = MFMA16(ldfrag(kp_ + ks * 64), Vb_[ks], o_[mt]); } \
        _Pragma("unroll") for (int mt = 0; mt < 8; ++mt) { S[mt] = S[mt] * dl_; const LAS unsigned char* kp_ = bb_ + SB_KGT + (16 * mt + cl) * 160 + q * 16; \
            _Pragma("unroll") for (int ks = 0; ks < 2; ++ks) S[mt] = MFMA16(ldfrag(kp_ + ks * 64), Vb_[ks], S[mt]); } \
        _Pragma("unroll") for (int mt = 0; mt < 4; ++mt) _Pragma("unroll") for (int r = 0; r < 4; ++r) { const int row_ = 16 * mt + 4 * q + r; \
            const unsigned off_ = (row_ < nrows) ? (unsigned)(n) * (64u * D * 2u) + (unsigned)(16 * mt + r) * (D * 2u) + laneoff : dumpoff; \
            *(bf16*)((char*)MX + off_) = f2bf(o_[mt][r]); } \
    } while (0)
#pragma unroll 1
        for (int n = 0; n < nsteps; n += 2) {
            SCAN_STEP(n, 0);
            if (n + 1 < nsteps) SCAN_STEP(n + 1, 1);
        }
#undef SCAN_STEP
#pragma unroll
        for (int mt = 0; mt < 8; ++mt)
#pragma unroll
            for (int r = 0; r < 4; ++r) Sout[(16 * mt + 4 * q + r) * 128 + c0 + cl] = S[mt][r];
    }
    __syncthreads();
}
#undef SCAN_BAR

__device__ __forceinline__ void scan_helper(gu32* prog, const bf16* gmain, size_t main_stride, const bf16* gqk, size_t qk_stride, float* sink, int tid, int lane) {
    constexpr int AHEAD = 8, RND = 4;
    unsigned acc = 0u;
    const unsigned vmain = (unsigned)tid * 128u, vqk = (unsigned)(tid & 63) * 128u;
#pragma unroll 1
    for (int n = 0; n < 64; n += RND) {
        if (n > AHEAD) {
            if (lane == 0) { unsigned sp = 0u; while ((int)__hip_atomic_load(prog, RLX_AGENT) < n - AHEAD && ++sp < 200000u) __builtin_amdgcn_s_sleep(16); }
        }
        unsigned a[RND], c[RND];
#pragma unroll
        for (int k = 0; k < RND; ++k) { a[k] = *(const unsigned*)((const char*)(gmain + (size_t)(n + k) * main_stride) + vmain); c[k] = *(const unsigned*)((const char*)(gqk + (size_t)(n + k) * qk_stride) + vqk); }
#pragma unroll
        for (int k = 0; k < RND; ++k) acc ^= a[k] ^ c[k];
    }
    if (acc == 0x9e3779b9u) *sink = 0.f;
}

__device__ __forceinline__ void phase_gdn_finish(const bf16* P, bf16* MIXIN, const float* gnw, int gw, int NGW, int lane) {
    const f32x2 gw2 = *(const f32x2*)(gnw + 2 * lane);
    for (int it = gw; it < M * 4; it += NGW) {
        const int m = it >> 2, h = it & 3;
        unsigned* op = (unsigned*)(MIXIN + (size_t)m * D + h * 128) + lane;
        const unsigned ow = *op, zw = *((const unsigned*)(P + (size_t)m * NIN + PC_Z + h * 128) + lane);
        const float o0 = bflo(ow), o1 = bfhi(ow), z0 = bflo(zw), z1 = bfhi(zw);
        const float rstd = rsq_(wave_sum(o0 * o0 + o1 * o1) * (1.f / 128.f) + EPS);
        *op = pk2(o0 * rstd * gw2.x * z0 * sigmoidf_(z0), o1 * rstd * gw2.y * z1 * sigmoidf_(z1));
    }
}

constexpr int ATT_WAVE_LDS = 18944;
constexpr float LOG2E = 1.4426950408889634f;
typedef short v4i16_t __attribute__((ext_vector_type(4)));
__device__ __forceinline__ s16x4 vtr(const LAS unsigned char* p) { return __builtin_bit_cast(s16x4, __builtin_amdgcn_ds_read_tr16_b64_v4i16((LAS v4i16_t*)p)); }
__device__ __forceinline__ void attn_item(LAS unsigned char* wl, int it, int& bt_h, const bf16* P, const float* ck, const float* cv, const float* relb, const float* anw, bf16* MIXIN, int lane) {
    LAS unsigned char* KL = wl; LAS unsigned char* VL = wl + 9216; LAS float* SC = (LAS float*)(wl + 17408); LAS float* BT = (LAS float*)(wl + 17664);
    const int r32 = lane & 31, hi = lane >> 5;
    const bool sample = it < 256;
    int b, h, n = 0, half = 0, mq, t0, t1;
    if (sample) { b = it >> 3; h = it & 7; mq = MP + b * 32; t0 = 0; t1 = 9; }
    else { const int idx = it - 256; half = idx & 1; n = (idx >> 1) & 63; h = (idx >> 7) & 7; b = idx >> 10; mq = b * SEQ + n * 64 + half * 32; t0 = n > 8 ? n - 8 : 0; t1 = n + 1; }
    if (h != bt_h) { for (int k = lane; k < 257; k += 64) BT[k] = relb[h * 257 + k] * LOG2E; bt_h = h; }
    bf16x8 qr[4];
#pragma unroll
    for (int d0 = 0; d0 < 4; ++d0) qr[d0] = *(const bf16x8*)(P + (size_t)(mq + r32) * NIN + PC_QB + h * 64 + d0 * 16 + hi * 8);
    float mrun = -1e30f, lrun = 0.f; f32x16 o0, o1;
#pragma unroll
    for (int r = 0; r < 16; ++r) { o0[r] = 0.f; o1[r] = 0.f; }
    const int ti = lane & 15, blk = (lane >> 4) & 1;
    const LAS unsigned char* vbase = VL + (4 * hi + (ti >> 2)) * 128 + (blk * 16 + 4 * (ti & 3)) * 2;
    v4u kvr[8], vvr[8];
#define ATT_LOADT(tt) do { const char* tb_ = (const char*)(P + (sample ? (size_t)MP + b * 32 : (size_t)b * SEQ + (size_t)(tt) * 64) * NIN + h * 64); \
        _Pragma("unroll") for (int i8 = 0; i8 < 8; ++i8) { kvr[i8] = *(const v4u*)(tb_ + i8 * (8 * NIN * 2) + PC_KB * 2 + loff); vvr[i8] = *(const v4u*)(tb_ + i8 * (8 * NIN * 2) + PC_VB * 2 + loff); \
            if (sample && i8 >= 4) { kvr[i8] = (v4u){0u, 0u, 0u, 0u}; vvr[i8] = (v4u){0u, 0u, 0u, 0u}; } } } while (0)
    const unsigned loff = (unsigned)(lane >> 3) * (unsigned)(NIN * 2) + (unsigned)(lane & 7) * 16u;
    if (!sample) ATT_LOADT(t0);
#pragma unroll 1
    for (int t = t0; t < t1; ++t) {
        int relbase; bool maskhalf = false;
        if (sample && t < 8) {
            relbase = 512 - 64 * t;
            int lq_ = lane; asm volatile("" : "+v"(lq_));
#pragma unroll
            for (int i8 = 0; i8 < 8; ++i8) { const int idx = i8 * 64 + lq_, key = idx >> 3, c8 = idx & 7; const size_t off = (((size_t)b * 512 + 64 * t + key) * 8 + h) * 64 + c8 * 8;
                const f32x4 ka = *(const f32x4*)(ck + off), kb = *(const f32x4*)(ck + off + 4), va = *(const f32x4*)(cv + off), vb = *(const f32x4*)(cv + off + 4);
                *(LAS v4u*)(KL + key * 144 + c8 * 16) = (v4u){pk2(ka.x, ka.y), pk2(ka.z, ka.w), pk2(kb.x, kb.y), pk2(kb.z, kb.w)};
                *(LAS v4u*)(VL + key * 128 + c8 * 16) = (v4u){pk2(va.x, va.y), pk2(va.z, va.w), pk2(vb.x, vb.y), pk2(vb.z, vb.w)}; }
        } else {
            if (sample) { relbase = 0; maskhalf = true; ATT_LOADT(t); }
            else relbase = 64 * (n - t) + 32 * half;
            int ln_ = lane; asm volatile("" : "+v"(ln_));
            LAS unsigned char* kw_ = KL + (ln_ >> 3) * 144 + (ln_ & 7) * 16; LAS unsigned char* vw_ = VL + (ln_ >> 3) * 128 + (ln_ & 7) * 16;
#pragma unroll
            for (int i8 = 0; i8 < 8; ++i8) { *(LAS v4u*)(kw_ + i8 * 1152) = kvr[i8]; *(LAS v4u*)(vw_ + i8 * 1024) = vvr[i8]; }
            asm volatile("" ::: "memory");
            if (!sample && t + 1 < t1) ATT_LOADT(t + 1);
        }
        f32x16 p0, p1;
#pragma unroll
        for (int r = 0; r < 16; ++r) { p0[r] = 0.f; p1[r] = 0.f; }
#pragma unroll
        for (int d0 = 0; d0 < 4; ++d0) { const bf16x8 k0 = *(const LAS bf16x8*)(KL + r32 * 144 + (2 * d0 + hi) * 16), k1 = *(const LAS bf16x8*)(KL + (32 + r32) * 144 + (2 * d0 + hi) * 16);
            p0 = MFMA32(k0, qr[d0], p0); p1 = MFMA32(k1, qr[d0], p1); }
        const float SC2 = 0.125f * LOG2E;
        if (relbase - 63 >= 128) { const float bc = BT[256];
#pragma unroll
            for (int r = 0; r < 16; ++r) { p0[r] = p0[r] * SC2 + bc; p1[r] = p1[r] * SC2 + bc; } }
        else {
#pragma unroll
            for (int r = 0; r < 16; ++r) { const int rel = relbase + r32 - crow(r, hi); int i0 = (rel > 128 ? 128 : rel) + 128, i1 = (rel - 32 > 128 ? 128 : rel - 32) + 128; i0 = i0 < 0 ? 0 : i0; i1 = i1 < 0 ? 0 : i1;
                p0[r] = p0[r] * SC2 + BT[i0]; p1[r] = p1[r] * SC2 + BT[i1]; } }
        if (maskhalf) {
#pragma unroll
            for (int r = 0; r < 16; ++r) p1[r] = -INFINITY; }
        float mx = fmaxf(p0[0], p1[0]);
#pragma unroll
        for (int r = 1; r < 16; ++r) mx = fmaxf(mx, fmaxf(p0[r], p1[r]));
        mx = fmaxf(mx, __shfl_xor(mx, 32));
        const float mnew = fmaxf(mrun, mx); const float alpha = __builtin_amdgcn_exp2f(mrun - mnew); mrun = mnew;
        float sum = 0.f;
#pragma unroll
        for (int r = 0; r < 16; ++r) { p0[r] = __builtin_amdgcn_exp2f(p0[r] - mnew); p1[r] = __builtin_amdgcn_exp2f(p1[r] - mnew); sum += p0[r] + p1[r]; }
        lrun = lrun * alpha + sum;
        if (hi == 0) SC[r32] = alpha;
#pragma unroll
        for (int r = 0; r < 16; ++r) { const float a = SC[crow(r, hi)]; o0[r] *= a; o1[r] *= a; }
#pragma unroll
        for (int s = 0; s < 4; ++s) {
            v4u pw;
            if (s < 2) pw = (v4u){pk2(p0[8 * s + 0], p0[8 * s + 1]), pk2(p0[8 * s + 2], p0[8 * s + 3]), pk2(p0[8 * s + 4], p0[8 * s + 5]), pk2(p0[8 * s + 6], p0[8 * s + 7])};
            else { const int ss = s - 2; pw = (v4u){pk2(p1[8 * ss + 0], p1[8 * ss + 1]), pk2(p1[8 * ss + 2], p1[8 * ss + 3]), pk2(p1[8 * ss + 4], p1[8 * ss + 5]), pk2(p1[8 * ss + 6], p1[8 * ss + 7])}; }
            const bf16x8 pa = __builtin_bit_cast(bf16x8, pw);
            const LAS unsigned char* vp = vbase + (16 * s) * 128;
            const s16x4 a0 = vtr(vp), a1 = vtr(vp + 8 * 128), b0 = vtr(vp + 64), b1 = vtr(vp + 8 * 128 + 64);
            const bf16x8 v0 = {a0[0], a0[1], a0[2], a0[3], a1[0], a1[1], a1[2], a1[3]}, v1 = {b0[0], b0[1], b0[2], b0[3], b1[0], b1[1], b1[2], b1[3]};
            o0 = MFMA32(pa, v0, o0); o1 = MFMA32(pa, v1, o1);
        }
    }
#undef ATT_LOADT
    lrun += __shfl_xor(lrun, 32);
    if (hi == 0) SC[32 + r32] = 1.f / lrun;
    LAS float* OL = (LAS float*)wl;
#pragma unroll
    for (int r = 0; r < 16; ++r) { const int qq = crow(r, hi); const float inv = SC[32 + qq]; OL[qq * 66 + r32] = o0[r] * inv; OL[qq * 66 + 32 + r32] = o1[r] * inv; }
    {
        const int qq = lane >> 1, dh = (lane & 1) * 32; float vals[32]; float ss = 0.f;
#pragma unroll
        for (int k = 0; k < 32; ++k) { vals[k] = OL[qq * 66 + dh + k]; ss += vals[k] * vals[k]; }
        ss += __shfl_xor(ss, 1);
        const float rstd = rsq_(ss * (1.f / 64.f) + EPS);
        bf16* op = MIXIN + (size_t)(mq + qq) * D + 512 + h * 64 + dh;
#pragma unroll
        for (int k4 = 0; k4 < 4; ++k4) { v4u o;
            const f32x4 wa = *(const f32x4*)(anw + dh + 8 * k4), wb = *(const f32x4*)(anw + dh + 8 * k4 + 4);
            o.x = pk2(vals[8 * k4 + 0] * rstd * wa.x, vals[8 * k4 + 1] * rstd * wa.y); o.y = pk2(vals[8 * k4 + 2] * rstd * wa.z, vals[8 * k4 + 3] * rstd * wa.w);
            o.z = pk2(vals[8 * k4 + 4] * rstd * wb.x, vals[8 * k4 + 5] * rstd * wb.y); o.w = pk2(vals[8 * k4 + 6] * rstd * wb.z, vals[8 * k4 + 7] * rstd * wb.w);
            *(v4u*)(op + 8 * k4) = o; }
    }
}

__device__ __forceinline__ void load_gemm_row(f32x4 (&v)[4], const bf16* Yb, const float* slab, int ns, int m, int lane) {
    if (m < MP) {
#pragma unroll
        for (int j = 0; j < 4; ++j) { const v2u t = ((const v2u*)(Yb + (size_t)m * D))[lane + 64 * j]; v[j] = (f32x4){bflo(t.x), bfhi(t.x), bflo(t.y), bfhi(t.y)}; }
    } else {
#pragma unroll
        for (int j = 0; j < 4; ++j) v[j] = (f32x4){0.f, 0.f, 0.f, 0.f};
        for (int k = 0; k < ns; ++k) {
#pragma unroll
            for (int j = 0; j < 4; ++j) v[j] += ((const f32x4*)(slab + ((size_t)k * MS + (m - MP)) * D))[lane + 64 * j]; }
    }
}
__device__ __forceinline__ void phase_rows1(const float* xp, const float* xs, const bf16* mixb, const float* slab, int ns, const float* w_post, const float* w_pre2, float* out, bf16* U, int gw, int NGW, int lane) {
    for (int m = gw; m < M; m += NGW) {
        const float* xrow = m < MP ? xp + (size_t)m * D : xs + (size_t)(m - MP) * D;
        f32x4 v[4], xv[4]; float s = 0.f;
        load_gemm_row(v, mixb, slab, ns, m, lane);
#pragma unroll
        for (int j = 0; j < 4; ++j) { xv[j] = ((const f32x4*)xrow)[lane + 64 * j]; s += (v[j].x * v[j].x + v[j].y * v[j].y) + (v[j].z * v[j].z + v[j].w * v[j].w); }
        const float rstd = rsq_(wave_sum(s) * (1.f / D) + EPS); float s2 = 0.f;
#pragma unroll
        for (int j = 0; j < 4; ++j) { const f32x4 g = ((const f32x4*)w_post)[lane + 64 * j]; v[j] = xv[j] + v[j] * rstd * g; ((f32x4*)(out + (size_t)m * D))[lane + 64 * j] = v[j];
            s2 += (v[j].x * v[j].x + v[j].y * v[j].y) + (v[j].z * v[j].z + v[j].w * v[j].w); }
        const float rstd2 = rsq_(wave_sum(s2) * (1.f / D) + EPS);
        unsigned long long* o8 = (unsigned long long*)(U + (size_t)m * D) + lane;
#pragma unroll
        for (int j = 0; j < 4; ++j) { const f32x4 g = ((const f32x4*)w_pre2)[lane + 64 * j]; const f32x4 t = v[j] * rstd2 * g;
            o8[64 * j] = (unsigned long long)pk2(t.x, t.y) | ((unsigned long long)pk2(t.z, t.w) << 32); }
    }
}
__device__ __forceinline__ void phase_rows2(const bf16* dnb, const float* slab, int ns, const float* w, float* out, int gw, int NGW, int lane) {
    for (int m = gw; m < M; m += NGW) {
        f32x4 v[4]; float s = 0.f;
        load_gemm_row(v, dnb, slab, ns, m, lane);
#pragma unroll
        for (int j = 0; j < 4; ++j) s += (v[j].x * v[j].x + v[j].y * v[j].y) + (v[j].z * v[j].z + v[j].w * v[j].w);
        const float rstd = rsq_(wave_sum(s) * (1.f / D) + EPS);
#pragma unroll
        for (int j = 0; j < 4; ++j) { const f32x4 g = ((const f32x4*)w)[lane + 64 * j]; f32x4* op = (f32x4*)(out + (size_t)m * D) + lane + 64 * j; *op = *op + v[j] * rstd * g; }
    }
}
__device__ __forceinline__ float gelu_tanh(float x) { const float y = 0.7978845608028654f * (x + 0.044715f * x * x * x); const float t = 1.f - 2.f * __builtin_amdgcn_rcpf(1.f + __builtin_amdgcn_exp2f(2.8853900817779268f * y)); return 0.5f * x * (1.f + t); }
__device__ __forceinline__ void unpack8(const v4u t, float (&g)[8]) { g[0] = bflo(t.x); g[1] = bfhi(t.x); g[2] = bflo(t.y); g[3] = bfhi(t.y); g[4] = bflo(t.z); g[5] = bfhi(t.z); g[6] = bflo(t.w); g[7] = bfhi(t.w); }
__device__ __forceinline__ void phase_h_fixup(const bf16* SB, bf16* H, const float* st_ffn, const float* cw, const float* cb, int gtid, int nth) {
    constexpr int CG = FF / 8;
    for (int task = gtid; task < 192 * CG; task += nth) {
        const int R = task / CG, c = (task % CG) * 8;
        float g0[8], g1[8], g2[8], up[8];
        int row;
        if (R < 128) { const int pm = R >> 1, t = R & 1; row = 256 * pm + t; const int grp = row >> 5; const bool prev = (pm & 15) != 0;
            unpack8(*(const v4u*)(SB + (((size_t)grp * 4 + t) * 2) * FF + c), g2); unpack8(*(const v4u*)(SB + (((size_t)grp * 4 + t) * 2 + 1) * FF + c), up);
            if (t == 0) { if (prev) { unpack8(*(const v4u*)(SB + (((size_t)(grp - 1) * 4 + 3) * 2) * FF + c), g1); unpack8(*(const v4u*)(SB + (((size_t)(grp - 1) * 4 + 2) * 2) * FF + c), g0); }
                          else {
#pragma unroll
                              for (int e = 0; e < 8; ++e) { g1[e] = 0.f; g0[e] = 0.f; } } }
            else { unpack8(*(const v4u*)(SB + (((size_t)grp * 4 + 0) * 2) * FF + c), g1);
                   if (prev) unpack8(*(const v4u*)(SB + (((size_t)(grp - 1) * 4 + 3) * 2) * FF + c), g0);
                   else {
#pragma unroll
                       for (int e = 0; e < 8; ++e) g0[e] = 0.f; } }
        } else { const int sR = R - 128, bs = sR >> 1, t = sR & 1; row = MP + 32 * bs + t; const int grp = row >> 5;
            unpack8(*(const v4u*)(SB + (((size_t)grp * 4 + t) * 2) * FF + c), g2); unpack8(*(const v4u*)(SB + (((size_t)grp * 4 + t) * 2 + 1) * FF + c), up);
            const float* s0 = st_ffn + ((size_t)bs * 2 + 0) * FF + c; const float* s1 = st_ffn + ((size_t)bs * 2 + 1) * FF + c;
            if (t == 0) {
#pragma unroll
                for (int e = 0; e < 8; ++e) { g0[e] = s0[e]; g1[e] = s1[e]; } }
            else { unpack8(*(const v4u*)(SB + (((size_t)grp * 4 + 0) * 2) * FF + c), g1);
#pragma unroll
                for (int e = 0; e < 8; ++e) g0[e] = s1[e]; }
        }
        float hv[8];
#pragma unroll
        for (int e = 0; e < 8; ++e) { const float x = cw[c + e] * g0[e] + cw[FF + c + e] * g1[e] + cw[2 * FF + c + e] * g2[e] + cb[c + e]; hv[e] = gelu_tanh(x) * up[e]; }
        *(v4u*)(H + (size_t)row * FF + c) = (v4u){pk2(hv[0], hv[1]), pk2(hv[2], hv[3]), pk2(hv[4], hv[5]), pk2(hv[6], hv[7])};
    }
}

#ifndef MK_N_LAUNCHES
#define MK_N_LAUNCHES 1
#endif
constexpr int NPH = 11;
constexpr int N_LAUNCHES = MK_N_LAUNCHES;
struct Args { const float* in[23]; float* out; unsigned char* ws; int ph_lo, ph_hi, li, pad; };
__global__ void __launch_bounds__(NWAVES * 64, 2) hybrid_fwd(Args args) {
    extern __shared__ __attribute__((aligned(16))) unsigned char lds_raw[];
    LAS unsigned char* lds = (LAS unsigned char*)lds_raw;
    volatile LAS unsigned* MISC = (volatile LAS unsigned*)(lds + MISC_OFF);
    const int tid = threadIdx.x, lane = tid & 63, wave = __builtin_amdgcn_readfirstlane(tid >> 6);
    const int G = gridDim.x; const int bx = blockIdx.x; const int vcu = (G % 8 == 0) ? (bx % 8) * (G / 8) + bx / 8 : bx;
    unsigned char* ws = args.ws; float* out = args.out;
    gu32* ctl = (gu32*)(ws + WS_CTL);
#define x_prompt (args.in[0])
#define x_sample (args.in[1])
#define cache_k (args.in[2])
#define cache_v (args.in[3])
#define state_delta (args.in[4])
#define state_qkv (args.in[5])
#define state_ffn (args.in[6])
#define norm_mix_pre (args.in[7])
#define w_in (args.in[8])
#define qkv_conv_w (args.in[9])
#define a_log (args.in[10])
#define dt_bias (args.in[11])
#define gdn_norm_w (args.in[12])
#define rel_bias (args.in[13])
#define attn_norm_w (args.in[14])
#define w_out (args.in[15])
#define norm_mix_post (args.in[16])
#define norm_ffn_pre (args.in[17])
#define w_gate_up (args.in[18])
#define ffn_conv_w (args.in[19])
#define ffn_conv_b (args.in[20])
#define w_down (args.in[21])
#define norm_ffn_post (args.in[22])
#define Win_t ((bf16*)(ws + WS_WIN))
#define Wout_t ((bf16*)(ws + WS_WOUT))
#define Wgu_t ((bf16*)(ws + WS_WGU))
#define Wdn_t ((bf16*)(ws + WS_WDN))
#define AB ((float*)(ws + WS_AB))
#define DL ((float*)(ws + WS_DL))
#define U ((bf16*)(ws + WS_U))
#define GQK ((bf16*)(ws + WS_GQK))
#define GS ((bf16*)(ws + WS_GS))
#define P ((bf16*)(ws + WS_P))
#define MIXIN ((bf16*)(ws + WS_MIXIN))
#define MIXB ((bf16*)(ws + WS_P))
#define SLAB1 ((float*)(ws + WS_P + 34 * MiB))
#define DOWNB ((bf16*)(ws + WS_U))
#define SLAB2 ((float*)(ws + WS_G))
#define SBUF ((bf16*)(ws + WS_G))
#define UP ((bf16*)(ws + WS_UP))
#define GMAIN ((bf16*)out)

    for (int u = tid; u < 64; u += NWAVES * 64) ((LAS unsigned*)(lds + MISC_OFF))[u] = 0u;
    __syncthreads();
    XcdBarrier bar; bar.bar = (unsigned*)(ctl + CW_BAR); bar.x = 0; bar.st = nullptr;
    if (N_LAUNCHES == 1) bar = xcd_barrier_post((unsigned*)(ctl + CW_BAR), MISC + 8);
#define GRID_BAR() do { if (N_LAUNCHES == 1) xcd_barrier(bar); } while (0)
    const int lo = args.ph_lo, hi_ = args.ph_hi;
#define IN(k) (lo <= (k) && (k) < hi_)
#define BOTH(k) (IN(k) && IN((k) + 1))
    const int gw = vcu * NWAVES + wave, NGW = G * NWAVES, gtid = bx * (NWAVES * 64) + tid, nth = G * NWAVES * 64;

    if (IN(0)) { phase_prologue(lds, x_prompt, x_sample, norm_mix_pre, w_in, w_out, w_gate_up, w_down, ws, vcu, G, tid, lane, wave); if (BOTH(0)) GRID_BAR(); }

    if (IN(1)) {
        pg8::Gemm g{U, Win_t, M, NIN, D, D}; pg8::StaticOrder S; S.init(M, NIN, G, bx);
        pg8::EpiBf16<0> E{P, NIN, nullptr, 0, 0, 1.f};
        pg8::gemm_phase<pg8::EpiBf16<0>, pg8::StaticOrder, true, true>(lds, g, S, E);
        if (BOTH(1)) GRID_BAR();
    }

    if (IN(2)) {
        phase_copy_outputs(P, out, gtid, nth);
        for (int u = bx; u < 1152; u += G) gdn_pre_unit(lds, u, P, AB, state_qkv, qkv_conv_w, a_log, dt_bias, GMAIN, GQK, GS, DL, tid, lane, wave);
        if (BOTH(2)) GRID_BAR();
    }

    if (IN(3)) {
        if (bx < 32) {
            const int sidx = bx & 15, half = bx >> 4; const int b = sidx >> 2, h = sidx & 3; const int u0 = b * 256 + h * 64; const size_t m0 = (size_t)b * SEQ;
            scan_half(lds, half, 64, 64, GMAIN + (size_t)u0 * 32768, 32768, GQK + (size_t)u0 * 4096, 4096, DL + u0, nullptr, out + O_DP + (size_t)(b * 4 + h) * 16384,
                      MIXIN + m0 * D + h * 128, (unsigned)(((size_t)M * D - (m0 * D + h * 128)) * 2), half == 0 ? ctl + 1024 + 64 * sidx : (gu32*)nullptr, tid, lane, wave);
        } else if (bx >= G - 16) {
            const int sidx = bx - (G - 16); const int b = sidx >> 2, h = sidx & 3; const int u0 = b * 256 + h * 64;
            scan_helper(ctl + 1024 + 64 * sidx, GMAIN + (size_t)u0 * 32768, 32768, GQK + (size_t)u0 * 4096, 4096, (float*)(ws + WS_DL + 65536), tid, lane);
        } else {
            for (int hu = bx - 32; hu < 256; hu += (G - 48)) {
                const int su = hu >> 1, half = hu & 1; const int b = su >> 2, h = su & 3; const size_t m0 = (size_t)MP + b * 32; const bf16* base = GS + (size_t)su * 36864;
                scan_half(lds, half, 1, 32, base, 0, base + 32768, 0, DL + 1024 + su, state_delta + (size_t)su * 16384, out + O_DS + (size_t)su * 16384,
                          MIXIN + m0 * D + h * 128, (unsigned)(((size_t)M * D - (m0 * D + h * 128)) * 2), (gu32*)nullptr, tid, lane, wave);
            }
            LAS unsigned char* wl = lds + wave * ATT_WAVE_LDS;
            int bt_h = -1;
            for (int it = (bx - 32) * NWAVES + wave; it < 4352; it += (G - 48) * NWAVES) attn_item(wl, it, bt_h, P, cache_k, cache_v, rel_bias, attn_norm_w, MIXIN, lane);
        }
        if (BOTH(3)) GRID_BAR();
    }

    if (IN(4)) { phase_gdn_finish(P, MIXIN, gdn_norm_w, gw, NGW, lane); if (BOTH(4)) GRID_BAR(); }

    if (IN(5)) {
        { pg8::Gemm g{MIXIN, Wout_t, MP, D, D, D}; pg8::StaticOrder S; S.init(MP, D, G, bx);
          pg8::EpiBf16<0> E{MIXB, D, nullptr, 0, 0, 1.f};
          pg8::gemm_phase<pg8::EpiBf16<0>, pg8::StaticOrder, true, true>(lds, g, S, E); }
        { pg8::Gemm g{MIXIN, Wout_t, M, D, 256, D}; pg8::SplitOrder S; S.init(MP / 256, MS / 256, D / 256, 4, bx);
          pg8::EpiF32 E{SLAB1 - (size_t)MP * D, D, (size_t)MS * D};
          pg8::gemm_phase<pg8::EpiF32, pg8::SplitOrder, true, true>(lds, g, S, E); }
        if (BOTH(5)) GRID_BAR();
    }

    if (IN(6)) { phase_rows1(x_prompt, x_sample, MIXB, SLAB1, 4, norm_mix_post, norm_ffn_pre, out, U, gw, NGW, lane); if (BOTH(6)) GRID_BAR(); }

    if (IN(7)) {
        pg8::Gemm g{U, Wgu_t, M, 2 * FF, D, D}; pg8::StaticOrder S; S.init(M, 2 * FF, G, bx);
        pg8::EpiGlu E{UP, FF, ffn_conv_w, ffn_conv_b, SBUF, out + O_FCP, out + O_FCS, MP, (pg8::PG8_LAS_F*)(lds + 131072)};
        pg8::gemm_phase<pg8::EpiGlu, pg8::StaticOrder, true, true>(lds, g, S, E);
        if (BOTH(7)) GRID_BAR();
    }

    if (IN(8)) { phase_h_fixup(SBUF, UP, state_ffn, ffn_conv_w, ffn_conv_b, gtid, nth); if (BOTH(8)) GRID_BAR(); }

    if (IN(9)) {
        { pg8::Gemm g{UP, Wdn_t, MP, D, FF, FF}; pg8::StaticOrder S; S.init(MP, D, G, bx);
          pg8::EpiBf16<0> E{DOWNB, D, nullptr, 0, 0, 1.f};
          pg8::gemm_phase<pg8::EpiBf16<0>, pg8::StaticOrder, true, true>(lds, g, S, E); }
        { pg8::Gemm g{UP, Wdn_t, M, D, 256, FF}; pg8::SplitOrder S; S.init(MP / 256, MS / 256, D / 256, 11, bx);
          pg8::EpiF32 E{SLAB2 - (size_t)MP * D, D, (size_t)MS * D};
          pg8::gemm_phase<pg8::EpiF32, pg8::SplitOrder, true, true>(lds, g, S, E); }
        if (BOTH(9)) GRID_BAR();
    }

    if (IN(10)) phase_rows2(DOWNB, SLAB2, 11, norm_ffn_post, out, gw, NGW, lane);
#undef IN
#undef BOTH
#undef GRID_BAR
}

extern "C" void kernel_launch(void* const* d_in, const int* in_sizes, int n_in, void* d_out, int out_size, void* d_ws, size_t ws_size, hipStream_t stream) {
    static int grid = 0;
    if (grid == 0) {
        if (n_in != 23 || out_size != 23699456 || ws_size < WS_END) { fprintf(stderr, "kernel_launch: unexpected shapes (n_in %d, out %d, ws %zu); nothing launched\n", n_in, out_size, ws_size); grid = -1; return; }
        int dev = 0, cus = 0, per_cu = 0;
        if (hipGetDevice(&dev) != hipSuccess || hipDeviceGetAttribute(&cus, hipDeviceAttributeMultiprocessorCount, dev) != hipSuccess) { grid = -1; return; }
        if (hipFuncSetAttribute((const void*)hybrid_fwd, hipFuncAttributeMaxDynamicSharedMemorySize, LDS_BYTES) != hipSuccess) { fprintf(stderr, "kernel_launch: hipFuncSetAttribute failed\n"); grid = -1; return; }
        if (hipOccupancyMaxActiveBlocksPerMultiprocessor(&per_cu, (const void*)hybrid_fwd, NWAVES * 64, LDS_BYTES) != hipSuccess || per_cu < 1) fprintf(stderr, "kernel_launch: occupancy query reports %d\n", per_cu);
        (void)hipGetLastError();
        grid = cus;
    }
    if (grid < 0) return;
    if (hipMemsetAsync((char*)d_ws + WS_CTL, 0, CTL_ZERO_BYTES, stream) != hipSuccess) { fprintf(stderr, "kernel_launch: memset failed\n"); return; }
    Args a{};
    for (int i = 0; i < 23; ++i) a.in[i] = (const float*)d_in[i];
    a.out = (float*)d_out; a.ws = (unsigned char*)d_ws;
    if (N_LAUNCHES == 1) { a.ph_lo = 0; a.ph_hi = NPH; a.li = 0; hipLaunchKernelGGL(hybrid_fwd, dim3(grid), dim3(NWAVES * 64), LDS_BYTES, stream, a); }
    else for (int li = 0; li < NPH; ++li) { a.ph_lo = li; a.ph_hi = li + 1; a.li = li; hipLaunchKernelGGL(hybrid_fwd, dim3(grid), dim3(NWAVES * 64), LDS_BYTES, stream, a);
#ifdef PROBE_DUP
        if (li == PROBE_DUP) hipLaunchKernelGGL(hybrid_fwd, dim3(grid), dim3(NWAVES * 64), LDS_BYTES, stream, a);
#endif
    }
    const hipError_t le = hipPeekAtLastError();
    if (le != hipSuccess) fprintf(stderr, "kernel_launch: launch failed: %s\n", hipGetErrorName(le));
}
```

```cpp
#include <hip/hip_runtime.h>
#include <cstdio>
#include <cstdint>
namespace pg8 {
#define PG8_LAS __attribute__((address_space(3)))
typedef unsigned short bf16_t;
typedef short bf16x8 __attribute__((ext_vector_type(8)));
typedef float f32x4 __attribute__((ext_vector_type(4)));
typedef unsigned u32x4 __attribute__((ext_vector_type(4)));
constexpr int BM = 256, BK = 64, HALF = 128, HTB = HALF * BK * 2  , STAGE_BYTES = 8 * HTB, NXCD = 8, WGM = 8;

__host__ __device__ __forceinline__ int lds_byte(int r, int c) { const int st = (r >> 4) * 2 + (c >> 5), rr = r & 15, cc = c & 31, ob = rr * 64 + cc * 2; return st * 1024 + (ob ^ (((ob >> 9) & 1) << 5)); }
__host__ __device__ __forceinline__ void stage_rc(int b, int& R, int& C) { const int st = b / 1024, sb = b % 1024, swz = sb ^ (((sb >> 9) & 1) << 5); R = (st >> 1) * 16 + swz / 64; C = (st & 1) * 32 + (swz % 64) / 2; }
__host__ __device__ __forceinline__ int perm32(int rho) { const int n = rho >> 4, i = rho & 15; return 8 * (i >> 2) + 4 * n + (i & 3); }

struct Unit { int pm, pn, kq; };
struct Gemm { const bf16_t* A; const bf16_t* Bt; int M, N, K, ld; };

struct StaticOrder {
    int nM, nN, nwg, G, c;
    __host__ __device__ void init(int M, int N, int G_, int c_) { nM = M / BM; nN = N / BM; nwg = nM * nN; G = G_; c = c_; }
    __host__ __device__ bool next(int i, Unit& u) const {
        const long L = (long)i * G + c; if (L >= nwg) return false;
        int wgid = (int)L; { const int q = nwg / NXCD, r = nwg % NXCD, xcd = wgid % NXCD, off = wgid / NXCD; wgid = (xcd < r ? xcd * (q + 1) : r * (q + 1) + (xcd - r) * q) + off; }
        const int nig = WGM * nN, gid = wgid / nig, fm = gid * WGM, gsz = (nM - fm) < WGM ? (nM - fm) : WGM;
        u.pm = fm + ((wgid % nig) % gsz); u.pn = (wgid % nig) / gsz; u.kq = 0; return true;
    }
    __device__ __forceinline__ void a_ready(const Unit&) const {}
    __device__ __forceinline__ void done(const Unit&) const {}
};

struct SplitOrder {
    int pm0, nN, ns, np, c;
    __host__ __device__ void init(int pm0_, int nP, int nN_, int ns_, int c_) { pm0 = pm0_; nN = nN_; ns = ns_; np = nP * nN_ * ns_; c = c_; }
    __host__ __device__ bool next(int i, Unit& u) const { if (i > 0 || c >= np) return false; const int t = c / ns; u.pm = pm0 + t / nN; u.pn = t % nN; u.kq = c % ns; return true; }
    __device__ __forceinline__ void a_ready(const Unit&) const {}
    __device__ __forceinline__ void done(const Unit&) const {}
};

__device__ __forceinline__ unsigned cvt_pk_bf16(float lo, float hi) { unsigned r; asm volatile("v_cvt_pk_bf16_f32 %0, %1, %2" : "=v"(r) : "v"(lo), "v"(hi)); return r; }
typedef float f32x2 __attribute__((ext_vector_type(2)));
__device__ __forceinline__ f32x2 gelu_pk(f32x2 v) {
    const f32x2 av = __builtin_elementwise_abs(v), d = av * 0.2316418882f + 1.0f;
    f32x2 t; t.x = __builtin_amdgcn_rcpf(d.x); t.y = __builtin_amdgcn_rcpf(d.y);
    f32x2 q = t * 0.5307027145f + (-0.7265760135f); q = q * t + 0.7107068705f; q = q * t + (-0.142248368f); q = q * t + 0.127414796f; q = q * t;
    const f32x2 s = (v * v) * (-0.72134752044f);
    f32x2 e; e.x = __builtin_amdgcn_exp2f(s.x); e.y = __builtin_amdgcn_exp2f(s.y);
    const f32x2 m = v * (q * e), r = v - m;
    f32x2 o; o.x = v.x < 0.f ? m.x : r.x; o.y = v.y < 0.f ? m.y : r.y; return o;
}

template <int ACT  > struct EpiBf16 {
    static constexpr bool PERM = true, AFTER_DRAIN = false; static_assert(ACT == 0 || ACT == 1, "EpiBf16: ACT is 0 (none) or 1 (gelu_pk)");
    bf16_t* O; int ldc; const float* bias; int split_cols; size_t split_stride; float scale0;
    __device__ __forceinline__ void operator()(const f32x4 (&acc)[2][2][4][2], const Unit& u, int wr, int wc, int fr, int fq) const {
        const int row0 = u.pm * BM + wr * 64 + fr; int colt = u.pn * BM; bf16_t* base = O;
        float sc = 1.f; if (split_cols) { const int t = colt / split_cols; base += (size_t)t * split_stride; colt -= t * split_cols; if (t == 0) sc = scale0; }
        const int col0 = colt + wc * 32 + 8 * fq, bcol0 = u.pn * BM + wc * 32 + 8 * fq;
        f32x4 bv[2][2];
#pragma unroll
        for (int bj = 0; bj < 2; ++bj)
#pragma unroll
            for (int n = 0; n < 2; ++n) bv[bj][n] = bias ? *(const f32x4*)(bias + bcol0 + bj * HALF + 4 * n) : (f32x4){0.f, 0.f, 0.f, 0.f};
#pragma unroll
        for (int ai = 0; ai < 2; ++ai)
#pragma unroll
            for (int m = 0; m < 4; ++m) { bf16_t* rowp = base + (size_t)(row0 + ai * HALF + m * 16) * ldc + col0;
#pragma unroll
                for (int bj = 0; bj < 2; ++bj) { f32x4 v0 = acc[ai][bj][m][0] + bv[bj][0], v1 = acc[ai][bj][m][1] + bv[bj][1];
                    if (ACT == 1) { f32x2 a = gelu_pk((f32x2){v0[0], v0[1]}), b = gelu_pk((f32x2){v0[2], v0[3]}), c = gelu_pk((f32x2){v1[0], v1[1]}), d = gelu_pk((f32x2){v1[2], v1[3]});
                        v0 = (f32x4){a.x, a.y, b.x, b.y}; v1 = (f32x4){c.x, c.y, d.x, d.y}; }
                    v0 = v0 * sc; v1 = v1 * sc; u32x4 w; w.x = cvt_pk_bf16(v0[0], v0[1]); w.y = cvt_pk_bf16(v0[2], v0[3]); w.z = cvt_pk_bf16(v1[0], v1[1]); w.w = cvt_pk_bf16(v1[2], v1[3]);
                    *(u32x4*)(rowp + bj * HALF) = w; } }
    }
};

struct EpiF32 {
    static constexpr bool PERM = false, AFTER_DRAIN = false;
    float* O; int ldc; size_t kq_stride;
    __device__ __forceinline__ void operator()(const f32x4 (&acc)[2][2][4][2], const Unit& u, int wr, int wc, int fr, int fq) const {
        const int row0 = u.pm * BM + wr * 64 + fr, col0 = u.pn * BM + wc * 32 + 4 * fq;
#pragma unroll
        for (int ai = 0; ai < 2; ++ai)
#pragma unroll
            for (int m = 0; m < 4; ++m) { float* rowp = O + (size_t)u.kq * kq_stride + (size_t)(row0 + ai * HALF + m * 16) * ldc + col0;
#pragma unroll
                for (int bj = 0; bj < 2; ++bj)
#pragma unroll
                    for (int n = 0; n < 2; ++n) *(f32x4*)(rowp + bj * HALF + n * 16) = acc[ai][bj][m][n]; }
    }
};
__device__ __forceinline__ float dpp_ror(float v, int ctrl_is_2) { return ctrl_is_2 ? __uint_as_float((unsigned)__builtin_amdgcn_update_dpp(0, (int)__float_as_uint(v), 0x122, 0xF, 0xF, false))
                                                                               : __uint_as_float((unsigned)__builtin_amdgcn_update_dpp(0, (int)__float_as_uint(v), 0x121, 0xF, 0xF, false)); }
__device__ __forceinline__ float gelu_tanh_f(float x) { const float y = 0.7978845608028654f * (x + 0.044715f * x * x * x); const float t = 1.f - 2.f * __builtin_amdgcn_rcpf(1.f + __builtin_amdgcn_exp2f(2.8853900817779268f * y)); return 0.5f * x * (1.f + t); }
typedef PG8_LAS float PG8_LAS_F;
struct EpiGlu {
    static constexpr bool PERM = true, AFTER_DRAIN = false;
    bf16_t* H; int ff; const float* cw; const float* cb; bf16_t* SB; float* fcp; float* fcs; int mp; PG8_LAS_F* XB;
    __device__ __forceinline__ void operator()(const f32x4 (&acc)[2][2][4][2], const Unit& u, int wr, int wc, int fr, int fq) const {
        const int hl = wc * 32 + 8 * fq, hc = 128 * u.pn + hl;
        float w0[8], w1[8], w2[8], bb[8];
#pragma unroll
        for (int n = 0; n < 2; ++n) { const f32x4 a = *(const f32x4*)(cw + hc + 4 * n), b = *(const f32x4*)(cw + ff + hc + 4 * n), c = *(const f32x4*)(cw + 2 * ff + hc + 4 * n), d = *(const f32x4*)(cb + hc + 4 * n);
#pragma unroll
            for (int e = 0; e < 4; ++e) { w0[4 * n + e] = a[e]; w1[4 * n + e] = b[e]; w2[4 * n + e] = c[e]; bb[4 * n + e] = d[e]; } }
        if (fr >= 14) {
#pragma unroll
            for (int ai = 0; ai < 2; ++ai)
#pragma unroll
                for (int n = 0; n < 2; ++n) *(PG8_LAS f32x4*)(XB + (((ai * 2 + wr) * 2 + (fr - 14)) * 128 + hl + 4 * n)) = acc[ai][0][3][n];
        }
        asm volatile("s_waitcnt lgkmcnt(0)\n\ts_barrier" ::: "memory");
#pragma unroll
        for (int ai = 0; ai < 2; ++ai) {
            float pm1[8], pm2[8];
            if (wr == 1 || ai == 1) { const PG8_LAS float* src = XB + ((wr == 1 ? ai * 2 + 0 : 0 * 2 + 1) * 2) * 128 + hl;
#pragma unroll
                for (int n = 0; n < 2; ++n) { const f32x4 a = *(const PG8_LAS f32x4*)(src + 4 * n), b = *(const PG8_LAS f32x4*)(src + 128 + 4 * n);
#pragma unroll
                    for (int e = 0; e < 4; ++e) { pm2[4 * n + e] = a[e]; pm1[4 * n + e] = b[e]; } } }
            else {
#pragma unroll
                for (int c = 0; c < 8; ++c) { pm1[c] = 0.f; pm2[c] = 0.f; } }
            float q1[8], q2[8];
#pragma unroll
            for (int m = 0; m < 4; ++m) {
                const int row = u.pm * BM + ai * HALF + wr * 64 + m * 16 + fr;
                float hv[8];
#pragma unroll
                for (int c = 0; c < 8; ++c) {
                    const float g = acc[ai][0][m][c >> 2][c & 3], up = acc[ai][1][m][c >> 2][c & 3];
                    const float r1 = dpp_ror(g, 0), r2 = dpp_ror(g, 1);
                    const float g1 = (fr >= 1) ? r1 : (m > 0 ? q1[c] : pm1[c]);
                    const float g0 = (fr >= 2) ? r2 : (m > 0 ? q2[c] : (fr == 1 ? pm1[c] : pm2[c]));
                    q1[c] = r1; q2[c] = r2;
                    hv[c] = gelu_tanh_f(w0[c] * g0 + w1[c] * g1 + w2[c] * g + bb[c]) * up;
                }
                u32x4 w; w.x = cvt_pk_bf16(hv[0], hv[1]); w.y = cvt_pk_bf16(hv[2], hv[3]); w.z = cvt_pk_bf16(hv[4], hv[5]); w.w = cvt_pk_bf16(hv[6], hv[7]);
                *(u32x4*)(H + (size_t)row * ff + hc) = w;
                const bool t01 = ((m & 1) == 0) && fr < 2, t3031 = ((m & 1) == 1) && fr >= 14;
                if (t01 || t3031) {
                    const int slot = t01 ? fr : fr - 12; bf16_t* sp = SB + (((size_t)(row >> 5) * 4 + slot) * 2) * ff + hc;
                    u32x4 gw; gw.x = cvt_pk_bf16(acc[ai][0][m][0][0], acc[ai][0][m][0][1]); gw.y = cvt_pk_bf16(acc[ai][0][m][0][2], acc[ai][0][m][0][3]); gw.z = cvt_pk_bf16(acc[ai][0][m][1][0], acc[ai][0][m][1][1]); gw.w = cvt_pk_bf16(acc[ai][0][m][1][2], acc[ai][0][m][1][3]);
                    u32x4 uw; uw.x = cvt_pk_bf16(acc[ai][1][m][0][0], acc[ai][1][m][0][1]); uw.y = cvt_pk_bf16(acc[ai][1][m][0][2], acc[ai][1][m][0][3]); uw.z = cvt_pk_bf16(acc[ai][1][m][1][0], acc[ai][1][m][1][1]); uw.w = cvt_pk_bf16(acc[ai][1][m][1][2], acc[ai][1][m][1][3]);
                    *(u32x4*)sp = gw; *(u32x4*)(sp + ff) = uw;
                    if (t3031) {
                        float* op = nullptr;
                        if (row >= mp) op = fcs + ((size_t)((row - mp) >> 5) * 2 + (fr - 14)) * ff + hc;
                        else if ((row & 4095) >= 4094) op = fcp + ((size_t)(row >> 12) * 2 + (fr - 14)) * ff + hc;
                        if (op) { *(f32x4*)op = acc[ai][0][m][0]; *(f32x4*)(op + 4) = acc[ai][0][m][1]; }
                    }
                }
            }
        }
    }
};
struct PanelRms {
    unsigned* xbuf;
    unsigned* cnt;
    unsigned* tmo;
    float eps; unsigned code;
    __device__ __forceinline__ bool run(const f32x4 (&v)[2][2][4][2], const Unit& u, int wr, int wc, int fr, int fq, PG8_LAS unsigned char* lds, int wid, int lane) const {
        PG8_LAS float* P = (PG8_LAS float*)lds;
        PG8_LAS float* S = (PG8_LAS float*)(lds + 8192);
        PG8_LAS unsigned* flag = (PG8_LAS unsigned*)(lds + 8192 + 2048);
#pragma unroll
        for (int ai = 0; ai < 2; ++ai)
#pragma unroll
            for (int m = 0; m < 4; ++m) {
                float q = 0.f;
#pragma unroll
                for (int bj = 0; bj < 2; ++bj)
#pragma unroll
                    for (int n = 0; n < 2; ++n) { const f32x4 x = v[ai][bj][m][n]; q += (x[0] * x[0] + x[1] * x[1]) + (x[2] * x[2] + x[3] * x[3]); }
                q += __shfl_xor(q, 16); q += __shfl_xor(q, 32);
                if (fq == 0) P[(ai * HALF + wr * 64 + m * 16 + fr) * 4 + wc] = q;
            }
        asm volatile("s_waitcnt lgkmcnt(0)" ::: "memory"); __builtin_amdgcn_s_barrier(); asm volatile("" ::: "memory");
        const int row = wid * 32 + (lane & 31);
        if (lane < 32) {
            const float t = (P[row * 4 + 0] + P[row * 4 + 1]) + (P[row * 4 + 2] + P[row * 4 + 3]);
            __hip_atomic_store(xbuf + ((size_t)(u.pm * BM + row) * 4 + u.pn), __float_as_uint(t), __ATOMIC_RELAXED, __HIP_MEMORY_SCOPE_AGENT);
        }
        asm volatile("s_waitcnt vmcnt(0)" ::: "memory");
        if (lane == 0) __hip_atomic_fetch_add(cnt + 64 * u.pm, 1u, __ATOMIC_RELAXED, __HIP_MEMORY_SCOPE_AGENT);
        if (wid == 0) {
            bool dead = false; const unsigned long long t0 = __builtin_amdgcn_s_memrealtime(); const unsigned want = 8u * 4u;
            for (;;) {
                if ((unsigned)__builtin_amdgcn_readfirstlane(__hip_atomic_load(cnt + 64 * u.pm, __ATOMIC_RELAXED, __HIP_MEMORY_SCOPE_AGENT)) >= want) break;
                if (__builtin_amdgcn_s_memrealtime() - t0 > 2000000ull) {
                    if (lane == 0) { unsigned expect = 0u; __hip_atomic_compare_exchange_strong(tmo + 1, &expect, code | (unsigned)(u.pm & 0xff), __ATOMIC_RELAXED, __ATOMIC_RELAXED, __HIP_MEMORY_SCOPE_AGENT);
                                     __hip_atomic_store(tmo, 1u, __ATOMIC_RELAXED, __HIP_MEMORY_SCOPE_AGENT); }
                    dead = true; break; }
                __builtin_amdgcn_s_sleep(2);
            }
            __builtin_amdgcn_fence(__ATOMIC_ACQUIRE, "agent");
            if (lane == 0) flag[0] = dead ? 1u : 0u;
        }
        asm volatile("s_waitcnt vmcnt(0) lgkmcnt(0)" ::: "memory"); __builtin_amdgcn_s_barrier(); asm volatile("" ::: "memory");
        const bool bad = flag[0] != 0u;
        if (lane < 32) {
            const unsigned* slot = xbuf + (size_t)(u.pm * BM + row) * 4; float tot = 0.f;
#pragma unroll
            for (int t = 0; t < 4; ++t) tot += __uint_as_float(__hip_atomic_load(slot + t, __ATOMIC_RELAXED, __HIP_MEMORY_SCOPE_AGENT));
            S[row] = __builtin_amdgcn_rsqf(tot * (1.0f / 1024.0f) + eps);
        }
        asm volatile("s_waitcnt lgkmcnt(0)" ::: "memory"); __builtin_amdgcn_s_barrier(); asm volatile("" ::: "memory");
        return bad;
    }
};
struct EpiRmsRes {
    static constexpr bool PERM = false, AFTER_DRAIN = true;
    float* out; int ldc; const float* w; PanelRms st; unsigned poison;
    __device__ __forceinline__ void fused(f32x4 (&acc)[2][2][4][2], const Unit& u, int wr, int wc, int fr, int fq, PG8_LAS unsigned char* lds, int wid, int lane) const {
        const PG8_LAS float* S = (const PG8_LAS float*)(lds + 8192);
        const int col0 = u.pn * BM + wc * 32 + 4 * fq;
        const bool bad = st.run(acc, u, wr, wc, fr, fq, lds, wid, lane) || poison != 0u;
        const float qnan = __builtin_nanf("");
        f32x4 wv[2][2];
#pragma unroll
        for (int bj = 0; bj < 2; ++bj)
#pragma unroll
            for (int n = 0; n < 2; ++n) wv[bj][n] = *(const f32x4*)(w + col0 + bj * HALF + n * 16);
#pragma unroll
        for (int ai = 0; ai < 2; ++ai)
#pragma unroll
            for (int m = 0; m < 4; ++m) { const int r = ai * HALF + wr * 64 + m * 16 + fr; const float rs = S[r]; const size_t off = (size_t)(u.pm * BM + r) * ldc + col0;
#pragma unroll
                for (int bj = 0; bj < 2; ++bj)
#pragma unroll
                    for (int n = 0; n < 2; ++n) { float* op = out + off + bj * HALF + n * 16; f32x4 o = *(const f32x4*)op + acc[ai][bj][m][n] * rs * wv[bj][n];
                        if (bad) o = (f32x4){qnan, qnan, qnan, qnan}; *(f32x4*)op = o; }
                if (m & 1) asm volatile("" ::: "memory"); }
    }
};
struct EpiRmsResRms {
    static constexpr bool PERM = false, AFTER_DRAIN = true;
    const float* base; float* out; bf16_t* xn; int ldc; const float* w1; const float* w2; PanelRms st1, st2; unsigned poison;
    __device__ __forceinline__ void fused(f32x4 (&acc)[2][2][4][2], const Unit& u, int wr, int wc, int fr, int fq, PG8_LAS unsigned char* lds, int wid, int lane) const {
        typedef unsigned u32x2v __attribute__((ext_vector_type(2)));
        const PG8_LAS float* S = (const PG8_LAS float*)(lds + 8192);
        const int col0 = u.pn * BM + wc * 32 + 4 * fq;
        bool bad = st1.run(acc, u, wr, wc, fr, fq, lds, wid, lane) || poison != 0u;
        const float qnan = __builtin_nanf("");
        {
            f32x4 wv[2][2];
#pragma unroll
            for (int bj = 0; bj < 2; ++bj)
#pragma unroll
                for (int n = 0; n < 2; ++n) wv[bj][n] = *(const f32x4*)(w1 + col0 + bj * HALF + n * 16);
#pragma unroll
            for (int ai = 0; ai < 2; ++ai)
#pragma unroll
                for (int m = 0; m < 4; ++m) { const int r = ai * HALF + wr * 64 + m * 16 + fr; const float rs = S[r]; const size_t off = (size_t)(u.pm * BM + r) * ldc + col0;
#pragma unroll
                    for (int bj = 0; bj < 2; ++bj)
#pragma unroll
                        for (int n = 0; n < 2; ++n) acc[ai][bj][m][n] = *(const f32x4*)(base + off + bj * HALF + n * 16) + acc[ai][bj][m][n] * rs * wv[bj][n];
                    asm volatile("" : "+v"(acc[ai][0][m][0]), "+v"(acc[ai][0][m][1]), "+v"(acc[ai][1][m][0]), "+v"(acc[ai][1][m][1]));
                    if (m & 1) asm volatile("" ::: "memory"); }
        }
        const bool bad1 = bad;
        bad = st2.run(acc, u, wr, wc, fr, fq, lds, wid, lane) || bad;
        f32x4 wv[2][2];
#pragma unroll
        for (int bj = 0; bj < 2; ++bj)
#pragma unroll
            for (int n = 0; n < 2; ++n) wv[bj][n] = *(const f32x4*)(w2 + col0 + bj * HALF + n * 16);
#pragma unroll
        for (int ai = 0; ai < 2; ++ai)
#pragma unroll
            for (int m = 0; m < 4; ++m) { const int r = ai * HALF + wr * 64 + m * 16 + fr; const float rs = S[r]; const size_t off = (size_t)(u.pm * BM + r) * ldc + col0;
#pragma unroll
                for (int bj = 0; bj < 2; ++bj)
#pragma unroll
                    for (int n = 0; n < 2; ++n) { const f32x4 x1 = acc[ai][bj][m][n]; *(f32x4*)(out + off + bj * HALF + n * 16) = bad1 ? (f32x4){qnan, qnan, qnan, qnan} : x1;
                        const f32x4 o = x1 * rs * wv[bj][n]; u32x2v wq; wq.x = cvt_pk_bf16(o[0], o[1]); wq.y = cvt_pk_bf16(o[2], o[3]);
                        if (bad) { wq.x = 0x7fc07fc0u; wq.y = 0x7fc07fc0u; } *(u32x2v*)(xn + off + bj * HALF + n * 16) = wq; }
                asm volatile("" ::: "memory"); }
    }
};

struct EpiProbe {
    static constexpr bool PERM = true, AFTER_DRAIN = true;
    EpiBf16<0> eb; PanelRms st;
    __device__ __forceinline__ void fused(f32x4 (&acc)[2][2][4][2], const Unit& u, int wr, int wc, int fr, int fq, PG8_LAS unsigned char* lds, int wid, int lane) const {
        eb(acc, u, wr, wc, fr, fq);
        (void)st.run(acc, u, wr, wc, fr, fq, lds, wid, lane);
    }
};

template <class Epi, class Sched, bool ALIGN_EPI = false, bool SP2 = false>
__device__ __forceinline__ void gemm_phase(PG8_LAS unsigned char* lds, const Gemm g, const Sched& S, const Epi& E) {
    const int tid = threadIdx.x, wid = __builtin_amdgcn_readfirstlane(tid >> 6), lane = tid & 63, wr = wid >> 2, wc = wid & 3, fr = lane & 15, fq = lane >> 4;
    const int K = g.K, ld = g.ld, nt = K / BK;
    unsigned voffA[2], voffB[2];
#pragma unroll
    for (int i = 0; i < 2; ++i) { int R, C; stage_rc(tid * 16 + i * 8192, R, C); const int Rb = Epi::PERM ? ((R & ~31) + perm32(R & 31)) : R;
        voffA[i] = (unsigned)(R * ld + C) * 2u; voffB[i] = (unsigned)(Rb * ld + C) * 2u; }
    const size_t kstep = (size_t)(BK * 2);
    const size_t hstep = (size_t)HALF * ld * 2;
    const size_t tstep = 2 * hstep;
    const unsigned ldsw = (unsigned)wid * 1024u;
    const int aoff = lds_byte(wr * 64 + fr, fq * 8), boff = lds_byte(wc * 32 + fr, fq * 8);
#define PG8_SA(b, h) (((b) * 2 + (h)) * HTB)
#define PG8_SB(b, h) ((4 + (b) * 2 + (h)) * HTB)
#define PG8_STAGE(bufoff, gbase, voff) do { _Pragma("unroll") for (int _i = 0; _i < 2; ++_i) \
        __builtin_amdgcn_global_load_lds((const unsigned*)((const char*)(gbase) + (voff)[_i]), (PG8_LAS unsigned*)(lds + (bufoff) + ldsw + _i * 8192), 16, 0, 0); } while (0)
#define PG8_LDA(dst, b, h) do { _Pragma("unroll") for (int m = 0; m < 4; ++m) _Pragma("unroll") for (int k = 0; k < 2; ++k) dst[m][k] = *(const PG8_LAS bf16x8*)(lds + PG8_SA(b, h) + aoff + m * 2048 + k * 1024); } while (0)
#define PG8_LDB(dst, b, h) do { _Pragma("unroll") for (int n = 0; n < 2; ++n) _Pragma("unroll") for (int k = 0; k < 2; ++k) dst[n][k] = *(const PG8_LAS bf16x8*)(lds + PG8_SB(b, h) + boff + n * 2048 + k * 1024); } while (0)
#define PG8_MMA(ai, bj, At, Bt) do { __builtin_amdgcn_s_setprio(1); _Pragma("unroll") for (int m = 0; m < 4; ++m) _Pragma("unroll") for (int n = 0; n < 2; ++n) _Pragma("unroll") for (int k = 0; k < 2; ++k) \
        acc[ai][bj][m][n] = __builtin_amdgcn_mfma_f32_16x16x32_bf16(Bt[n][k], At[m][k], acc[ai][bj][m][n], 0, 0, 0); __builtin_amdgcn_s_setprio(0); } while (0)
#define PG8_WAIT_V(n) asm volatile("s_waitcnt vmcnt(" #n ")" ::: "memory")
#define PG8_WAIT_L(n) asm volatile("s_waitcnt lgkmcnt(" #n ")" ::: "memory")
#define PG8_BAR __builtin_amdgcn_s_barrier()
#define PG8_SCHED __builtin_amdgcn_sched_barrier(0)
    Unit cur, nxt; int ui = 0;
    if (!S.next(0, cur)) return;
    f32x4 acc[2][2][4][2];
#pragma unroll
    for (int a = 0; a < 2; ++a)
#pragma unroll
        for (int b = 0; b < 2; ++b)
#pragma unroll
            for (int m = 0; m < 4; ++m)
#pragma unroll
                for (int n = 0; n < 2; ++n) acc[a][b][m][n] = (f32x4){0.f, 0.f, 0.f, 0.f};
    bf16x8 At[4][2], B0[2][2], B1[2][2];
    const size_t kqb = (size_t)K * 2;
    const char* cA = (const char*)g.A + (size_t)cur.pm * tstep + cur.kq * kqb; const char* cB = (const char*)g.Bt + (size_t)cur.pn * tstep + cur.kq * kqb;
    S.a_ready(cur);
    if constexpr (SP2) {
        PG8_STAGE(PG8_SB(0, 0), cB, voffB); PG8_STAGE(PG8_SB(0, 1), cB + hstep, voffB); PG8_STAGE(PG8_SA(0, 0), cA, voffA); PG8_STAGE(PG8_SA(0, 1), cA + hstep, voffA);
        if (wr == 1) PG8_BAR;
        PG8_WAIT_V(2); PG8_BAR;
        PG8_STAGE(PG8_SB(1, 0), cB + kstep, voffB); PG8_STAGE(PG8_SA(1, 0), cA + kstep, voffA); PG8_STAGE(PG8_SB(1, 1), cB + hstep + kstep, voffB);
        PG8_WAIT_V(6); PG8_BAR;
    } else {
        PG8_STAGE(PG8_SB(0, 0), cB, voffB); PG8_STAGE(PG8_SA(0, 0), cA, voffA); PG8_STAGE(PG8_SB(0, 1), cB + hstep, voffB); PG8_STAGE(PG8_SA(0, 1), cA + hstep, voffA);
        if (wr == 1) PG8_BAR;
        PG8_WAIT_V(4); PG8_BAR;
        PG8_STAGE(PG8_SB(1, 0), cB + kstep, voffB); PG8_STAGE(PG8_SA(1, 0), cA + kstep, voffA); PG8_STAGE(PG8_SB(1, 1), cB + hstep + kstep, voffB);
        PG8_WAIT_V(6); PG8_BAR;
    }
    for (;;) {
        const bool has_next = S.next(ui + 1, nxt);
        const char* nA = has_next ? (const char*)g.A + (size_t)nxt.pm * tstep + nxt.kq * kqb : cA; const char* nB = has_next ? (const char*)g.Bt + (size_t)nxt.pn * tstep + nxt.kq * kqb : cB;
        for (int t = 0; t < nt; t += 2) {
            const bool last = (t == nt - 2);
            const char* a1 = cA + (size_t)(t + 1) * kstep;
            const char* a2 = last ? nA : cA + (size_t)(t + 2) * kstep; const char* b2 = last ? nB : cB + (size_t)(t + 2) * kstep;
            const char* a3 = a2 + kstep; const char* b3 = b2 + kstep;
            if (last && has_next) S.a_ready(nxt);
            if constexpr (SP2) {
            PG8_LDB(B0, 0, 0); PG8_LDB(B1, 0, 1); PG8_SCHED; PG8_LDA(At, 0, 0); PG8_STAGE(PG8_SA(1, 1), a1 + hstep, voffA);
            PG8_WAIT_V(8); PG8_WAIT_L(0); PG8_BAR; PG8_MMA(0, 0, At, B0); PG8_MMA(0, 1, At, B1); PG8_BAR; PG8_SCHED;
            PG8_LDA(At, 0, 1); PG8_STAGE(PG8_SB(0, 0), b2, voffB); PG8_STAGE(PG8_SB(0, 1), b2 + hstep, voffB); PG8_STAGE(PG8_SA(0, 0), a2, voffA);
            PG8_WAIT_V(8); PG8_WAIT_L(0); PG8_BAR; PG8_MMA(1, 0, At, B0); PG8_MMA(1, 1, At, B1); PG8_BAR; PG8_SCHED;
            PG8_LDB(B0, 1, 0); PG8_LDB(B1, 1, 1); PG8_SCHED; PG8_LDA(At, 1, 0); PG8_STAGE(PG8_SA(0, 1), a2 + hstep, voffA);
            PG8_WAIT_V(8); PG8_WAIT_L(0); PG8_BAR; PG8_MMA(0, 0, At, B0); PG8_MMA(0, 1, At, B1); PG8_BAR; PG8_SCHED;
            PG8_LDA(At, 1, 1); PG8_STAGE(PG8_SB(1, 0), b3, voffB); PG8_STAGE(PG8_SB(1, 1), b3 + hstep, voffB); PG8_STAGE(PG8_SA(1, 0), a3, voffA);
            PG8_WAIT_V(8); PG8_WAIT_L(0); PG8_BAR; PG8_MMA(1, 0, At, B0); PG8_MMA(1, 1, At, B1); PG8_BAR; PG8_SCHED;
            } else {
            PG8_LDB(B0, 0, 0); PG8_SCHED; PG8_LDA(At, 0, 0); PG8_STAGE(PG8_SA(1, 1), a1 + hstep, voffA);
            PG8_WAIT_L(8); PG8_BAR; PG8_WAIT_L(0); PG8_MMA(0, 0, At, B0); PG8_BAR; PG8_SCHED;
            PG8_LDB(B1, 0, 1); PG8_STAGE(PG8_SB(0, 0), b2, voffB);
            PG8_BAR; PG8_WAIT_L(0); PG8_MMA(0, 1, At, B1); PG8_BAR;
            PG8_LDA(At, 0, 1); PG8_STAGE(PG8_SA(0, 0), a2, voffA);
            PG8_BAR; PG8_WAIT_L(0); PG8_MMA(1, 0, At, B0); PG8_BAR; PG8_SCHED;
            PG8_STAGE(PG8_SB(0, 1), b2 + hstep, voffB);
            PG8_WAIT_V(6); PG8_BAR; PG8_MMA(1, 1, At, B1); PG8_BAR;
            PG8_LDB(B0, 1, 0); PG8_SCHED; PG8_LDA(At, 1, 0); PG8_STAGE(PG8_SA(0, 1), a2 + hstep, voffA);
            PG8_WAIT_L(8); PG8_BAR; PG8_WAIT_L(0); PG8_MMA(0, 0, At, B0); PG8_BAR; PG8_SCHED;
            PG8_LDB(B1, 1, 1); PG8_STAGE(PG8_SB(1, 0), b3, voffB);
            PG8_BAR; PG8_WAIT_L(0); PG8_MMA(0, 1, At, B1); PG8_BAR;
            PG8_LDA(At, 1, 1); PG8_STAGE(PG8_SA(1, 0), a3, voffA);
            PG8_BAR; PG8_WAIT_L(0); PG8_MMA(1, 0, At, B0); PG8_BAR; PG8_SCHED;
            PG8_STAGE(PG8_SB(1, 1), b3 + hstep, voffB);
            PG8_WAIT_V(6); PG8_BAR; PG8_MMA(1, 1, At, B1); PG8_BAR;
            }
        }
        if constexpr (ALIGN_EPI) { if (wr == 0) PG8_BAR; }
        if constexpr (!Epi::AFTER_DRAIN) { E(acc, cur, wr, wc, fr, fq); S.done(cur); }
        if (!has_next) break;
#pragma unroll
        for (int a = 0; a < 2; ++a)
#pragma unroll
            for (int b = 0; b < 2; ++b)
#pragma unroll
                for (int m = 0; m < 4; ++m)
#pragma unroll
                    for (int n = 0; n < 2; ++n) acc[a][b][m][n] = (f32x4){0.f, 0.f, 0.f, 0.f};
        cur = nxt; cA = nA; cB = nB; ++ui;
        if constexpr (ALIGN_EPI) { if (wr == 1) PG8_BAR; }
    }
    PG8_WAIT_V(0);
    if constexpr (!ALIGN_EPI) { if (wr == 0) PG8_BAR; }
    PG8_BAR;
    if constexpr (Epi::AFTER_DRAIN) { E.fused(acc, cur, wr, wc, fr, fq, lds, wid, lane); S.done(cur); }
#undef PG8_SA
#undef PG8_SB
#undef PG8_STAGE
#undef PG8_LDA
#undef PG8_LDB
#undef PG8_MMA
#undef PG8_WAIT_V
#undef PG8_WAIT_L
#undef PG8_BAR
#undef PG8_SCHED
}
}

constexpr int NWAVES = 8;
constexpr int D = 1024, SEQ = 4096, MP = 16384, MS = 1024, M = MP + MS;
constexpr int NIN = 3584, INC = 3592, FF = 2816;
constexpr int PC_Z = 1536, PC_QB = 2048, PC_KB = 2560, PC_VB = 3072;
constexpr float EPS = 1e-6f;
constexpr size_t O_YP = 0, O_YS = 16777216, O_BKP = 17825792, O_BVP = 18874368, O_DP = 19922944, O_QCP = 20185088, O_FCP = 20203520,
                 O_BKS = 20226048, O_BVS = 20750336, O_DS = 21274624, O_QCS = 23371776, O_FCS = 23519232;
constexpr size_t MiB = 1u << 20;
constexpr size_t WS_CTL = 0, CTL_ZERO_BYTES = 1 * MiB;
constexpr size_t WS_WIN = 1 * MiB, WS_WOUT = 8 * MiB, WS_WGU = 10 * MiB, WS_WDN = 21 * MiB;
constexpr size_t WS_AB = 27 * MiB, WS_DL = 27 * MiB + 768 * 1024;
constexpr size_t WS_U = 28 * MiB;
constexpr size_t WS_GQK = WS_U, WS_GS = WS_U + 8 * MiB;
constexpr size_t WS_P = 62 * MiB;
constexpr size_t WS_MIXIN = 181 * MiB;
constexpr size_t WS_G = WS_P, WS_UP = WS_P + (size_t)M * FF * 2;
constexpr size_t WS_END = 256 * MiB;
static_assert(WS_UP + (size_t)M * FF * 2 <= WS_END, "ws map");
constexpr int CW_BAR = 4096, CW_SEAM = 16384;
constexpr size_t WS_XB = 250 * MiB;

constexpr int LDS_BYTES = 163840;
constexpr int MISC_OFF = LDS_BYTES - 256;

#define GAS __attribute__((address_space(1)))
#define LAS __attribute__((address_space(3)))
typedef unsigned short bf16;
typedef unsigned v4u __attribute__((ext_vector_type(4)));
typedef unsigned v2u __attribute__((ext_vector_type(2)));
typedef float f32x2 __attribute__((ext_vector_type(2)));
typedef float f32x4 __attribute__((ext_vector_type(4)));
typedef float f32x16 __attribute__((ext_vector_type(16)));
typedef short bf16x8 __attribute__((ext_vector_type(8)));
typedef short s16x4 __attribute__((ext_vector_type(4)));
typedef __bf16 bf16x2_t __attribute__((ext_vector_type(2)));
typedef GAS unsigned gu32;
#define RLX_AGENT __ATOMIC_RELAXED, __HIP_MEMORY_SCOPE_AGENT
#define LDS_WAIT() asm volatile("s_waitcnt lgkmcnt(0)" ::: "memory")
#define VM_WAIT() asm volatile("s_waitcnt vmcnt(0)" ::: "memory")
__device__ __forceinline__ unsigned pk2(float lo, float hi) { f32x2 v = {lo, hi}; bf16x2_t b = __builtin_convertvector(v, bf16x2_t); return __builtin_bit_cast(unsigned, b); }
__device__ __forceinline__ float bflo(unsigned w) { return __uint_as_float(w << 16); }
__device__ __forceinline__ float bfhi(unsigned w) { return __uint_as_float(w & 0xffff0000u); }
__device__ __forceinline__ float bf1(bf16 b) { return __uint_as_float((unsigned)b << 16); }
__device__ __forceinline__ bf16 f2bf(float f) { return (bf16)(pk2(f, 0.f) & 0xffffu); }
__device__ __forceinline__ float wave_sum(float v) {
#pragma unroll
    for (int o = 1; o < 64; o <<= 1) v += __shfl_xor(v, o);
    return v;
}
__device__ __forceinline__ float sigmoidf_(float x) { return __builtin_amdgcn_rcpf(1.0f + __builtin_amdgcn_exp2f(-1.4426950408889634f * x)); }
__device__ __forceinline__ float rsq_(float x) { return __builtin_amdgcn_rsqf(x); }
__device__ __forceinline__ int crow(int r, int hi) { return (r & 3) + 8 * (r >> 2) + 4 * hi; }
#define MFMA32(a, b, c) __builtin_amdgcn_mfma_f32_32x32x16_bf16((a), (b), (c), 0, 0, 0)
#define MFMA16(a, b, c) __builtin_amdgcn_mfma_f32_16x16x32_bf16((a), (b), (c), 0, 0, 0)
#define XB_TMO      128
#define XB_XCNT(j)  (256  + 64 * (j))
#define XB_XSUB(j)  (1280 + 64 * (j))
#define XB_XGEN(j)  (2304 + 64 * (j))
#define XB_TOP      3328
#define XB_TOPGEN   3392
#define XCD_BAR_WORDS 3456
#define XB_SPIN_CAP (1u << 18)

__device__ __forceinline__ unsigned xb_ld(unsigned* p)              { return __hip_atomic_load(p, __ATOMIC_RELAXED, __HIP_MEMORY_SCOPE_AGENT); }
__device__ __forceinline__ unsigned xb_add(unsigned* p, unsigned v) { return __hip_atomic_fetch_add(p, v, __ATOMIC_RELAXED, __HIP_MEMORY_SCOPE_AGENT); }
__device__ __forceinline__ unsigned xb_xcc_id() { return (unsigned)__builtin_amdgcn_s_getreg((3 << 11) | 20) & 0xFu; }
#define XB_SPIN(cond, bar) do { unsigned _sp = 0; while (cond) { __builtin_amdgcn_s_sleep(1); \
    if ((++_sp & 255u) == 0u) { if (xb_ld(&(bar)[XB_TMO])) break; if (_sp > XB_SPIN_CAP) { atomicAdd(&(bar)[XB_TMO], 1u); break; } } } } while (0)

struct XcdBarrier {
    unsigned* bar; unsigned x;
    volatile LAS unsigned* st;
};

__device__ __forceinline__ XcdBarrier xcd_barrier_post(unsigned* bar, volatile LAS unsigned* st) {
    XcdBarrier b; b.bar = bar; b.x = xb_xcc_id(); b.st = st;
    if (threadIdx.x == 0) (void)xb_add(&bar[XB_XCNT(b.x)], 1u);
    return b;
}
__device__ __forceinline__ void xcd_barrier_complete(unsigned* bar, unsigned x, unsigned& nloc, unsigned& nx) {
    const unsigned G = gridDim.x * gridDim.y * gridDim.z;
    unsigned sum, cnt, mine, sp = 0u;
    for (;;) {
        sum = 0u; cnt = 0u; mine = 0u;
#pragma unroll
        for (unsigned j = 0; j < 16; ++j) { const unsigned c = xb_ld(&bar[XB_XCNT(j)]); sum += c; cnt += (c > 0u) ? 1u : 0u; mine = (j == x) ? c : mine; }
        if (sum == G) break;
        __builtin_amdgcn_s_sleep(1);
        if ((++sp & 255u) == 0u) { if (xb_ld(&bar[XB_TMO])) break; if (sp > XB_SPIN_CAP) { atomicAdd(&bar[XB_TMO], 1u); break; } }
    }
    nloc = mine > 0u ? mine : 1u; nx = cnt > 0u ? cnt : 1u;
}

__device__ __forceinline__ void xcd_barrier(const XcdBarrier& b) {
    asm volatile("s_waitcnt vmcnt(0)" ::: "memory");
    __syncthreads();
    if (threadIdx.x == 0) {
        unsigned* bar = b.bar;
        __builtin_amdgcn_s_waitcnt(0);
        unsigned nloc = b.st[0], nx = b.st[1];
        if (nloc == 0u) { xcd_barrier_complete(bar, b.x, nloc, nx); b.st[0] = nloc; b.st[1] = nx; }
        const unsigned old = xb_add(&bar[XB_XSUB(b.x)], 1u);
        const unsigned gen = old / nloc;
        if (old + 1u == (gen + 1u) * nloc) {
            __builtin_amdgcn_fence(__ATOMIC_RELEASE, "agent");
            asm volatile("s_waitcnt vmcnt(0)" ::: "memory");
            const unsigned og = xb_add(&bar[XB_TOP], 1u);
            const unsigned tg = og / nx;
            if (og + 1u == (tg + 1u) * nx) xb_add(&bar[XB_TOPGEN], 1u);
            else XB_SPIN(xb_ld(&bar[XB_TOPGEN]) == tg, bar);
            __builtin_amdgcn_fence(__ATOMIC_ACQUIRE, "agent");
            xb_add(&bar[XB_XGEN(b.x)], 1u);
            asm volatile("s_waitcnt vmcnt(0)" ::: "memory");
        } else {
            XB_SPIN(xb_ld(&bar[XB_XGEN(b.x)]) == gen, bar);
            __builtin_amdgcn_fence(__ATOMIC_ACQUIRE, "agent");
            asm volatile("s_waitcnt vmcnt(0)" ::: "memory");
        }
    }
    __syncthreads();
}

__device__ __forceinline__ void p0_transpose_item(const float* W, int ldw, int K, int N, bf16* WT, int row_off, LAS float* scr, int item, int lane) {
    const int nblk = N / 32, kb = item / nblk, nb = item % nblk, k0 = 64 * kb, n0 = 32 * nb;
#pragma unroll 8
    for (int i = 0; i < 32; ++i) { const int kk = 2 * i + (lane >> 5); scr[kk * 33 + (lane & 31)] = W[(size_t)(k0 + kk) * ldw + n0 + (lane & 31)]; }
    LDS_WAIT(); asm volatile("" ::: "memory");
    const int c = lane & 7;
#pragma unroll
    for (int j = 0; j < 4; ++j) { const int n = (lane >> 3) + 8 * j; const LAS float* s = scr + (8 * c) * 33 + n;
        v4u o; o.x = pk2(s[0 * 33], s[1 * 33]); o.y = pk2(s[2 * 33], s[3 * 33]); o.z = pk2(s[4 * 33], s[5 * 33]); o.w = pk2(s[6 * 33], s[7 * 33]);
        *(v4u*)(WT + (size_t)(row_off + n0 + n) * K + k0 + 8 * c) = o; }
    LDS_WAIT(); asm volatile("" ::: "memory");
}

__device__ __forceinline__ void phase_prologue(LAS unsigned char* lds, const float* xp, const float* xs, const float* nw, const float* w_in, const float* w_out, const float* w_gu, const float* w_dn,
                                               unsigned char* ws, int vcu, int G, int tid, int lane, int wave) {
    LAS float* scr = (LAS float*)(lds + wave * 8448);
    LAS float* W8T = (LAS float*)(lds + 67584);
    for (int k = tid; k < 1024; k += 512) {
        const f32x4 a = *(const f32x4*)(w_in + (size_t)k * INC + 2048), b = *(const f32x4*)(w_in + (size_t)k * INC + 2052);
        W8T[0 * 1024 + k] = a.x; W8T[1 * 1024 + k] = a.y; W8T[2 * 1024 + k] = a.z; W8T[3 * 1024 + k] = a.w;
        W8T[4 * 1024 + k] = b.x; W8T[5 * 1024 + k] = b.y; W8T[6 * 1024 + k] = b.z; W8T[7 * 1024 + k] = b.w;
    }
    __syncthreads();
    const int gw = vcu * NWAVES + wave, NGW = G * NWAVES;
    bf16* Win_t = (bf16*)(ws + WS_WIN); bf16* Wout_t = (bf16*)(ws + WS_WOUT); bf16* Wgu_t = (bf16*)(ws + WS_WGU); bf16* Wdn_t = (bf16*)(ws + WS_WDN);
    constexpr int I_A = 16 * 64, I_B = 16 * 48, I_O = 16 * 32, I_GU = 16 * 176, I_DN = 44 * 32;
    constexpr int NITEMS = I_A + I_B + I_O + I_GU + I_DN;
    for (int it = gw; it < NITEMS; it += NGW) {
        int r = it;
        if (r < I_A) { p0_transpose_item(w_in, INC, D, 2048, Win_t, 0, scr, r, lane); continue; } r -= I_A;
        if (r < I_B) { p0_transpose_item(w_in + 2056, INC, D, 1536, Win_t, 2048, scr, r, lane); continue; } r -= I_B;
        if (r < I_O) { p0_transpose_item(w_out, D, D, D, Wout_t, 0, scr, r, lane); continue; } r -= I_O;
        if (r < I_GU) { const int blk = r >> 6, sub = r & 63;
            if (blk < 22) p0_transpose_item(w_gu + 128 * blk, 2 * FF, D, 128, Wgu_t, 256 * blk, scr, sub, lane);
            else p0_transpose_item(w_gu + FF + 128 * (blk - 22), 2 * FF, D, 128, Wgu_t, 256 * (blk - 22) + 128, scr, sub, lane);
            continue; } r -= I_GU;
        p0_transpose_item(w_dn, D, FF, D, Wdn_t, 0, scr, r, lane);
    }
    bf16* U = (bf16*)(ws + WS_U); float* AB = (float*)(ws + WS_AB);
    for (int m = gw; m < M; m += NGW) {
        const float* xrow = m < MP ? xp + (size_t)m * D : xs + (size_t)(m - MP) * D;
        f32x4 v[4]; float s = 0.f;
#pragma unroll
        for (int j = 0; j < 4; ++j) { v[j] = ((const f32x4*)xrow)[lane + 64 * j]; s += (v[j].x * v[j].x + v[j].y * v[j].y) + (v[j].z * v[j].z + v[j].w * v[j].w); }
        const float rstd = rsq_(wave_sum(s) * (1.f / D) + EPS);
        unsigned long long* o8 = (unsigned long long*)(U + (size_t)m * D) + lane;
#pragma unroll
        for (int j = 0; j < 4; ++j) { const f32x4 g = ((const f32x4*)nw)[lane + 64 * j]; v[j] = v[j] * rstd * g;
            o8[64 * j] = (unsigned long long)pk2(v[j].x, v[j].y) | ((unsigned long long)pk2(v[j].z, v[j].w) << 32); }
        float dv = 0.f;
#pragma unroll
        for (int jj = 0; jj < 8; ++jj) { float acc = 0.f;
#pragma unroll
            for (int j = 0; j < 4; ++j) { const f32x4 w = *(const LAS f32x4*)(W8T + jj * 1024 + 4 * lane + 256 * j); acc += (v[j].x * w.x + v[j].y * w.y) + (v[j].z * w.z + v[j].w * w.w); }
            acc = wave_sum(acc); if (lane == jj) dv = acc; }
        if (lane < 8) AB[(size_t)m * 8 + lane] = dv;
    }
}

__device__ __forceinline__ void cp8(const bf16* src, float* dst) { const v4u t = *(const v4u*)src; *(f32x4*)dst = (f32x4){bflo(t.x), bfhi(t.x), bflo(t.y), bfhi(t.y)}; *(f32x4*)(dst + 4) = (f32x4){bflo(t.z), bfhi(t.z), bflo(t.w), bfhi(t.w)}; }
__device__ __forceinline__ void phase_copy_outputs(const bf16* P, float* out, int gtid, int nth) {
    for (int e8 = gtid; e8 < 4 * 512 * 64; e8 += nth) { const int e = e8 * 8; const int b = e >> 18, j = (e >> 9) & 511, c = e & 511; const size_t row = (size_t)(b * SEQ + 3584 + j) * NIN;
        cp8(P + row + PC_KB + c, out + O_BKP + e); cp8(P + row + PC_VB + c, out + O_BVP + e); }
    for (int e8 = gtid; e8 < 32 * 32 * 64; e8 += nth) { const int e = e8 * 8; const int r = e >> 9, c = e & 511; const size_t row = (size_t)(MP + r) * NIN;
        cp8(P + row + PC_KB + c, out + O_BKS + e); cp8(P + row + PC_VB + c, out + O_BVS + e); }
    for (int e8 = gtid; e8 < 4 * 3 * 192; e8 += nth) { const int e = e8 * 8; const int b = e / 4608, i = (e / 1536) % 3, c = e % 1536; cp8(P + (size_t)(b * SEQ + 4093 + i) * NIN + c, out + O_QCP + e); }
    for (int e8 = gtid; e8 < 32 * 3 * 192; e8 += nth) { const int e = e8 * 8; const int b = e / 4608, i = (e / 1536) % 3, c = e % 1536; cp8(P + (size_t)(MP + b * 32 + 29 + i) * NIN + c, out + O_QCS + e); }
}

__device__ __forceinline__ bf16x8 pack8(const f32x4& a, const f32x4& b) { const v4u t = {pk2(a[0], a[1]), pk2(a[2], a[3]), pk2(b[0], b[1]), pk2(b[2], b[3])}; return __builtin_bit_cast(bf16x8, t); }
__device__ __forceinline__ float dpp_sum16(float v) {
    v += __uint_as_float((unsigned)__builtin_amdgcn_update_dpp(0, (int)__float_as_uint(v), 0xB1, 0xF, 0xF, true));
    v += __uint_as_float((unsigned)__builtin_amdgcn_update_dpp(0, (int)__float_as_uint(v), 0x4E, 0xF, 0xF, true));
    v += __uint_as_float((unsigned)__builtin_amdgcn_update_dpp(0, (int)__float_as_uint(v), 0x141, 0xF, 0xF, true));
    v += __uint_as_float((unsigned)__builtin_amdgcn_update_dpp(0, (int)__float_as_uint(v), 0x140, 0xF, 0xF, true));
    return v;
}
__device__ __forceinline__ int kperm(int k) { const int kk = k & 31; return (k & ~31) | (8 * ((kk & 15) >> 2) + (kk & 3) + 4 * (kk >> 4)); }
__device__ __forceinline__ void gdn_pre_unit(LAS unsigned char* lds, int u, const bf16* P, const float* AB, const float* st_qkv, const float* conv_w, const float* a_log, const float* dt_bias,
                                             bf16* gmain, bf16* gqk, bf16* gs, float* DL, int tid, int lane, int wave) {
    LAS float* RHS = (LAS float*)(lds + 0);
    LAS bf16* QB = (LAS bf16*)(lds + 65536);
    LAS bf16* KB = (LAS bf16*)(lds + 82944);
    LAS bf16* RAW = (LAS bf16*)(lds + 100352);
    LAS bf16* KGT = (LAS bf16*)(lds + 117760);
    LAS bf16* AMN = (LAS bf16*)(lds + 117760);
    LAS float* TD = (LAS float*)(lds + 117760 + 10240);
    LAS bf16* TB = (LAS bf16*)(lds + 117760 + 14336);
    LAS float* SMG = (LAS float*)(lds + 136192);
    const bool prompt = u < 1024;
    int b, h, n, m0, valid; bf16 *o_w, *o_qg, *o_kgt, *o_ut, *o_qk;
    if (prompt) { b = u >> 8; h = (u >> 6) & 3; n = u & 63; m0 = b * SEQ + n * 64; valid = 64; bf16* base = gmain + (size_t)u * 32768; o_w = base; o_qg = base + 8192; o_kgt = base + 16384; o_ut = base + 24576; o_qk = gqk + (size_t)u * 4096; }
    else { const int su = u - 1024; b = su >> 2; h = su & 3; n = 0; m0 = MP + b * 32; valid = 32; bf16* base = gs + (size_t)su * 36864; o_w = base; o_qg = base + 8192; o_kgt = base + 16384; o_ut = base + 24576; o_qk = base + 32768; }
    unsigned xr[3][11];
    if (prompt) {
#pragma unroll
        for (int part = 0; part < 3; ++part) { const int pcol = (part == 0 ? 512 : part == 1 ? 0 : 1024) + h * 128 + 2 * lane;
#pragma unroll
            for (int j = 0; j < 11; ++j) { const int ts = n * 64 - 3 + wave * 8 + j; const unsigned val = *(const unsigned*)(P + (size_t)(b * SEQ + (ts < 0 ? 0 : ts)) * NIN + pcol); xr[part][j] = ts < 0 ? 0u : val; } }
    } else {
#pragma unroll
        for (int part = 0; part < 3; ++part) { const int pcol = (part == 0 ? 512 : part == 1 ? 0 : 1024) + h * 128 + 2 * lane;
#pragma unroll
            for (int j = 0; j < 11; ++j) { const int pr = wave * 8 + j - 3; const int prc = pr < 0 ? 0 : (pr > 31 ? 31 : pr); const unsigned val = *(const unsigned*)(P + (size_t)(MP + b * 32 + prc) * NIN + pcol); xr[part][j] = (pr < 0 || pr > 31) ? 0u : val; }
#pragma unroll
            for (int j = 0; j < 3; ++j) { const int rr = wave * 8 + j; const f32x2 sv = *(const f32x2*)(st_qkv + ((size_t)b * 3 + (rr > 2 ? 2 : rr)) * 1536 + pcol); if (rr < 3) xr[part][j] = pk2(sv.x, sv.y); } }
    }
    float cw0[3][4], cw1[3][4];
#pragma unroll
    for (int part = 0; part < 3; ++part)
#pragma unroll
        for (int i = 0; i < 4; ++i) { const f32x2 t = *(const f32x2*)(conv_w + i * 1536 + (part == 0 ? 512 : part == 1 ? 0 : 1024) + h * 128 + 2 * lane); cw0[part][i] = t.x; cw1[part][i] = t.y; }
    if (wave == 0) {
        const int i = lane; const bool v = i < valid;
        const float araw = v ? AB[(size_t)(m0 + i) * 8 + 4 + h] : 0.f, braw = v ? AB[(size_t)(m0 + i) * 8 + h] : 0.f;
        const float A = expf(a_log[h]); const float x = araw + dt_bias[h];
        const float sp = x > 20.f ? x : log1pf(expf(x));
        const float g = v ? -A * sp : 0.f; const float beta = v ? 1.f / (1.f + expf(-braw)) : 0.f;
        float Gc = g;
#pragma unroll
        for (int off = 1; off < 64; off <<= 1) { const float t = __shfl_up(Gc, off); if (lane >= off) Gc += t; }
        const float Gl = __shfl(Gc, 63);
        SMG[i] = Gc; SMG[64 + i] = beta; SMG[128 + i] = expf(Gc); SMG[192 + i] = expf(Gl - Gc);
        if (lane == 0) DL[u] = expf(Gl);
    }
    __syncthreads();
    const int r0 = wave * 8;
#pragma unroll
    for (int part = 0; part < 3; ++part) {
        float s0[8], s1[8], rinv[8];
#pragma unroll
        for (int rq = 0; rq < 8; ++rq) { float y0 = 0.f, y1 = 0.f;
#pragma unroll
            for (int i = 0; i < 4; ++i) { const unsigned xw = xr[part][rq + i]; y0 += cw0[part][i] * bflo(xw); y1 += cw1[part][i] * bfhi(xw); }
            s0[rq] = y0 * sigmoidf_(y0); s1[rq] = y1 * sigmoidf_(y1);
            if (r0 + rq >= valid) { s0[rq] = 0.f; s1[rq] = 0.f; } }
        if (part != 2) {
#pragma unroll
            for (int rq = 0; rq < 8; ++rq) { const int tb = (int)__float_as_uint(dpp_sum16(s0[rq] * s0[rq] + s1[rq] * s1[rq]));
                const float tot = (__uint_as_float(__builtin_amdgcn_readlane(tb, 0)) + __uint_as_float(__builtin_amdgcn_readlane(tb, 16))) + (__uint_as_float(__builtin_amdgcn_readlane(tb, 32)) + __uint_as_float(__builtin_amdgcn_readlane(tb, 48)));
                rinv[rq] = rsq_(tot + EPS); }
        }
        if (part == 2) {
#pragma unroll
            for (int rq = 0; rq < 8; ++rq) { const int r = r0 + rq; const float be = SMG[64 + r]; *(LAS f32x2*)(RHS + r * 256 + 2 * lane) = (f32x2){s0[rq] * be, s1[rq] * be}; }
        } else if (part == 0) {
            float kg0[8], kg1[8];
#pragma unroll
            for (int rq = 0; rq < 8; ++rq) { const int r = r0 + rq; const float k0 = s0[rq] * rinv[rq], k1 = s1[rq] * rinv[rq]; *(LAS unsigned*)(KB + r * 136 + 2 * lane) = pk2(k0, k1);
                const float be = SMG[64 + r] * SMG[128 + r]; *(LAS f32x2*)(RHS + r * 256 + 128 + 2 * lane) = (f32x2){k0 * be, k1 * be};
                const float egl = SMG[192 + r]; kg0[rq] = k0 * egl; kg1[rq] = k1 * egl; }
            const int pa = kperm(r0), pb = kperm(r0 + 4);
            *(LAS v2u*)(KGT + (2 * lane) * 64 + pa) = (v2u){pk2(kg0[0], kg0[1]), pk2(kg0[2], kg0[3])}; *(LAS v2u*)(KGT + (2 * lane) * 64 + pb) = (v2u){pk2(kg0[4], kg0[5]), pk2(kg0[6], kg0[7])};
            *(LAS v2u*)(KGT + (2 * lane + 1) * 64 + pa) = (v2u){pk2(kg1[0], kg1[1]), pk2(kg1[2], kg1[3])}; *(LAS v2u*)(KGT + (2 * lane + 1) * 64 + pb) = (v2u){pk2(kg1[4], kg1[5]), pk2(kg1[6], kg1[7])};
        } else {
#pragma unroll
            for (int rq = 0; rq < 8; ++rq) { const int r = r0 + rq; const float sc = rinv[rq] * 0.08838834764831845f; const float q0 = s0[rq] * sc, q1 = s1[rq] * sc; *(LAS unsigned*)(QB + r * 136 + 2 * lane) = pk2(q0, q1);
                const float eg = SMG[128 + r]; *(unsigned*)(o_qg + r * 128 + kperm(2 * lane)) = pk2(q0 * eg, q1 * eg); }
        }
    }
    __syncthreads();
#pragma unroll
    for (int k = 0; k < 2; ++k) { const int pi = tid + 512 * k; *(v4u*)(o_kgt + pi * 8) = *(const LAS v4u*)(KGT + pi * 8); }
    __syncthreads();
    {
        const int mat = wave >> 2, ti = (wave >> 1) & 1, tj = wave & 1, r32 = lane & 31, hi = lane >> 5;
        const LAS bf16* Ab = (mat == 0 ? KB : QB) + (32 * ti + r32) * 136 + 8 * hi;
        const LAS bf16* Bb = KB + (32 * tj + r32) * 136 + 8 * hi;
        f32x16 acc;
#pragma unroll
        for (int r = 0; r < 16; ++r) acc[r] = 0.f;
#pragma unroll
        for (int s = 0; s < 8; ++s) acc = MFMA32(*(const LAS bf16x8*)(Ab + 16 * s), *(const LAS bf16x8*)(Bb + 16 * s), acc);
        const int j = 32 * tj + r32; const float Gj = SMG[j];
#pragma unroll
        for (int r = 0; r < 16; ++r) { const int i = 32 * ti + crow(r, hi); const float dec = __builtin_amdgcn_exp2f(1.4426950408889634f * fminf(SMG[i] - Gj, 0.f));
            if (mat == 0) { const float av = (i > j) ? acc[r] * SMG[64 + i] * dec : 0.f; AMN[i * 80 + kperm(j)] = f2bf(-av); if ((i >> 4) == (j >> 4)) TD[(i >> 4) * 256 + (i & 15) * 16 + (j & 15)] = av; }
            else o_qk[i * 64 + kperm(j)] = f2bf((i >= j) ? acc[r] * dec : 0.f); }
    }
    __syncthreads();
    if (wave == 0) {
        const int bb = lane >> 4, c = lane & 15; float y[16];
        const LAS float* tdp = TD + bb * 256;
#pragma unroll
        for (int i = 0; i < 16; ++i) { float a[16];
#pragma unroll
            for (int j4 = 0; j4 < 4; ++j4) if (4 * j4 < i) { const f32x4 t = *(const LAS f32x4*)(tdp + i * 16 + 4 * j4); a[4 * j4] = t.x; a[4 * j4 + 1] = t.y; a[4 * j4 + 2] = t.z; a[4 * j4 + 3] = t.w; }
            float s0 = (i == c) ? 1.f : 0.f, s1 = 0.f;
#pragma unroll
            for (int j = 0; j < i; ++j) { if (j & 1) s1 = fmaf(-a[j], y[j], s1); else s0 = fmaf(-a[j], y[j], s0); }
            y[i] = s0 + s1;
            const int pc = 8 * (c >> 2) + (c & 3);
            TB[(bb * 16 + i) * 32 + pc] = f2bf(y[i]); TB[(bb * 16 + i) * 32 + pc + 4] = 0; }
    }
    __syncthreads();
    {
        const int cl = lane & 15, q = lane >> 4;
        const f32x4 zero4 = {0.f, 0.f, 0.f, 0.f};
        const LAS unsigned char* amn = (const LAS unsigned char*)AMN + cl * 160 + q * 16;
        const LAS unsigned char* tbp = (const LAS unsigned char*)TB + cl * 64 + q * 16;
#pragma unroll 1
        for (int nt = 0; nt < 2; ++nt) {
            const int col = 32 * wave + 16 * nt + cl;
            f32x4 X[4];
#pragma unroll
            for (int b4 = 0; b4 < 4; ++b4) {
                f32x4 R;
#pragma unroll
                for (int r = 0; r < 4; ++r) R[r] = RHS[(16 * b4 + 4 * q + r) * 256 + col];
                if (b4 == 1) R = MFMA16(*(const LAS bf16x8*)(amn + 16 * 160), pack8(X[0], zero4), R);
                if (b4 == 2) R = MFMA16(*(const LAS bf16x8*)(amn + 32 * 160), pack8(X[0], X[1]), R);
                if (b4 == 3) { R = MFMA16(*(const LAS bf16x8*)(amn + 48 * 160), pack8(X[0], X[1]), R); R = MFMA16(*(const LAS bf16x8*)(amn + 48 * 160 + 64), pack8(X[2], zero4), R); }
                X[b4] = MFMA16(*(const LAS bf16x8*)(tbp + b4 * 16 * 64), pack8(R, zero4), zero4);
            }
            if (wave < 4) {
#pragma unroll
                for (int b4 = 0; b4 < 4; ++b4) *(v2u*)(o_ut + col * 64 + 16 * b4 + 4 * q) = (v2u){pk2(X[b4][0], X[b4][1]), pk2(X[b4][2], X[b4][3])};
            } else { const int pk = kperm(col - 128);
#pragma unroll
                for (int b4 = 0; b4 < 4; ++b4)
#pragma unroll
                    for (int r = 0; r < 4; ++r) o_w[(16 * b4 + 4 * q + r) * 128 + pk] = f2bf(X[b4][r]); }
        }
    }
    __syncthreads();
}

constexpr int SB_W = 0, SB_QG = 18432, SB_KGT = 36864, SB_QK = 57344, SB_UT = 67584, SB_SIZE = 76800;
__device__ __forceinline__ bf16x8 ldfrag(const LAS unsigned char* p) { return *(const LAS bf16x8*)p; }
#ifdef PROBE_W
#define SCAN_BAR() do { asm volatile("s_waitcnt lgkmcnt(0)" ::: "memory"); const unsigned long long tb0_ = __builtin_amdgcn_s_memrealtime(); asm volatile("s_barrier" ::: "memory"); pwait += (unsigned)(__builtin_amdgcn_s_memrealtime() - tb0_); } while (0)
#else
#define SCAN_BAR() asm volatile("s_waitcnt lgkmcnt(0)\n\ts_barrier" ::: "memory")
#endif
__device__ __forceinline__ void scan_half(LAS unsigned char* lds, int half, int nsteps, int nrows, const bf16* gmain, size_t main_stride, const bf16* gqk, size_t qk_stride, const float* DLp,
                                          const float* S0, float* Sout, bf16* MX  , unsigned dumpoff  , gu32* prog, gu32* pw, int tid, int lane, int wave) {
    unsigned pwait = 0u;
    if (wave >= 4) {
        const int lt = tid - 256;
        const unsigned v16 = (unsigned)lt * 16u;
        v4u A[16], B[16], C[16];
#define LD_LOAD(R, nn) do { const char* mp_ = (const char*)(gmain + (size_t)(nn) * main_stride); \
            _Pragma("unroll") for (int k = 0; k < 12; ++k) R[k] = *(const v4u*)(mp_ + k * 4096 + v16); \
            _Pragma("unroll") for (int k = 0; k < 2; ++k) R[12 + k] = *(const v4u*)((const char*)(gqk + (size_t)(nn) * qk_stride) + k * 4096 + v16); \
            _Pragma("unroll") for (int k = 0; k < 2; ++k) R[14 + k] = *(const v4u*)(mp_ + 49152 + half * 8192 + k * 4096 + v16); } while (0)
#define LD_WRITE(R, buf) do { LAS unsigned char* bb_ = lds + (buf) * SB_SIZE; \
            _Pragma("unroll") for (int k = 0; k < 12; ++k) { const int a_ = k >> 2, within_ = lt + 256 * (k & 3); \
                const int dst_ = (a_ == 0 ? SB_W + (within_ >> 4) * 288 + (within_ & 15) * 16 : a_ == 1 ? SB_QG + (within_ >> 4) * 288 + (within_ & 15) * 16 : SB_KGT + (within_ >> 3) * 160 + (within_ & 7) * 16); \
                *(LAS v4u*)(bb_ + dst_) = R[k]; } \
            _Pragma("unroll") for (int k = 0; k < 2; ++k) { const int within_ = lt + 256 * k; *(LAS v4u*)(bb_ + SB_QK + (within_ >> 3) * 160 + (within_ & 7) * 16) = R[12 + k]; } \
            _Pragma("unroll") for (int k = 0; k < 2; ++k) { const int within_ = lt + 256 * k; *(LAS v4u*)(bb_ + SB_UT + (within_ >> 3) * 144 + (within_ & 7) * 16) = R[14 + k]; } } while (0)
        LD_LOAD(A, 0);
        if (nsteps > 1) LD_LOAD(B, 1);
        if (nsteps > 2) LD_LOAD(C, 2);
        LD_WRITE(A, 0);
        asm volatile("" ::: "memory");
        if (nsteps > 3) LD_LOAD(A, 3);
        SCAN_BAR();
#pragma unroll 1
        for (int n = 0; n < nsteps; n += 3) {
            if (n + 1 < nsteps) { LD_WRITE(B, (n + 1) & 1); asm volatile("" ::: "memory"); if (n + 4 < nsteps) LD_LOAD(B, n + 4); SCAN_BAR(); }
            if (n + 2 < nsteps) { LD_WRITE(C, (n + 2) & 1); asm volatile("" ::: "memory"); if (n + 5 < nsteps) LD_LOAD(C, n + 5); SCAN_BAR(); }
            if (n + 3 < nsteps) { LD_WRITE(A, (n + 3) & 1); asm volatile("" ::: "memory"); if (n + 6 < nsteps) LD_LOAD(A, n + 6); SCAN_BAR(); }
        }
#undef LD_LOAD
#undef LD_WRITE
    } else {
        const int cl = lane & 15, q = lane >> 4, cw = wave, c0 = 64 * half + 16 * cw;
        f32x4 S[8];
#pragma unroll
        for (int mt = 0; mt < 8; ++mt)
#pragma unroll
            for (int r = 0; r < 4; ++r) S[mt][r] = S0 ? S0[(16 * mt + 4 * q + r) * 128 + c0 + cl] : 0.f;
        LAS bf16* ost_ = (LAS bf16*)(lds + 2 * SB_SIZE + cw * 2048);
        dumpoff += (unsigned)lane * 16u;
        const int dlbits = (int)__float_as_uint(lane < nsteps ? DLp[lane] : 1.f);
#ifdef PROBE_S
#define PT_MARK(k) do { const unsigned long long tm_ = __builtin_amdgcn_s_memrealtime(); if ((k) > 0) pseg[(k) - 1] += (unsigned)(tm_ - ptl); ptl = tm_; } while (0)
#define PT_USE(x) asm volatile("" :: "v"(x))
        unsigned pseg[3] = {0u, 0u, 0u}; unsigned long long ptl = 0ull;
#else
#define PT_MARK(k) do {} while (0)
#define PT_USE(x) do {} while (0)
#endif
#define SCAN_STEP(n, buf) do { \
        SCAN_BAR();                                            \
        if (prog && tid == 0) __hip_atomic_store(prog, (unsigned)(n) + 1u, RLX_AGENT); \
        const LAS unsigned char* bb_ = lds + (buf) * SB_SIZE; \
        const float dl_ = __uint_as_float(__builtin_amdgcn_readlane(dlbits, (n))); \
        PT_MARK(0); \
          \
        bf16x8 fw_[4][4], fg_[4][4]; \
        _Pragma("unroll") for (int mt = 0; mt < 4; ++mt) _Pragma("unroll") for (int ks = 0; ks < 4; ++ks) { \
            fw_[mt][ks] = ldfrag(bb_ + SB_W + (16 * mt + cl) * 288 + q * 16 + ks * 64); fg_[mt][ks] = ldfrag(bb_ + SB_QG + (16 * mt + cl) * 288 + q * 16 + ks * 64); } \
        v2u uu_[4]; \
        _Pragma("unroll") for (int mt = 0; mt < 4; ++mt) uu_[mt] = *(const LAS v2u*)(bb_ + SB_UT + (16 * cw + cl) * 144 + (16 * mt + 4 * q) * 2); \
        bf16x8 Sb_[4]; \
        _Pragma("unroll") for (int ks = 0; ks < 4; ++ks) Sb_[ks] = pack8(S[2 * ks], S[2 * ks + 1]); \
        asm volatile("" ::: "memory"); \
        f32x4 vn_[4], o_[4]; \
        _Pragma("unroll") for (int mt = 0; mt < 4; ++mt) { \
            f32x4 aw_ = {0.f, 0.f, 0.f, 0.f}, ao_ = {0.f, 0.f, 0.f, 0.f}; \
            _Pragma("unroll") for (int ks = 0; ks < 4; ++ks) { aw_ = MFMA16(fw_[mt][ks], Sb_[ks], aw_); ao_ = MFMA16(fg_[mt][ks], Sb_[ks], ao_); } \
            vn_[mt] = (f32x4){bflo(uu_[mt].x) - aw_[0], bfhi(uu_[mt].x) - aw_[1], bflo(uu_[mt].y) - aw_[2], bfhi(uu_[mt].y) - aw_[3]}; \
            o_[mt] = ao_; } \
        PT_USE(vn_[3][0]); PT_MARK(1); \
        bf16x8 fk_[4][2], ft_[8][2]; \
        _Pragma("unroll") for (int mt = 0; mt < 4; ++mt) _Pragma("unroll") for (int ks = 0; ks < 2; ++ks) fk_[mt][ks] = ldfrag(bb_ + SB_QK + (16 * mt + cl) * 160 + q * 16 + ks * 64); \
        _Pragma("unroll") for (int mt = 0; mt < 8; ++mt) _Pragma("unroll") for (int ks = 0; ks < 2; ++ks) ft_[mt][ks] = ldfrag(bb_ + SB_KGT + (16 * mt + cl) * 160 + q * 16 + ks * 64); \
        asm volatile("" ::: "memory"); \
        bf16x8 Vb_[2]; \
        _Pragma("unroll") for (int ks = 0; ks < 2; ++ks) Vb_[ks] = pack8(vn_[2 * ks], vn_[2 * ks + 1]); \
        _Pragma("unroll") for (int mt = 0; mt < 4; ++mt) _Pragma("unroll") for (int ks = 0; ks < 2; ++ks) o_[mt] = MFMA16(fk_[mt][ks], Vb_[ks], o_[mt]); \
        _Pragma("unroll") for (int mt = 0; mt < 8; ++mt) { S[mt] = S[mt] * dl_; \
            _Pragma("unroll") for (int ks = 0; ks < 2; ++ks) S[mt] = MFMA16(ft_[mt][ks], Vb_[ks], S[mt]); } \
        PT_USE(S[7][0]); PT_MARK(2); \
          \
        _Pragma("unroll") for (int mt = 0; mt < 4; ++mt) _Pragma("unroll") for (int r = 0; r < 4; ++r) ost_[(16 * mt + 4 * q + r) * 16 + cl] = f2bf(o_[mt][r]); \
        _Pragma("unroll") for (int k = 0; k < 2; ++k) { const int p_ = lane + 64 * k, row_ = p_ >> 1, hh_ = p_ & 1; const v4u ov_ = *(const LAS v4u*)(ost_ + row_ * 16 + hh_ * 8); \
            const unsigned off_ = (row_ < nrows) ? (unsigned)(n) * (64u * D * 2u) + (unsigned)row_ * (D * 2u) + (unsigned)(c0 + hh_ * 8) * 2u : dumpoff; \
            *(v4u*)((char*)MX + off_) = ov_; } \
        PT_MARK(3); \
    } while (0)
#pragma unroll 1
        for (int n = 0; n < nsteps; n += 2) {
            SCAN_STEP(n, 0);
            if (n + 1 < nsteps) SCAN_STEP(n + 1, 1);
        }
#undef SCAN_STEP
#ifdef PROBE_S
        if (nsteps == 64 && half == 0 && tid == 0) { __hip_atomic_fetch_max(pw + 2, pseg[0], RLX_AGENT); __hip_atomic_fetch_max(pw + 3, pseg[1], RLX_AGENT); __hip_atomic_fetch_max(pw + 4, pseg[2], RLX_AGENT); }
#endif
#pragma unroll
        for (int mt = 0; mt < 8; ++mt)
#pragma unroll
            for (int r = 0; r < 4; ++r) Sout[(16 * mt + 4 * q + r) * 128 + c0 + cl] = S[mt][r];
    }
#ifdef PROBE_W
    if (nsteps == 64 && half == 0 && (tid == 0 || tid == 256)) __hip_atomic_fetch_max(pw + (tid >> 8), pwait, RLX_AGENT);
#endif
    __syncthreads();
}
#undef SCAN_BAR

__device__ __forceinline__ void scan_helper(gu32* prog, const bf16* gmain, size_t main_stride, const bf16* gqk, size_t qk_stride, float* sink, int tid, int lane) {
    constexpr int AHEAD = 2, RND = 2;
    unsigned acc = 0u;
    const unsigned vmain = (unsigned)tid * 128u, vqk = (unsigned)(tid & 63) * 128u;
#pragma unroll 1
    for (int n = 0; n < 64; n += RND) {
        if (n > AHEAD) {
            if (lane == 0) { unsigned sp = 0u; while ((int)__hip_atomic_load(prog, RLX_AGENT) < n - AHEAD && ++sp < 200000u) __builtin_amdgcn_s_sleep(16); }
        }
        unsigned a[RND], c[RND];
#pragma unroll
        for (int k = 0; k < RND; ++k) { a[k] = *(const unsigned*)((const char*)(gmain + (size_t)(n + k) * main_stride) + vmain); c[k] = *(const unsigned*)((const char*)(gqk + (size_t)(n + k) * qk_stride) + vqk); }
#pragma unroll
        for (int k = 0; k < RND; ++k) acc ^= a[k] ^ c[k];
    }
    if (acc == 0x9e3779b9u) *sink = 0.f;
}

__device__ __forceinline__ void phase_gdn_finish(const bf16* P, bf16* MIXIN, const float* gnw, int gw, int NGW, int lane) {
    const f32x2 gw2 = *(const f32x2*)(gnw + 2 * lane);
    for (int it = gw; it < M * 4; it += NGW) {
        const int m = it >> 2, h = it & 3;
        unsigned* op = (unsigned*)(MIXIN + (size_t)m * D + h * 128) + lane;
        const unsigned ow = *op, zw = *((const unsigned*)(P + (size_t)m * NIN + PC_Z + h * 128) + lane);
        const float o0 = bflo(ow), o1 = bfhi(ow), z0 = bflo(zw), z1 = bfhi(zw);
        const float rstd = rsq_(wave_sum(o0 * o0 + o1 * o1) * (1.f / 128.f) + EPS);
        *op = pk2(o0 * rstd * gw2.x * z0 * sigmoidf_(z0), o1 * rstd * gw2.y * z1 * sigmoidf_(z1));
    }
}

constexpr int ATT_WAVE_LDS = 17920, ATT_BT_OFF = 8 * ATT_WAVE_LDS;
constexpr float LOG2E = 1.4426950408889634f;
typedef short v4i16_t __attribute__((ext_vector_type(4)));
__device__ __forceinline__ s16x4 vtr(const LAS unsigned char* p) { return __builtin_bit_cast(s16x4, __builtin_amdgcn_ds_read_tr16_b64_v4i16((LAS v4i16_t*)p)); }
__device__ __forceinline__ void attn_item(LAS unsigned char* wl, const LAS float* BT8, int it, gu32* pa, const bf16* P, const float* ck, const float* cv, const float* anw, bf16* MIXIN, int lane) {
    LAS unsigned char* KL = wl; LAS unsigned char* VL = wl + 9216; LAS float* SC = (LAS float*)(wl + 17408);
    const int r32 = lane & 31, hi = lane >> 5;
    const bool sample = it < 256;
    int b, h, n = 0, half = 0, mq, t0, t1;
    if (sample) { b = it >> 3; h = it & 7; mq = MP + b * 32; t0 = 0; t1 = 9; }
    else { const int idx = it - 256; half = idx & 1; n = (idx >> 1) & 63; h = (idx >> 7) & 7; b = idx >> 10; mq = b * SEQ + n * 64 + half * 32; t0 = n > 8 ? n - 8 : 0; t1 = n + 1; }
    const LAS float* BT = BT8 + h * 257;
    bf16x8 qr[4];
#pragma unroll
    for (int d0 = 0; d0 < 4; ++d0) qr[d0] = *(const bf16x8*)(P + (size_t)(mq + r32) * NIN + PC_QB + h * 64 + d0 * 16 + hi * 8);
    float mrun = -1e30f, lrun = 0.f; f32x16 o0, o1;
#pragma unroll
    for (int r = 0; r < 16; ++r) { o0[r] = 0.f; o1[r] = 0.f; }
    const int ti = lane & 15, blk = (lane >> 4) & 1;
    const LAS unsigned char* vbase = VL + (4 * hi + (ti >> 2)) * 128 + (blk * 16 + 4 * (ti & 3)) * 2;
    v4u kvr[8], vvr[8];
#define ATT_LOADT(tt) do { const char* tb_ = (const char*)(P + (sample ? (size_t)MP + b * 32 : (size_t)b * SEQ + (size_t)(tt) * 64) * NIN + h * 64); \
        _Pragma("unroll") for (int i8 = 0; i8 < 8; ++i8) { kvr[i8] = *(const v4u*)(tb_ + i8 * (8 * NIN * 2) + PC_KB * 2 + loff); vvr[i8] = *(const v4u*)(tb_ + i8 * (8 * NIN * 2) + PC_VB * 2 + loff); \
            if (sample && i8 >= 4) { kvr[i8] = (v4u){0u, 0u, 0u, 0u}; vvr[i8] = (v4u){0u, 0u, 0u, 0u}; } } } while (0)
    const unsigned loff = (unsigned)(lane >> 3) * (unsigned)(NIN * 2) + (unsigned)(lane & 7) * 16u;
    if (!sample) ATT_LOADT(t0);
#ifdef PROBE_A
#define AT_MARK(k) do { const unsigned long long tm_ = __builtin_amdgcn_s_memrealtime(); if ((k) > 0) aseg[(k) - 1] += (unsigned)(tm_ - atl); else aseg[3] += atl ? (unsigned)(tm_ - atl) : 0u; atl = tm_; } while (0)
#define AT_USE(x) asm volatile("" :: "v"(x))
    unsigned aseg[4] = {0u, 0u, 0u, 0u}; unsigned long long atl = 0ull;
#else
#define AT_MARK(k) do {} while (0)
#define AT_USE(x) do {} while (0)
#endif
#pragma unroll 1
    for (int t = t0; t < t1; ++t) {
        AT_MARK(0);
        int relbase; bool maskhalf = false;
        if (sample && t < 8) {
            relbase = 512 - 64 * t;
            int lq_ = lane; asm volatile("" : "+v"(lq_));
#pragma unroll
            for (int i8 = 0; i8 < 8; ++i8) { const int idx = i8 * 64 + lq_, key = idx >> 3, c8 = idx & 7; const size_t off = (((size_t)b * 512 + 64 * t + key) * 8 + h) * 64 + c8 * 8;
                const f32x4 ka = *(const f32x4*)(ck + off), kb = *(const f32x4*)(ck + off + 4), va = *(const f32x4*)(cv + off), vb = *(const f32x4*)(cv + off + 4);
                *(LAS v4u*)(KL + key * 144 + c8 * 16) = (v4u){pk2(ka.x, ka.y), pk2(ka.z, ka.w), pk2(kb.x, kb.y), pk2(kb.z, kb.w)};
                *(LAS v4u*)(VL + key * 128 + c8 * 16) = (v4u){pk2(va.x, va.y), pk2(va.z, va.w), pk2(vb.x, vb.y), pk2(vb.z, vb.w)}; }
        } else {
            if (sample) { relbase = 0; maskhalf = true; ATT_LOADT(t); }
            else relbase = 64 * (n - t) + 32 * half;
            int ln_ = lane; asm volatile("" : "+v"(ln_));
            LAS unsigned char* kw_ = KL + (ln_ >> 3) * 144 + (ln_ & 7) * 16; LAS unsigned char* vw_ = VL + (ln_ >> 3) * 128 + (ln_ & 7) * 16;
#pragma unroll
            for (int i8 = 0; i8 < 8; ++i8) { *(LAS v4u*)(kw_ + i8 * 1152) = kvr[i8]; *(LAS v4u*)(vw_ + i8 * 1024) = vvr[i8]; }
            asm volatile("" ::: "memory");
            if (!sample && t + 1 < t1) ATT_LOADT(t + 1);
        }
        AT_MARK(1);
        f32x16 p0, p1;
#pragma unroll
        for (int r = 0; r < 16; ++r) { p0[r] = 0.f; p1[r] = 0.f; }
#pragma unroll
        for (int d0 = 0; d0 < 4; ++d0) { const bf16x8 k0 = *(const LAS bf16x8*)(KL + r32 * 144 + (2 * d0 + hi) * 16), k1 = *(const LAS bf16x8*)(KL + (32 + r32) * 144 + (2 * d0 + hi) * 16);
            p0 = MFMA32(k0, qr[d0], p0); p1 = MFMA32(k1, qr[d0], p1); }
        const float SC2 = 0.125f * LOG2E;
        if (relbase - 63 >= 128) { const float bc = BT[256];
#pragma unroll
            for (int r = 0; r < 16; ++r) { p0[r] = p0[r] * SC2 + bc; p1[r] = p1[r] * SC2 + bc; } }
        else {
#pragma unroll
            for (int r = 0; r < 16; ++r) { const int rel = relbase + r32 - crow(r, hi); int i0 = (rel > 128 ? 128 : rel) + 128, i1 = (rel - 32 > 128 ? 128 : rel - 32) + 128; i0 = i0 < 0 ? 0 : i0; i1 = i1 < 0 ? 0 : i1;
                p0[r] = p0[r] * SC2 + BT[i0]; p1[r] = p1[r] * SC2 + BT[i1]; } }
        if (maskhalf) {
#pragma unroll
            for (int r = 0; r < 16; ++r) p1[r] = -INFINITY; }
        float mx = fmaxf(p0[0], p1[0]);
#pragma unroll
        for (int r = 1; r < 16; ++r) mx = fmaxf(mx, fmaxf(p0[r], p1[r]));
        mx = fmaxf(mx, __shfl_xor(mx, 32));
        const float mnew = fmaxf(mrun, mx); const float alpha = __builtin_amdgcn_exp2f(mrun - mnew); mrun = mnew;
        float sum = 0.f;
#pragma unroll
        for (int r = 0; r < 16; ++r) { p0[r] = __builtin_amdgcn_exp2f(p0[r] - mnew); p1[r] = __builtin_amdgcn_exp2f(p1[r] - mnew); sum += p0[r] + p1[r]; }
        lrun = lrun * alpha + sum;
        AT_USE(p0[0]); AT_MARK(2);
        if (hi == 0) SC[r32] = alpha;
#pragma unroll
        for (int r = 0; r < 16; ++r) { const float a = SC[crow(r, hi)]; o0[r] *= a; o1[r] *= a; }
#pragma unroll
        for (int s = 0; s < 4; ++s) {
            v4u pw;
            if (s < 2) pw = (v4u){pk2(p0[8 * s + 0], p0[8 * s + 1]), pk2(p0[8 * s + 2], p0[8 * s + 3]), pk2(p0[8 * s + 4], p0[8 * s + 5]), pk2(p0[8 * s + 6], p0[8 * s + 7])};
            else { const int ss = s - 2; pw = (v4u){pk2(p1[8 * ss + 0], p1[8 * ss + 1]), pk2(p1[8 * ss + 2], p1[8 * ss + 3]), pk2(p1[8 * ss + 4], p1[8 * ss + 5]), pk2(p1[8 * ss + 6], p1[8 * ss + 7])}; }
            const bf16x8 pa = __builtin_bit_cast(bf16x8, pw);
            const LAS unsigned char* vp = vbase + (16 * s) * 128;
            const s16x4 a0 = vtr(vp), a1 = vtr(vp + 8 * 128), b0 = vtr(vp + 64), b1 = vtr(vp + 8 * 128 + 64);
            const bf16x8 v0 = {a0[0], a0[1], a0[2], a0[3], a1[0], a1[1], a1[2], a1[3]}, v1 = {b0[0], b0[1], b0[2], b0[3], b1[0], b1[1], b1[2], b1[3]};
            o0 = MFMA32(pa, v0, o0); o1 = MFMA32(pa, v1, o1);
        }
        AT_USE(o0[0]); AT_MARK(3);
    }
#ifdef PROBE_A
    if (pa) { __hip_atomic_fetch_add(pa + 0, aseg[0], RLX_AGENT); __hip_atomic_fetch_add(pa + 1, aseg[1], RLX_AGENT); __hip_atomic_fetch_add(pa + 2, aseg[2], RLX_AGENT); __hip_atomic_fetch_add(pa + 3, aseg[3], RLX_AGENT); }
#endif
#undef ATT_LOADT
    lrun += __shfl_xor(lrun, 32);
    if (hi == 0) SC[32 + r32] = 1.f / lrun;
    LAS float* OL = (LAS float*)wl;
#pragma unroll
    for (int r = 0; r < 16; ++r) { const int qq = crow(r, hi); const float inv = SC[32 + qq]; OL[qq * 66 + r32] = o0[r] * inv; OL[qq * 66 + 32 + r32] = o1[r] * inv; }
    {
        const int qq = lane >> 1, dh = (lane & 1) * 32; float vals[32]; float ss = 0.f;
#pragma unroll
        for (int k = 0; k < 32; ++k) { vals[k] = OL[qq * 66 + dh + k]; ss += vals[k] * vals[k]; }
        ss += __shfl_xor(ss, 1);
        const float rstd = rsq_(ss * (1.f / 64.f) + EPS);
        bf16* op = MIXIN + (size_t)(mq + qq) * D + 512 + h * 64 + dh;
#pragma unroll
        for (int k4 = 0; k4 < 4; ++k4) { v4u o;
            const f32x4 wa = *(const f32x4*)(anw + dh + 8 * k4), wb = *(const f32x4*)(anw + dh + 8 * k4 + 4);
            o.x = pk2(vals[8 * k4 + 0] * rstd * wa.x, vals[8 * k4 + 1] * rstd * wa.y); o.y = pk2(vals[8 * k4 + 2] * rstd * wa.z, vals[8 * k4 + 3] * rstd * wa.w);
            o.z = pk2(vals[8 * k4 + 4] * rstd * wb.x, vals[8 * k4 + 5] * rstd * wb.y); o.w = pk2(vals[8 * k4 + 6] * rstd * wb.z, vals[8 * k4 + 7] * rstd * wb.w);
            *(v4u*)(op + 8 * k4) = o; }
    }
}

__device__ __forceinline__ void load_gemm_row(f32x4 (&v)[4], const bf16* Yb, const float* slab, int ns, int m, int lane) {
    if (m < MP) {
#pragma unroll
        for (int j = 0; j < 4; ++j) { const v2u t = ((const v2u*)(Yb + (size_t)m * D))[lane + 64 * j]; v[j] = (f32x4){bflo(t.x), bfhi(t.x), bflo(t.y), bfhi(t.y)}; }
    } else {
#pragma unroll
        for (int j = 0; j < 4; ++j) v[j] = (f32x4){0.f, 0.f, 0.f, 0.f};
        for (int k = 0; k < ns; ++k) {
#pragma unroll
            for (int j = 0; j < 4; ++j) v[j] += ((const f32x4*)(slab + ((size_t)k * MS + (m - MP)) * D))[lane + 64 * j]; }
    }
}
__device__ __forceinline__ void phase_rows1(const float* xp, const float* xs, const bf16* mixb, const float* slab, int ns, const float* w_post, const float* w_pre2, bf16* x1b, bf16* U, int mstart, int NGW, int lane) {
    f32x4 v[4], xv[4], vn[4], xvn[4];
    int m = mstart;
    if (m < M) { load_gemm_row(v, mixb, slab, ns, m, lane); const float* xrow = m < MP ? xp + (size_t)m * D : xs + (size_t)(m - MP) * D;
#pragma unroll
        for (int j = 0; j < 4; ++j) xv[j] = ((const f32x4*)xrow)[lane + 64 * j]; }
    for (; m < M; m += NGW) {
        const int mn = m + NGW;
        if (mn < M) { load_gemm_row(vn, mixb, slab, ns, mn, lane); const float* xrow = mn < MP ? xp + (size_t)mn * D : xs + (size_t)(mn - MP) * D;
#pragma unroll
            for (int j = 0; j < 4; ++j) xvn[j] = ((const f32x4*)xrow)[lane + 64 * j]; }
        float s = 0.f;
#pragma unroll
        for (int j = 0; j < 4; ++j) s += (v[j].x * v[j].x + v[j].y * v[j].y) + (v[j].z * v[j].z + v[j].w * v[j].w);
        const float rstd = rsq_(wave_sum(s) * (1.f / D) + EPS); float s2 = 0.f;
#pragma unroll
        for (int j = 0; j < 4; ++j) { const f32x4 g = ((const f32x4*)w_post)[lane + 64 * j]; v[j] = xv[j] + v[j] * rstd * g; ((v2u*)(x1b + (size_t)m * D))[lane + 64 * j] = (v2u){pk2(v[j].x, v[j].y), pk2(v[j].z, v[j].w)};
            s2 += (v[j].x * v[j].x + v[j].y * v[j].y) + (v[j].z * v[j].z + v[j].w * v[j].w); }
        const float rstd2 = rsq_(wave_sum(s2) * (1.f / D) + EPS);
        unsigned long long* o8 = (unsigned long long*)(U + (size_t)m * D) + lane;
#pragma unroll
        for (int j = 0; j < 4; ++j) { const f32x4 g = ((const f32x4*)w_pre2)[lane + 64 * j]; const f32x4 t = v[j] * rstd2 * g;
            o8[64 * j] = (unsigned long long)pk2(t.x, t.y) | ((unsigned long long)pk2(t.z, t.w) << 32); }
#pragma unroll
        for (int j = 0; j < 4; ++j) { v[j] = vn[j]; xv[j] = xvn[j]; }
    }
}
__device__ __forceinline__ void phase_rows2(const bf16* dnb, const float* slab, int ns, const float* w, const bf16* x1b, float* out, int mstart, int NGW, int lane) {
    f32x4 v[4], vn[4]; v2u xq[4], xqn[4];
    int m = mstart;
    if (m < M) { load_gemm_row(v, dnb, slab, ns, m, lane);
#pragma unroll
        for (int j = 0; j < 4; ++j) xq[j] = ((const v2u*)(x1b + (size_t)m * D))[lane + 64 * j]; }
    for (; m < M; m += NGW) {
        const int mn = m + NGW;
        if (mn < M) { load_gemm_row(vn, dnb, slab, ns, mn, lane);
#pragma unroll
            for (int j = 0; j < 4; ++j) xqn[j] = ((const v2u*)(x1b + (size_t)mn * D))[lane + 64 * j]; }
        float s = 0.f;
#pragma unroll
        for (int j = 0; j < 4; ++j) s += (v[j].x * v[j].x + v[j].y * v[j].y) + (v[j].z * v[j].z + v[j].w * v[j].w);
        const float rstd = rsq_(wave_sum(s) * (1.f / D) + EPS);
#pragma unroll
        for (int j = 0; j < 4; ++j) { const f32x4 g = ((const f32x4*)w)[lane + 64 * j]; const v2u t = xq[j];
            ((f32x4*)(out + (size_t)m * D))[lane + 64 * j] = (f32x4){bflo(t.x), bfhi(t.x), bflo(t.y), bfhi(t.y)} + v[j] * rstd * g; }
#pragma unroll
        for (int j = 0; j < 4; ++j) { v[j] = vn[j]; xq[j] = xqn[j]; }
    }
}
__device__ __forceinline__ float gelu_tanh(float x) { const float y = 0.7978845608028654f * (x + 0.044715f * x * x * x); const float t = 1.f - 2.f * __builtin_amdgcn_rcpf(1.f + __builtin_amdgcn_exp2f(2.8853900817779268f * y)); return 0.5f * x * (1.f + t); }
__device__ __forceinline__ void unpack8(const v4u t, float (&g)[8]) { g[0] = bflo(t.x); g[1] = bfhi(t.x); g[2] = bflo(t.y); g[3] = bfhi(t.y); g[4] = bflo(t.z); g[5] = bfhi(t.z); g[6] = bflo(t.w); g[7] = bfhi(t.w); }
__device__ __forceinline__ void phase_h_fixup(const bf16* SB, bf16* H, const float* st_ffn, const float* cw, const float* cb, int gtid, int nth) {
    constexpr int CG = FF / 8;
    for (int task = gtid; task < 192 * CG; task += nth) {
        const int R = task / CG, c = (task % CG) * 8;
        float g0[8], g1[8], g2[8], up[8];
        int row;
        if (R < 128) { const int pm = R >> 1, t = R & 1; row = 256 * pm + t; const int grp = row >> 5; const bool prev = (pm & 15) != 0;
            unpack8(*(const v4u*)(SB + (((size_t)grp * 4 + t) * 2) * FF + c), g2); unpack8(*(const v4u*)(SB + (((size_t)grp * 4 + t) * 2 + 1) * FF + c), up);
            if (t == 0) { if (prev) { unpack8(*(const v4u*)(SB + (((size_t)(grp - 1) * 4 + 3) * 2) * FF + c), g1); unpack8(*(const v4u*)(SB + (((size_t)(grp - 1) * 4 + 2) * 2) * FF + c), g0); }
                          else {
#pragma unroll
                              for (int e = 0; e < 8; ++e) { g1[e] = 0.f; g0[e] = 0.f; } } }
            else { unpack8(*(const v4u*)(SB + (((size_t)grp * 4 + 0) * 2) * FF + c), g1);
                   if (prev) unpack8(*(const v4u*)(SB + (((size_t)(grp - 1) * 4 + 3) * 2) * FF + c), g0);
                   else {
#pragma unroll
                       for (int e = 0; e < 8; ++e) g0[e] = 0.f; } }
        } else { const int sR = R - 128, bs = sR >> 1, t = sR & 1; row = MP + 32 * bs + t; const int grp = row >> 5;
            unpack8(*(const v4u*)(SB + (((size_t)grp * 4 + t) * 2) * FF + c), g2); unpack8(*(const v4u*)(SB + (((size_t)grp * 4 + t) * 2 + 1) * FF + c), up);
            const float* s0 = st_ffn + ((size_t)bs * 2 + 0) * FF + c; const float* s1 = st_ffn + ((size_t)bs * 2 + 1) * FF + c;
            if (t == 0) {
#pragma unroll
                for (int e = 0; e < 8; ++e) { g0[e] = s0[e]; g1[e] = s1[e]; } }
            else { unpack8(*(const v4u*)(SB + (((size_t)grp * 4 + 0) * 2) * FF + c), g1);
#pragma unroll
                for (int e = 0; e < 8; ++e) g0[e] = s1[e]; }
        }
        float hv[8];
#pragma unroll
        for (int e = 0; e < 8; ++e) { const float x = cw[c + e] * g0[e] + cw[FF + c + e] * g1[e] + cw[2 * FF + c + e] * g2[e] + cb[c + e]; hv[e] = gelu_tanh(x) * up[e]; }
        *(v4u*)(H + (size_t)row * FF + c) = (v4u){pk2(hv[0], hv[1]), pk2(hv[2], hv[3]), pk2(hv[4], hv[5]), pk2(hv[6], hv[7])};
    }
}

#ifndef MK_N_LAUNCHES
#define MK_N_LAUNCHES 1
#endif
constexpr int NPH = 11;
constexpr int N_LAUNCHES = MK_N_LAUNCHES;
struct Args { const float* in[23]; float* out; unsigned char* ws; int ph_lo, ph_hi, li, pad; };
__global__ void __launch_bounds__(NWAVES * 64, 2) hybrid_fwd(Args args) {
    extern __shared__ __attribute__((aligned(16))) unsigned char lds_raw[];
    LAS unsigned char* lds = (LAS unsigned char*)lds_raw;
    volatile LAS unsigned* MISC = (volatile LAS unsigned*)(lds + MISC_OFF);
    const int tid = threadIdx.x, lane = tid & 63, wave = __builtin_amdgcn_readfirstlane(tid >> 6);
    const int G = gridDim.x; const int bx = blockIdx.x; const int vcu = (G % 8 == 0) ? (bx % 8) * (G / 8) + bx / 8 : bx;
    unsigned char* ws = args.ws; float* out = args.out;
    gu32* ctl = (gu32*)(ws + WS_CTL);
#define x_prompt (args.in[0])
#define x_sample (args.in[1])
#define cache_k (args.in[2])
#define cache_v (args.in[3])
#define state_delta (args.in[4])
#define state_qkv (args.in[5])
#define state_ffn (args.in[6])
#define norm_mix_pre (args.in[7])
#define w_in (args.in[8])
#define qkv_conv_w (args.in[9])
#define a_log (args.in[10])
#define dt_bias (args.in[11])
#define gdn_norm_w (args.in[12])
#define rel_bias (args.in[13])
#define attn_norm_w (args.in[14])
#define w_out (args.in[15])
#define norm_mix_post (args.in[16])
#define norm_ffn_pre (args.in[17])
#define w_gate_up (args.in[18])
#define ffn_conv_w (args.in[19])
#define ffn_conv_b (args.in[20])
#define w_down (args.in[21])
#define norm_ffn_post (args.in[22])
#define Win_t ((bf16*)(ws + WS_WIN))
#define Wout_t ((bf16*)(ws + WS_WOUT))
#define Wgu_t ((bf16*)(ws + WS_WGU))
#define Wdn_t ((bf16*)(ws + WS_WDN))
#define AB ((float*)(ws + WS_AB))
#define DL ((float*)(ws + WS_DL))
#define U ((bf16*)(ws + WS_U))
#define GQK ((bf16*)(ws + WS_GQK))
#define GS ((bf16*)(ws + WS_GS))
#define P ((bf16*)(ws + WS_P))
#define MIXIN ((bf16*)(ws + WS_MIXIN))
#define MIXB ((bf16*)(ws + WS_P))
#define X1B ((bf16*)(ws + WS_P + 50 * MiB))
#define SLAB1 ((float*)(ws + WS_P + 34 * MiB))
#define DOWNB ((bf16*)(ws + WS_U))
#define SLAB2 ((float*)(ws + WS_G))
#define SBUF ((bf16*)(ws + WS_G))
#define UP ((bf16*)(ws + WS_UP))
#define GMAIN ((bf16*)out)

    for (int u = tid; u < 64; u += NWAVES * 64) ((LAS unsigned*)(lds + MISC_OFF))[u] = 0u;
    __syncthreads();
    XcdBarrier bar; bar.bar = (unsigned*)(ctl + CW_BAR); bar.x = 0; bar.st = nullptr;
    if (N_LAUNCHES == 1) bar = xcd_barrier_post((unsigned*)(ctl + CW_BAR), MISC + 8);
#define GRID_BAR() do { if (N_LAUNCHES == 1) xcd_barrier(bar); } while (0)
#ifdef PROBE_PH
    const unsigned long long ph_t0 = __builtin_amdgcn_s_memrealtime(); unsigned ph_prev = 0u, ph_dur = 0u;
#define STAMP(k) do { const unsigned now_ = (unsigned)(__builtin_amdgcn_s_memrealtime() - ph_t0); if ((k) == PROBE_PH) ph_dur = now_ - ph_prev; ph_prev = now_; } while (0)
#else
#define STAMP(k) do {} while (0)
#endif
    const int lo = args.ph_lo, hi_ = args.ph_hi;
#define IN(k) (lo <= (k) && (k) < hi_)
#define BOTH(k) (IN(k) && IN((k) + 1))
    const int gw = vcu * NWAVES + wave, NGW = G * NWAVES, gtid = bx * (NWAVES * 64) + tid, nth = G * NWAVES * 64;

    if (IN(0)) { phase_prologue(lds, x_prompt, x_sample, norm_mix_pre, w_in, w_out, w_gate_up, w_down, ws, vcu, G, tid, lane, wave); if (BOTH(0)) GRID_BAR(); }

    STAMP(0);
    if (IN(1)) {
        pg8::Gemm g{U, Win_t, M, NIN, D, D}; pg8::StaticOrder S; S.init(M, NIN, G, bx);
        pg8::EpiBf16<0> E{P, NIN, nullptr, 0, 0, 1.f};
        pg8::gemm_phase<pg8::EpiBf16<0>, pg8::StaticOrder, true, true>(lds, g, S, E);
        if (BOTH(1)) GRID_BAR();
    }

    STAMP(1);
    if (IN(2)) {
        phase_copy_outputs(P, out, gtid, nth);
        for (int u = bx; u < 1152; u += G) gdn_pre_unit(lds, u, P, AB, state_qkv, qkv_conv_w, a_log, dt_bias, GMAIN, GQK, GS, DL, tid, lane, wave);
        if (BOTH(2)) GRID_BAR();
    }

#ifdef PROBE_T
    const unsigned long long pt0 = __builtin_amdgcn_s_memrealtime();
#endif
    STAMP(2);
    if (IN(3)) {
        if (bx < 32) {
            const int sidx = bx & 15, half = bx >> 4; const int b = sidx >> 2, h = sidx & 3; const int u0 = b * 256 + h * 64; const size_t m0 = (size_t)b * SEQ;
            scan_half(lds, half, 64, 64, GMAIN + (size_t)u0 * 32768, 32768, GQK + (size_t)u0 * 4096, 4096, DL + u0, nullptr, out + O_DP + (size_t)(b * 4 + h) * 16384,
                      MIXIN + m0 * D + h * 128, (unsigned)(((size_t)M * D - (m0 * D + h * 128)) * 2), half == 0 ? ctl + 1024 + 64 * sidx : (gu32*)nullptr, ctl + 2115, tid, lane, wave);
#ifdef PROBE_T
            if (tid == 0) __hip_atomic_fetch_max(ctl + 2112, (unsigned)(__builtin_amdgcn_s_memrealtime() - pt0), RLX_AGENT);
#endif
        } else if (bx >= G - 16) {
            const int sidx = bx - (G - 16); const int b = sidx >> 2, h = sidx & 3; const int u0 = b * 256 + h * 64;
            scan_helper(ctl + 1024 + 64 * sidx, GMAIN + (size_t)u0 * 32768, 32768, GQK + (size_t)u0 * 4096, 4096, (float*)(ws + WS_DL + 65536), tid, lane);
        } else {
            for (int hu = bx - 32; hu < 256; hu += (G - 48)) {
                const int su = hu >> 1, half = hu & 1; const int b = su >> 2, h = su & 3; const size_t m0 = (size_t)MP + b * 32; const bf16* base = GS + (size_t)su * 36864;
                scan_half(lds, half, 1, 32, base, 0, base + 32768, 0, DL + 1024 + su, state_delta + (size_t)su * 16384, out + O_DS + (size_t)su * 16384,
                          MIXIN + m0 * D + h * 128, (unsigned)(((size_t)M * D - (m0 * D + h * 128)) * 2), (gu32*)nullptr, ctl + 2115, tid, lane, wave);
            }
            LAS unsigned char* wl = lds + wave * ATT_WAVE_LDS;
#ifdef PROBE_T
            if (tid == 0) __hip_atomic_fetch_max(ctl + 2113, (unsigned)(__builtin_amdgcn_s_memrealtime() - pt0), RLX_AGENT);
#endif
            __syncthreads();
            LAS float* BT8 = (LAS float*)(lds + ATT_BT_OFF);
            for (int k = tid; k < 8 * 257; k += NWAVES * 64) BT8[k] = rel_bias[k] * LOG2E;
            __syncthreads();
            for (;;) {
                int q_ = 0; if (lane == 0) q_ = (int)__hip_atomic_fetch_add(ctl + 2048, 1u, RLX_AGENT);
                q_ = __builtin_amdgcn_readfirstlane(q_);
                if (q_ >= 4352) break;
                int it = q_;
                if (q_ >= 256) { const int j = q_ - 256; const int nn = 63 - (j >> 6), r6 = j & 63; it = 256 + (r6 & 1) + (nn << 1) + ((r6 >> 1) << 7); }
                attn_item(wl, BT8, it, (bx == 100 && wave == 0 && lane == 0) ? ctl + 2120 : (gu32*)nullptr, P, cache_k, cache_v, attn_norm_w, MIXIN, lane);
            }
#ifdef PROBE_T
            if (lane == 0) __hip_atomic_fetch_max(ctl + 2114, (unsigned)(__builtin_amdgcn_s_memrealtime() - pt0), RLX_AGENT);
#endif
        }
        if (BOTH(3)) GRID_BAR();
#ifdef PROBE_T
        if (bx == 0 && tid == 0) { const unsigned d = __hip_atomic_load(ctl + 2111 + PROBE_T, RLX_AGENT); const unsigned long long t1 = __builtin_amdgcn_s_memrealtime(); while (__builtin_amdgcn_s_memrealtime() - t1 < d) __builtin_amdgcn_s_sleep(4); }
#endif
    }

    STAMP(3);
    if (IN(4)) { phase_gdn_finish(P, MIXIN, gdn_norm_w, gw, NGW, lane); if (BOTH(4)) GRID_BAR(); }

    STAMP(4);
    if (IN(5)) {
        { pg8::Gemm g{MIXIN, Wout_t, MP, D, D, D}; pg8::StaticOrder S; S.init(MP, D, G, bx);
          pg8::EpiBf16<0> E{MIXB, D, nullptr, 0, 0, 1.f};
          pg8::gemm_phase<pg8::EpiBf16<0>, pg8::StaticOrder, true, true>(lds, g, S, E); }
        { pg8::Gemm g{MIXIN, Wout_t, M, D, 256, D}; pg8::SplitOrder S; S.init(MP / 256, MS / 256, D / 256, 4, bx);
          pg8::EpiF32 E{SLAB1 - (size_t)MP * D, D, (size_t)MS * D};
          pg8::gemm_phase<pg8::EpiF32, pg8::SplitOrder, true, true>(lds, g, S, E); }
        if (BOTH(5)) GRID_BAR();
    }

    STAMP(5);
    if (IN(6)) { phase_rows1(x_prompt, x_sample, MIXB, SLAB1, 4, norm_mix_post, norm_ffn_pre, X1B, U, gw, NGW, lane); if (BOTH(6)) GRID_BAR(); }

    STAMP(6);
    if (IN(7)) {
        pg8::Gemm g{U, Wgu_t, M, 2 * FF, D, D}; pg8::StaticOrder S; S.init(M, 2 * FF, G, bx);
        pg8::EpiGlu E{UP, FF, ffn_conv_w, ffn_conv_b, SBUF, out + O_FCP, out + O_FCS, MP, (pg8::PG8_LAS_F*)(lds + 131072)};
        pg8::gemm_phase<pg8::EpiGlu, pg8::StaticOrder, true, true>(lds, g, S, E);
        if (BOTH(7)) GRID_BAR();
    }

    STAMP(7);
    if (IN(8)) { phase_h_fixup(SBUF, UP, state_ffn, ffn_conv_w, ffn_conv_b, gtid, nth); if (BOTH(8)) GRID_BAR(); }

    STAMP(8);
    if (IN(9)) {
        { pg8::Gemm g{UP, Wdn_t, MP, D, FF, FF}; pg8::StaticOrder S; S.init(MP, D, G, bx);
          pg8::EpiBf16<0> E{DOWNB, D, nullptr, 0, 0, 1.f};
          pg8::gemm_phase<pg8::EpiBf16<0>, pg8::StaticOrder, true, true>(lds, g, S, E); }
        { pg8::Gemm g{UP, Wdn_t, M, D, 256, FF}; pg8::SplitOrder S; S.init(MP / 256, MS / 256, D / 256, 11, bx);
          pg8::EpiF32 E{SLAB2 - (size_t)MP * D, D, (size_t)MS * D};
          pg8::gemm_phase<pg8::EpiF32, pg8::SplitOrder, true, true>(lds, g, S, E); }
        if (BOTH(9)) GRID_BAR();
    }

    STAMP(9);
    if (IN(10)) phase_rows2(DOWNB, SLAB2, 11, norm_ffn_post, X1B, out, gw, NGW, lane);
    STAMP(10);
#ifdef PROBE_PH
    if (bx == 0 && tid == 0) { const unsigned long long t1 = __builtin_amdgcn_s_memrealtime(); while (__builtin_amdgcn_s_memrealtime() - t1 < ph_dur) __builtin_amdgcn_s_sleep(4); }
#endif
#undef IN
#undef BOTH
#undef GRID_BAR
}

extern "C" void kernel_launch(void* const* d_in, const int* in_sizes, int n_in, void* d_out, int out_size, void* d_ws, size_t ws_size, hipStream_t stream) {
    static int grid = 0;
    if (grid == 0) {
        if (n_in != 23 || out_size != 23699456 || ws_size < WS_END) { fprintf(stderr, "kernel_launch: unexpected shapes (n_in %d, out %d, ws %zu); nothing launched\n", n_in, out_size, ws_size); grid = -1; return; }
        int dev = 0, cus = 0, per_cu = 0;
        if (hipGetDevice(&dev) != hipSuccess || hipDeviceGetAttribute(&cus, hipDeviceAttributeMultiprocessorCount, dev) != hipSuccess) { grid = -1; return; }
        if (hipFuncSetAttribute((const void*)hybrid_fwd, hipFuncAttributeMaxDynamicSharedMemorySize, LDS_BYTES) != hipSuccess) { fprintf(stderr, "kernel_launch: hipFuncSetAttribute failed\n"); grid = -1; return; }
        if (hipOccupancyMaxActiveBlocksPerMultiprocessor(&per_cu, (const void*)hybrid_fwd, NWAVES * 64, LDS_BYTES) != hipSuccess || per_cu < 1) fprintf(stderr, "kernel_launch: occupancy query reports %d\n", per_cu);
        (void)hipGetLastError();
        grid = cus;
    }
    if (grid < 0) return;
    if (hipMemsetAsync((char*)d_ws + WS_CTL, 0, CTL_ZERO_BYTES, stream) != hipSuccess) { fprintf(stderr, "kernel_launch: memset failed\n"); return; }
    Args a{};
    for (int i = 0; i < 23; ++i) a.in[i] = (const float*)d_in[i];
    a.out = (float*)d_out; a.ws = (unsigned char*)d_ws;
    if (N_LAUNCHES == 1) { a.ph_lo = 0; a.ph_hi = NPH; a.li = 0; hipLaunchKernelGGL(hybrid_fwd, dim3(grid), dim3(NWAVES * 64), LDS_BYTES, stream, a); }
    else for (int li = 0; li < NPH; ++li) { a.ph_lo = li; a.ph_hi = li + 1; a.li = li; hipLaunchKernelGGL(hybrid_fwd, dim3(grid), dim3(NWAVES * 64), LDS_BYTES, stream, a);
#ifdef PROBE_DUP
        if (li == PROBE_DUP) hipLaunchKernelGGL(hybrid_fwd, dim3(grid), dim3(NWAVES * 64), LDS_BYTES, stream, a);
#endif
    }
    const hipError_t le = hipPeekAtLastError();
    if (le != hipSuccess) fprintf(stderr, "kernel_launch: launch failed: %s\n", hipGetErrorName(le));
}
```
